# Optimizing an MI355X kernel written in HIP

```python
import math
import jax, jax.numpy as jnp
from jax import lax
import numpy as np

D_MODEL = 1024
BATCH = 8
SEQ = 2048
DEPTH = 1

MEM_LEN = 256
HG_HEADS = 4
HG_DIM = 128
HG_WIDTH = HG_HEADS * HG_DIM
HG_CHUNK = 64
DA_HEADS = 4
DA_QK_DIM = 64
DA_V_DIM = 2 * DA_QK_DIM
DA_QK_WIDTH = DA_HEADS * 2 * DA_QK_DIM
DA_WIDTH = DA_HEADS * DA_V_DIM
ROPE_DIM = DA_QK_DIM // 4
ROPE_THETA = 500000.0
Q_BLOCK = 128
MIX_WIDTH = HG_WIDTH + DA_WIDTH
XA_HEADS = 4
XA_DIM = D_MODEL // XA_HEADS
N_EXPERTS = 16
EC_FACTOR = 2
D_FF_EXPERT = 2 * D_MODEL
LN_EPS = 1e-5
RMS_EPS = 1e-6
DEEPNORM_ALPHA = (2.0 * DEPTH) ** 0.25
DEEPNORM_BETA = (8.0 * DEPTH) ** -0.25
IN_SIZES = (HG_WIDTH, HG_WIDTH, HG_WIDTH, HG_WIDTH, HG_WIDTH, DA_QK_WIDTH, DA_QK_WIDTH, DA_WIDTH)
IN_COLS = sum(IN_SIZES)
IN_OFFSETS = tuple(sum(IN_SIZES[:i + 1]) for i in range(len(IN_SIZES) - 1))

kernel_name = 'hybrid_hgrn2_diffattn_ecmoe_encoder'


def layer_norm(x, g, b):
    xf = x.astype(jnp.float32)
    mu = jnp.mean(xf, axis=-1, keepdims=True)
    var = jnp.mean(jnp.square(xf - mu), axis=-1, keepdims=True)
    y = (xf - mu) * lax.rsqrt(var + LN_EPS) * g.astype(jnp.float32) + b.astype(jnp.float32)
    return y.astype(x.dtype)


def rms_norm(x, g):
    xf = x.astype(jnp.float32)
    y = xf * lax.rsqrt(jnp.mean(jnp.square(xf), axis=-1, keepdims=True) + RMS_EPS) * g.astype(jnp.float32)
    return y.astype(x.dtype)


def rope_tables(seq_len):
    inv = 1.0 / (ROPE_THETA ** (jnp.arange(0, ROPE_DIM, 2, dtype=jnp.float32) / ROPE_DIM))
    ang = jnp.arange(seq_len, dtype=jnp.float32)[:, None] * inv[None, :]
    return jnp.cos(ang), jnp.sin(ang)


def apply_partial_rope(t, cos, sin):
    rot, rest = t[..., :ROPE_DIM], t[..., ROPE_DIM:]
    r1, r2 = rot[..., :ROPE_DIM // 2], rot[..., ROPE_DIM // 2:]
    c = cos.astype(t.dtype)
    s = sin.astype(t.dtype)
    return jnp.concatenate([r1 * c - r2 * s, r2 * c + r1 * s, rest], axis=-1)


def gla_chunkwise(q, k, v, log_f):
    out_dtype = v.dtype
    B, H, L, dk = q.shape
    dv = v.shape[-1]
    n = L // HG_CHUNK
    rs = lambda t: t.astype(jnp.float32).reshape(B, H, n, HG_CHUNK, t.shape[-1])
    q, k, v, log_f = rs(q), rs(k), rs(v), rs(log_f)
    bcum = jnp.cumsum(log_f, axis=3)
    b_last = bcum[:, :, :, -1:, :]
    q_in = q * jnp.exp(bcum)
    k_in = k * jnp.exp(-bcum)
    k_out = k * jnp.exp(b_last - bcum)
    mask = jnp.tril(jnp.ones((HG_CHUNK, HG_CHUNK), dtype=bool))
    att = jnp.where(mask, jnp.einsum('bhnck,bhnsk->bhncs', q_in, k_in), 0.0)
    o_intra = jnp.einsum('bhncs,bhnsv->bhncv', att, v)
    delta = jnp.einsum('bhnck,bhncv->nbhkv', k_out, v)
    decay = jnp.moveaxis(jnp.exp(b_last[:, :, :, 0, :]), 2, 0)

    def step(S, inp):
        d, dl = inp
        return d[..., None] * S + dl, S

    S0 = jnp.zeros((B, H, dk, dv), jnp.float32)
    _, S_prev = lax.scan(step, S0, (decay, delta))
    o_inter = jnp.einsum('bhnck,nbhkv->bhncv', q_in, S_prev)
    return (o_intra + o_inter).reshape(B, H, L, dv).astype(out_dtype)


def hgrn2_group(u_q, u_i, u_g, u_ff, u_fb, lb_fwd, lb_bwd, norm_g):
    B, L, _ = u_q.shape
    heads = lambda t: t.reshape(B, L, HG_HEADS, HG_DIM).transpose(0, 2, 1, 3)
    q = heads(jax.nn.silu(u_q))
    v = heads(u_i)

    def gates(u_f, lb):
        f = lb + (1.0 - lb) * jax.nn.sigmoid(u_f.astype(jnp.float32))
        return heads((1.0 - f).astype(u_f.dtype)), heads(jnp.log(f))

    k_f, lf_f = gates(u_ff, lb_fwd)
    k_b, lf_b = gates(u_fb, lb_bwd)
    flip = lambda t: jnp.flip(t, axis=2)
    o_f = gla_chunkwise(q, k_f, v, lf_f)
    o_b = flip(gla_chunkwise(flip(q), flip(k_b), flip(v), flip(lf_b)))
    o = (o_f + o_b).transpose(0, 2, 1, 3)
    o = rms_norm(o, norm_g.reshape(HG_HEADS, HG_DIM))
    return o.reshape(B, L, HG_WIDTH) * jax.nn.silu(u_g)


def diff_attention_group(u_q, u_k, u_v, lam, lambda_init, subln_g, cos, sin):
    B, L, _ = u_q.shape
    q = u_q.reshape(B, L, 2 * DA_HEADS, DA_QK_DIM).transpose(0, 2, 1, 3)
    k = u_k.reshape(B, L, 2 * DA_HEADS, DA_QK_DIM).transpose(0, 2, 1, 3)
    v = u_v.reshape(B, L, DA_HEADS, DA_V_DIM).transpose(0, 2, 1, 3)
    q = apply_partial_rope(q, cos, sin) * (DA_QK_DIM ** -0.5)
    k = apply_partial_rope(k, cos, sin)
    nb = L // Q_BLOCK
    qb = jnp.moveaxis(q.reshape(B, 2 * DA_HEADS, nb, Q_BLOCK, DA_QK_DIM), 2, 0)

    def block(q_blk):
        s = jnp.einsum('bgqd,bgkd->bgqk', q_blk, k).astype(jnp.float32)
        p = jax.nn.softmax(s, axis=-1).reshape(B, DA_HEADS, 2, Q_BLOCK, L)
        a = (p[:, :, 0] - lam * p[:, :, 1]).astype(v.dtype)
        return jnp.einsum('bhqk,bhkv->bhqv', a, v)

    o = lax.map(block, qb)
    o = jnp.moveaxis(o, 0, 2).reshape(B, DA_HEADS, L, DA_V_DIM)
    o = rms_norm(o, subln_g) * (1.0 - lambda_init)
    return o.transpose(0, 2, 1, 3).reshape(B, L, DA_WIDTH)


def memory_cross_attention(h, mem, wq, wk, wv, wo):
    B, L, _ = h.shape
    M = mem.shape[1]
    q = jnp.einsum('bld,de->ble', h, wq).reshape(B, L, XA_HEADS, XA_DIM)
    k = jnp.einsum('bmd,de->bme', mem, wk).reshape(B, M, XA_HEADS, XA_DIM)
    v = jnp.einsum('bmd,de->bme', mem, wv).reshape(B, M, XA_HEADS, XA_DIM)
    s = jnp.einsum('blhd,bmhd->bhlm', q, k).astype(jnp.float32) * (XA_DIM ** -0.5)
    p = jax.nn.softmax(s, axis=-1).astype(v.dtype)
    o = jnp.einsum('bhlm,bmhd->blhd', p, v).reshape(B, L, D_MODEL)
    return jnp.einsum('bld,de->ble', o, wo)


def expert_choice_moe(h, w_router, w_gate, w_up, w_down):
    B, L, D = h.shape
    cap = EC_FACTOR * L // N_EXPERTS
    aff = jax.nn.softmax(jnp.einsum('bld,de->ble', h, w_router).astype(jnp.float32), axis=-1)
    gates, idx = lax.top_k(jnp.swapaxes(aff, 1, 2), cap)
    xs = jax.vmap(lambda hb, ib: hb[ib])(h, idx)
    a = jax.nn.silu(jnp.einsum('becd,edf->becf', xs, w_gate)) * jnp.einsum('becd,edf->becf', xs, w_up)
    y = jnp.einsum('becf,efd->becd', a, w_down) * gates[..., None].astype(h.dtype)
    return jax.vmap(lambda ib, yb: jnp.zeros((L, D), yb.dtype).at[ib.reshape(-1)].add(yb.reshape(-1, D)))(idx, y)


def setup_inputs(seed: int = 0) -> dict:
    key = jax.random.key(seed)
    ks = jax.random.split(key, 32)
    f32 = jnp.float32
    nrm = lambda k, shape, scale: jax.random.normal(k, shape, f32) * scale
    gain = lambda k, shape: 1.0 + 0.02 * jax.random.normal(k, shape, f32)
    return {
        'x': nrm(ks[0], (BATCH, SEQ, D_MODEL), 1.0),
        'mem': nrm(ks[1], (BATCH, MEM_LEN, D_MODEL), 1.0),
        'emb_ln_g': gain(ks[2], (D_MODEL,)),
        'emb_ln_b': nrm(ks[3], (D_MODEL,), 0.02),
        'w_in': nrm(ks[4], (DEPTH, D_MODEL, IN_COLS), D_MODEL ** -0.5),
        'hg_lb_logits': nrm(ks[5], (2, DEPTH + 1, HG_WIDTH), 0.1),
        'hg_norm_g': gain(ks[6], (DEPTH, HG_WIDTH)),
        'da_lambda_q1': nrm(ks[7], (DEPTH, DA_QK_DIM), 0.1),
        'da_lambda_k1': nrm(ks[8], (DEPTH, DA_QK_DIM), 0.1),
        'da_lambda_q2': nrm(ks[9], (DEPTH, DA_QK_DIM), 0.1),
        'da_lambda_k2': nrm(ks[10], (DEPTH, DA_QK_DIM), 0.1),
        'da_subln_g': gain(ks[11], (DEPTH, DA_V_DIM)),
        'w_mix_out': nrm(ks[12], (DEPTH, MIX_WIDTH, D_MODEL), MIX_WIDTH ** -0.5 * DEEPNORM_BETA),
        'ln1_g': gain(ks[13], (DEPTH, D_MODEL)),
        'ln1_b': nrm(ks[14], (DEPTH, D_MODEL), 0.02),
        'xa_wq': nrm(ks[15], (DEPTH, D_MODEL, D_MODEL), D_MODEL ** -0.5),
        'xa_wk': nrm(ks[16], (DEPTH, D_MODEL, D_MODEL), D_MODEL ** -0.5),
        'xa_wv': nrm(ks[17], (DEPTH, D_MODEL, D_MODEL), D_MODEL ** -0.5),
        'xa_wo': nrm(ks[18], (DEPTH, D_MODEL, D_MODEL), D_MODEL ** -0.5 * DEEPNORM_BETA),
        'ln2_g': gain(ks[19], (DEPTH, D_MODEL)),
        'ln2_b': nrm(ks[20], (DEPTH, D_MODEL), 0.02),
        'w_router': nrm(ks[21], (DEPTH, D_MODEL, N_EXPERTS), D_MODEL ** -0.5),
        'w_gate': nrm(ks[22], (DEPTH, N_EXPERTS, D_MODEL, D_FF_EXPERT), D_MODEL ** -0.5),
        'w_up': nrm(ks[23], (DEPTH, N_EXPERTS, D_MODEL, D_FF_EXPERT), D_MODEL ** -0.5),
        'w_down': nrm(ks[24], (DEPTH, N_EXPERTS, D_FF_EXPERT, D_MODEL), D_FF_EXPERT ** -0.5 * DEEPNORM_BETA),
        'ln3_g': gain(ks[25], (DEPTH, D_MODEL)),
        'ln3_b': nrm(ks[26], (DEPTH, D_MODEL), 0.02),
    }


def reference(x, mem, emb_ln_g, emb_ln_b, w_in, hg_lb_logits, hg_norm_g, da_lambda_q1, da_lambda_k1,
              da_lambda_q2, da_lambda_k2, da_subln_g, w_mix_out, ln1_g, ln1_b, xa_wq, xa_wk, xa_wv, xa_wo,
              ln2_g, ln2_b, w_router, w_gate, w_up, w_down, ln3_g, ln3_b):
    L = x.shape[1]
    cos, sin = rope_tables(L)
    lb_all = jnp.cumsum(jax.nn.softmax(hg_lb_logits.astype(jnp.float32), axis=1), axis=1)
    h = layer_norm(x, emb_ln_g, emb_ln_b)
    for l in range(DEPTH):
        lambda_init = 0.8 - 0.6 * math.exp(-0.3 * l)
        u = jnp.einsum('bld,dc->blc', h, w_in[l])
        hq, hi, hgt, hff, hfb, dq, dk, dv = jnp.split(u, IN_OFFSETS, axis=-1)
        hg_out = hgrn2_group(hq, hi, hgt, hff, hfb, lb_all[0, l], lb_all[1, l], hg_norm_g[l])
        lam = (jnp.exp(jnp.sum(da_lambda_q1[l].astype(jnp.float32) * da_lambda_k1[l].astype(jnp.float32)))
               - jnp.exp(jnp.sum(da_lambda_q2[l].astype(jnp.float32) * da_lambda_k2[l].astype(jnp.float32)))
               + lambda_init)
        da_out = diff_attention_group(dq, dk, dv, lam, lambda_init, da_subln_g[l], cos, sin)
        mix = jnp.einsum('blc,cd->bld', jnp.concatenate([hg_out, da_out], axis=-1), w_mix_out[l])
        h = layer_norm(DEEPNORM_ALPHA * h + mix, ln1_g[l], ln1_b[l])
        xa = memory_cross_attention(h, mem, xa_wq[l], xa_wk[l], xa_wv[l], xa_wo[l])
        h = layer_norm(DEEPNORM_ALPHA * h + xa, ln2_g[l], ln2_b[l])
        moe = expert_choice_moe(h, w_router[l], w_gate[l], w_up[l], w_down[l])
        h = layer_norm(DEEPNORM_ALPHA * h + moe, ln3_g[l], ln3_b[l])
    return h
```

```cpp
#include <hip/hip_runtime.h>
#include <cstdint>
#include <cstdio>

typedef unsigned short bf16_t;

constexpr int BATCH = 8, SEQ = 2048, DM = 1024, NTOK = BATCH * SEQ;
constexpr int MEML = 256, NMEM = BATCH * MEML;
constexpr int NU = 4096;
constexpr int U_HQ = 0, U_HI = 512, U_HG = 1024, U_HFF = 1536, U_HFB = 2048, U_DQ = 2560, U_DK = 3072, U_DV = 3584;
constexpr int NEXP = 16, CAP = 256, DFF = 2048, NGRP = BATCH * NEXP;
constexpr float ALPHA = 1.189207115002721f;
constexpr float LN_EPS = 1e-5f, RMS_EPS = 1e-6f;
constexpr float LAMBDA_INIT = 0.2f;

constexpr size_t MiB = 1u << 20;
constexpr size_t WS_CTL = 0;
constexpr size_t WS_ROPE = 1 * MiB;
constexpr size_t WS_LB = WS_ROPE + 256 * 1024;
constexpr size_t WS_AFF = 2 * MiB;
constexpr size_t WS_INV = 3 * MiB;
constexpr size_t WS_IDX = 4 * MiB;
constexpr size_t WS_GATE = 4 * MiB + 512 * 1024;
constexpr size_t WS_WIN = 5 * MiB;
constexpr size_t WS_WKV = 13 * MiB;
constexpr size_t WS_WMIX = 17 * MiB;
constexpr size_t WS_WQ = 19 * MiB;
constexpr size_t WS_WO = 21 * MiB;
constexpr size_t WS_WGU = 23 * MiB;
constexpr size_t WS_WD = 151 * MiB;
constexpr size_t WS_U = 215 * MiB;
constexpr size_t WS_XN = 343 * MiB;
constexpr size_t WS_MIX = 375 * MiB;
constexpr size_t WS_KV = 407 * MiB;
constexpr size_t WS_XS = 415 * MiB;
constexpr size_t WS_MEMB = 479 * MiB;
constexpr size_t WS_END = 483 * MiB;

__device__ __forceinline__ unsigned f2bf(float f) { unsigned u = __builtin_bit_cast(unsigned, f); return (u + 0x7fffu + ((u >> 16) & 1u)) >> 16; }
__device__ __forceinline__ float bf2f(bf16_t b) { return __builtin_bit_cast(float, (unsigned)b << 16); }
__device__ __forceinline__ float wave_sum(float v) {
#pragma unroll
    for (int o = 1; o < 64; o <<= 1) v += __shfl_xor(v, o);
    return v;
}
__device__ __forceinline__ float silu_f(float x) { return x / (1.f + expf(-x)); }
__device__ __forceinline__ float sigmoid_f(float x) { return 1.f / (1.f + expf(-x)); }

__global__ void k_prep_small(const float* lb_logits, const float* lq1, const float* lk1, const float* lq2, const float* lk2, float* rope, float* lb) {
    int i = blockIdx.x * blockDim.x + threadIdx.x;
    if (i < SEQ * 8) {
        int t = i / 8, j = i % 8;
        float inv = (float)(1.0 / pow(500000.0, (double)j / 8.0));
        float ang = (float)t * inv;
        rope[t * 16 + j] = (float)cos((double)ang);
        rope[t * 16 + 8 + j] = (float)sin((double)ang);
    }
    if (i < 1024) {
        int d = i / 512, c = i % 512;
        float l0 = lb_logits[d * 1024 + c], l1 = lb_logits[d * 1024 + 512 + c];
        float m = fmaxf(l0, l1); float e0 = expf(l0 - m), e1 = expf(l1 - m);
        lb[i] = e0 / (e0 + e1);
    }
    if (i == 0) {
        float s1 = 0.f, s2 = 0.f;
        for (int k = 0; k < 64; ++k) { s1 += lq1[k] * lk1[k]; s2 += lq2[k] * lk2[k]; }
        lb[1024] = expf(s1) - expf(s2) + LAMBDA_INIT;
    }
}

__global__ void __launch_bounds__(256) k_transpose(const float* W, int K, int N, bf16_t* WT, int mode, long src_zs, long dst_zs) {
    __shared__ float t[32][33];
    W += (long)blockIdx.z * src_zs; WT += (long)blockIdx.z * dst_zs;
    int k0 = blockIdx.y * 32, n0 = blockIdx.x * 32, tx = threadIdx.x & 31, ty = threadIdx.x >> 5;
    for (int i = ty; i < 32; i += 8) t[i][tx] = W[(long)(k0 + i) * N + n0 + tx];
    __syncthreads();
    for (int i = ty; i < 32; i += 8) {
        int n = n0 + i; long r = n;
        if (mode == 1) r = (long)(n / 128) * 256 + (n % 128);
        if (mode == 2) r = (long)(n / 128) * 256 + 128 + (n % 128);
        WT[r * K + k0 + tx] = (bf16_t)f2bf(t[tx][i]);
    }
}
__global__ void k_cvt_bf16(const float* src, bf16_t* dst, long n) {
    long i = (long)blockIdx.x * blockDim.x + threadIdx.x;
    if (i < n) dst[i] = (bf16_t)f2bf(src[i]);
}

template <int MODE>
__global__ void __launch_bounds__(256) k_ln_rows(const float* X, const float* S, const float* g, const float* b, float* H, bf16_t* XN, const float* wr, float* AFF) {
    const int lane = threadIdx.x & 63, row = blockIdx.x * 4 + (threadIdx.x >> 6);
    float4 v[4]; float s = 0.f;
#pragma unroll
    for (int j = 0; j < 4; ++j) {
        const long off = (long)row * DM + 4 * lane + 256 * j;
        if (MODE == 0) v[j] = *(const float4*)(X + off);
        else { float4 h = *(const float4*)(H + off), a = *(const float4*)(S + off); v[j] = make_float4(ALPHA * h.x + a.x, ALPHA * h.y + a.y, ALPHA * h.z + a.z, ALPHA * h.w + a.w); }
        s += (v[j].x + v[j].y) + (v[j].z + v[j].w);
    }
    const float mean = wave_sum(s) * (1.f / DM); float s2 = 0.f;
#pragma unroll
    for (int j = 0; j < 4; ++j) { v[j].x -= mean; v[j].y -= mean; v[j].z -= mean; v[j].w -= mean; s2 += (v[j].x * v[j].x + v[j].y * v[j].y) + (v[j].z * v[j].z + v[j].w * v[j].w); }
    const float rstd = 1.f / sqrtf(wave_sum(s2) * (1.f / DM) + LN_EPS);
#pragma unroll
    for (int j = 0; j < 4; ++j) {
        const int c = 4 * lane + 256 * j; const float4 gg = *(const float4*)(g + c), bb = *(const float4*)(b + c);
        v[j].x = v[j].x * rstd * gg.x + bb.x; v[j].y = v[j].y * rstd * gg.y + bb.y; v[j].z = v[j].z * rstd * gg.z + bb.z; v[j].w = v[j].w * rstd * gg.w + bb.w;
        *(float4*)(H + (long)row * DM + c) = v[j];
        uint2 o; o.x = f2bf(v[j].x) | (f2bf(v[j].y) << 16); o.y = f2bf(v[j].z) | (f2bf(v[j].w) << 16);
        *(uint2*)(XN + (long)row * DM + c) = o;
    }
    if (MODE == 2) {
        float acc[16];
#pragma unroll
        for (int e = 0; e < 16; ++e) acc[e] = 0.f;
#pragma unroll
        for (int j = 0; j < 4; ++j) {
            const float vv[4] = {v[j].x, v[j].y, v[j].z, v[j].w};
#pragma unroll
            for (int i = 0; i < 4; ++i) {
                const float4* w4 = (const float4*)(wr + (long)(4 * lane + 256 * j + i) * 16);
#pragma unroll
                for (int q = 0; q < 4; ++q) { const float4 w = w4[q]; acc[4 * q] += vv[i] * w.x; acc[4 * q + 1] += vv[i] * w.y; acc[4 * q + 2] += vv[i] * w.z; acc[4 * q + 3] += vv[i] * w.w; }
            }
        }
        float m = -INFINITY;
#pragma unroll
        for (int e = 0; e < 16; ++e) { acc[e] = wave_sum(acc[e]); m = fmaxf(m, acc[e]); }
        float sum = 0.f, mine = 0.f;
#pragma unroll
        for (int e = 0; e < 16; ++e) { const float p = expf(acc[e] - m); sum += p; if (e == lane) mine = p; }
        if (lane < 16) AFF[(long)row * 16 + lane] = mine / sum;
    }
}

__global__ void __launch_bounds__(256) k_gemm_naive(const bf16_t* A, long sa_z, int lda, const bf16_t* B, long sb_z, long sbn, long sbk,
                                                    float* C, long sc_z, int ldc, int K) {
    __shared__ float As[16][65], Bs[16][65];
    A += (long)blockIdx.z * sa_z; B += (long)blockIdx.z * sb_z; C += (long)blockIdx.z * sc_z;
    const int m0 = blockIdx.y * 64, n0 = blockIdx.x * 64, tx = threadIdx.x & 15, ty = threadIdx.x >> 4;
    float acc[4][4];
#pragma unroll
    for (int i = 0; i < 4; ++i)
#pragma unroll
        for (int j = 0; j < 4; ++j) acc[i][j] = 0.f;
    for (int k0 = 0; k0 < K; k0 += 16) {
        for (int i = threadIdx.x; i < 1024; i += 256) { const int m = i >> 4, k = i & 15; As[k][m] = bf2f(A[(long)(m0 + m) * lda + k0 + k]); }
        for (int i = threadIdx.x; i < 1024; i += 256) { const int n = i >> 4, k = i & 15; Bs[k][n] = bf2f(B[(long)(n0 + n) * sbn + (long)(k0 + k) * sbk]); }
        __syncthreads();
#pragma unroll
        for (int k = 0; k < 16; ++k) {
            float a[4], bb[4];
#pragma unroll
            for (int i = 0; i < 4; ++i) { a[i] = As[k][ty * 4 + i]; bb[i] = Bs[k][tx * 4 + i]; }
#pragma unroll
            for (int i = 0; i < 4; ++i)
#pragma unroll
                for (int j = 0; j < 4; ++j) acc[i][j] += a[i] * bb[j];
        }
        __syncthreads();
    }
#pragma unroll
    for (int i = 0; i < 4; ++i)
#pragma unroll
        for (int j = 0; j < 4; ++j) C[(long)(m0 + ty * 4 + i) * ldc + n0 + tx * 4 + j] = acc[i][j];
}

__global__ void k_transform(const float* SC, int lds_, bf16_t* dst, int ldd, int rows, int cols, int op, const float* rope, float scale) {
    long i = (long)blockIdx.x * blockDim.x + threadIdx.x;
    if (i >= (long)rows * cols) return;
    const int r = (int)(i / cols), c = (int)(i % cols);
    float v = SC[(long)r * lds_ + c];
    if (op == 1) v = silu_f(v);
    else if (op == 2 || op == 3) {
        const int d = c & 63, t = r % SEQ;
        if (d < 8) { const float v2 = SC[(long)r * lds_ + c + 8]; v = v * rope[t * 16 + d] - v2 * rope[t * 16 + 8 + d]; }
        else if (d < 16) { const float v1 = SC[(long)r * lds_ + c - 8]; v = v * rope[t * 16 + d - 8] + v1 * rope[t * 16 + 8 + d - 8]; }
        if (op == 2) v *= 0.125f;
    } else if (op == 4) v *= scale;
    dst[(long)r * ldd + c] = (bf16_t)f2bf(v);
}

__global__ void __launch_bounds__(128) k_hgrn_naive(const bf16_t* U, const float* LB, float* OSC) {
    __shared__ float red[2][16];
    const int dvs = blockIdx.x, h = blockIdx.y, b = blockIdx.z >> 1, dir = blockIdx.z & 1, k = threadIdx.x;
    float S[16];
#pragma unroll
    for (int j = 0; j < 16; ++j) S[j] = 0.f;
    const float lbv = LB[dir * 512 + h * 128 + k];
    for (int step = 0; step < SEQ; ++step) {
        const int t = dir ? (SEQ - 1 - step) : step; const long row = (long)b * SEQ + t;
        const bf16_t* ur = U + row * NU;
        const float qv = bf2f(ur[U_HQ + h * 128 + k]);
        const float uf = bf2f(ur[(dir ? U_HFB : U_HFF) + h * 128 + k]);
        const float f = lbv + (1.f - lbv) * sigmoid_f(uf), kk = 1.f - f;
        float part[16];
#pragma unroll
        for (int j = 0; j < 16; ++j) { const float vv = bf2f(ur[U_HI + h * 128 + dvs * 16 + j]); S[j] = f * S[j] + kk * vv; part[j] = wave_sum(S[j] * qv); }
        if ((k & 63) == 0) {
#pragma unroll
            for (int j = 0; j < 16; ++j) red[k >> 6][j] = part[j];
        }
        __syncthreads();
        if (k < 16) OSC[((long)dir * NTOK + row) * 512 + h * 128 + dvs * 16 + k] = red[0][k] + red[1][k];
        __syncthreads();
    }
}
__global__ void __launch_bounds__(256) k_hgrn_combine(const float* OSC, const bf16_t* U, const float* ng, bf16_t* MIX) {
    const int lane = threadIdx.x & 63; const long w = (long)blockIdx.x * 4 + (threadIdx.x >> 6); const long row = w >> 2; const int h = (int)(w & 3);
    float o[2]; float ss = 0.f;
#pragma unroll
    for (int i = 0; i < 2; ++i) { const int d = lane + 64 * i; o[i] = OSC[row * 512 + h * 128 + d] + OSC[((long)NTOK + row) * 512 + h * 128 + d]; ss += o[i] * o[i]; }
    const float r = 1.f / sqrtf(wave_sum(ss) * (1.f / 128.f) + RMS_EPS);
#pragma unroll
    for (int i = 0; i < 2; ++i) { const int d = lane + 64 * i; const float y = o[i] * r * ng[h * 128 + d] * bf2f(U[row * NU + U_HG + h * 128 + d]); MIX[row * DM + h * 128 + d] = (bf16_t)f2bf(y); }
}

__global__ void __launch_bounds__(256) k_dattn_naive(const bf16_t* U, float* OSC) {
    __shared__ float Ks[32][64]; __shared__ float Vs[32][128];
    const int qb = blockIdx.x, g = blockIdx.y, b = blockIdx.z, h = g >> 1, r = threadIdx.x & 127, half = threadIdx.x >> 7;
    const long row = (long)b * SEQ + qb * 128 + r;
    float q[64], o[64];
#pragma unroll
    for (int d = 0; d < 64; ++d) { q[d] = bf2f(U[row * NU + U_DQ + g * 64 + d]); o[d] = 0.f; }
    float m = -INFINITY, l = 0.f;
    for (int k0 = 0; k0 < SEQ; k0 += 32) {
        for (int i = threadIdx.x; i < 32 * 64; i += 256) { const int kk = i >> 6, d = i & 63; Ks[kk][d] = bf2f(U[((long)b * SEQ + k0 + kk) * NU + U_DK + g * 64 + d]); }
        for (int i = threadIdx.x; i < 32 * 128; i += 256) { const int kk = i >> 7, d = i & 127; Vs[kk][d] = bf2f(U[((long)b * SEQ + k0 + kk) * NU + U_DV + h * 128 + d]); }
        __syncthreads();
        float s[32]; float tm = m;
#pragma unroll
        for (int kk = 0; kk < 32; ++kk) { float a = 0.f;
#pragma unroll
            for (int d = 0; d < 64; ++d) a += q[d] * Ks[kk][d];
            s[kk] = a; tm = fmaxf(tm, a); }
        const float corr = expf(m - tm); m = tm; l *= corr;
#pragma unroll
        for (int d = 0; d < 64; ++d) o[d] *= corr;
#pragma unroll
        for (int kk = 0; kk < 32; ++kk) { const float p = expf(s[kk] - m); l += p;
#pragma unroll
            for (int d = 0; d < 64; ++d) o[d] += p * Vs[kk][half * 64 + d]; }
        __syncthreads();
    }
    const float il = 1.f / l;
#pragma unroll
    for (int d = 0; d < 64; ++d) OSC[(row * 8 + g) * 128 + half * 64 + d] = o[d] * il;
}
__global__ void __launch_bounds__(256) k_dattn_combine(const float* OSC, const float* lamp, const float* sg, bf16_t* MIX) {
    const int lane = threadIdx.x & 63; const long w = (long)blockIdx.x * 4 + (threadIdx.x >> 6); const long row = w >> 2; const int h = (int)(w & 3);
    const float lam = lamp[0]; float o[2]; float ss = 0.f;
#pragma unroll
    for (int i = 0; i < 2; ++i) { const int d = lane + 64 * i; o[i] = OSC[(row * 8 + 2 * h) * 128 + d] - lam * OSC[(row * 8 + 2 * h + 1) * 128 + d]; ss += o[i] * o[i]; }
    const float r = 1.f / sqrtf(wave_sum(ss) * (1.f / 128.f) + RMS_EPS);
#pragma unroll
    for (int i = 0; i < 2; ++i) { const int d = lane + 64 * i; MIX[row * DM + 512 + h * 128 + d] = (bf16_t)f2bf(o[i] * r * sg[d] * (1.f - LAMBDA_INIT)); }
}

__global__ void __launch_bounds__(256) k_softmax256(const float* S, bf16_t* P, float scale) {
    const int lane = threadIdx.x & 63; const long row = (long)blockIdx.x * 4 + (threadIdx.x >> 6);
    float4 v = *(const float4*)(S + row * 256 + 4 * lane);
    v.x *= scale; v.y *= scale; v.z *= scale; v.w *= scale;
    float m = fmaxf(fmaxf(v.x, v.y), fmaxf(v.z, v.w));
#pragma unroll
    for (int o = 1; o < 64; o <<= 1) m = fmaxf(m, __shfl_xor(m, o));
    v.x = expf(v.x - m); v.y = expf(v.y - m); v.z = expf(v.z - m); v.w = expf(v.w - m);
    const float il = 1.f / wave_sum((v.x + v.y) + (v.z + v.w));
    uint2 o; o.x = f2bf(v.x * il) | (f2bf(v.y * il) << 16); o.y = f2bf(v.z * il) | (f2bf(v.w * il) << 16);
    *(uint2*)(P + row * 256 + 4 * lane) = o;
}

__global__ void __launch_bounds__(256) k_topk_gather(const float* AFF, const bf16_t* XN, int* IDX, float* GATE, int* INV, bf16_t* XS) {
    __shared__ float a[SEQ]; __shared__ int sel[CAP];
    const int grp = blockIdx.x, b = grp >> 4, e = grp & 15, tid = threadIdx.x;
    for (int t = tid; t < SEQ; t += 256) a[t] = AFF[((long)b * SEQ + t) * 16 + e];
    __syncthreads();
    for (int t = tid; t < SEQ; t += 256) {
        const float mine = a[t]; int rank = 0;
        for (int u = 0; u < SEQ; ++u) { const float x = a[u]; rank += (x > mine || (x == mine && u < t)) ? 1 : 0; }
        if (rank < CAP) { sel[rank] = t; IDX[grp * CAP + rank] = t; GATE[grp * CAP + rank] = mine; INV[((long)b * SEQ + t) * 16 + e] = rank; }
        else INV[((long)b * SEQ + t) * 16 + e] = -1;
    }
    __syncthreads();
    const int lane = tid & 63, wv = tid >> 6;
    for (int r = wv; r < CAP; r += 4) {
        const uint4* src = (const uint4*)(XN + ((long)b * SEQ + sel[r]) * DM); uint4* dst = (uint4*)(XS + ((long)grp * CAP + r) * DM);
        dst[lane] = src[lane]; dst[lane + 64] = src[lane + 64];
    }
}

__global__ void k_swiglu(const float* SC, int ldsc, bf16_t* ACT, int ldact, int rows, int cols_out) {
    long i = (long)blockIdx.x * blockDim.x + threadIdx.x;
    if (i >= (long)rows * cols_out) return;
    const int r = (int)(i / cols_out), c = (int)(i % cols_out), jt = c >> 7, cc = c & 127;
    const float gt = SC[(long)r * ldsc + jt * 256 + cc], up = SC[(long)r * ldsc + jt * 256 + 128 + cc];
    ACT[(long)r * ldact + c] = (bf16_t)f2bf(silu_f(gt) * up);
}
__global__ void k_ygate(const float* SC, const float* GATE, bf16_t* Y, int rows) {
    long i = (long)blockIdx.x * blockDim.x + threadIdx.x;
    if (i >= (long)rows * DM) return;
    const int r = (int)(i / DM);
    Y[i] = (bf16_t)f2bf(SC[i] * GATE[r]);
}

__global__ void __launch_bounds__(256) k_final(float* H, const bf16_t* Y, const int* INV, const float* g, const float* b) {
    const int lane = threadIdx.x & 63; const long row = (long)blockIdx.x * 4 + (threadIdx.x >> 6); const int bt = (int)(row / SEQ);
    float4 v[4];
#pragma unroll
    for (int j = 0; j < 4; ++j) { const float4 h = *(const float4*)(H + row * DM + 4 * lane + 256 * j); v[j] = make_float4(ALPHA * h.x, ALPHA * h.y, ALPHA * h.z, ALPHA * h.w); }
    for (int e = 0; e < 16; ++e) {
        const int slot = INV[row * 16 + e];
        if (slot >= 0) {
            const bf16_t* yr = Y + ((long)(bt * 16 + e) * CAP + slot) * DM;
#pragma unroll
            for (int j = 0; j < 4; ++j) { const uint2 p = *(const uint2*)(yr + 4 * lane + 256 * j);
                v[j].x += bf2f((bf16_t)(p.x & 0xffff)); v[j].y += bf2f((bf16_t)(p.x >> 16)); v[j].z += bf2f((bf16_t)(p.y & 0xffff)); v[j].w += bf2f((bf16_t)(p.y >> 16)); }
        }
    }
    float s = 0.f;
#pragma unroll
    for (int j = 0; j < 4; ++j) s += (v[j].x + v[j].y) + (v[j].z + v[j].w);
    const float mean = wave_sum(s) * (1.f / DM); float s2 = 0.f;
#pragma unroll
    for (int j = 0; j < 4; ++j) { v[j].x -= mean; v[j].y -= mean; v[j].z -= mean; v[j].w -= mean; s2 += (v[j].x * v[j].x + v[j].y * v[j].y) + (v[j].z * v[j].z + v[j].w * v[j].w); }
    const float rstd = 1.f / sqrtf(wave_sum(s2) * (1.f / DM) + LN_EPS);
#pragma unroll
    for (int j = 0; j < 4; ++j) {
        const int c = 4 * lane + 256 * j; const float4 gg = *(const float4*)(g + c), bb = *(const float4*)(b + c);
        float4 o; o.x = v[j].x * rstd * gg.x + bb.x; o.y = v[j].y * rstd * gg.y + bb.y; o.z = v[j].z * rstd * gg.z + bb.z; o.w = v[j].w * rstd * gg.w + bb.w;
        *(float4*)(H + row * DM + c) = o;
    }
}

static void gemm_naive(hipStream_t st, const bf16_t* A, long sa_z, int lda, const bf16_t* B, long sb_z, long sbn, long sbk, float* C, long sc_z, int ldc, int M, int N, int K, int Z) {
    k_gemm_naive<<<dim3(N / 64, M / 64, Z), 256, 0, st>>>(A, sa_z, lda, B, sb_z, sbn, sbk, C, sc_z, ldc, K);
}
static void transform(hipStream_t st, const float* SC, int ldsc, bf16_t* dst, int ldd, int rows, int cols, int op, const float* rope, float scale) {
    long n = (long)rows * cols; k_transform<<<(unsigned)((n + 255) / 256), 256, 0, st>>>(SC, ldsc, dst, ldd, rows, cols, op, rope, scale);
}

extern "C" void kernel_launch(void* const* d_in, const int* in_sizes, int n_in, void* d_out, int out_size, void* d_ws, size_t ws_size, hipStream_t stream) {
    if (n_in != 27 || out_size != NTOK * DM || ws_size < WS_END) { fprintf(stderr, "kernel_launch: unexpected shapes (n_in %d out %d ws %zu)\n", n_in, out_size, ws_size); return; }
    const float* x = (const float*)d_in[0]; const float* mem = (const float*)d_in[1];
    const float* emb_g = (const float*)d_in[2]; const float* emb_b = (const float*)d_in[3];
    const float* w_in = (const float*)d_in[4]; const float* lb_logits = (const float*)d_in[5]; const float* hg_norm_g = (const float*)d_in[6];
    const float* lq1 = (const float*)d_in[7]; const float* lk1 = (const float*)d_in[8]; const float* lq2 = (const float*)d_in[9]; const float* lk2 = (const float*)d_in[10];
    const float* subln_g = (const float*)d_in[11]; const float* w_mix = (const float*)d_in[12];
    const float* ln1_g = (const float*)d_in[13]; const float* ln1_b = (const float*)d_in[14];
    const float* xa_wq = (const float*)d_in[15]; const float* xa_wk = (const float*)d_in[16]; const float* xa_wv = (const float*)d_in[17]; const float* xa_wo = (const float*)d_in[18];
    const float* ln2_g = (const float*)d_in[19]; const float* ln2_b = (const float*)d_in[20];
    const float* w_router = (const float*)d_in[21]; const float* w_gate = (const float*)d_in[22]; const float* w_up = (const float*)d_in[23]; const float* w_down = (const float*)d_in[24];
    const float* ln3_g = (const float*)d_in[25]; const float* ln3_b = (const float*)d_in[26];
    unsigned char* ws = (unsigned char*)d_ws;
    float* H = (float*)d_out;
    float* ROPE = (float*)(ws + WS_ROPE); float* LB = (float*)(ws + WS_LB); float* LAM = LB + 1024;
    float* AFF = (float*)(ws + WS_AFF); int* INV = (int*)(ws + WS_INV); int* IDX = (int*)(ws + WS_IDX); float* GATE = (float*)(ws + WS_GATE);
    bf16_t* WIN = (bf16_t*)(ws + WS_WIN); bf16_t* WKV = (bf16_t*)(ws + WS_WKV); bf16_t* WMIX = (bf16_t*)(ws + WS_WMIX); bf16_t* WQ = (bf16_t*)(ws + WS_WQ); bf16_t* WO = (bf16_t*)(ws + WS_WO);
    bf16_t* WGU = (bf16_t*)(ws + WS_WGU); bf16_t* WD = (bf16_t*)(ws + WS_WD);
    bf16_t* U = (bf16_t*)(ws + WS_U); bf16_t* ACT = U; bf16_t* XN = (bf16_t*)(ws + WS_XN); bf16_t* MIX = (bf16_t*)(ws + WS_MIX); bf16_t* Q = MIX; bf16_t* XO = MIX;
    bf16_t* KV = (bf16_t*)(ws + WS_KV); bf16_t* XS = (bf16_t*)(ws + WS_XS); bf16_t* Y = XS; bf16_t* MEMB = (bf16_t*)(ws + WS_MEMB);
    float* SC_XS = (float*)(ws + WS_XS);
    float* SC_MIX = (float*)(ws + WS_MIX);
    bf16_t* P = XN;

    k_prep_small<<<64, 256, 0, stream>>>(lb_logits, lq1, lk1, lq2, lk2, ROPE, LB);
    k_transpose<<<dim3(NU / 32, DM / 32, 1), 256, 0, stream>>>(w_in, DM, NU, WIN, 0, 0, 0);
    k_transpose<<<dim3(DM / 32, DM / 32, 1), 256, 0, stream>>>(xa_wk, DM, DM, WKV, 0, 0, 0);
    k_transpose<<<dim3(DM / 32, DM / 32, 1), 256, 0, stream>>>(xa_wv, DM, DM, WKV + (size_t)DM * DM, 0, 0, 0);
    k_transpose<<<dim3(DM / 32, DM / 32, 1), 256, 0, stream>>>(w_mix, DM, DM, WMIX, 0, 0, 0);
    k_transpose<<<dim3(DM / 32, DM / 32, 1), 256, 0, stream>>>(xa_wq, DM, DM, WQ, 0, 0, 0);
    k_transpose<<<dim3(DM / 32, DM / 32, 1), 256, 0, stream>>>(xa_wo, DM, DM, WO, 0, 0, 0);
    k_transpose<<<dim3(DFF / 32, DM / 32, NEXP), 256, 0, stream>>>(w_gate, DM, DFF, WGU, 1, (long)DM * DFF, (long)2 * DFF * DM);
    k_transpose<<<dim3(DFF / 32, DM / 32, NEXP), 256, 0, stream>>>(w_up, DM, DFF, WGU, 2, (long)DM * DFF, (long)2 * DFF * DM);
    k_transpose<<<dim3(DM / 32, DFF / 32, NEXP), 256, 0, stream>>>(w_down, DFF, DM, WD, 0, (long)DFF * DM, (long)DFF * DM);
    k_cvt_bf16<<<(NMEM * DM + 255) / 256, 256, 0, stream>>>(mem, MEMB, (long)NMEM * DM);
    k_ln_rows<0><<<NTOK / 4, 256, 0, stream>>>(x, nullptr, emb_g, emb_b, H, XN, nullptr, nullptr);

    static const int seg_op[8] = {1, 0, 1, 0, 0, 2, 3, 0};
    for (int s = 0; s < 8; ++s) {
        gemm_naive(stream, XN, 0, DM, WIN + (size_t)s * 512 * DM, 0, DM, 1, SC_XS, 0, 512, NTOK, 512, DM, 1);
        transform(stream, SC_XS, 512, U + s * 512, NU, NTOK, 512, seg_op[s], ROPE, 1.f);
    }
    gemm_naive(stream, MEMB, 0, DM, WKV, 0, DM, 1, SC_XS, 0, 2048, NMEM, 2048, DM, 1);
    transform(stream, SC_XS, 2048, KV, 2048, NMEM, 2048, 0, ROPE, 1.f);

    k_hgrn_naive<<<dim3(8, 4, 16), 128, 0, stream>>>(U, LB, SC_XS);
    k_hgrn_combine<<<NTOK, 256, 0, stream>>>(SC_XS, U, hg_norm_g, MIX);
    k_dattn_naive<<<dim3(16, 8, 8), 256, 0, stream>>>(U, SC_XS);
    k_dattn_combine<<<NTOK, 256, 0, stream>>>(SC_XS, LAM, subln_g, MIX);

    gemm_naive(stream, MIX, 0, DM, WMIX, 0, DM, 1, SC_XS, 0, DM, NTOK, DM, DM, 1);
    k_ln_rows<1><<<NTOK / 4, 256, 0, stream>>>(nullptr, SC_XS, ln1_g, ln1_b, H, XN, nullptr, nullptr);

    gemm_naive(stream, XN, 0, DM, WQ, 0, DM, 1, SC_XS, 0, DM, NTOK, DM, DM, 1);
    transform(stream, SC_XS, DM, Q, DM, NTOK, DM, 0, ROPE, 1.f);
    for (int b = 0; b < BATCH; ++b)
        gemm_naive(stream, Q + (size_t)b * SEQ * DM, 256, DM, KV + (size_t)b * MEML * 2048, 256, 2048, 1, SC_XS + (size_t)b * 4 * SEQ * 256, (long)SEQ * 256, 256, SEQ, 256, 256, 4);
    k_softmax256<<<BATCH * 4 * SEQ / 4, 256, 0, stream>>>(SC_XS, P, 0.0625f);
    for (int b = 0; b < BATCH; ++b)
        gemm_naive(stream, P + (size_t)b * 4 * SEQ * 256, (long)SEQ * 256, 256, KV + (size_t)b * MEML * 2048 + 1024, 256, 1, 2048, SC_XS + (size_t)b * SEQ * DM, 256, DM, SEQ, 256, 256, 4);
    transform(stream, SC_XS, DM, XO, DM, NTOK, DM, 0, ROPE, 1.f);
    gemm_naive(stream, XO, 0, DM, WO, 0, DM, 1, SC_XS, 0, DM, NTOK, DM, DM, 1);
    k_ln_rows<2><<<NTOK / 4, 256, 0, stream>>>(nullptr, SC_XS, ln2_g, ln2_b, H, XN, w_router, AFF);

    k_topk_gather<<<NGRP, 256, 0, stream>>>(AFF, XN, IDX, GATE, INV, XS);

    for (int b = 0; b < BATCH; ++b)
        for (int half = 0; half < 2; ++half) {
            gemm_naive(stream, XS + (size_t)b * 16 * CAP * DM, (long)CAP * DM, DM, WGU + (size_t)half * 2048 * DM, (long)4096 * DM, DM, 1, SC_MIX, (long)CAP * 2048, 2048, CAP, 2048, DM, NEXP);
            long n = (long)16 * CAP * 1024;
            k_swiglu<<<(unsigned)((n + 255) / 256), 256, 0, stream>>>(SC_MIX, 2048, ACT + (size_t)b * 16 * CAP * DFF + half * 1024, DFF, 16 * CAP, 1024);
        }
    for (int b = 0; b < BATCH; ++b) {
        gemm_naive(stream, ACT + (size_t)b * 16 * CAP * DFF, (long)CAP * DFF, DFF, WD, (long)DM * DFF, DFF, 1, SC_MIX, (long)CAP * DM, DM, CAP, DM, DFF, NEXP);
        long n = (long)16 * CAP * DM;
        k_ygate<<<(unsigned)((n + 255) / 256), 256, 0, stream>>>(SC_MIX, GATE + b * 16 * CAP, Y + (size_t)b * 16 * CAP * DM, 16 * CAP);
    }
    k_final<<<NTOK / 4, 256, 0, stream>>>(H, Y, INV, ln3_g, ln3_b);
}
```

```cpp
#include <hip/hip_runtime.h>
#include <cstdint>
#include <cstdio>

typedef unsigned short bf16_t;

constexpr int BATCH = 8, SEQ = 2048, DM = 1024, NTOK = BATCH * SEQ;
constexpr int MEML = 256, NMEM = BATCH * MEML;
constexpr int NU = 4096;
constexpr int U_HQ = 0, U_HI = 512, U_HG = 1024, U_HFF = 1536, U_HFB = 2048, U_DQ = 2560, U_DK = 3072, U_DV = 3584;
constexpr int NEXP = 16, CAP = 256, DFF = 2048, NGRP = BATCH * NEXP;
constexpr float ALPHA = 1.189207115002721f;
constexpr float LN_EPS = 1e-5f, RMS_EPS = 1e-6f;
constexpr float LAMBDA_INIT = 0.2f;

constexpr size_t MiB = 1u << 20;
constexpr size_t WS_CTL = 0;
constexpr size_t WS_ROPE = 1 * MiB;
constexpr size_t WS_LB = WS_ROPE + 256 * 1024;
constexpr size_t WS_AFF = 2 * MiB;
constexpr size_t WS_INV = 3 * MiB;
constexpr size_t WS_IDX = 4 * MiB;
constexpr size_t WS_GATE = 4 * MiB + 512 * 1024;
constexpr size_t WS_WIN = 5 * MiB;
constexpr size_t WS_WKV = 13 * MiB;
constexpr size_t WS_WMIX = 17 * MiB;
constexpr size_t WS_WQ = 19 * MiB;
constexpr size_t WS_WO = 21 * MiB;
constexpr size_t WS_WGU = 23 * MiB;
constexpr size_t WS_WD = 151 * MiB;
constexpr size_t WS_U = 215 * MiB;
constexpr size_t WS_XN = 343 * MiB;
constexpr size_t WS_MIX = 375 * MiB;
constexpr size_t WS_KV = 407 * MiB;
constexpr size_t WS_XS = 415 * MiB;
constexpr size_t WS_MEMB = 479 * MiB;
constexpr size_t WS_END = 483 * MiB;

__device__ __forceinline__ unsigned f2bf(float f) { unsigned u = __builtin_bit_cast(unsigned, f); return (u + 0x7fffu + ((u >> 16) & 1u)) >> 16; }
__device__ __forceinline__ float bf2f(bf16_t b) { return __builtin_bit_cast(float, (unsigned)b << 16); }
__device__ __forceinline__ float wave_sum(float v) {
#pragma unroll
    for (int o = 1; o < 64; o <<= 1) v += __shfl_xor(v, o);
    return v;
}
__device__ __forceinline__ float silu_f(float x) { return x / (1.f + expf(-x)); }
__device__ __forceinline__ float sigmoid_f(float x) { return 1.f / (1.f + expf(-x)); }

__global__ void k_prep_small(const float* lb_logits, const float* lq1, const float* lk1, const float* lq2, const float* lk2, float* rope, float* lb) {
    int i = blockIdx.x * blockDim.x + threadIdx.x;
    if (i < SEQ * 8) {
        int t = i / 8, j = i % 8;
        float inv = (float)(1.0 / pow(500000.0, (double)j / 8.0));
        float ang = (float)t * inv;
        rope[t * 16 + j] = (float)cos((double)ang);
        rope[t * 16 + 8 + j] = (float)sin((double)ang);
    }
    if (i < 1024) {
        int d = i / 512, c = i % 512;
        float l0 = lb_logits[d * 1024 + c], l1 = lb_logits[d * 1024 + 512 + c];
        float m = fmaxf(l0, l1); float e0 = expf(l0 - m), e1 = expf(l1 - m);
        lb[i] = e0 / (e0 + e1);
    }
    if (i == 0) {
        float s1 = 0.f, s2 = 0.f;
        for (int k = 0; k < 64; ++k) { s1 += lq1[k] * lk1[k]; s2 += lq2[k] * lk2[k]; }
        lb[1024] = expf(s1) - expf(s2) + LAMBDA_INIT;
    }
}

__global__ void __launch_bounds__(256) k_transpose(const float* W, int K, int N, bf16_t* WT, int mode, long src_zs, long dst_zs) {
    __shared__ float t[32][33];
    W += (long)blockIdx.z * src_zs; WT += (long)blockIdx.z * dst_zs;
    int k0 = blockIdx.y * 32, n0 = blockIdx.x * 32, tx = threadIdx.x & 31, ty = threadIdx.x >> 5;
    for (int i = ty; i < 32; i += 8) t[i][tx] = W[(long)(k0 + i) * N + n0 + tx];
    __syncthreads();
    for (int i = ty; i < 32; i += 8) {
        int n = n0 + i; long r = n;
        if (mode == 1) r = (long)(n / 128) * 256 + (n % 128);
        if (mode == 2) r = (long)(n / 128) * 256 + 128 + (n % 128);
        WT[r * K + k0 + tx] = (bf16_t)f2bf(t[tx][i]);
    }
}
__global__ void k_cvt_bf16(const float* src, bf16_t* dst, long n) {
    long i = (long)blockIdx.x * blockDim.x + threadIdx.x;
    if (i < n) dst[i] = (bf16_t)f2bf(src[i]);
}

template <int MODE>
__global__ void __launch_bounds__(256) k_ln_rows(const float* X, const float* g, const float* b, float* H, bf16_t* XN, const float* wr, float* AFF) {
    const int lane = threadIdx.x & 63, row = blockIdx.x * 4 + (threadIdx.x >> 6);
    float4 v[4]; float s = 0.f;
#pragma unroll
    for (int j = 0; j < 4; ++j) {
        const long off = (long)row * DM + 4 * lane + 256 * j;
        v[j] = (MODE == 0) ? *(const float4*)(X + off) : *(const float4*)(H + off);
        s += (v[j].x + v[j].y) + (v[j].z + v[j].w);
    }
    const float mean = wave_sum(s) * (1.f / DM); float s2 = 0.f;
#pragma unroll
    for (int j = 0; j < 4; ++j) { v[j].x -= mean; v[j].y -= mean; v[j].z -= mean; v[j].w -= mean; s2 += (v[j].x * v[j].x + v[j].y * v[j].y) + (v[j].z * v[j].z + v[j].w * v[j].w); }
    const float rstd = 1.f / sqrtf(wave_sum(s2) * (1.f / DM) + LN_EPS);
#pragma unroll
    for (int j = 0; j < 4; ++j) {
        const int c = 4 * lane + 256 * j; const float4 gg = *(const float4*)(g + c), bb = *(const float4*)(b + c);
        v[j].x = v[j].x * rstd * gg.x + bb.x; v[j].y = v[j].y * rstd * gg.y + bb.y; v[j].z = v[j].z * rstd * gg.z + bb.z; v[j].w = v[j].w * rstd * gg.w + bb.w;
        *(float4*)(H + (long)row * DM + c) = v[j];
        uint2 o; o.x = f2bf(v[j].x) | (f2bf(v[j].y) << 16); o.y = f2bf(v[j].z) | (f2bf(v[j].w) << 16);
        *(uint2*)(XN + (long)row * DM + c) = o;
    }
    if (MODE == 2) {
        float acc[16];
#pragma unroll
        for (int e = 0; e < 16; ++e) acc[e] = 0.f;
#pragma unroll
        for (int j = 0; j < 4; ++j) {
            const float vv[4] = {v[j].x, v[j].y, v[j].z, v[j].w};
#pragma unroll
            for (int i = 0; i < 4; ++i) {
                const float4* w4 = (const float4*)(wr + (long)(4 * lane + 256 * j + i) * 16);
#pragma unroll
                for (int q = 0; q < 4; ++q) { const float4 w = w4[q]; acc[4 * q] += vv[i] * w.x; acc[4 * q + 1] += vv[i] * w.y; acc[4 * q + 2] += vv[i] * w.z; acc[4 * q + 3] += vv[i] * w.w; }
            }
        }
        float m = -INFINITY;
#pragma unroll
        for (int e = 0; e < 16; ++e) { acc[e] = wave_sum(acc[e]); m = fmaxf(m, acc[e]); }
        float sum = 0.f, mine = 0.f;
#pragma unroll
        for (int e = 0; e < 16; ++e) { const float p = expf(acc[e] - m); sum += p; if (e == lane) mine = p; }
        if (lane < 16) AFF[(long)row * 16 + lane] = mine / sum;
    }
}

__global__ void __launch_bounds__(256) k_gemm_naive(const bf16_t* A, long sa_z, int lda, const bf16_t* B, long sb_z, long sbn, long sbk,
                                                    float* C, long sc_z, int ldc, int K) {
    __shared__ float As[16][65], Bs[16][65];
    A += (long)blockIdx.z * sa_z; B += (long)blockIdx.z * sb_z; C += (long)blockIdx.z * sc_z;
    const int m0 = blockIdx.y * 64, n0 = blockIdx.x * 64, tx = threadIdx.x & 15, ty = threadIdx.x >> 4;
    float acc[4][4];
#pragma unroll
    for (int i = 0; i < 4; ++i)
#pragma unroll
        for (int j = 0; j < 4; ++j) acc[i][j] = 0.f;
    for (int k0 = 0; k0 < K; k0 += 16) {
        for (int i = threadIdx.x; i < 1024; i += 256) { const int m = i >> 4, k = i & 15; As[k][m] = bf2f(A[(long)(m0 + m) * lda + k0 + k]); }
        for (int i = threadIdx.x; i < 1024; i += 256) { const int n = i >> 4, k = i & 15; Bs[k][n] = bf2f(B[(long)(n0 + n) * sbn + (long)(k0 + k) * sbk]); }
        __syncthreads();
#pragma unroll
        for (int k = 0; k < 16; ++k) {
            float a[4], bb[4];
#pragma unroll
            for (int i = 0; i < 4; ++i) { a[i] = As[k][ty * 4 + i]; bb[i] = Bs[k][tx * 4 + i]; }
#pragma unroll
            for (int i = 0; i < 4; ++i)
#pragma unroll
                for (int j = 0; j < 4; ++j) acc[i][j] += a[i] * bb[j];
        }
        __syncthreads();
    }
#pragma unroll
    for (int i = 0; i < 4; ++i)
#pragma unroll
        for (int j = 0; j < 4; ++j) C[(long)(m0 + ty * 4 + i) * ldc + n0 + tx * 4 + j] = acc[i][j];
}

__global__ void k_transform(const float* SC, int lds_, bf16_t* dst, int ldd, int rows, int cols, int op, const float* rope, float scale) {
    long i = (long)blockIdx.x * blockDim.x + threadIdx.x;
    if (i >= (long)rows * cols) return;
    const int r = (int)(i / cols), c = (int)(i % cols);
    float v = SC[(long)r * lds_ + c];
    if (op == 1) v = silu_f(v);
    else if (op == 2 || op == 3) {
        const int d = c & 63, t = r % SEQ;
        if (d < 8) { const float v2 = SC[(long)r * lds_ + c + 8]; v = v * rope[t * 16 + d] - v2 * rope[t * 16 + 8 + d]; }
        else if (d < 16) { const float v1 = SC[(long)r * lds_ + c - 8]; v = v * rope[t * 16 + d - 8] + v1 * rope[t * 16 + 8 + d - 8]; }
        if (op == 2) v *= 0.125f * 1.4426950408889634f;
    } else if (op == 4) v *= scale;
    dst[(long)r * ldd + c] = (bf16_t)f2bf(v);
}

__global__ void __launch_bounds__(128) k_hgrn_naive(const bf16_t* U, const float* LB, float* OSC) {
    __shared__ float red[2][16];
    const int dvs = blockIdx.x, h = blockIdx.y, b = blockIdx.z >> 1, dir = blockIdx.z & 1, k = threadIdx.x;
    float S[16];
#pragma unroll
    for (int j = 0; j < 16; ++j) S[j] = 0.f;
    const float lbv = LB[dir * 512 + h * 128 + k];
    for (int step = 0; step < SEQ; ++step) {
        const int t = dir ? (SEQ - 1 - step) : step; const long row = (long)b * SEQ + t;
        const bf16_t* ur = U + row * NU;
        const float qv = bf2f(ur[U_HQ + h * 128 + k]);
        const float uf = bf2f(ur[(dir ? U_HFB : U_HFF) + h * 128 + k]);
        const float f = lbv + (1.f - lbv) * sigmoid_f(uf), kk = 1.f - f;
        float part[16];
#pragma unroll
        for (int j = 0; j < 16; ++j) { const float vv = bf2f(ur[U_HI + h * 128 + dvs * 16 + j]); S[j] = f * S[j] + kk * vv; part[j] = wave_sum(S[j] * qv); }
        if ((k & 63) == 0) {
#pragma unroll
            for (int j = 0; j < 16; ++j) red[k >> 6][j] = part[j];
        }
        __syncthreads();
        if (k < 16) OSC[((long)dir * NTOK + row) * 512 + h * 128 + dvs * 16 + k] = red[0][k] + red[1][k];
        __syncthreads();
    }
}
__global__ void __launch_bounds__(256) k_hgrn_combine(const float* OSC, const bf16_t* U, const float* ng, bf16_t* MIX) {
    const int lane = threadIdx.x & 63; const long w = (long)blockIdx.x * 4 + (threadIdx.x >> 6); const long row = w >> 2; const int h = (int)(w & 3);
    float o[2]; float ss = 0.f;
#pragma unroll
    for (int i = 0; i < 2; ++i) { const int d = lane + 64 * i; o[i] = OSC[row * 512 + h * 128 + d] + OSC[((long)NTOK + row) * 512 + h * 128 + d]; ss += o[i] * o[i]; }
    const float r = 1.f / sqrtf(wave_sum(ss) * (1.f / 128.f) + RMS_EPS);
#pragma unroll
    for (int i = 0; i < 2; ++i) { const int d = lane + 64 * i; const float y = o[i] * r * ng[h * 128 + d] * bf2f(U[row * NU + U_HG + h * 128 + d]); MIX[row * DM + h * 128 + d] = (bf16_t)f2bf(y); }
}

__global__ void __launch_bounds__(256) k_dattn_naive(const bf16_t* U, float* OSC) {
    __shared__ float Ks[32][64]; __shared__ float Vs[32][128];
    const int qb = blockIdx.x, g = blockIdx.y, b = blockIdx.z, h = g >> 1, r = threadIdx.x & 127, half = threadIdx.x >> 7;
    const long row = (long)b * SEQ + qb * 128 + r;
    float q[64], o[64];
#pragma unroll
    for (int d = 0; d < 64; ++d) { q[d] = bf2f(U[row * NU + U_DQ + g * 64 + d]); o[d] = 0.f; }
    float m = -INFINITY, l = 0.f;
    for (int k0 = 0; k0 < SEQ; k0 += 32) {
        for (int i = threadIdx.x; i < 32 * 64; i += 256) { const int kk = i >> 6, d = i & 63; Ks[kk][d] = bf2f(U[((long)b * SEQ + k0 + kk) * NU + U_DK + g * 64 + d]); }
        for (int i = threadIdx.x; i < 32 * 128; i += 256) { const int kk = i >> 7, d = i & 127; Vs[kk][d] = bf2f(U[((long)b * SEQ + k0 + kk) * NU + U_DV + h * 128 + d]); }
        __syncthreads();
        float s[32]; float tm = m;
#pragma unroll
        for (int kk = 0; kk < 32; ++kk) { float a = 0.f;
#pragma unroll
            for (int d = 0; d < 64; ++d) a += q[d] * Ks[kk][d];
            s[kk] = a; tm = fmaxf(tm, a); }
        const float corr = exp2f(m - tm); m = tm; l *= corr;
#pragma unroll
        for (int d = 0; d < 64; ++d) o[d] *= corr;
#pragma unroll
        for (int kk = 0; kk < 32; ++kk) { const float p = exp2f(s[kk] - m); l += p;
#pragma unroll
            for (int d = 0; d < 64; ++d) o[d] += p * Vs[kk][half * 64 + d]; }
        __syncthreads();
    }
    const float il = 1.f / l;
#pragma unroll
    for (int d = 0; d < 64; ++d) OSC[(row * 8 + g) * 128 + half * 64 + d] = o[d] * il;
}
__global__ void __launch_bounds__(256) k_dattn_combine(const float* OSC, const float* lamp, const float* sg, bf16_t* MIX) {
    const int lane = threadIdx.x & 63; const long w = (long)blockIdx.x * 4 + (threadIdx.x >> 6); const long row = w >> 2; const int h = (int)(w & 3);
    const float lam = lamp[0]; float o[2]; float ss = 0.f;
#pragma unroll
    for (int i = 0; i < 2; ++i) { const int d = lane + 64 * i; o[i] = OSC[(row * 8 + 2 * h) * 128 + d] - lam * OSC[(row * 8 + 2 * h + 1) * 128 + d]; ss += o[i] * o[i]; }
    const float r = 1.f / sqrtf(wave_sum(ss) * (1.f / 128.f) + RMS_EPS);
#pragma unroll
    for (int i = 0; i < 2; ++i) { const int d = lane + 64 * i; MIX[row * DM + 512 + h * 128 + d] = (bf16_t)f2bf(o[i] * r * sg[d] * (1.f - LAMBDA_INIT)); }
}

__global__ void __launch_bounds__(256) k_softmax256(const float* S, bf16_t* P) {
    const int lane = threadIdx.x & 63; const long row = (long)blockIdx.x * 4 + (threadIdx.x >> 6);
    float4 v = *(const float4*)(S + row * 256 + 4 * lane);
    float m = fmaxf(fmaxf(v.x, v.y), fmaxf(v.z, v.w));
#pragma unroll
    for (int o = 1; o < 64; o <<= 1) m = fmaxf(m, __shfl_xor(m, o));
    v.x = exp2f(v.x - m); v.y = exp2f(v.y - m); v.z = exp2f(v.z - m); v.w = exp2f(v.w - m);
    const float il = 1.f / wave_sum((v.x + v.y) + (v.z + v.w));
    uint2 o; o.x = f2bf(v.x * il) | (f2bf(v.y * il) << 16); o.y = f2bf(v.z * il) | (f2bf(v.w * il) << 16);
    *(uint2*)(P + row * 256 + 4 * lane) = o;
}

__global__ void __launch_bounds__(256) k_topk_gather(const float* AFF, const bf16_t* XN, int* IDX, float* GATE, int* INV, bf16_t* XS) {
    __shared__ float a[SEQ]; __shared__ int sel[CAP];
    const int grp = blockIdx.x, b = grp >> 4, e = grp & 15, tid = threadIdx.x;
    for (int t = tid; t < SEQ; t += 256) a[t] = AFF[((long)b * SEQ + t) * 16 + e];
    __syncthreads();
    for (int t = tid; t < SEQ; t += 256) {
        const float mine = a[t]; int rank = 0;
        for (int u = 0; u < SEQ; ++u) { const float x = a[u]; rank += (x > mine || (x == mine && u < t)) ? 1 : 0; }
        if (rank < CAP) { sel[rank] = t; IDX[grp * CAP + rank] = t; GATE[grp * CAP + rank] = mine; INV[((long)b * SEQ + t) * 16 + e] = rank; }
        else INV[((long)b * SEQ + t) * 16 + e] = -1;
    }
    __syncthreads();
    const int lane = tid & 63, wv = tid >> 6;
    for (int r = wv; r < CAP; r += 4) {
        const uint4* src = (const uint4*)(XN + ((long)b * SEQ + sel[r]) * DM); uint4* dst = (uint4*)(XS + ((long)grp * CAP + r) * DM);
        dst[lane] = src[lane]; dst[lane + 64] = src[lane + 64];
    }
}

__global__ void k_swiglu(const float* SC, int ldsc, bf16_t* ACT, int ldact, int rows, int cols_out) {
    long i = (long)blockIdx.x * blockDim.x + threadIdx.x;
    if (i >= (long)rows * cols_out) return;
    const int r = (int)(i / cols_out), c = (int)(i % cols_out), jt = c >> 7, cc = c & 127;
    const float gt = SC[(long)r * ldsc + jt * 256 + cc], up = SC[(long)r * ldsc + jt * 256 + 128 + cc];
    ACT[(long)r * ldact + c] = (bf16_t)f2bf(silu_f(gt) * up);
}
__global__ void k_ygate(const float* SC, const float* GATE, bf16_t* Y, int rows) {
    long i = (long)blockIdx.x * blockDim.x + threadIdx.x;
    if (i >= (long)rows * DM) return;
    const int r = (int)(i / DM);
    Y[i] = (bf16_t)f2bf(SC[i] * GATE[r]);
}

__global__ void __launch_bounds__(256) k_final(float* H, const bf16_t* Y, const int* INV, const float* g, const float* b) {
    const int lane = threadIdx.x & 63; const long row = (long)blockIdx.x * 4 + (threadIdx.x >> 6); const int bt = (int)(row / SEQ);
    float4 v[4];
#pragma unroll
    for (int j = 0; j < 4; ++j) { const float4 h = *(const float4*)(H + row * DM + 4 * lane + 256 * j); v[j] = make_float4(ALPHA * h.x, ALPHA * h.y, ALPHA * h.z, ALPHA * h.w); }
    for (int e = 0; e < 16; ++e) {
        const int slot = INV[row * 16 + e];
        if (slot >= 0) {
            const bf16_t* yr = Y + ((long)(bt * 16 + e) * CAP + slot) * DM;
#pragma unroll
            for (int j = 0; j < 4; ++j) { const uint2 p = *(const uint2*)(yr + 4 * lane + 256 * j);
                v[j].x += bf2f((bf16_t)(p.x & 0xffff)); v[j].y += bf2f((bf16_t)(p.x >> 16)); v[j].z += bf2f((bf16_t)(p.y & 0xffff)); v[j].w += bf2f((bf16_t)(p.y >> 16)); }
        }
    }
    float s = 0.f;
#pragma unroll
    for (int j = 0; j < 4; ++j) s += (v[j].x + v[j].y) + (v[j].z + v[j].w);
    const float mean = wave_sum(s) * (1.f / DM); float s2 = 0.f;
#pragma unroll
    for (int j = 0; j < 4; ++j) { v[j].x -= mean; v[j].y -= mean; v[j].z -= mean; v[j].w -= mean; s2 += (v[j].x * v[j].x + v[j].y * v[j].y) + (v[j].z * v[j].z + v[j].w * v[j].w); }
    const float rstd = 1.f / sqrtf(wave_sum(s2) * (1.f / DM) + LN_EPS);
#pragma unroll
    for (int j = 0; j < 4; ++j) {
        const int c = 4 * lane + 256 * j; const float4 gg = *(const float4*)(g + c), bb = *(const float4*)(b + c);
        float4 o; o.x = v[j].x * rstd * gg.x + bb.x; o.y = v[j].y * rstd * gg.y + bb.y; o.z = v[j].z * rstd * gg.z + bb.z; o.w = v[j].w * rstd * gg.w + bb.w;
        *(float4*)(H + row * DM + c) = o;
    }
}


namespace pg8 {
#define PG8_LAS __attribute__((address_space(3)))
typedef unsigned short bf16_t;
typedef short bf16x8 __attribute__((ext_vector_type(8)));
typedef float f32x4 __attribute__((ext_vector_type(4)));
typedef unsigned u32x4 __attribute__((ext_vector_type(4)));
constexpr int BM = 256, BK = 64, HALF = 128, HTB = HALF * BK * 2  , STAGE_BYTES = 8 * HTB, NXCD = 8, WGM = 8;

__host__ __device__ __forceinline__ int lds_byte(int r, int c) { const int st = (r >> 4) * 2 + (c >> 5), rr = r & 15, cc = c & 31, ob = rr * 64 + cc * 2; return st * 1024 + (ob ^ (((ob >> 9) & 1) << 5)); }
__host__ __device__ __forceinline__ void stage_rc(int b, int& R, int& C) { const int st = b / 1024, sb = b % 1024, swz = sb ^ (((sb >> 9) & 1) << 5); R = (st >> 1) * 16 + swz / 64; C = (st & 1) * 32 + (swz % 64) / 2; }
__host__ __device__ __forceinline__ int perm32(int rho) { const int n = rho >> 4, i = rho & 15; return 8 * (i >> 2) + 4 * n + (i & 3); }

struct Unit { int pm, pn; };
struct Gemm { const bf16_t* A; const bf16_t* Bt; int M, N, K; };

struct StaticOrder {
    int nM, nN, nwg, G, c;
    __host__ __device__ void init(int M, int N, int G_, int c_) { nM = M / BM; nN = N / BM; nwg = nM * nN; G = G_; c = c_; }
    __host__ __device__ bool next(int i, Unit& u) const {
        const long L = (long)i * G + c; if (L >= nwg) return false;
        int wgid = (int)L; { const int q = nwg / NXCD, r = nwg % NXCD, xcd = wgid % NXCD, off = wgid / NXCD; wgid = (xcd < r ? xcd * (q + 1) : r * (q + 1) + (xcd - r) * q) + off; }
        const int nig = WGM * nN, gid = wgid / nig, fm = gid * WGM, gsz = (nM - fm) < WGM ? (nM - fm) : WGM;
        u.pm = fm + ((wgid % nig) % gsz); u.pn = (wgid % nig) / gsz; return true;
    }
    __device__ __forceinline__ void a_ready(const Unit&) const {}
    __device__ __forceinline__ void done(const Unit&) const {}
};

__device__ __forceinline__ unsigned cvt_pk_bf16(float lo, float hi) { unsigned r; asm volatile("v_cvt_pk_bf16_f32 %0, %1, %2" : "=v"(r) : "v"(lo), "v"(hi)); return r; }
typedef float f32x2 __attribute__((ext_vector_type(2)));
typedef unsigned u32x4 __attribute__((ext_vector_type(4)));
constexpr float QSCALE_DA = 0.125f * 1.4426950408889634f;
constexpr float QSCALE_XA = 0.0625f * 1.4426950408889634f;
__device__ __forceinline__ float silu_fast(float x) { return x * __builtin_amdgcn_rcpf(1.f + __builtin_amdgcn_exp2f(-1.4426950408889634f * x)); }

struct EpiStore {
    static constexpr bool PERM = true, AFTER_DRAIN = false;
    bf16_t* O; int ldc; float scale; int mode; const float* rope;
    __device__ __forceinline__ void operator()(const f32x4 (&acc)[2][2][4][2], const Unit& u, int wr, int wc, int fr, int fq) const {
        const int row0 = u.pm * BM + wr * 64 + fr, col0 = u.pn * BM + wc * 32 + 8 * fq;
        int op = 0; float sc = scale;
        if (mode == 1) { const int seg = u.pn >> 1; op = (seg == 0 || seg == 2) ? 1 : (seg == 5 ? 2 : (seg == 6 ? 3 : 0)); if (seg == 5) sc = QSCALE_DA; }
        const bool do_rope = (op >= 2) && !(wc & 1);
#pragma unroll
        for (int ai = 0; ai < 2; ++ai)
#pragma unroll
            for (int m = 0; m < 4; ++m) {
                const int row = row0 + ai * HALF + m * 16; bf16_t* rowp = O + (size_t)row * ldc + col0;
                f32x4 c0 = {1.f, 1.f, 1.f, 1.f}, c1 = c0, s0 = {0.f, 0.f, 0.f, 0.f}, s1 = s0;
                if (do_rope) { const float* rp = rope + (row & 2047) * 16; c0 = *(const f32x4*)rp; c1 = *(const f32x4*)(rp + 4); s0 = *(const f32x4*)(rp + 8); s1 = *(const f32x4*)(rp + 12);
                    if (fq == 0) { s0 = -s0; s1 = -s1; } else if (fq >= 2) { c0 = (f32x4){1.f, 1.f, 1.f, 1.f}; c1 = c0; s0 = (f32x4){0.f, 0.f, 0.f, 0.f}; s1 = s0; } }
#pragma unroll
                for (int bj = 0; bj < 2; ++bj) {
                    f32x4 v0 = acc[ai][bj][m][0], v1 = acc[ai][bj][m][1];
                    if (op == 1) {
#pragma unroll
                        for (int j = 0; j < 4; ++j) { v0[j] = silu_fast(v0[j]); v1[j] = silu_fast(v1[j]); }
                    }
                    if (do_rope) {
                        f32x4 p0, p1;
#pragma unroll
                        for (int j = 0; j < 4; ++j) { p0[j] = __shfl_xor(v0[j], 16); p1[j] = __shfl_xor(v1[j], 16); }
                        v0 = v0 * c0 + p0 * s0; v1 = v1 * c1 + p1 * s1;
                    }
                    v0 = v0 * sc; v1 = v1 * sc;
                    u32x4 w; w.x = cvt_pk_bf16(v0[0], v0[1]); w.y = cvt_pk_bf16(v0[2], v0[3]); w.z = cvt_pk_bf16(v1[0], v1[1]); w.w = cvt_pk_bf16(v1[2], v1[3]);
                    *(u32x4*)(rowp + bj * HALF) = w;
                }
            }
    }
};
struct EpiResid {
    static constexpr bool PERM = false, AFTER_DRAIN = false;
    float* H; float alpha;
    __device__ __forceinline__ void operator()(const f32x4 (&acc)[2][2][4][2], const Unit& u, int wr, int wc, int fr, int fq) const {
        const int row0 = u.pm * BM + wr * 64 + fr, col0 = u.pn * BM + wc * 32 + 4 * fq;
#pragma unroll
        for (int ai = 0; ai < 2; ++ai)
#pragma unroll
            for (int m = 0; m < 4; ++m) { float* rowp = H + (size_t)(row0 + ai * HALF + m * 16) * 1024 + col0;
#pragma unroll
                for (int bj = 0; bj < 2; ++bj)
#pragma unroll
                    for (int n = 0; n < 2; ++n) { f32x4* p = (f32x4*)(rowp + bj * HALF + n * 16); const f32x4 h = *p; *p = h * alpha + acc[ai][bj][m][n]; } }
    }
};
struct EpiSwiglu {
    static constexpr bool PERM = true, AFTER_DRAIN = false;
    bf16_t* ACT;
    __device__ __forceinline__ void operator()(const f32x4 (&acc)[2][2][4][2], const Unit& u, int wr, int wc, int fr, int fq) const {
        const int row0 = u.pm * BM + wr * 64 + fr, col0 = (u.pn & 15) * 128 + wc * 32 + 8 * fq;
#pragma unroll
        for (int ai = 0; ai < 2; ++ai)
#pragma unroll
            for (int m = 0; m < 4; ++m) {
                f32x4 v0 = acc[ai][0][m][0], v1 = acc[ai][0][m][1]; const f32x4 u0 = acc[ai][1][m][0], u1 = acc[ai][1][m][1];
#pragma unroll
                for (int j = 0; j < 4; ++j) { v0[j] = silu_fast(v0[j]) * u0[j]; v1[j] = silu_fast(v1[j]) * u1[j]; }
                u32x4 w; w.x = cvt_pk_bf16(v0[0], v0[1]); w.y = cvt_pk_bf16(v0[2], v0[3]); w.z = cvt_pk_bf16(v1[0], v1[1]); w.w = cvt_pk_bf16(v1[2], v1[3]);
                *(u32x4*)(ACT + (size_t)(row0 + ai * HALF + m * 16) * 2048 + col0) = w;
            }
    }
};
struct EpiYGate {
    static constexpr bool PERM = true, AFTER_DRAIN = false;
    bf16_t* Y; const float* GATE;
    __device__ __forceinline__ void operator()(const f32x4 (&acc)[2][2][4][2], const Unit& u, int wr, int wc, int fr, int fq) const {
        const int row0 = u.pm * BM + wr * 64 + fr, col0 = (u.pn & 3) * BM + wc * 32 + 8 * fq;
#pragma unroll
        for (int ai = 0; ai < 2; ++ai)
#pragma unroll
            for (int m = 0; m < 4; ++m) { const int row = row0 + ai * HALF + m * 16; const float gt = GATE[row]; bf16_t* rowp = Y + (size_t)row * 1024 + col0;
#pragma unroll
                for (int bj = 0; bj < 2; ++bj) { const f32x4 v0 = acc[ai][bj][m][0] * gt, v1 = acc[ai][bj][m][1] * gt;
                    u32x4 w; w.x = cvt_pk_bf16(v0[0], v0[1]); w.y = cvt_pk_bf16(v0[2], v0[3]); w.z = cvt_pk_bf16(v1[0], v1[1]); w.w = cvt_pk_bf16(v1[2], v1[3]);
                    *(u32x4*)(rowp + bj * HALF) = w; } }
    }
};
template <int WHICH> struct MoeOrder {
    int G, c;
    __device__ bool next(int i, Unit& u) const {
        constexpr int NWG = WHICH == 1 ? 2048 : 512;
        const int L = i * G + c; if (L >= NWG) return false;
        const int Ux = (G % 8 == 0 && NWG % 8 == 0) ? (L % 8) * (NWG / 8) + L / 8 : L;
        if (WHICH == 1) { const int e = Ux >> 7, jg = (Ux & 127) >> 5, b = (Ux & 31) >> 2, jj = Ux & 3; u.pm = b * 16 + e; u.pn = e * 16 + jg * 4 + jj; }
        else { const int e = Ux >> 5, b = (Ux & 31) >> 2, j = Ux & 3; u.pm = b * 16 + e; u.pn = e * 4 + j; }
        return true;
    }
    __device__ __forceinline__ void a_ready(const Unit&) const {}
    __device__ __forceinline__ void done(const Unit&) const {}
};
template <class Epi, class Sched, bool ALIGN_EPI = false, bool SP2 = false>
__device__ __forceinline__ void gemm_phase(PG8_LAS unsigned char* lds, const Gemm g, const Sched& S, const Epi& E) {
    const int tid = threadIdx.x, wid = __builtin_amdgcn_readfirstlane(tid >> 6), lane = tid & 63, wr = wid >> 2, wc = wid & 3, fr = lane & 15, fq = lane >> 4;
    const int K = g.K, nt = K / BK;
    unsigned voffA[2], voffB[2];
#pragma unroll
    for (int i = 0; i < 2; ++i) { int R, C; stage_rc(tid * 16 + i * 8192, R, C); const int Rb = Epi::PERM ? ((R & ~31) + perm32(R & 31)) : R;
        voffA[i] = (unsigned)(R * K + C) * 2u; voffB[i] = (unsigned)(Rb * K + C) * 2u; }
    const size_t kstep = (size_t)(BK * 2);
    const size_t hstep = (size_t)HALF * K * 2;
    const size_t tstep = 2 * hstep;
    const unsigned ldsw = (unsigned)wid * 1024u;
    const int aoff = lds_byte(wr * 64 + fr, fq * 8), boff = lds_byte(wc * 32 + fr, fq * 8);
#define PG8_SA(b, h) (((b) * 2 + (h)) * HTB)
#define PG8_SB(b, h) ((4 + (b) * 2 + (h)) * HTB)
#define PG8_STAGE(bufoff, gbase, voff) do { _Pragma("unroll") for (int _i = 0; _i < 2; ++_i) \
        __builtin_amdgcn_global_load_lds((const unsigned*)((const char*)(gbase) + (voff)[_i]), (PG8_LAS unsigned*)(lds + (bufoff) + ldsw + _i * 8192), 16, 0, 0); } while (0)
#define PG8_LDA(dst, b, h) do { _Pragma("unroll") for (int m = 0; m < 4; ++m) _Pragma("unroll") for (int k = 0; k < 2; ++k) dst[m][k] = *(const PG8_LAS bf16x8*)(lds + PG8_SA(b, h) + aoff + m * 2048 + k * 1024); } while (0)
#define PG8_LDB(dst, b, h) do { _Pragma("unroll") for (int n = 0; n < 2; ++n) _Pragma("unroll") for (int k = 0; k < 2; ++k) dst[n][k] = *(const PG8_LAS bf16x8*)(lds + PG8_SB(b, h) + boff + n * 2048 + k * 1024); } while (0)
#define PG8_MMA(ai, bj, At, Bt) do { __builtin_amdgcn_s_setprio(1); _Pragma("unroll") for (int m = 0; m < 4; ++m) _Pragma("unroll") for (int n = 0; n < 2; ++n) _Pragma("unroll") for (int k = 0; k < 2; ++k) \
        acc[ai][bj][m][n] = __builtin_amdgcn_mfma_f32_16x16x32_bf16(Bt[n][k], At[m][k], acc[ai][bj][m][n], 0, 0, 0); __builtin_amdgcn_s_setprio(0); } while (0)
#define PG8_WAIT_V(n) asm volatile("s_waitcnt vmcnt(" #n ")" ::: "memory")
#define PG8_WAIT_L(n) asm volatile("s_waitcnt lgkmcnt(" #n ")" ::: "memory")
#define PG8_BAR __builtin_amdgcn_s_barrier()
#define PG8_SCHED __builtin_amdgcn_sched_barrier(0)
    Unit cur, nxt; int ui = 0;
    if (!S.next(0, cur)) return;
    f32x4 acc[2][2][4][2];
#pragma unroll
    for (int a = 0; a < 2; ++a)
#pragma unroll
        for (int b = 0; b < 2; ++b)
#pragma unroll
            for (int m = 0; m < 4; ++m)
#pragma unroll
                for (int n = 0; n < 2; ++n) acc[a][b][m][n] = (f32x4){0.f, 0.f, 0.f, 0.f};
    bf16x8 At[4][2], B0[2][2], B1[2][2];
    const char* cA = (const char*)g.A + (size_t)cur.pm * tstep; const char* cB = (const char*)g.Bt + (size_t)cur.pn * tstep;
    S.a_ready(cur);
    if constexpr (SP2) {
        PG8_STAGE(PG8_SB(0, 0), cB, voffB); PG8_STAGE(PG8_SB(0, 1), cB + hstep, voffB); PG8_STAGE(PG8_SA(0, 0), cA, voffA); PG8_STAGE(PG8_SA(0, 1), cA + hstep, voffA);
        if (wr == 1) PG8_BAR;
        PG8_WAIT_V(2); PG8_BAR;
        PG8_STAGE(PG8_SB(1, 0), cB + kstep, voffB); PG8_STAGE(PG8_SA(1, 0), cA + kstep, voffA); PG8_STAGE(PG8_SB(1, 1), cB + hstep + kstep, voffB);
        PG8_WAIT_V(6); PG8_BAR;
    } else {
        PG8_STAGE(PG8_SB(0, 0), cB, voffB); PG8_STAGE(PG8_SA(0, 0), cA, voffA); PG8_STAGE(PG8_SB(0, 1), cB + hstep, voffB); PG8_STAGE(PG8_SA(0, 1), cA + hstep, voffA);
        if (wr == 1) PG8_BAR;
        PG8_WAIT_V(4); PG8_BAR;
        PG8_STAGE(PG8_SB(1, 0), cB + kstep, voffB); PG8_STAGE(PG8_SA(1, 0), cA + kstep, voffA); PG8_STAGE(PG8_SB(1, 1), cB + hstep + kstep, voffB);
        PG8_WAIT_V(6); PG8_BAR;
    }
    for (;;) {
        const bool has_next = S.next(ui + 1, nxt);
        const char* nA = has_next ? (const char*)g.A + (size_t)nxt.pm * tstep : cA; const char* nB = has_next ? (const char*)g.Bt + (size_t)nxt.pn * tstep : cB;
        for (int t = 0; t < nt; t += 2) {
            const bool last = (t == nt - 2);
            const char* a1 = cA + (size_t)(t + 1) * kstep;
            const char* a2 = last ? nA : cA + (size_t)(t + 2) * kstep; const char* b2 = last ? nB : cB + (size_t)(t + 2) * kstep;
            const char* a3 = a2 + kstep; const char* b3 = b2 + kstep;
            if (last && has_next) S.a_ready(nxt);
            if constexpr (SP2) {
            PG8_LDB(B0, 0, 0); PG8_LDB(B1, 0, 1); PG8_SCHED; PG8_LDA(At, 0, 0); PG8_STAGE(PG8_SA(1, 1), a1 + hstep, voffA);
            PG8_WAIT_V(8); PG8_WAIT_L(0); PG8_BAR; PG8_MMA(0, 0, At, B0); PG8_MMA(0, 1, At, B1); PG8_BAR; PG8_SCHED;
            PG8_LDA(At, 0, 1); PG8_STAGE(PG8_SB(0, 0), b2, voffB); PG8_STAGE(PG8_SB(0, 1), b2 + hstep, voffB); PG8_STAGE(PG8_SA(0, 0), a2, voffA);
            PG8_WAIT_V(8); PG8_WAIT_L(0); PG8_BAR; PG8_MMA(1, 0, At, B0); PG8_MMA(1, 1, At, B1); PG8_BAR; PG8_SCHED;
            PG8_LDB(B0, 1, 0); PG8_LDB(B1, 1, 1); PG8_SCHED; PG8_LDA(At, 1, 0); PG8_STAGE(PG8_SA(0, 1), a2 + hstep, voffA);
            PG8_WAIT_V(8); PG8_WAIT_L(0); PG8_BAR; PG8_MMA(0, 0, At, B0); PG8_MMA(0, 1, At, B1); PG8_BAR; PG8_SCHED;
            PG8_LDA(At, 1, 1); PG8_STAGE(PG8_SB(1, 0), b3, voffB); PG8_STAGE(PG8_SB(1, 1), b3 + hstep, voffB); PG8_STAGE(PG8_SA(1, 0), a3, voffA);
            PG8_WAIT_V(8); PG8_WAIT_L(0); PG8_BAR; PG8_MMA(1, 0, At, B0); PG8_MMA(1, 1, At, B1); PG8_BAR; PG8_SCHED;
            } else {
            PG8_LDB(B0, 0, 0); PG8_SCHED; PG8_LDA(At, 0, 0); PG8_STAGE(PG8_SA(1, 1), a1 + hstep, voffA);
            PG8_WAIT_L(8); PG8_BAR; PG8_WAIT_L(0); PG8_MMA(0, 0, At, B0); PG8_BAR; PG8_SCHED;
            PG8_LDB(B1, 0, 1); PG8_STAGE(PG8_SB(0, 0), b2, voffB);
            PG8_BAR; PG8_WAIT_L(0); PG8_MMA(0, 1, At, B1); PG8_BAR;
            PG8_LDA(At, 0, 1); PG8_STAGE(PG8_SA(0, 0), a2, voffA);
            PG8_BAR; PG8_WAIT_L(0); PG8_MMA(1, 0, At, B0); PG8_BAR; PG8_SCHED;
            PG8_STAGE(PG8_SB(0, 1), b2 + hstep, voffB);
            PG8_WAIT_V(6); PG8_BAR; PG8_MMA(1, 1, At, B1); PG8_BAR;
            PG8_LDB(B0, 1, 0); PG8_SCHED; PG8_LDA(At, 1, 0); PG8_STAGE(PG8_SA(0, 1), a2 + hstep, voffA);
            PG8_WAIT_L(8); PG8_BAR; PG8_WAIT_L(0); PG8_MMA(0, 0, At, B0); PG8_BAR; PG8_SCHED;
            PG8_LDB(B1, 1, 1); PG8_STAGE(PG8_SB(1, 0), b3, voffB);
            PG8_BAR; PG8_WAIT_L(0); PG8_MMA(0, 1, At, B1); PG8_BAR;
            PG8_LDA(At, 1, 1); PG8_STAGE(PG8_SA(1, 0), a3, voffA);
            PG8_BAR; PG8_WAIT_L(0); PG8_MMA(1, 0, At, B0); PG8_BAR; PG8_SCHED;
            PG8_STAGE(PG8_SB(1, 1), b3 + hstep, voffB);
            PG8_WAIT_V(6); PG8_BAR; PG8_MMA(1, 1, At, B1); PG8_BAR;
            }
        }
        if constexpr (ALIGN_EPI) { if (wr == 0) PG8_BAR; }
        if constexpr (!Epi::AFTER_DRAIN) { E(acc, cur, wr, wc, fr, fq); S.done(cur); }
        if (!has_next) break;
#pragma unroll
        for (int a = 0; a < 2; ++a)
#pragma unroll
            for (int b = 0; b < 2; ++b)
#pragma unroll
                for (int m = 0; m < 4; ++m)
#pragma unroll
                    for (int n = 0; n < 2; ++n) acc[a][b][m][n] = (f32x4){0.f, 0.f, 0.f, 0.f};
        cur = nxt; cA = nA; cB = nB; ++ui;
        if constexpr (ALIGN_EPI) { if (wr == 1) PG8_BAR; }
    }
    PG8_WAIT_V(0);
    if constexpr (!ALIGN_EPI) { if (wr == 0) PG8_BAR; }
    PG8_BAR;
    if constexpr (Epi::AFTER_DRAIN) { E.fused(acc, cur, wr, wc, fr, fq, lds, wid, lane); S.done(cur); }
#undef PG8_SA
#undef PG8_SB
#undef PG8_STAGE
#undef PG8_LDA
#undef PG8_LDB
#undef PG8_MMA
#undef PG8_WAIT_V
#undef PG8_WAIT_L
#undef PG8_BAR
#undef PG8_SCHED
}
}

constexpr int NWAVES = 8;
constexpr int LDS_BYTES = 147456;
constexpr int RING_BYTES = 131072;
enum { PH_PROLOGUE = 0, PH_INPROJ, PH_MIXER, PH_MIXGEMM, PH_LN1, PH_QPROJ, PH_XATTN, PH_WOGEMM, PH_LN2, PH_TOPK, PH_MOE1, PH_MOE2, PH_FINAL, PH_COUNT };
struct MKArgs { const float* in[27]; float* out; unsigned char* ws; int ph_lo, ph_hi; };

__global__ void __launch_bounds__(NWAVES * 64, 2) mk_fwd(MKArgs a) {
    extern __shared__ __attribute__((aligned(16))) unsigned char lds_raw[];
    PG8_LAS unsigned char* lds = (PG8_LAS unsigned char*)lds_raw;
    unsigned char* ws = a.ws;
    const int G = gridDim.x, bx = blockIdx.x;
    const int lo = a.ph_lo, hi = a.ph_hi;
#define IN(k) (lo <= (k) && (k) < hi)
    float* H = a.out;
    bf16_t* XN = (bf16_t*)(ws + WS_XN); bf16_t* MIX = (bf16_t*)(ws + WS_MIX); bf16_t* U = (bf16_t*)(ws + WS_U); bf16_t* XS = (bf16_t*)(ws + WS_XS);

    if (IN(PH_INPROJ)) {
        {
            pg8::Gemm g{XN, (const bf16_t*)(ws + WS_WIN), NTOK, NU, DM}; pg8::StaticOrder S; S.init(NTOK, NU, G, bx);
            pg8::EpiStore E{U, NU, 1.f, 1, (const float*)(ws + WS_ROPE)};
            pg8::gemm_phase<pg8::EpiStore, pg8::StaticOrder, true, true>(lds, g, S, E);
        }
        {
            pg8::Gemm g{(const bf16_t*)(ws + WS_MEMB), (const bf16_t*)(ws + WS_WKV), NMEM, 2048, DM}; pg8::StaticOrder S; S.init(NMEM, 2048, G, bx);
            pg8::EpiStore E{(bf16_t*)(ws + WS_KV), 2048, 1.f, 0, nullptr};
            pg8::gemm_phase<pg8::EpiStore, pg8::StaticOrder, true, true>(lds, g, S, E);
        }
    }
    if (IN(PH_MIXGEMM)) {
        pg8::Gemm g{MIX, (const bf16_t*)(ws + WS_WMIX), NTOK, DM, DM}; pg8::StaticOrder S; S.init(NTOK, DM, G, bx);
        pg8::EpiResid E{H, ALPHA};
        pg8::gemm_phase<pg8::EpiResid, pg8::StaticOrder, true, true>(lds, g, S, E);
    }
    if (IN(PH_QPROJ)) {
        pg8::Gemm g{XN, (const bf16_t*)(ws + WS_WQ), NTOK, DM, DM}; pg8::StaticOrder S; S.init(NTOK, DM, G, bx);
        pg8::EpiStore E{MIX, DM, pg8::QSCALE_XA, 0, nullptr};
        pg8::gemm_phase<pg8::EpiStore, pg8::StaticOrder, true, true>(lds, g, S, E);
    }
    if (IN(PH_WOGEMM)) {
        pg8::Gemm g{MIX, (const bf16_t*)(ws + WS_WO), NTOK, DM, DM}; pg8::StaticOrder S; S.init(NTOK, DM, G, bx);
        pg8::EpiResid E{H, ALPHA};
        pg8::gemm_phase<pg8::EpiResid, pg8::StaticOrder, true, true>(lds, g, S, E);
    }
    if (IN(PH_MOE1)) {
        pg8::Gemm g{XS, (const bf16_t*)(ws + WS_WGU), NGRP * CAP, NEXP * 4096, DM}; pg8::MoeOrder<1> S{G, bx};
        pg8::EpiSwiglu E{U};
        pg8::gemm_phase<pg8::EpiSwiglu, pg8::MoeOrder<1>, true, true>(lds, g, S, E);
    }
    if (IN(PH_MOE2)) {
        pg8::Gemm g{U, (const bf16_t*)(ws + WS_WD), NGRP * CAP, NEXP * DM, DFF}; pg8::MoeOrder<2> S{G, bx};
        pg8::EpiYGate E{XS, (const float*)(ws + WS_GATE)};
        pg8::gemm_phase<pg8::EpiYGate, pg8::MoeOrder<2>, true, true>(lds, g, S, E);
    }
#undef IN
}

static void gemm_naive(hipStream_t st, const bf16_t* A, long sa_z, int lda, const bf16_t* B, long sb_z, long sbn, long sbk, float* C, long sc_z, int ldc, int M, int N, int K, int Z) {
    k_gemm_naive<<<dim3(N / 64, M / 64, Z), 256, 0, st>>>(A, sa_z, lda, B, sb_z, sbn, sbk, C, sc_z, ldc, K);
}
static void transform(hipStream_t st, const float* SC, int ldsc, bf16_t* dst, int ldd, int rows, int cols, int op, const float* rope, float scale) {
    long n = (long)rows * cols; k_transform<<<(unsigned)((n + 255) / 256), 256, 0, st>>>(SC, ldsc, dst, ldd, rows, cols, op, rope, scale);
}

extern "C" void kernel_launch(void* const* d_in, const int* in_sizes, int n_in, void* d_out, int out_size, void* d_ws, size_t ws_size, hipStream_t stream) {
    if (n_in != 27 || out_size != NTOK * DM || ws_size < WS_END) { fprintf(stderr, "kernel_launch: unexpected shapes (n_in %d out %d ws %zu)\n", n_in, out_size, ws_size); return; }
    static int grid = 0;
    if (grid == 0) {
        int dev = 0, cus = 0, per_cu = 0;
        (void)hipGetDevice(&dev); (void)hipDeviceGetAttribute(&cus, hipDeviceAttributeMultiprocessorCount, dev);
        (void)hipFuncSetAttribute((const void*)mk_fwd, hipFuncAttributeMaxDynamicSharedMemorySize, LDS_BYTES);
        (void)hipOccupancyMaxActiveBlocksPerMultiprocessor(&per_cu, (const void*)mk_fwd, NWAVES * 64, LDS_BYTES);
        (void)hipGetLastError();
        if (per_cu < 1) per_cu = 1;
        grid = cus * 1;
        if (grid != 256) fprintf(stderr, "kernel_launch: note: %d CUs (kernel tuned for 256)\n", grid);
    }
    const float* x = (const float*)d_in[0]; const float* mem = (const float*)d_in[1];
    const float* emb_g = (const float*)d_in[2]; const float* emb_b = (const float*)d_in[3];
    const float* w_in = (const float*)d_in[4]; const float* lb_logits = (const float*)d_in[5]; const float* hg_norm_g = (const float*)d_in[6];
    const float* lq1 = (const float*)d_in[7]; const float* lk1 = (const float*)d_in[8]; const float* lq2 = (const float*)d_in[9]; const float* lk2 = (const float*)d_in[10];
    const float* subln_g = (const float*)d_in[11]; const float* w_mix = (const float*)d_in[12];
    const float* ln1_g = (const float*)d_in[13]; const float* ln1_b = (const float*)d_in[14];
    const float* xa_wq = (const float*)d_in[15]; const float* xa_wk = (const float*)d_in[16]; const float* xa_wv = (const float*)d_in[17]; const float* xa_wo = (const float*)d_in[18];
    const float* ln2_g = (const float*)d_in[19]; const float* ln2_b = (const float*)d_in[20];
    const float* w_router = (const float*)d_in[21]; const float* w_gate = (const float*)d_in[22]; const float* w_up = (const float*)d_in[23]; const float* w_down = (const float*)d_in[24];
    const float* ln3_g = (const float*)d_in[25]; const float* ln3_b = (const float*)d_in[26];
    unsigned char* ws = (unsigned char*)d_ws;
    float* H = (float*)d_out;
    float* ROPE = (float*)(ws + WS_ROPE); float* LB = (float*)(ws + WS_LB); float* LAM = LB + 1024;
    float* AFF = (float*)(ws + WS_AFF); int* INV = (int*)(ws + WS_INV); int* IDX = (int*)(ws + WS_IDX); float* GATE = (float*)(ws + WS_GATE);
    bf16_t* WIN = (bf16_t*)(ws + WS_WIN); bf16_t* WKV = (bf16_t*)(ws + WS_WKV); bf16_t* WMIX = (bf16_t*)(ws + WS_WMIX); bf16_t* WQ = (bf16_t*)(ws + WS_WQ); bf16_t* WO = (bf16_t*)(ws + WS_WO);
    bf16_t* WGU = (bf16_t*)(ws + WS_WGU); bf16_t* WD = (bf16_t*)(ws + WS_WD);
    bf16_t* U = (bf16_t*)(ws + WS_U); bf16_t* XN = (bf16_t*)(ws + WS_XN); bf16_t* MIX = (bf16_t*)(ws + WS_MIX); bf16_t* Q = MIX; bf16_t* XO = MIX;
    bf16_t* KV = (bf16_t*)(ws + WS_KV); bf16_t* XS = (bf16_t*)(ws + WS_XS); bf16_t* Y = XS; bf16_t* MEMB = (bf16_t*)(ws + WS_MEMB);
    float* SC_XS = (float*)(ws + WS_XS);
    bf16_t* P = XN;

    MKArgs ka{};
    for (int i = 0; i < 27; ++i) ka.in[i] = (const float*)d_in[i];
    ka.out = (float*)d_out; ka.ws = ws;
    auto run_phase = [&](int p) { MKArgs k2 = ka; k2.ph_lo = p; k2.ph_hi = p + 1; hipLaunchKernelGGL(mk_fwd, dim3(grid), dim3(NWAVES * 64), LDS_BYTES, stream, k2); };

    k_prep_small<<<64, 256, 0, stream>>>(lb_logits, lq1, lk1, lq2, lk2, ROPE, LB);
    k_transpose<<<dim3(NU / 32, DM / 32, 1), 256, 0, stream>>>(w_in, DM, NU, WIN, 0, 0, 0);
    k_transpose<<<dim3(DM / 32, DM / 32, 1), 256, 0, stream>>>(xa_wk, DM, DM, WKV, 0, 0, 0);
    k_transpose<<<dim3(DM / 32, DM / 32, 1), 256, 0, stream>>>(xa_wv, DM, DM, WKV + (size_t)DM * DM, 0, 0, 0);
    k_transpose<<<dim3(DM / 32, DM / 32, 1), 256, 0, stream>>>(w_mix, DM, DM, WMIX, 0, 0, 0);
    k_transpose<<<dim3(DM / 32, DM / 32, 1), 256, 0, stream>>>(xa_wq, DM, DM, WQ, 0, 0, 0);
    k_transpose<<<dim3(DM / 32, DM / 32, 1), 256, 0, stream>>>(xa_wo, DM, DM, WO, 0, 0, 0);
    k_transpose<<<dim3(DFF / 32, DM / 32, NEXP), 256, 0, stream>>>(w_gate, DM, DFF, WGU, 1, (long)DM * DFF, (long)2 * DFF * DM);
    k_transpose<<<dim3(DFF / 32, DM / 32, NEXP), 256, 0, stream>>>(w_up, DM, DFF, WGU, 2, (long)DM * DFF, (long)2 * DFF * DM);
    k_transpose<<<dim3(DM / 32, DFF / 32, NEXP), 256, 0, stream>>>(w_down, DFF, DM, WD, 0, (long)DFF * DM, (long)DFF * DM);
    k_cvt_bf16<<<(NMEM * DM + 255) / 256, 256, 0, stream>>>(mem, MEMB, (long)NMEM * DM);
    k_ln_rows<0><<<NTOK / 4, 256, 0, stream>>>(x, emb_g, emb_b, H, XN, nullptr, nullptr);

    run_phase(PH_INPROJ);

    k_hgrn_naive<<<dim3(8, 4, 16), 128, 0, stream>>>(U, LB, SC_XS);
    k_hgrn_combine<<<NTOK, 256, 0, stream>>>(SC_XS, U, hg_norm_g, MIX);
    k_dattn_naive<<<dim3(16, 8, 8), 256, 0, stream>>>(U, SC_XS);
    k_dattn_combine<<<NTOK, 256, 0, stream>>>(SC_XS, LAM, subln_g, MIX);

    run_phase(PH_MIXGEMM);
    k_ln_rows<1><<<NTOK / 4, 256, 0, stream>>>(nullptr, ln1_g, ln1_b, H, XN, nullptr, nullptr);

    run_phase(PH_QPROJ);
    for (int b = 0; b < BATCH; ++b)
        gemm_naive(stream, Q + (size_t)b * SEQ * DM, 256, DM, KV + (size_t)b * MEML * 2048, 256, 2048, 1, SC_XS + (size_t)b * 4 * SEQ * 256, (long)SEQ * 256, 256, SEQ, 256, 256, 4);
    k_softmax256<<<BATCH * 4 * SEQ / 4, 256, 0, stream>>>(SC_XS, P);
    for (int b = 0; b < BATCH; ++b)
        gemm_naive(stream, P + (size_t)b * 4 * SEQ * 256, (long)SEQ * 256, 256, KV + (size_t)b * MEML * 2048 + 1024, 256, 1, 2048, SC_XS + (size_t)b * SEQ * DM, 256, DM, SEQ, 256, 256, 4);
    transform(stream, SC_XS, DM, XO, DM, NTOK, DM, 0, ROPE, 1.f);
    run_phase(PH_WOGEMM);
    k_ln_rows<2><<<NTOK / 4, 256, 0, stream>>>(nullptr, ln2_g, ln2_b, H, XN, w_router, AFF);

    k_topk_gather<<<NGRP, 256, 0, stream>>>(AFF, XN, IDX, GATE, INV, XS);

    run_phase(PH_MOE1);
    run_phase(PH_MOE2);

    k_final<<<NTOK / 4, 256, 0, stream>>>(H, Y, INV, ln3_g, ln3_b);
}
```

```cpp
#include <hip/hip_runtime.h>
#include <hip/hip_cooperative_groups.h>
#include <cstdint>
#include <cstdio>

typedef unsigned short bf16_t;

constexpr int BATCH = 8, SEQ = 2048, DM = 1024, NTOK = BATCH * SEQ;
constexpr int MEML = 256, NMEM = BATCH * MEML;
constexpr int NU = 4096;
constexpr int U_HQ = 0, U_HI = 512, U_HG = 1024, U_HFF = 1536, U_HFB = 2048, U_DQ = 2560, U_DK = 3072, U_DV = 3584;
constexpr int NEXP = 16, CAP = 256, DFF = 2048, NGRP = BATCH * NEXP;
constexpr float ALPHA = 1.189207115002721f;
constexpr float LN_EPS = 1e-5f, RMS_EPS = 1e-6f;
constexpr float LAMBDA_INIT = 0.2f;

constexpr size_t MiB = 1u << 20;
constexpr size_t WS_CTL = 0;
constexpr size_t WS_ROPE = 1 * MiB;
constexpr size_t WS_LB = WS_ROPE + 256 * 1024;
constexpr size_t WS_AFF = 2 * MiB;
constexpr size_t WS_INV = 3 * MiB;
constexpr size_t WS_IDX = 4 * MiB;
constexpr size_t WS_GATE = 4 * MiB + 512 * 1024;
constexpr size_t WS_WIN = 5 * MiB;
constexpr size_t WS_WKV = 13 * MiB;
constexpr size_t WS_WMIX = 17 * MiB;
constexpr size_t WS_WQ = 19 * MiB;
constexpr size_t WS_WO = 21 * MiB;
constexpr size_t WS_WGU = 23 * MiB;
constexpr size_t WS_WD = 151 * MiB;
constexpr size_t WS_U = 215 * MiB;
constexpr size_t WS_XN = 343 * MiB;
constexpr size_t WS_MIX = 375 * MiB;
constexpr size_t WS_KV = 407 * MiB;
constexpr size_t WS_XS = 415 * MiB;
constexpr size_t WS_MEMB = 479 * MiB;
constexpr size_t WS_END = 483 * MiB;

__device__ __forceinline__ unsigned f2bf(float f) { unsigned u = __builtin_bit_cast(unsigned, f); return (u + 0x7fffu + ((u >> 16) & 1u)) >> 16; }
__device__ __forceinline__ float bf2f(bf16_t b) { return __builtin_bit_cast(float, (unsigned)b << 16); }
__device__ __forceinline__ float wave_sum(float v) {
#pragma unroll
    for (int o = 1; o < 64; o <<= 1) v += __shfl_xor(v, o);
    return v;
}
__device__ __forceinline__ float silu_f(float x) { return x / (1.f + expf(-x)); }
__device__ __forceinline__ float sigmoid_f(float x) { return 1.f / (1.f + expf(-x)); }

#define VB_LOOP(NT, nvb, vb, valid, tid, sub) \
    for (int _r = 0, _sub = (int)threadIdx.x / (NT), tid = (int)threadIdx.x % (NT), sub = _sub, _pr = (int)gridDim.x * (512 / (NT)), _nr = ((nvb) + _pr - 1) / _pr, vb = 0, valid = 0; \
         _r < _nr && ((vb = (_r * (int)gridDim.x + (int)blockIdx.x) * (512 / (NT)) + _sub), (valid = vb < (nvb)), true); ++_r)

__device__ __forceinline__ void sp_prep_small(const float* lb_logits, const float* lq1, const float* lk1, const float* lq2, const float* lk2, float* rope, float* lb) {
    for (int i = blockIdx.x * 512 + threadIdx.x; i < SEQ * 8; i += gridDim.x * 512) {
        const int t = i / 8, j = i % 8;
        const float inv = (float)(1.0 / pow(500000.0, (double)j / 8.0));
        const float ang = (float)t * inv;
        rope[t * 16 + j] = (float)cos((double)ang);
        rope[t * 16 + 8 + j] = (float)sin((double)ang);
        if (i < 1024) {
            const int d = i / 512, c = i % 512;
            const float l0 = lb_logits[d * 1024 + c], l1 = lb_logits[d * 1024 + 512 + c];
            const float m = fmaxf(l0, l1); const float e0 = expf(l0 - m), e1 = expf(l1 - m);
            lb[i] = e0 / (e0 + e1);
        }
        if (i == 0) {
            float s1 = 0.f, s2 = 0.f;
            for (int k = 0; k < 64; ++k) { s1 += lq1[k] * lk1[k]; s2 += lq2[k] * lk2[k]; }
            lb[1024] = expf(s1) - expf(s2) + LAMBDA_INIT;
        }
    }
}
__device__ __forceinline__ void sp_transpose(float* smem, const float* W, int K, int N, bf16_t* WT, int mode, long src_zs, long dst_zs, int nz) {
    const int nbx = N / 32, nby = K / 32, nvb = nbx * nby * nz;
    VB_LOOP(256, nvb, vb, valid, tid, sub) {
        float* t = smem + sub * (32 * 33);
        const int z = vb / (nbx * nby), rem = vb % (nbx * nby), by = rem / nbx, bxx = rem % nbx;
        const float* Wz = W + (long)z * src_zs; bf16_t* WTz = WT + (long)z * dst_zs;
        const int k0 = by * 32, n0 = bxx * 32, tx = tid & 31, ty = tid >> 5;
        if (valid) for (int i = ty; i < 32; i += 8) t[i * 33 + tx] = Wz[(long)(k0 + i) * N + n0 + tx];
        __syncthreads();
        if (valid) for (int i = ty; i < 32; i += 8) {
            const int n = n0 + i; long r = n;
            if (mode == 1) r = (long)(n / 128) * 256 + (n % 128);
            if (mode == 2) r = (long)(n / 128) * 256 + 128 + (n % 128);
            WTz[r * K + k0 + tx] = (bf16_t)f2bf(t[tx * 33 + i]);
        }
        __syncthreads();
    }
}
__device__ __forceinline__ void sp_cvt_bf16(const float* src, bf16_t* dst, long n) {
    for (long i = (long)blockIdx.x * 512 + threadIdx.x; i < n; i += (long)gridDim.x * 512) dst[i] = (bf16_t)f2bf(src[i]);
}

template <int MODE>
__device__ __forceinline__ void sp_ln_rows(const float* X, const float* g, const float* b, float* H, bf16_t* XN, const float* wr, float* AFF) {
    const int lane = threadIdx.x & 63;
    for (int row = blockIdx.x * 8 + (threadIdx.x >> 6); row < NTOK; row += gridDim.x * 8) {
        float4 v[4]; float s = 0.f;
#pragma unroll
        for (int j = 0; j < 4; ++j) {
            const long off = (long)row * DM + 4 * lane + 256 * j;
            v[j] = (MODE == 0) ? *(const float4*)(X + off) : *(const float4*)(H + off);
            s += (v[j].x + v[j].y) + (v[j].z + v[j].w);
        }
        const float mean = wave_sum(s) * (1.f / DM); float s2 = 0.f;
#pragma unroll
        for (int j = 0; j < 4; ++j) { v[j].x -= mean; v[j].y -= mean; v[j].z -= mean; v[j].w -= mean; s2 += (v[j].x * v[j].x + v[j].y * v[j].y) + (v[j].z * v[j].z + v[j].w * v[j].w); }
        const float rstd = 1.f / sqrtf(wave_sum(s2) * (1.f / DM) + LN_EPS);
#pragma unroll
        for (int j = 0; j < 4; ++j) {
            const int c = 4 * lane + 256 * j; const float4 gg = *(const float4*)(g + c), bb = *(const float4*)(b + c);
            v[j].x = v[j].x * rstd * gg.x + bb.x; v[j].y = v[j].y * rstd * gg.y + bb.y; v[j].z = v[j].z * rstd * gg.z + bb.z; v[j].w = v[j].w * rstd * gg.w + bb.w;
            *(float4*)(H + (long)row * DM + c) = v[j];
            uint2 o; o.x = f2bf(v[j].x) | (f2bf(v[j].y) << 16); o.y = f2bf(v[j].z) | (f2bf(v[j].w) << 16);
            *(uint2*)(XN + (long)row * DM + c) = o;
        }
        if (MODE == 2) {
            float acc[16];
#pragma unroll
            for (int e = 0; e < 16; ++e) acc[e] = 0.f;
#pragma unroll
            for (int j = 0; j < 4; ++j) {
                const float vv[4] = {v[j].x, v[j].y, v[j].z, v[j].w};
#pragma unroll
                for (int i = 0; i < 4; ++i) {
                    const float4* w4 = (const float4*)(wr + (long)(4 * lane + 256 * j + i) * 16);
#pragma unroll
                    for (int q = 0; q < 4; ++q) { const float4 w = w4[q]; acc[4 * q] += vv[i] * w.x; acc[4 * q + 1] += vv[i] * w.y; acc[4 * q + 2] += vv[i] * w.z; acc[4 * q + 3] += vv[i] * w.w; }
                }
            }
            float m = -INFINITY;
#pragma unroll
            for (int e = 0; e < 16; ++e) { acc[e] = wave_sum(acc[e]); m = fmaxf(m, acc[e]); }
            float sum = 0.f;
#pragma unroll
            for (int e = 0; e < 16; ++e) { acc[e] = expf(acc[e] - m); sum += acc[e]; }
            if (lane == 0) {
#pragma unroll
                for (int q = 0; q < 4; ++q) *(float4*)(AFF + (long)row * 16 + 4 * q) = make_float4(acc[4 * q] / sum, acc[4 * q + 1] / sum, acc[4 * q + 2] / sum, acc[4 * q + 3] / sum);
            }
        }
    }
}

__device__ __forceinline__ void sp_gemm(float* smem, const bf16_t* A0, long sa_z, int lda, const bf16_t* B0, long sb_z, long sbn, long sbk, float* C0, long sc_z, int ldc, int M, int N, int K, int Z) {
    const int nbx = N / 64, nby = M / 64, nvb = nbx * nby * Z;
    VB_LOOP(256, nvb, vb, valid, tid, sub) {
        float* As = smem + sub * (2 * 16 * 65); float* Bs = As + 16 * 65;
        const int z = vb / (nbx * nby), rem = vb % (nbx * nby), by = rem / nbx, bxx = rem % nbx;
        const bf16_t* A = A0 + (long)z * sa_z; const bf16_t* B = B0 + (long)z * sb_z; float* C = C0 + (long)z * sc_z;
        const int m0 = by * 64, n0 = bxx * 64, tx = tid & 15, ty = tid >> 4;
        float acc[4][4];
#pragma unroll
        for (int i = 0; i < 4; ++i)
#pragma unroll
            for (int j = 0; j < 4; ++j) acc[i][j] = 0.f;
        for (int k0 = 0; k0 < K; k0 += 16) {
            if (valid) {
                for (int i = tid; i < 1024; i += 256) { const int m = i >> 4, k = i & 15; As[k * 65 + m] = bf2f(A[(long)(m0 + m) * lda + k0 + k]); }
                for (int i = tid; i < 1024; i += 256) { const int n = i >> 4, k = i & 15; Bs[k * 65 + n] = bf2f(B[(long)(n0 + n) * sbn + (long)(k0 + k) * sbk]); }
            }
            __syncthreads();
#pragma unroll
            for (int k = 0; k < 16; ++k) {
                float a[4], bb[4];
#pragma unroll
                for (int i = 0; i < 4; ++i) { a[i] = As[k * 65 + ty * 4 + i]; bb[i] = Bs[k * 65 + tx * 4 + i]; }
#pragma unroll
                for (int i = 0; i < 4; ++i)
#pragma unroll
                    for (int j = 0; j < 4; ++j) acc[i][j] += a[i] * bb[j];
            }
            __syncthreads();
        }
        if (valid) {
#pragma unroll
            for (int i = 0; i < 4; ++i)
#pragma unroll
                for (int j = 0; j < 4; ++j) C[(long)(m0 + ty * 4 + i) * ldc + n0 + tx * 4 + j] = acc[i][j];
        }
    }
}
__device__ __forceinline__ void sp_cvt2d(const float* SC, int ldsc, bf16_t* dst, int ldd, int rows, int cols) {
    const long n = (long)rows * cols;
    for (long i = (long)blockIdx.x * 512 + threadIdx.x; i < n; i += (long)gridDim.x * 512) { const int r = (int)(i / cols), c = (int)(i % cols); dst[(long)r * ldd + c] = (bf16_t)f2bf(SC[(long)r * ldsc + c]); }
}

__device__ __forceinline__ void sp_hgrn(float* smem, const bf16_t* U, const float* LB, float* OSC) {
    VB_LOOP(128, 8 * 4 * 16, vb, valid, k, sub) {
        float* red = smem + sub * 32;
        const int dvs = vb & 7, h = (vb >> 3) & 3, bz = vb >> 5, b = bz >> 1, dir = bz & 1;
        float S[16];
#pragma unroll
        for (int j = 0; j < 16; ++j) S[j] = 0.f;
        const float lbv = valid ? LB[dir * 512 + h * 128 + k] : 0.5f;
        for (int step = 0; step < SEQ; ++step) {
            const int t = dir ? (SEQ - 1 - step) : step; const long row = (long)(valid ? b : 0) * SEQ + t;
            const bf16_t* ur = U + row * NU;
            const float qv = bf2f(ur[U_HQ + h * 128 + k]);
            const float uf = bf2f(ur[(dir ? U_HFB : U_HFF) + h * 128 + k]);
            const float f = lbv + (1.f - lbv) * sigmoid_f(uf), kk = 1.f - f;
            float part[16];
#pragma unroll
            for (int j = 0; j < 16; ++j) { const float vv = bf2f(ur[U_HI + h * 128 + dvs * 16 + j]); S[j] = f * S[j] + kk * vv; part[j] = wave_sum(S[j] * qv); }
            if ((k & 63) == 0) {
#pragma unroll
                for (int j = 0; j < 16; ++j) red[(k >> 6) * 16 + j] = part[j];
            }
            __syncthreads();
            if (valid && k < 16) OSC[((long)dir * NTOK + row) * 512 + h * 128 + dvs * 16 + k] = red[k] + red[16 + k];
            __syncthreads();
        }
    }
}
__device__ __forceinline__ void sp_hgrn_combine(const float* OSC, const bf16_t* U, const float* ng, bf16_t* MIX) {
    const int lane = threadIdx.x & 63;
    for (long w = (long)blockIdx.x * 8 + (threadIdx.x >> 6); w < (long)NTOK * 4; w += (long)gridDim.x * 8) {
        const long row = w >> 2; const int h = (int)(w & 3);
        float o[2]; float ss = 0.f;
#pragma unroll
        for (int i = 0; i < 2; ++i) { const int d = lane + 64 * i; o[i] = OSC[row * 512 + h * 128 + d] + OSC[((long)NTOK + row) * 512 + h * 128 + d]; ss += o[i] * o[i]; }
        const float r = 1.f / sqrtf(wave_sum(ss) * (1.f / 128.f) + RMS_EPS);
#pragma unroll
        for (int i = 0; i < 2; ++i) { const int d = lane + 64 * i; const float y = o[i] * r * ng[h * 128 + d] * bf2f(U[row * NU + U_HG + h * 128 + d]); MIX[row * DM + h * 128 + d] = (bf16_t)f2bf(y); }
    }
}

__device__ __forceinline__ void sp_dattn(float* smem, const bf16_t* U, float* OSC) {
    VB_LOOP(256, 32 * 8 * 8, vb, valid, tid, sub) {
        float* Ks = smem + sub * (16 * 64 + 16 * 128); float* Vs = Ks + 16 * 64;
        const int qb = vb & 31, g = (vb >> 5) & 7, b = valid ? (vb >> 8) : 0, h = g >> 1, r = tid & 63, qt = tid >> 6;
        const long row = (long)b * SEQ + qb * 64 + r;
        float q[64], o[32];
#pragma unroll
        for (int d = 0; d < 64; ++d) q[d] = bf2f(U[row * NU + U_DQ + g * 64 + d]);
#pragma unroll
        for (int d = 0; d < 32; ++d) o[d] = 0.f;
        float m = -INFINITY, l = 0.f;
        for (int k0 = 0; k0 < SEQ; k0 += 16) {
            for (int i = tid; i < 16 * 64; i += 256) { const int kk = i >> 6, d = i & 63; Ks[kk * 64 + d] = bf2f(U[((long)b * SEQ + k0 + kk) * NU + U_DK + g * 64 + d]); }
            for (int i = tid; i < 16 * 128; i += 256) { const int kk = i >> 7, d = i & 127; Vs[kk * 128 + d] = bf2f(U[((long)b * SEQ + k0 + kk) * NU + U_DV + h * 128 + d]); }
            __syncthreads();
            float s[16]; float tm = m;
#pragma unroll
            for (int kk = 0; kk < 16; ++kk) { float a = 0.f;
#pragma unroll
                for (int d = 0; d < 64; ++d) a += q[d] * Ks[kk * 64 + d];
                s[kk] = a; tm = fmaxf(tm, a); }
            const float corr = exp2f(m - tm); m = tm; l *= corr;
#pragma unroll
            for (int d = 0; d < 32; ++d) o[d] *= corr;
#pragma unroll
            for (int kk = 0; kk < 16; ++kk) { const float p = exp2f(s[kk] - m); l += p;
#pragma unroll
                for (int d = 0; d < 32; ++d) o[d] += p * Vs[kk * 128 + qt * 32 + d]; }
            __syncthreads();
        }
        const float il = 1.f / l;
        if (valid) {
#pragma unroll
            for (int d = 0; d < 32; ++d) OSC[(row * 8 + g) * 128 + qt * 32 + d] = o[d] * il;
        }
    }
}
__device__ __forceinline__ void sp_dattn_combine(const float* OSC, const float* lamp, const float* sg, bf16_t* MIX) {
    const int lane = threadIdx.x & 63; const float lam = lamp[0];
    for (long w = (long)blockIdx.x * 8 + (threadIdx.x >> 6); w < (long)NTOK * 4; w += (long)gridDim.x * 8) {
        const long row = w >> 2; const int h = (int)(w & 3);
        float o[2]; float ss = 0.f;
#pragma unroll
        for (int i = 0; i < 2; ++i) { const int d = lane + 64 * i; o[i] = OSC[(row * 8 + 2 * h) * 128 + d] - lam * OSC[(row * 8 + 2 * h + 1) * 128 + d]; ss += o[i] * o[i]; }
        const float r = 1.f / sqrtf(wave_sum(ss) * (1.f / 128.f) + RMS_EPS);
#pragma unroll
        for (int i = 0; i < 2; ++i) { const int d = lane + 64 * i; MIX[row * DM + 512 + h * 128 + d] = (bf16_t)f2bf(o[i] * r * sg[d] * (1.f - LAMBDA_INIT)); }
    }
}

__device__ __forceinline__ void sp_softmax256(const float* S, bf16_t* P, long nrows) {
    const int lane = threadIdx.x & 63;
    for (long row = (long)blockIdx.x * 8 + (threadIdx.x >> 6); row < nrows; row += (long)gridDim.x * 8) {
        float4 v = *(const float4*)(S + row * 256 + 4 * lane);
        float m = fmaxf(fmaxf(v.x, v.y), fmaxf(v.z, v.w));
#pragma unroll
        for (int o = 1; o < 64; o <<= 1) m = fmaxf(m, __shfl_xor(m, o));
        v.x = exp2f(v.x - m); v.y = exp2f(v.y - m); v.z = exp2f(v.z - m); v.w = exp2f(v.w - m);
        const float il = 1.f / wave_sum((v.x + v.y) + (v.z + v.w));
        uint2 o; o.x = f2bf(v.x * il) | (f2bf(v.y * il) << 16); o.y = f2bf(v.z * il) | (f2bf(v.w * il) << 16);
        *(uint2*)(P + row * 256 + 4 * lane) = o;
    }
}

__device__ __forceinline__ void sp_topk_gather(float* smem, const float* AFF, const bf16_t* XN, int* IDX, float* GATE, int* INV, bf16_t* XS) {
    VB_LOOP(256, NGRP, grp, valid, tid, sub) {
        float* a = smem + sub * (SEQ + CAP); int* sel = (int*)(a + SEQ);
        const int b = valid ? (grp >> 4) : 0, e = grp & 15;
        for (int t = tid; t < SEQ; t += 256) a[t] = AFF[((long)b * SEQ + t) * 16 + e];
        __syncthreads();
        if (valid) for (int t = tid; t < SEQ; t += 256) {
            const float mine = a[t]; int rank = 0;
            for (int u = 0; u < SEQ; ++u) { const float x = a[u]; rank += (x > mine || (x == mine && u < t)) ? 1 : 0; }
            if (rank < CAP) { sel[rank] = t; IDX[grp * CAP + rank] = t; GATE[grp * CAP + rank] = mine; INV[((long)b * SEQ + t) * 16 + e] = rank; }
            else INV[((long)b * SEQ + t) * 16 + e] = -1;
        }
        __syncthreads();
        const int lane = tid & 63, wv = tid >> 6;
        if (valid) for (int r = wv; r < CAP; r += 4) {
            const uint4* src = (const uint4*)(XN + ((long)b * SEQ + sel[r]) * DM); uint4* dst = (uint4*)(XS + ((long)grp * CAP + r) * DM);
            dst[lane] = src[lane]; dst[lane + 64] = src[lane + 64];
        }
        __syncthreads();
    }
}

__device__ __forceinline__ void sp_final(float* H, const bf16_t* Y, const int* INV, const float* g, const float* b) {
    const int lane = threadIdx.x & 63;
    for (long row = (long)blockIdx.x * 8 + (threadIdx.x >> 6); row < NTOK; row += (long)gridDim.x * 8) {
        const int bt = (int)(row / SEQ);
        float4 v[4];
#pragma unroll
        for (int j = 0; j < 4; ++j) { const float4 h = *(const float4*)(H + row * DM + 4 * lane + 256 * j); v[j] = make_float4(ALPHA * h.x, ALPHA * h.y, ALPHA * h.z, ALPHA * h.w); }
        for (int e = 0; e < 16; ++e) {
            const int slot = INV[row * 16 + e];
            if (slot >= 0) {
                const bf16_t* yr = Y + ((long)(bt * 16 + e) * CAP + slot) * DM;
#pragma unroll
                for (int j = 0; j < 4; ++j) { const uint2 p = *(const uint2*)(yr + 4 * lane + 256 * j);
                    v[j].x += bf2f((bf16_t)(p.x & 0xffff)); v[j].y += bf2f((bf16_t)(p.x >> 16)); v[j].z += bf2f((bf16_t)(p.y & 0xffff)); v[j].w += bf2f((bf16_t)(p.y >> 16)); }
            }
        }
        float s = 0.f;
#pragma unroll
        for (int j = 0; j < 4; ++j) s += (v[j].x + v[j].y) + (v[j].z + v[j].w);
        const float mean = wave_sum(s) * (1.f / DM); float s2 = 0.f;
#pragma unroll
        for (int j = 0; j < 4; ++j) { v[j].x -= mean; v[j].y -= mean; v[j].z -= mean; v[j].w -= mean; s2 += (v[j].x * v[j].x + v[j].y * v[j].y) + (v[j].z * v[j].z + v[j].w * v[j].w); }
        const float rstd = 1.f / sqrtf(wave_sum(s2) * (1.f / DM) + LN_EPS);
#pragma unroll
        for (int j = 0; j < 4; ++j) {
            const int c = 4 * lane + 256 * j; const float4 gg = *(const float4*)(g + c), bb = *(const float4*)(b + c);
            float4 o; o.x = v[j].x * rstd * gg.x + bb.x; o.y = v[j].y * rstd * gg.y + bb.y; o.z = v[j].z * rstd * gg.z + bb.z; o.w = v[j].w * rstd * gg.w + bb.w;
            *(float4*)(H + row * DM + c) = o;
        }
    }
}
namespace pg8 {
#define PG8_LAS __attribute__((address_space(3)))
typedef unsigned short bf16_t;
typedef short bf16x8 __attribute__((ext_vector_type(8)));
typedef float f32x4 __attribute__((ext_vector_type(4)));
typedef unsigned u32x4 __attribute__((ext_vector_type(4)));
constexpr int BM = 256, BK = 64, HALF = 128, HTB = HALF * BK * 2  , STAGE_BYTES = 8 * HTB, NXCD = 8, WGM = 8;

__host__ __device__ __forceinline__ int lds_byte(int r, int c) { const int st = (r >> 4) * 2 + (c >> 5), rr = r & 15, cc = c & 31, ob = rr * 64 + cc * 2; return st * 1024 + (ob ^ (((ob >> 9) & 1) << 5)); }
__host__ __device__ __forceinline__ void stage_rc(int b, int& R, int& C) { const int st = b / 1024, sb = b % 1024, swz = sb ^ (((sb >> 9) & 1) << 5); R = (st >> 1) * 16 + swz / 64; C = (st & 1) * 32 + (swz % 64) / 2; }
__host__ __device__ __forceinline__ int perm32(int rho) { const int n = rho >> 4, i = rho & 15; return 8 * (i >> 2) + 4 * n + (i & 3); }

struct Unit { int pm, pn; };
struct Gemm { const bf16_t* A; const bf16_t* Bt; int M, N, K; };

struct StaticOrder {
    int nM, nN, nwg, G, c;
    __host__ __device__ void init(int M, int N, int G_, int c_) { nM = M / BM; nN = N / BM; nwg = nM * nN; G = G_; c = c_; }
    __host__ __device__ bool next(int i, Unit& u) const {
        const long L = (long)i * G + c; if (L >= nwg) return false;
        int wgid = (int)L; { const int q = nwg / NXCD, r = nwg % NXCD, xcd = wgid % NXCD, off = wgid / NXCD; wgid = (xcd < r ? xcd * (q + 1) : r * (q + 1) + (xcd - r) * q) + off; }
        const int nig = WGM * nN, gid = wgid / nig, fm = gid * WGM, gsz = (nM - fm) < WGM ? (nM - fm) : WGM;
        u.pm = fm + ((wgid % nig) % gsz); u.pn = (wgid % nig) / gsz; return true;
    }
    __device__ __forceinline__ void a_ready(const Unit&) const {}
    __device__ __forceinline__ void done(const Unit&) const {}
};

__device__ __forceinline__ unsigned cvt_pk_bf16(float lo, float hi) { unsigned r; asm volatile("v_cvt_pk_bf16_f32 %0, %1, %2" : "=v"(r) : "v"(lo), "v"(hi)); return r; }
typedef float f32x2 __attribute__((ext_vector_type(2)));
typedef unsigned u32x4 __attribute__((ext_vector_type(4)));
constexpr float QSCALE_DA = 0.125f * 1.4426950408889634f;
constexpr float QSCALE_XA = 0.0625f * 1.4426950408889634f;
__device__ __forceinline__ float silu_fast(float x) { return x * __builtin_amdgcn_rcpf(1.f + __builtin_amdgcn_exp2f(-1.4426950408889634f * x)); }

struct EpiStore {
    static constexpr bool PERM = true, AFTER_DRAIN = false;
    bf16_t* O; int ldc; float scale; int mode; const float* rope;
    __device__ __forceinline__ void operator()(const f32x4 (&acc)[2][2][4][2], const Unit& u, int wr, int wc, int fr, int fq) const {
        const int row0 = u.pm * BM + wr * 64 + fr, col0 = u.pn * BM + wc * 32 + 8 * fq;
        int op = 0; float sc = scale;
        if (mode == 1) { const int seg = u.pn >> 1; op = (seg == 0 || seg == 2) ? 1 : (seg == 5 ? 2 : (seg == 6 ? 3 : 0)); if (seg == 5) sc = QSCALE_DA; }
        const bool do_rope = (op >= 2) && !(wc & 1);
#pragma unroll
        for (int ai = 0; ai < 2; ++ai)
#pragma unroll
            for (int m = 0; m < 4; ++m) {
                const int row = row0 + ai * HALF + m * 16; bf16_t* rowp = O + (size_t)row * ldc + col0;
                f32x4 c0 = {1.f, 1.f, 1.f, 1.f}, c1 = c0, s0 = {0.f, 0.f, 0.f, 0.f}, s1 = s0;
                if (do_rope) { const float* rp = rope + (row & 2047) * 16; c0 = *(const f32x4*)rp; c1 = *(const f32x4*)(rp + 4); s0 = *(const f32x4*)(rp + 8); s1 = *(const f32x4*)(rp + 12);
                    if (fq == 0) { s0 = -s0; s1 = -s1; } else if (fq >= 2) { c0 = (f32x4){1.f, 1.f, 1.f, 1.f}; c1 = c0; s0 = (f32x4){0.f, 0.f, 0.f, 0.f}; s1 = s0; } }
#pragma unroll
                for (int bj = 0; bj < 2; ++bj) {
                    f32x4 v0 = acc[ai][bj][m][0], v1 = acc[ai][bj][m][1];
                    if (op == 1) {
#pragma unroll
                        for (int j = 0; j < 4; ++j) { v0[j] = silu_fast(v0[j]); v1[j] = silu_fast(v1[j]); }
                    }
                    if (do_rope) {
                        f32x4 p0, p1;
#pragma unroll
                        for (int j = 0; j < 4; ++j) { p0[j] = __shfl_xor(v0[j], 16); p1[j] = __shfl_xor(v1[j], 16); }
                        v0 = v0 * c0 + p0 * s0; v1 = v1 * c1 + p1 * s1;
                    }
                    v0 = v0 * sc; v1 = v1 * sc;
                    u32x4 w; w.x = cvt_pk_bf16(v0[0], v0[1]); w.y = cvt_pk_bf16(v0[2], v0[3]); w.z = cvt_pk_bf16(v1[0], v1[1]); w.w = cvt_pk_bf16(v1[2], v1[3]);
                    *(u32x4*)(rowp + bj * HALF) = w;
                }
            }
    }
};
struct EpiResid {
    static constexpr bool PERM = false, AFTER_DRAIN = false;
    float* H; float alpha;
    __device__ __forceinline__ void operator()(const f32x4 (&acc)[2][2][4][2], const Unit& u, int wr, int wc, int fr, int fq) const {
        const int row0 = u.pm * BM + wr * 64 + fr, col0 = u.pn * BM + wc * 32 + 4 * fq;
#pragma unroll
        for (int ai = 0; ai < 2; ++ai)
#pragma unroll
            for (int m = 0; m < 4; ++m) { float* rowp = H + (size_t)(row0 + ai * HALF + m * 16) * 1024 + col0;
#pragma unroll
                for (int bj = 0; bj < 2; ++bj)
#pragma unroll
                    for (int n = 0; n < 2; ++n) { f32x4* p = (f32x4*)(rowp + bj * HALF + n * 16); const f32x4 h = *p; *p = h * alpha + acc[ai][bj][m][n]; } }
    }
};
struct EpiSwiglu {
    static constexpr bool PERM = true, AFTER_DRAIN = false;
    bf16_t* ACT;
    __device__ __forceinline__ void operator()(const f32x4 (&acc)[2][2][4][2], const Unit& u, int wr, int wc, int fr, int fq) const {
        const int row0 = u.pm * BM + wr * 64 + fr, col0 = (u.pn & 15) * 128 + wc * 32 + 8 * fq;
#pragma unroll
        for (int ai = 0; ai < 2; ++ai)
#pragma unroll
            for (int m = 0; m < 4; ++m) {
                f32x4 v0 = acc[ai][0][m][0], v1 = acc[ai][0][m][1]; const f32x4 u0 = acc[ai][1][m][0], u1 = acc[ai][1][m][1];
#pragma unroll
                for (int j = 0; j < 4; ++j) { v0[j] = silu_fast(v0[j]) * u0[j]; v1[j] = silu_fast(v1[j]) * u1[j]; }
                u32x4 w; w.x = cvt_pk_bf16(v0[0], v0[1]); w.y = cvt_pk_bf16(v0[2], v0[3]); w.z = cvt_pk_bf16(v1[0], v1[1]); w.w = cvt_pk_bf16(v1[2], v1[3]);
                *(u32x4*)(ACT + (size_t)(row0 + ai * HALF + m * 16) * 2048 + col0) = w;
            }
    }
};
struct EpiYGate {
    static constexpr bool PERM = true, AFTER_DRAIN = false;
    bf16_t* Y; const float* GATE;
    __device__ __forceinline__ void operator()(const f32x4 (&acc)[2][2][4][2], const Unit& u, int wr, int wc, int fr, int fq) const {
        const int row0 = u.pm * BM + wr * 64 + fr, col0 = (u.pn & 3) * BM + wc * 32 + 8 * fq;
#pragma unroll
        for (int ai = 0; ai < 2; ++ai)
#pragma unroll
            for (int m = 0; m < 4; ++m) { const int row = row0 + ai * HALF + m * 16; const float gt = GATE[row]; bf16_t* rowp = Y + (size_t)row * 1024 + col0;
#pragma unroll
                for (int bj = 0; bj < 2; ++bj) { const f32x4 v0 = acc[ai][bj][m][0] * gt, v1 = acc[ai][bj][m][1] * gt;
                    u32x4 w; w.x = cvt_pk_bf16(v0[0], v0[1]); w.y = cvt_pk_bf16(v0[2], v0[3]); w.z = cvt_pk_bf16(v1[0], v1[1]); w.w = cvt_pk_bf16(v1[2], v1[3]);
                    *(u32x4*)(rowp + bj * HALF) = w; } }
    }
};
template <int WHICH> struct MoeOrder {
    int G, c;
    __device__ bool next(int i, Unit& u) const {
        constexpr int NWG = WHICH == 1 ? 2048 : 512;
        const int L = i * G + c; if (L >= NWG) return false;
        const int Ux = (G % 8 == 0 && NWG % 8 == 0) ? (L % 8) * (NWG / 8) + L / 8 : L;
        if (WHICH == 1) { const int e = Ux >> 7, jg = (Ux & 127) >> 5, b = (Ux & 31) >> 2, jj = Ux & 3; u.pm = b * 16 + e; u.pn = e * 16 + jg * 4 + jj; }
        else { const int e = Ux >> 5, b = (Ux & 31) >> 2, j = Ux & 3; u.pm = b * 16 + e; u.pn = e * 4 + j; }
        return true;
    }
    __device__ __forceinline__ void a_ready(const Unit&) const {}
    __device__ __forceinline__ void done(const Unit&) const {}
};
template <class Epi, class Sched, bool ALIGN_EPI = false, bool SP2 = false>
__device__ __forceinline__ void gemm_phase(PG8_LAS unsigned char* lds, const Gemm g, const Sched& S, const Epi& E) {
    const int tid = threadIdx.x, wid = __builtin_amdgcn_readfirstlane(tid >> 6), lane = tid & 63, wr = wid >> 2, wc = wid & 3, fr = lane & 15, fq = lane >> 4;
    const int K = g.K, nt = K / BK;
    unsigned voffA[2], voffB[2];
#pragma unroll
    for (int i = 0; i < 2; ++i) { int R, C; stage_rc(tid * 16 + i * 8192, R, C); const int Rb = Epi::PERM ? ((R & ~31) + perm32(R & 31)) : R;
        voffA[i] = (unsigned)(R * K + C) * 2u; voffB[i] = (unsigned)(Rb * K + C) * 2u; }
    const size_t kstep = (size_t)(BK * 2);
    const size_t hstep = (size_t)HALF * K * 2;
    const size_t tstep = 2 * hstep;
    const unsigned ldsw = (unsigned)wid * 1024u;
    const int aoff = lds_byte(wr * 64 + fr, fq * 8), boff = lds_byte(wc * 32 + fr, fq * 8);
#define PG8_SA(b, h) (((b) * 2 + (h)) * HTB)
#define PG8_SB(b, h) ((4 + (b) * 2 + (h)) * HTB)
#define PG8_STAGE(bufoff, gbase, voff) do { _Pragma("unroll") for (int _i = 0; _i < 2; ++_i) \
        __builtin_amdgcn_global_load_lds((const unsigned*)((const char*)(gbase) + (voff)[_i]), (PG8_LAS unsigned*)(lds + (bufoff) + ldsw + _i * 8192), 16, 0, 0); } while (0)
#define PG8_LDA(dst, b, h) do { _Pragma("unroll") for (int m = 0; m < 4; ++m) _Pragma("unroll") for (int k = 0; k < 2; ++k) dst[m][k] = *(const PG8_LAS bf16x8*)(lds + PG8_SA(b, h) + aoff + m * 2048 + k * 1024); } while (0)
#define PG8_LDB(dst, b, h) do { _Pragma("unroll") for (int n = 0; n < 2; ++n) _Pragma("unroll") for (int k = 0; k < 2; ++k) dst[n][k] = *(const PG8_LAS bf16x8*)(lds + PG8_SB(b, h) + boff + n * 2048 + k * 1024); } while (0)
#define PG8_MMA(ai, bj, At, Bt) do { __builtin_amdgcn_s_setprio(1); _Pragma("unroll") for (int m = 0; m < 4; ++m) _Pragma("unroll") for (int n = 0; n < 2; ++n) _Pragma("unroll") for (int k = 0; k < 2; ++k) \
        acc[ai][bj][m][n] = __builtin_amdgcn_mfma_f32_16x16x32_bf16(Bt[n][k], At[m][k], acc[ai][bj][m][n], 0, 0, 0); __builtin_amdgcn_s_setprio(0); } while (0)
#define PG8_WAIT_V(n) asm volatile("s_waitcnt vmcnt(" #n ")" ::: "memory")
#define PG8_WAIT_L(n) asm volatile("s_waitcnt lgkmcnt(" #n ")" ::: "memory")
#define PG8_BAR __builtin_amdgcn_s_barrier()
#define PG8_SCHED __builtin_amdgcn_sched_barrier(0)
    Unit cur, nxt; int ui = 0;
    if (!S.next(0, cur)) return;
    f32x4 acc[2][2][4][2];
#pragma unroll
    for (int a = 0; a < 2; ++a)
#pragma unroll
        for (int b = 0; b < 2; ++b)
#pragma unroll
            for (int m = 0; m < 4; ++m)
#pragma unroll
                for (int n = 0; n < 2; ++n) acc[a][b][m][n] = (f32x4){0.f, 0.f, 0.f, 0.f};
    bf16x8 At[4][2], B0[2][2], B1[2][2];
    const char* cA = (const char*)g.A + (size_t)cur.pm * tstep; const char* cB = (const char*)g.Bt + (size_t)cur.pn * tstep;
    S.a_ready(cur);
    if constexpr (SP2) {
        PG8_STAGE(PG8_SB(0, 0), cB, voffB); PG8_STAGE(PG8_SB(0, 1), cB + hstep, voffB); PG8_STAGE(PG8_SA(0, 0), cA, voffA); PG8_STAGE(PG8_SA(0, 1), cA + hstep, voffA);
        if (wr == 1) PG8_BAR;
        PG8_WAIT_V(2); PG8_BAR;
        PG8_STAGE(PG8_SB(1, 0), cB + kstep, voffB); PG8_STAGE(PG8_SA(1, 0), cA + kstep, voffA); PG8_STAGE(PG8_SB(1, 1), cB + hstep + kstep, voffB);
        PG8_WAIT_V(6); PG8_BAR;
    } else {
        PG8_STAGE(PG8_SB(0, 0), cB, voffB); PG8_STAGE(PG8_SA(0, 0), cA, voffA); PG8_STAGE(PG8_SB(0, 1), cB + hstep, voffB); PG8_STAGE(PG8_SA(0, 1), cA + hstep, voffA);
        if (wr == 1) PG8_BAR;
        PG8_WAIT_V(4); PG8_BAR;
        PG8_STAGE(PG8_SB(1, 0), cB + kstep, voffB); PG8_STAGE(PG8_SA(1, 0), cA + kstep, voffA); PG8_STAGE(PG8_SB(1, 1), cB + hstep + kstep, voffB);
        PG8_WAIT_V(6); PG8_BAR;
    }
    for (;;) {
        const bool has_next = S.next(ui + 1, nxt);
        const char* nA = has_next ? (const char*)g.A + (size_t)nxt.pm * tstep : cA; const char* nB = has_next ? (const char*)g.Bt + (size_t)nxt.pn * tstep : cB;
        for (int t = 0; t < nt; t += 2) {
            const bool last = (t == nt - 2);
            const char* a1 = cA + (size_t)(t + 1) * kstep;
            const char* a2 = last ? nA : cA + (size_t)(t + 2) * kstep; const char* b2 = last ? nB : cB + (size_t)(t + 2) * kstep;
            const char* a3 = a2 + kstep; const char* b3 = b2 + kstep;
            if (last && has_next) S.a_ready(nxt);
            if constexpr (SP2) {
            PG8_LDB(B0, 0, 0); PG8_LDB(B1, 0, 1); PG8_SCHED; PG8_LDA(At, 0, 0); PG8_STAGE(PG8_SA(1, 1), a1 + hstep, voffA);
            PG8_WAIT_V(8); PG8_WAIT_L(0); PG8_BAR; PG8_MMA(0, 0, At, B0); PG8_MMA(0, 1, At, B1); PG8_BAR; PG8_SCHED;
            PG8_LDA(At, 0, 1); PG8_STAGE(PG8_SB(0, 0), b2, voffB); PG8_STAGE(PG8_SB(0, 1), b2 + hstep, voffB); PG8_STAGE(PG8_SA(0, 0), a2, voffA);
            PG8_WAIT_V(8); PG8_WAIT_L(0); PG8_BAR; PG8_MMA(1, 0, At, B0); PG8_MMA(1, 1, At, B1); PG8_BAR; PG8_SCHED;
            PG8_LDB(B0, 1, 0); PG8_LDB(B1, 1, 1); PG8_SCHED; PG8_LDA(At, 1, 0); PG8_STAGE(PG8_SA(0, 1), a2 + hstep, voffA);
            PG8_WAIT_V(8); PG8_WAIT_L(0); PG8_BAR; PG8_MMA(0, 0, At, B0); PG8_MMA(0, 1, At, B1); PG8_BAR; PG8_SCHED;
            PG8_LDA(At, 1, 1); PG8_STAGE(PG8_SB(1, 0), b3, voffB); PG8_STAGE(PG8_SB(1, 1), b3 + hstep, voffB); PG8_STAGE(PG8_SA(1, 0), a3, voffA);
            PG8_WAIT_V(8); PG8_WAIT_L(0); PG8_BAR; PG8_MMA(1, 0, At, B0); PG8_MMA(1, 1, At, B1); PG8_BAR; PG8_SCHED;
            } else {
            PG8_LDB(B0, 0, 0); PG8_SCHED; PG8_LDA(At, 0, 0); PG8_STAGE(PG8_SA(1, 1), a1 + hstep, voffA);
            PG8_WAIT_L(8); PG8_BAR; PG8_WAIT_L(0); PG8_MMA(0, 0, At, B0); PG8_BAR; PG8_SCHED;
            PG8_LDB(B1, 0, 1); PG8_STAGE(PG8_SB(0, 0), b2, voffB);
            PG8_BAR; PG8_WAIT_L(0); PG8_MMA(0, 1, At, B1); PG8_BAR;
            PG8_LDA(At, 0, 1); PG8_STAGE(PG8_SA(0, 0), a2, voffA);
            PG8_BAR; PG8_WAIT_L(0); PG8_MMA(1, 0, At, B0); PG8_BAR; PG8_SCHED;
            PG8_STAGE(PG8_SB(0, 1), b2 + hstep, voffB);
            PG8_WAIT_V(6); PG8_BAR; PG8_MMA(1, 1, At, B1); PG8_BAR;
            PG8_LDB(B0, 1, 0); PG8_SCHED; PG8_LDA(At, 1, 0); PG8_STAGE(PG8_SA(0, 1), a2 + hstep, voffA);
            PG8_WAIT_L(8); PG8_BAR; PG8_WAIT_L(0); PG8_MMA(0, 0, At, B0); PG8_BAR; PG8_SCHED;
            PG8_LDB(B1, 1, 1); PG8_STAGE(PG8_SB(1, 0), b3, voffB);
            PG8_BAR; PG8_WAIT_L(0); PG8_MMA(0, 1, At, B1); PG8_BAR;
            PG8_LDA(At, 1, 1); PG8_STAGE(PG8_SA(1, 0), a3, voffA);
            PG8_BAR; PG8_WAIT_L(0); PG8_MMA(1, 0, At, B0); PG8_BAR; PG8_SCHED;
            PG8_STAGE(PG8_SB(1, 1), b3 + hstep, voffB);
            PG8_WAIT_V(6); PG8_BAR; PG8_MMA(1, 1, At, B1); PG8_BAR;
            }
        }
        if constexpr (ALIGN_EPI) { if (wr == 0) PG8_BAR; }
        if constexpr (!Epi::AFTER_DRAIN) { E(acc, cur, wr, wc, fr, fq); S.done(cur); }
        if (!has_next) break;
#pragma unroll
        for (int a = 0; a < 2; ++a)
#pragma unroll
            for (int b = 0; b < 2; ++b)
#pragma unroll
                for (int m = 0; m < 4; ++m)
#pragma unroll
                    for (int n = 0; n < 2; ++n) acc[a][b][m][n] = (f32x4){0.f, 0.f, 0.f, 0.f};
        cur = nxt; cA = nA; cB = nB; ++ui;
        if constexpr (ALIGN_EPI) { if (wr == 1) PG8_BAR; }
    }
    PG8_WAIT_V(0);
    if constexpr (!ALIGN_EPI) { if (wr == 0) PG8_BAR; }
    PG8_BAR;
    if constexpr (Epi::AFTER_DRAIN) { E.fused(acc, cur, wr, wc, fr, fq, lds, wid, lane); S.done(cur); }
#undef PG8_SA
#undef PG8_SB
#undef PG8_STAGE
#undef PG8_LDA
#undef PG8_LDB
#undef PG8_MMA
#undef PG8_WAIT_V
#undef PG8_WAIT_L
#undef PG8_BAR
#undef PG8_SCHED
}
}
namespace cg = cooperative_groups;
constexpr int NWAVES = 8;
constexpr int LDS_BYTES = 147456;
enum { PH_PROLOGUE = 0, PH_INPROJ, PH_HGRN, PH_HGRN_COMB, PH_DATTN, PH_DATTN_COMB, PH_MIXGEMM, PH_LN1, PH_QPROJ, PH_XA_SCORES, PH_XA_SOFTMAX, PH_XA_PV, PH_XA_CVT,
       PH_WOGEMM, PH_LN2, PH_TOPK, PH_MOE1, PH_MOE2, PH_FINAL, PH_COUNT };
struct MKArgs { const float* in[27]; float* out; unsigned char* ws; int ph_lo, ph_hi; };

__global__ void __launch_bounds__(NWAVES * 64, 2) mk_fwd(MKArgs a) {
    extern __shared__ __attribute__((aligned(16))) unsigned char lds_raw[];
    PG8_LAS unsigned char* lds = (PG8_LAS unsigned char*)lds_raw;
    float* smem = (float*)lds_raw;
    unsigned char* ws = a.ws;
    const int G = gridDim.x, bx = blockIdx.x;
    const int lo = a.ph_lo, hi = a.ph_hi;
#define IN(k) (lo <= (k) && (k) < hi)
#define SEAM(k) do { if (IN(k) && IN((k) + 1)) cg::this_grid().sync(); } while (0)
    float* H = a.out;
    float* ROPE = (float*)(ws + WS_ROPE); float* LB = (float*)(ws + WS_LB); float* LAM = LB + 1024;
    float* AFF = (float*)(ws + WS_AFF); int* INV = (int*)(ws + WS_INV); int* IDX = (int*)(ws + WS_IDX); float* GATE = (float*)(ws + WS_GATE);
    bf16_t* XN = (bf16_t*)(ws + WS_XN); bf16_t* MIX = (bf16_t*)(ws + WS_MIX); bf16_t* U = (bf16_t*)(ws + WS_U); bf16_t* XS = (bf16_t*)(ws + WS_XS);
    bf16_t* KV = (bf16_t*)(ws + WS_KV); bf16_t* MEMB = (bf16_t*)(ws + WS_MEMB);
    float* SC_XS = (float*)(ws + WS_XS);
    bf16_t* P = XN;

    if (IN(PH_PROLOGUE)) {
        sp_prep_small(a.in[5], a.in[7], a.in[8], a.in[9], a.in[10], ROPE, LB);
        sp_transpose(smem, a.in[4], DM, NU, (bf16_t*)(ws + WS_WIN), 0, 0, 0, 1);
        sp_transpose(smem, a.in[16], DM, DM, (bf16_t*)(ws + WS_WKV), 0, 0, 0, 1);
        sp_transpose(smem, a.in[17], DM, DM, (bf16_t*)(ws + WS_WKV) + (size_t)DM * DM, 0, 0, 0, 1);
        sp_transpose(smem, a.in[12], DM, DM, (bf16_t*)(ws + WS_WMIX), 0, 0, 0, 1);
        sp_transpose(smem, a.in[15], DM, DM, (bf16_t*)(ws + WS_WQ), 0, 0, 0, 1);
        sp_transpose(smem, a.in[18], DM, DM, (bf16_t*)(ws + WS_WO), 0, 0, 0, 1);
        sp_transpose(smem, a.in[22], DM, DFF, (bf16_t*)(ws + WS_WGU), 1, (long)DM * DFF, (long)2 * DFF * DM, NEXP);
        sp_transpose(smem, a.in[23], DM, DFF, (bf16_t*)(ws + WS_WGU), 2, (long)DM * DFF, (long)2 * DFF * DM, NEXP);
        sp_transpose(smem, a.in[24], DFF, DM, (bf16_t*)(ws + WS_WD), 0, (long)DFF * DM, (long)DFF * DM, NEXP);
        sp_cvt_bf16(a.in[1], MEMB, (long)NMEM * DM);
        sp_ln_rows<0>(a.in[0], a.in[2], a.in[3], H, XN, nullptr, nullptr);
    }
    SEAM(PH_PROLOGUE);
    if (IN(PH_INPROJ)) {
        {
            pg8::Gemm g{XN, (const bf16_t*)(ws + WS_WIN), NTOK, NU, DM}; pg8::StaticOrder S; S.init(NTOK, NU, G, bx);
            pg8::EpiStore E{U, NU, 1.f, 1, ROPE};
            pg8::gemm_phase<pg8::EpiStore, pg8::StaticOrder, true, true>(lds, g, S, E);
        }
        {
            pg8::Gemm g{MEMB, (const bf16_t*)(ws + WS_WKV), NMEM, 2048, DM}; pg8::StaticOrder S; S.init(NMEM, 2048, G, bx);
            pg8::EpiStore E{KV, 2048, 1.f, 0, nullptr};
            pg8::gemm_phase<pg8::EpiStore, pg8::StaticOrder, true, true>(lds, g, S, E);
        }
    }
    SEAM(PH_INPROJ);
    if (IN(PH_HGRN)) sp_hgrn(smem, U, LB, SC_XS);
    SEAM(PH_HGRN);
    if (IN(PH_HGRN_COMB)) sp_hgrn_combine(SC_XS, U, a.in[6], MIX);
    SEAM(PH_HGRN_COMB);
    if (IN(PH_DATTN)) sp_dattn(smem, U, SC_XS);
    SEAM(PH_DATTN);
    if (IN(PH_DATTN_COMB)) sp_dattn_combine(SC_XS, LAM, a.in[11], MIX);
    SEAM(PH_DATTN_COMB);
    if (IN(PH_MIXGEMM)) {
        pg8::Gemm g{MIX, (const bf16_t*)(ws + WS_WMIX), NTOK, DM, DM}; pg8::StaticOrder S; S.init(NTOK, DM, G, bx);
        pg8::EpiResid E{H, ALPHA};
        pg8::gemm_phase<pg8::EpiResid, pg8::StaticOrder, true, true>(lds, g, S, E);
    }
    SEAM(PH_MIXGEMM);
    if (IN(PH_LN1)) sp_ln_rows<1>(nullptr, a.in[13], a.in[14], H, XN, nullptr, nullptr);
    SEAM(PH_LN1);
    if (IN(PH_QPROJ)) {
        pg8::Gemm g{XN, (const bf16_t*)(ws + WS_WQ), NTOK, DM, DM}; pg8::StaticOrder S; S.init(NTOK, DM, G, bx);
        pg8::EpiStore E{MIX, DM, pg8::QSCALE_XA, 0, nullptr};
        pg8::gemm_phase<pg8::EpiStore, pg8::StaticOrder, true, true>(lds, g, S, E);
    }
    SEAM(PH_QPROJ);
    if (IN(PH_XA_SCORES))
        for (int b = 0; b < BATCH; ++b)
            sp_gemm(smem, MIX + (size_t)b * SEQ * DM, 256, DM, KV + (size_t)b * MEML * 2048, 256, 2048, 1, SC_XS + (size_t)b * 4 * SEQ * 256, (long)SEQ * 256, 256, SEQ, 256, 256, 4);
    SEAM(PH_XA_SCORES);
    if (IN(PH_XA_SOFTMAX)) sp_softmax256(SC_XS, P, (long)BATCH * 4 * SEQ);
    SEAM(PH_XA_SOFTMAX);
    if (IN(PH_XA_PV))
        for (int b = 0; b < BATCH; ++b)
            sp_gemm(smem, P + (size_t)b * 4 * SEQ * 256, (long)SEQ * 256, 256, KV + (size_t)b * MEML * 2048 + 1024, 256, 1, 2048, SC_XS + (size_t)b * SEQ * DM, 256, DM, SEQ, 256, 256, 4);
    SEAM(PH_XA_PV);
    if (IN(PH_XA_CVT)) sp_cvt2d(SC_XS, DM, MIX, DM, NTOK, DM);
    SEAM(PH_XA_CVT);
    if (IN(PH_WOGEMM)) {
        pg8::Gemm g{MIX, (const bf16_t*)(ws + WS_WO), NTOK, DM, DM}; pg8::StaticOrder S; S.init(NTOK, DM, G, bx);
        pg8::EpiResid E{H, ALPHA};
        pg8::gemm_phase<pg8::EpiResid, pg8::StaticOrder, true, true>(lds, g, S, E);
    }
    SEAM(PH_WOGEMM);
    if (IN(PH_LN2)) sp_ln_rows<2>(nullptr, a.in[19], a.in[20], H, XN, a.in[21], AFF);
    SEAM(PH_LN2);
    if (IN(PH_TOPK)) sp_topk_gather(smem, AFF, XN, IDX, GATE, INV, XS);
    SEAM(PH_TOPK);
    if (IN(PH_MOE1)) {
        pg8::Gemm g{XS, (const bf16_t*)(ws + WS_WGU), NGRP * CAP, NEXP * 4096, DM}; pg8::MoeOrder<1> S{G, bx};
        pg8::EpiSwiglu E{U};
        pg8::gemm_phase<pg8::EpiSwiglu, pg8::MoeOrder<1>, true, true>(lds, g, S, E);
    }
    SEAM(PH_MOE1);
    if (IN(PH_MOE2)) {
        pg8::Gemm g{U, (const bf16_t*)(ws + WS_WD), NGRP * CAP, NEXP * DM, DFF}; pg8::MoeOrder<2> S{G, bx};
        pg8::EpiYGate E{XS, GATE};
        pg8::gemm_phase<pg8::EpiYGate, pg8::MoeOrder<2>, true, true>(lds, g, S, E);
    }
    SEAM(PH_MOE2);
    if (IN(PH_FINAL)) sp_final(H, XS, INV, a.in[25], a.in[26]);
#undef IN
#undef SEAM
}

#ifndef MK_PER_PHASE
#define MK_PER_PHASE 0
#endif
extern "C" void kernel_launch(void* const* d_in, const int* in_sizes, int n_in, void* d_out, int out_size, void* d_ws, size_t ws_size, hipStream_t stream) {
    if (n_in != 27 || out_size != NTOK * DM || ws_size < WS_END) { fprintf(stderr, "kernel_launch: unexpected shapes (n_in %d out %d ws %zu)\n", n_in, out_size, ws_size); return; }
    static int grid = 0;
    if (grid == 0) {
        int dev = 0, cus = 0, per_cu = 0;
        (void)hipGetDevice(&dev); (void)hipDeviceGetAttribute(&cus, hipDeviceAttributeMultiprocessorCount, dev);
        (void)hipFuncSetAttribute((const void*)mk_fwd, hipFuncAttributeMaxDynamicSharedMemorySize, LDS_BYTES);
        (void)hipOccupancyMaxActiveBlocksPerMultiprocessor(&per_cu, (const void*)mk_fwd, NWAVES * 64, LDS_BYTES);
        (void)hipGetLastError();
        if (per_cu < 1) { fprintf(stderr, "kernel_launch: occupancy query says %d blocks/CU\n", per_cu); per_cu = 1; }
        grid = cus;
    }
    MKArgs ka{};
    for (int i = 0; i < 27; ++i) ka.in[i] = (const float*)d_in[i];
    ka.out = (float*)d_out; ka.ws = (unsigned char*)d_ws;
#if MK_PER_PHASE
    for (int p = 0; p < PH_COUNT; ++p) { MKArgs k2 = ka; k2.ph_lo = p; k2.ph_hi = p + 1; hipLaunchKernelGGL(mk_fwd, dim3(grid), dim3(NWAVES * 64), LDS_BYTES, stream, k2); }
#else
    ka.ph_lo = 0; ka.ph_hi = PH_COUNT;
    void* args[] = {&ka};
    hipError_t e = hipLaunchCooperativeKernel((const void*)mk_fwd, dim3(grid), dim3(NWAVES * 64), args, LDS_BYTES, stream);
    if (e != hipSuccess) fprintf(stderr, "kernel_launch: cooperative launch failed: %s (grid %d)\n", hipGetErrorString(e), grid);
#endif
}
```

```cpp
#include <hip/hip_runtime.h>
#include <hip/hip_cooperative_groups.h>
#include <cstdint>
#include <cstdio>

typedef unsigned short bf16_t;

constexpr int BATCH = 8, SEQ = 2048, DM = 1024, NTOK = BATCH * SEQ;
constexpr int MEML = 256, NMEM = BATCH * MEML;
constexpr int NU = 4096;
constexpr int U_HQ = 0, U_HI = 512, U_HG = 1024, U_HFF = 1536, U_HFB = 2048, U_DQ = 2560, U_DK = 3072, U_DV = 3584;
constexpr int NEXP = 16, CAP = 256, DFF = 2048, NGRP = BATCH * NEXP;
constexpr float ALPHA = 1.189207115002721f;
constexpr float LN_EPS = 1e-5f, RMS_EPS = 1e-6f;
constexpr float LAMBDA_INIT = 0.2f;

constexpr size_t MiB = 1u << 20;
constexpr size_t WS_CTL = 0;
constexpr size_t WS_ROPE = 1 * MiB;
constexpr size_t WS_LB = WS_ROPE + 256 * 1024;
constexpr size_t WS_AFF = 2 * MiB;
constexpr size_t WS_INV = 3 * MiB;
constexpr size_t WS_IDX = 4 * MiB;
constexpr size_t WS_GATE = 4 * MiB + 512 * 1024;
constexpr size_t WS_WIN = 5 * MiB;
constexpr size_t WS_WKV = 13 * MiB;
constexpr size_t WS_WMIX = 17 * MiB;
constexpr size_t WS_WQ = 19 * MiB;
constexpr size_t WS_WO = 21 * MiB;
constexpr size_t WS_WGU = 23 * MiB;
constexpr size_t WS_WD = 151 * MiB;
constexpr size_t WS_U = 215 * MiB;
constexpr size_t WS_XN = 343 * MiB;
constexpr size_t WS_MIX = 375 * MiB;
constexpr size_t WS_KV = 407 * MiB;
constexpr size_t WS_XS = 415 * MiB;
constexpr size_t WS_MEMB = 479 * MiB;
constexpr size_t WS_END = 483 * MiB;

__device__ __forceinline__ unsigned f2bf(float f) { unsigned u = __builtin_bit_cast(unsigned, f); return (u + 0x7fffu + ((u >> 16) & 1u)) >> 16; }
__device__ __forceinline__ float bf2f(bf16_t b) { return __builtin_bit_cast(float, (unsigned)b << 16); }
__device__ __forceinline__ float wave_sum(float v) {
#pragma unroll
    for (int o = 1; o < 64; o <<= 1) v += __shfl_xor(v, o);
    return v;
}
__device__ __forceinline__ float silu_f(float x) { return x / (1.f + expf(-x)); }
__device__ __forceinline__ float sigmoid_f(float x) { return 1.f / (1.f + expf(-x)); }

#define VB_LOOP(NT, nvb, vb, valid, tid, sub) \
    for (int _r = 0, _sub = (int)threadIdx.x / (NT), tid = (int)threadIdx.x % (NT), sub = _sub, _pr = (int)gridDim.x * (512 / (NT)), _nr = ((nvb) + _pr - 1) / _pr, vb = 0, valid = 0; \
         _r < _nr && ((vb = (_r * (int)gridDim.x + (int)blockIdx.x) * (512 / (NT)) + _sub), (valid = vb < (nvb)), true); ++_r)

__device__ __forceinline__ void sp_prep_small(const float* lb_logits, const float* lq1, const float* lk1, const float* lq2, const float* lk2, float* rope, float* lb) {
    for (int i = blockIdx.x * 512 + threadIdx.x; i < SEQ * 8; i += gridDim.x * 512) {
        const int t = i / 8, j = i % 8;
        const float inv = (float)(1.0 / pow(500000.0, (double)j / 8.0));
        const float ang = (float)t * inv;
        rope[t * 16 + j] = (float)cos((double)ang);
        rope[t * 16 + 8 + j] = (float)sin((double)ang);
        if (i < 1024) {
            const int d = i / 512, c = i % 512;
            const float l0 = lb_logits[d * 1024 + c], l1 = lb_logits[d * 1024 + 512 + c];
            const float m = fmaxf(l0, l1); const float e0 = expf(l0 - m), e1 = expf(l1 - m);
            lb[i] = e0 / (e0 + e1);
        }
        if (i == 0) {
            float s1 = 0.f, s2 = 0.f;
            for (int k = 0; k < 64; ++k) { s1 += lq1[k] * lk1[k]; s2 += lq2[k] * lk2[k]; }
            lb[1024] = expf(s1) - expf(s2) + LAMBDA_INIT;
        }
    }
}
__device__ __forceinline__ void sp_transpose(float* smem, const float* W, int K, int N, bf16_t* WT, int mode, long src_zs, long dst_zs, int nz) {
    const int nbx = N / 32, nby = K / 32, nvb = nbx * nby * nz;
    VB_LOOP(256, nvb, vb, valid, tid, sub) {
        float* t = smem + sub * (32 * 33);
        const int z = vb / (nbx * nby), rem = vb % (nbx * nby), by = rem / nbx, bxx = rem % nbx;
        const float* Wz = W + (long)z * src_zs; bf16_t* WTz = WT + (long)z * dst_zs;
        const int k0 = by * 32, n0 = bxx * 32, tx = tid & 31, ty = tid >> 5;
        if (valid) for (int i = ty; i < 32; i += 8) t[i * 33 + tx] = Wz[(long)(k0 + i) * N + n0 + tx];
        __syncthreads();
        if (valid) for (int i = ty; i < 32; i += 8) {
            const int n = n0 + i; long r = n;
            if (mode == 1) r = (long)(n / 128) * 256 + (n % 128);
            if (mode == 2) r = (long)(n / 128) * 256 + 128 + (n % 128);
            WTz[r * K + k0 + tx] = (bf16_t)f2bf(t[tx * 33 + i]);
        }
        __syncthreads();
    }
}
__device__ __forceinline__ void sp_cvt_bf16(const float* src, bf16_t* dst, long n) {
    for (long i = (long)blockIdx.x * 512 + threadIdx.x; i < n; i += (long)gridDim.x * 512) dst[i] = (bf16_t)f2bf(src[i]);
}

template <int MODE>
__device__ __forceinline__ void sp_ln_rows(const float* X, const float* g, const float* b, float* H, bf16_t* XN, const float* wr, float* AFF) {
    const int lane = threadIdx.x & 63;
    for (int row = blockIdx.x * 8 + (threadIdx.x >> 6); row < NTOK; row += gridDim.x * 8) {
        float4 v[4]; float s = 0.f;
#pragma unroll
        for (int j = 0; j < 4; ++j) {
            const long off = (long)row * DM + 4 * lane + 256 * j;
            v[j] = (MODE == 0) ? *(const float4*)(X + off) : *(const float4*)(H + off);
            s += (v[j].x + v[j].y) + (v[j].z + v[j].w);
        }
        const float mean = wave_sum(s) * (1.f / DM); float s2 = 0.f;
#pragma unroll
        for (int j = 0; j < 4; ++j) { v[j].x -= mean; v[j].y -= mean; v[j].z -= mean; v[j].w -= mean; s2 += (v[j].x * v[j].x + v[j].y * v[j].y) + (v[j].z * v[j].z + v[j].w * v[j].w); }
        const float rstd = 1.f / sqrtf(wave_sum(s2) * (1.f / DM) + LN_EPS);
#pragma unroll
        for (int j = 0; j < 4; ++j) {
            const int c = 4 * lane + 256 * j; const float4 gg = *(const float4*)(g + c), bb = *(const float4*)(b + c);
            v[j].x = v[j].x * rstd * gg.x + bb.x; v[j].y = v[j].y * rstd * gg.y + bb.y; v[j].z = v[j].z * rstd * gg.z + bb.z; v[j].w = v[j].w * rstd * gg.w + bb.w;
            *(float4*)(H + (long)row * DM + c) = v[j];
            uint2 o; o.x = f2bf(v[j].x) | (f2bf(v[j].y) << 16); o.y = f2bf(v[j].z) | (f2bf(v[j].w) << 16);
            *(uint2*)(XN + (long)row * DM + c) = o;
        }
        if (MODE == 2) {
            float acc[16];
#pragma unroll
            for (int e = 0; e < 16; ++e) acc[e] = 0.f;
#pragma unroll
            for (int j = 0; j < 4; ++j) {
                const float vv[4] = {v[j].x, v[j].y, v[j].z, v[j].w};
#pragma unroll
                for (int i = 0; i < 4; ++i) {
                    const float4* w4 = (const float4*)(wr + (long)(4 * lane + 256 * j + i) * 16);
#pragma unroll
                    for (int q = 0; q < 4; ++q) { const float4 w = w4[q]; acc[4 * q] += vv[i] * w.x; acc[4 * q + 1] += vv[i] * w.y; acc[4 * q + 2] += vv[i] * w.z; acc[4 * q + 3] += vv[i] * w.w; }
                }
            }
            float m = -INFINITY;
#pragma unroll
            for (int e = 0; e < 16; ++e) { acc[e] = wave_sum(acc[e]); m = fmaxf(m, acc[e]); }
            float sum = 0.f;
#pragma unroll
            for (int e = 0; e < 16; ++e) { acc[e] = expf(acc[e] - m); sum += acc[e]; }
            if (lane == 0) {
#pragma unroll
                for (int q = 0; q < 4; ++q) *(float4*)(AFF + (long)row * 16 + 4 * q) = make_float4(acc[4 * q] / sum, acc[4 * q + 1] / sum, acc[4 * q + 2] / sum, acc[4 * q + 3] / sum);
            }
        }
    }
}

__device__ __forceinline__ void sp_gemm(float* smem, const bf16_t* A0, long sa_z, int lda, const bf16_t* B0, long sb_z, long sbn, long sbk, float* C0, long sc_z, int ldc, int M, int N, int K, int Z) {
    const int nbx = N / 64, nby = M / 64, nvb = nbx * nby * Z;
    VB_LOOP(256, nvb, vb, valid, tid, sub) {
        float* As = smem + sub * (2 * 16 * 65); float* Bs = As + 16 * 65;
        const int z = vb / (nbx * nby), rem = vb % (nbx * nby), by = rem / nbx, bxx = rem % nbx;
        const bf16_t* A = A0 + (long)z * sa_z; const bf16_t* B = B0 + (long)z * sb_z; float* C = C0 + (long)z * sc_z;
        const int m0 = by * 64, n0 = bxx * 64, tx = tid & 15, ty = tid >> 4;
        float acc[4][4];
#pragma unroll
        for (int i = 0; i < 4; ++i)
#pragma unroll
            for (int j = 0; j < 4; ++j) acc[i][j] = 0.f;
        for (int k0 = 0; k0 < K; k0 += 16) {
            if (valid) {
                for (int i = tid; i < 1024; i += 256) { const int m = i >> 4, k = i & 15; As[k * 65 + m] = bf2f(A[(long)(m0 + m) * lda + k0 + k]); }
                for (int i = tid; i < 1024; i += 256) { const int n = i >> 4, k = i & 15; Bs[k * 65 + n] = bf2f(B[(long)(n0 + n) * sbn + (long)(k0 + k) * sbk]); }
            }
            __syncthreads();
#pragma unroll
            for (int k = 0; k < 16; ++k) {
                float a[4], bb[4];
#pragma unroll
                for (int i = 0; i < 4; ++i) { a[i] = As[k * 65 + ty * 4 + i]; bb[i] = Bs[k * 65 + tx * 4 + i]; }
#pragma unroll
                for (int i = 0; i < 4; ++i)
#pragma unroll
                    for (int j = 0; j < 4; ++j) acc[i][j] += a[i] * bb[j];
            }
            __syncthreads();
        }
        if (valid) {
#pragma unroll
            for (int i = 0; i < 4; ++i)
#pragma unroll
                for (int j = 0; j < 4; ++j) C[(long)(m0 + ty * 4 + i) * ldc + n0 + tx * 4 + j] = acc[i][j];
        }
    }
}
__device__ __forceinline__ void sp_cvt2d(const float* SC, int ldsc, bf16_t* dst, int ldd, int rows, int cols) {
    const long n = (long)rows * cols;
    for (long i = (long)blockIdx.x * 512 + threadIdx.x; i < n; i += (long)gridDim.x * 512) { const int r = (int)(i / cols), c = (int)(i % cols); dst[(long)r * ldd + c] = (bf16_t)f2bf(SC[(long)r * ldsc + c]); }
}

__device__ __forceinline__ void sp_hgrn(float* smem, const bf16_t* U, const float* LB, float* OSC) {
    VB_LOOP(128, 8 * 4 * 16, vb, valid, k, sub) {
        float* red = smem + sub * 32;
        const int dvs = vb & 7, h = (vb >> 3) & 3, bz = vb >> 5, b = bz >> 1, dir = bz & 1;
        float S[16];
#pragma unroll
        for (int j = 0; j < 16; ++j) S[j] = 0.f;
        const float lbv = valid ? LB[dir * 512 + h * 128 + k] : 0.5f;
        for (int step = 0; step < SEQ; ++step) {
            const int t = dir ? (SEQ - 1 - step) : step; const long row = (long)(valid ? b : 0) * SEQ + t;
            const bf16_t* ur = U + row * NU;
            const float qv = bf2f(ur[U_HQ + h * 128 + k]);
            const float uf = bf2f(ur[(dir ? U_HFB : U_HFF) + h * 128 + k]);
            const float f = lbv + (1.f - lbv) * sigmoid_f(uf), kk = 1.f - f;
            float part[16];
#pragma unroll
            for (int j = 0; j < 16; ++j) { const float vv = bf2f(ur[U_HI + h * 128 + dvs * 16 + j]); S[j] = f * S[j] + kk * vv; part[j] = wave_sum(S[j] * qv); }
            if ((k & 63) == 0) {
#pragma unroll
                for (int j = 0; j < 16; ++j) red[(k >> 6) * 16 + j] = part[j];
            }
            __syncthreads();
            if (valid && k < 16) OSC[((long)dir * NTOK + row) * 512 + h * 128 + dvs * 16 + k] = red[k] + red[16 + k];
            __syncthreads();
        }
    }
}
__device__ __forceinline__ void sp_hgrn_combine(const float* OSC, const bf16_t* U, const float* ng, bf16_t* MIX) {
    const int lane = threadIdx.x & 63;
    for (long w = (long)blockIdx.x * 8 + (threadIdx.x >> 6); w < (long)NTOK * 4; w += (long)gridDim.x * 8) {
        const long row = w >> 2; const int h = (int)(w & 3);
        float o[2]; float ss = 0.f;
#pragma unroll
        for (int i = 0; i < 2; ++i) { const int d = lane + 64 * i; o[i] = OSC[row * 512 + h * 128 + d] + OSC[((long)NTOK + row) * 512 + h * 128 + d]; ss += o[i] * o[i]; }
        const float r = 1.f / sqrtf(wave_sum(ss) * (1.f / 128.f) + RMS_EPS);
#pragma unroll
        for (int i = 0; i < 2; ++i) { const int d = lane + 64 * i; const float y = o[i] * r * ng[h * 128 + d] * bf2f(U[row * NU + U_HG + h * 128 + d]); MIX[row * DM + h * 128 + d] = (bf16_t)f2bf(y); }
    }
}

__device__ __forceinline__ void sp_dattn(float* smem, const bf16_t* U, float* OSC) {
    VB_LOOP(256, 32 * 8 * 8, vb, valid, tid, sub) {
        float* Ks = smem + sub * (16 * 64 + 16 * 128); float* Vs = Ks + 16 * 64;
        const int qb = vb & 31, g = (vb >> 5) & 7, b = valid ? (vb >> 8) : 0, h = g >> 1, r = tid & 63, qt = tid >> 6;
        const long row = (long)b * SEQ + qb * 64 + r;
        float q[64], o[32];
#pragma unroll
        for (int d = 0; d < 64; ++d) q[d] = bf2f(U[row * NU + U_DQ + g * 64 + d]);
#pragma unroll
        for (int d = 0; d < 32; ++d) o[d] = 0.f;
        float m = -INFINITY, l = 0.f;
        for (int k0 = 0; k0 < SEQ; k0 += 16) {
            for (int i = tid; i < 16 * 64; i += 256) { const int kk = i >> 6, d = i & 63; Ks[kk * 64 + d] = bf2f(U[((long)b * SEQ + k0 + kk) * NU + U_DK + g * 64 + d]); }
            for (int i = tid; i < 16 * 128; i += 256) { const int kk = i >> 7, d = i & 127; Vs[kk * 128 + d] = bf2f(U[((long)b * SEQ + k0 + kk) * NU + U_DV + h * 128 + d]); }
            __syncthreads();
            float s[16]; float tm = m;
#pragma unroll
            for (int kk = 0; kk < 16; ++kk) { float a = 0.f;
#pragma unroll
                for (int d = 0; d < 64; ++d) a += q[d] * Ks[kk * 64 + d];
                s[kk] = a; tm = fmaxf(tm, a); }
            const float corr = exp2f(m - tm); m = tm; l *= corr;
#pragma unroll
            for (int d = 0; d < 32; ++d) o[d] *= corr;
#pragma unroll
            for (int kk = 0; kk < 16; ++kk) { const float p = exp2f(s[kk] - m); l += p;
#pragma unroll
                for (int d = 0; d < 32; ++d) o[d] += p * Vs[kk * 128 + qt * 32 + d]; }
            __syncthreads();
        }
        const float il = 1.f / l;
        if (valid) {
#pragma unroll
            for (int d = 0; d < 32; ++d) OSC[(row * 8 + g) * 128 + qt * 32 + d] = o[d] * il;
        }
    }
}
__device__ __forceinline__ void sp_dattn_combine(const float* OSC, const float* lamp, const float* sg, bf16_t* MIX) {
    const int lane = threadIdx.x & 63; const float lam = lamp[0];
    for (long w = (long)blockIdx.x * 8 + (threadIdx.x >> 6); w < (long)NTOK * 4; w += (long)gridDim.x * 8) {
        const long row = w >> 2; const int h = (int)(w & 3);
        float o[2]; float ss = 0.f;
#pragma unroll
        for (int i = 0; i < 2; ++i) { const int d = lane + 64 * i; o[i] = OSC[(row * 8 + 2 * h) * 128 + d] - lam * OSC[(row * 8 + 2 * h + 1) * 128 + d]; ss += o[i] * o[i]; }
        const float r = 1.f / sqrtf(wave_sum(ss) * (1.f / 128.f) + RMS_EPS);
#pragma unroll
        for (int i = 0; i < 2; ++i) { const int d = lane + 64 * i; MIX[row * DM + 512 + h * 128 + d] = (bf16_t)f2bf(o[i] * r * sg[d] * (1.f - LAMBDA_INIT)); }
    }
}

__device__ __forceinline__ void sp_softmax256(const float* S, bf16_t* P, long nrows) {
    const int lane = threadIdx.x & 63;
    for (long row = (long)blockIdx.x * 8 + (threadIdx.x >> 6); row < nrows; row += (long)gridDim.x * 8) {
        float4 v = *(const float4*)(S + row * 256 + 4 * lane);
        float m = fmaxf(fmaxf(v.x, v.y), fmaxf(v.z, v.w));
#pragma unroll
        for (int o = 1; o < 64; o <<= 1) m = fmaxf(m, __shfl_xor(m, o));
        v.x = exp2f(v.x - m); v.y = exp2f(v.y - m); v.z = exp2f(v.z - m); v.w = exp2f(v.w - m);
        const float il = 1.f / wave_sum((v.x + v.y) + (v.z + v.w));
        uint2 o; o.x = f2bf(v.x * il) | (f2bf(v.y * il) << 16); o.y = f2bf(v.z * il) | (f2bf(v.w * il) << 16);
        *(uint2*)(P + row * 256 + 4 * lane) = o;
    }
}

__device__ __forceinline__ void sp_topk_gather(float* smem, const float* AFF, const bf16_t* XN, int* IDX, float* GATE, int* INV, bf16_t* XS) {
    VB_LOOP(256, NGRP, grp, valid, tid, sub) {
        float* a = smem + sub * (SEQ + CAP); int* sel = (int*)(a + SEQ);
        const int b = valid ? (grp >> 4) : 0, e = grp & 15;
        for (int t = tid; t < SEQ; t += 256) a[t] = AFF[((long)b * SEQ + t) * 16 + e];
        __syncthreads();
        if (valid) for (int t = tid; t < SEQ; t += 256) {
            const float mine = a[t]; int rank = 0;
            for (int u = 0; u < SEQ; ++u) { const float x = a[u]; rank += (x > mine || (x == mine && u < t)) ? 1 : 0; }
            if (rank < CAP) { sel[rank] = t; IDX[grp * CAP + rank] = t; GATE[grp * CAP + rank] = mine; INV[((long)b * SEQ + t) * 16 + e] = rank; }
            else INV[((long)b * SEQ + t) * 16 + e] = -1;
        }
        __syncthreads();
        const int lane = tid & 63, wv = tid >> 6;
        if (valid) for (int r = wv; r < CAP; r += 4) {
            const uint4* src = (const uint4*)(XN + ((long)b * SEQ + sel[r]) * DM); uint4* dst = (uint4*)(XS + ((long)grp * CAP + r) * DM);
            dst[lane] = src[lane]; dst[lane + 64] = src[lane + 64];
        }
        __syncthreads();
    }
}

__device__ __forceinline__ void sp_final(float* H, const bf16_t* Y, const int* INV, const float* g, const float* b) {
    const int lane = threadIdx.x & 63;
    for (long row = (long)blockIdx.x * 8 + (threadIdx.x >> 6); row < NTOK; row += (long)gridDim.x * 8) {
        const int bt = (int)(row / SEQ);
        float4 v[4];
#pragma unroll
        for (int j = 0; j < 4; ++j) { const float4 h = *(const float4*)(H + row * DM + 4 * lane + 256 * j); v[j] = make_float4(ALPHA * h.x, ALPHA * h.y, ALPHA * h.z, ALPHA * h.w); }
        for (int e = 0; e < 16; ++e) {
            const int slot = INV[row * 16 + e];
            if (slot >= 0) {
                const bf16_t* yr = Y + ((long)(bt * 16 + e) * CAP + slot) * DM;
#pragma unroll
                for (int j = 0; j < 4; ++j) { const uint2 p = *(const uint2*)(yr + 4 * lane + 256 * j);
                    v[j].x += bf2f((bf16_t)(p.x & 0xffff)); v[j].y += bf2f((bf16_t)(p.x >> 16)); v[j].z += bf2f((bf16_t)(p.y & 0xffff)); v[j].w += bf2f((bf16_t)(p.y >> 16)); }
            }
        }
        float s = 0.f;
#pragma unroll
        for (int j = 0; j < 4; ++j) s += (v[j].x + v[j].y) + (v[j].z + v[j].w);
        const float mean = wave_sum(s) * (1.f / DM); float s2 = 0.f;
#pragma unroll
        for (int j = 0; j < 4; ++j) { v[j].x -= mean; v[j].y -= mean; v[j].z -= mean; v[j].w -= mean; s2 += (v[j].x * v[j].x + v[j].y * v[j].y) + (v[j].z * v[j].z + v[j].w * v[j].w); }
        const float rstd = 1.f / sqrtf(wave_sum(s2) * (1.f / DM) + LN_EPS);
#pragma unroll
        for (int j = 0; j < 4; ++j) {
            const int c = 4 * lane + 256 * j; const float4 gg = *(const float4*)(g + c), bb = *(const float4*)(b + c);
            float4 o; o.x = v[j].x * rstd * gg.x + bb.x; o.y = v[j].y * rstd * gg.y + bb.y; o.z = v[j].z * rstd * gg.z + bb.z; o.w = v[j].w * rstd * gg.w + bb.w;
            *(float4*)(H + row * DM + c) = o;
        }
    }
}
namespace pg8 {
#define PG8_LAS __attribute__((address_space(3)))
typedef unsigned short bf16_t;
typedef short bf16x8 __attribute__((ext_vector_type(8)));
typedef float f32x4 __attribute__((ext_vector_type(4)));
typedef unsigned u32x4 __attribute__((ext_vector_type(4)));
constexpr int BM = 256, BK = 64, HALF = 128, HTB = HALF * BK * 2  , STAGE_BYTES = 8 * HTB, NXCD = 8, WGM = 8;

__host__ __device__ __forceinline__ int lds_byte(int r, int c) { const int st = (r >> 4) * 2 + (c >> 5), rr = r & 15, cc = c & 31, ob = rr * 64 + cc * 2; return st * 1024 + (ob ^ (((ob >> 9) & 1) << 5)); }
__host__ __device__ __forceinline__ void stage_rc(int b, int& R, int& C) { const int st = b / 1024, sb = b % 1024, swz = sb ^ (((sb >> 9) & 1) << 5); R = (st >> 1) * 16 + swz / 64; C = (st & 1) * 32 + (swz % 64) / 2; }
__host__ __device__ __forceinline__ int perm32(int rho) { const int n = rho >> 4, i = rho & 15; return 8 * (i >> 2) + 4 * n + (i & 3); }

struct Unit { int pm, pn; };
struct Gemm { const bf16_t* A; const bf16_t* Bt; int M, N, K; };

struct StaticOrder {
    int nM, nN, nwg, G, c;
    __host__ __device__ void init(int M, int N, int G_, int c_) { nM = M / BM; nN = N / BM; nwg = nM * nN; G = G_; c = c_; }
    __host__ __device__ bool next(int i, Unit& u) const {
        const long L = (long)i * G + c; if (L >= nwg) return false;
        int wgid = (int)L; { const int q = nwg / NXCD, r = nwg % NXCD, xcd = wgid % NXCD, off = wgid / NXCD; wgid = (xcd < r ? xcd * (q + 1) : r * (q + 1) + (xcd - r) * q) + off; }
        const int nig = WGM * nN, gid = wgid / nig, fm = gid * WGM, gsz = (nM - fm) < WGM ? (nM - fm) : WGM;
        u.pm = fm + ((wgid % nig) % gsz); u.pn = (wgid % nig) / gsz; return true;
    }
    __device__ __forceinline__ void a_ready(const Unit&) const {}
    __device__ __forceinline__ void done(const Unit&) const {}
};

__device__ __forceinline__ unsigned cvt_pk_bf16(float lo, float hi) { unsigned r; asm volatile("v_cvt_pk_bf16_f32 %0, %1, %2" : "=v"(r) : "v"(lo), "v"(hi)); return r; }
typedef float f32x2 __attribute__((ext_vector_type(2)));
typedef unsigned u32x4 __attribute__((ext_vector_type(4)));
constexpr float QSCALE_DA = 0.125f * 1.4426950408889634f;
constexpr float QSCALE_XA = 0.0625f * 1.4426950408889634f;
__device__ __forceinline__ float silu_fast(float x) { return x * __builtin_amdgcn_rcpf(1.f + __builtin_amdgcn_exp2f(-1.4426950408889634f * x)); }

struct EpiStore {
    static constexpr bool PERM = true, AFTER_DRAIN = false;
    bf16_t* O; int ldc; float scale; int mode; const float* rope;
    __device__ __forceinline__ void operator()(const f32x4 (&acc)[2][2][4][2], const Unit& u, int wr, int wc, int fr, int fq) const {
        const int row0 = u.pm * BM + wr * 64 + fr, col0 = u.pn * BM + wc * 32 + 8 * fq;
        int op = 0; float sc = scale;
        if (mode == 1) { const int seg = u.pn >> 1; op = (seg == 0 || seg == 2) ? 1 : (seg == 5 ? 2 : (seg == 6 ? 3 : 0)); if (seg == 5) sc = QSCALE_DA; }
        const bool do_rope = (op >= 2) && !(wc & 1);
#pragma unroll
        for (int ai = 0; ai < 2; ++ai)
#pragma unroll
            for (int m = 0; m < 4; ++m) {
                const int row = row0 + ai * HALF + m * 16; bf16_t* rowp = O + (size_t)row * ldc + col0;
                f32x4 c0 = {1.f, 1.f, 1.f, 1.f}, c1 = c0, s0 = {0.f, 0.f, 0.f, 0.f}, s1 = s0;
                if (do_rope) { const float* rp = rope + (row & 2047) * 16; c0 = *(const f32x4*)rp; c1 = *(const f32x4*)(rp + 4); s0 = *(const f32x4*)(rp + 8); s1 = *(const f32x4*)(rp + 12);
                    if (fq == 0) { s0 = -s0; s1 = -s1; } else if (fq >= 2) { c0 = (f32x4){1.f, 1.f, 1.f, 1.f}; c1 = c0; s0 = (f32x4){0.f, 0.f, 0.f, 0.f}; s1 = s0; } }
#pragma unroll
                for (int bj = 0; bj < 2; ++bj) {
                    f32x4 v0 = acc[ai][bj][m][0], v1 = acc[ai][bj][m][1];
                    if (op == 1) {
#pragma unroll
                        for (int j = 0; j < 4; ++j) { v0[j] = silu_fast(v0[j]); v1[j] = silu_fast(v1[j]); }
                    }
                    if (do_rope) {
                        f32x4 p0, p1;
#pragma unroll
                        for (int j = 0; j < 4; ++j) { p0[j] = __shfl_xor(v0[j], 16); p1[j] = __shfl_xor(v1[j], 16); }
                        v0 = v0 * c0 + p0 * s0; v1 = v1 * c1 + p1 * s1;
                    }
                    v0 = v0 * sc; v1 = v1 * sc;
                    u32x4 w; w.x = cvt_pk_bf16(v0[0], v0[1]); w.y = cvt_pk_bf16(v0[2], v0[3]); w.z = cvt_pk_bf16(v1[0], v1[1]); w.w = cvt_pk_bf16(v1[2], v1[3]);
                    *(u32x4*)(rowp + bj * HALF) = w;
                }
            }
    }
};
struct EpiResid {
    static constexpr bool PERM = false, AFTER_DRAIN = false;
    float* H; float alpha;
    __device__ __forceinline__ void operator()(const f32x4 (&acc)[2][2][4][2], const Unit& u, int wr, int wc, int fr, int fq) const {
        const int row0 = u.pm * BM + wr * 64 + fr, col0 = u.pn * BM + wc * 32 + 4 * fq;
#pragma unroll
        for (int ai = 0; ai < 2; ++ai)
#pragma unroll
            for (int m = 0; m < 4; ++m) { float* rowp = H + (size_t)(row0 + ai * HALF + m * 16) * 1024 + col0;
#pragma unroll
                for (int bj = 0; bj < 2; ++bj)
#pragma unroll
                    for (int n = 0; n < 2; ++n) { f32x4* p = (f32x4*)(rowp + bj * HALF + n * 16); const f32x4 h = *p; *p = h * alpha + acc[ai][bj][m][n]; } }
    }
};
struct EpiSwiglu {
    static constexpr bool PERM = true, AFTER_DRAIN = false;
    bf16_t* ACT;
    __device__ __forceinline__ void operator()(const f32x4 (&acc)[2][2][4][2], const Unit& u, int wr, int wc, int fr, int fq) const {
        const int row0 = u.pm * BM + wr * 64 + fr, col0 = (u.pn & 15) * 128 + wc * 32 + 8 * fq;
#pragma unroll
        for (int ai = 0; ai < 2; ++ai)
#pragma unroll
            for (int m = 0; m < 4; ++m) {
                f32x4 v0 = acc[ai][0][m][0], v1 = acc[ai][0][m][1]; const f32x4 u0 = acc[ai][1][m][0], u1 = acc[ai][1][m][1];
#pragma unroll
                for (int j = 0; j < 4; ++j) { v0[j] = silu_fast(v0[j]) * u0[j]; v1[j] = silu_fast(v1[j]) * u1[j]; }
                u32x4 w; w.x = cvt_pk_bf16(v0[0], v0[1]); w.y = cvt_pk_bf16(v0[2], v0[3]); w.z = cvt_pk_bf16(v1[0], v1[1]); w.w = cvt_pk_bf16(v1[2], v1[3]);
                *(u32x4*)(ACT + (size_t)(row0 + ai * HALF + m * 16) * 2048 + col0) = w;
            }
    }
};
struct EpiYGate {
    static constexpr bool PERM = true, AFTER_DRAIN = false;
    bf16_t* Y; const float* GATE;
    __device__ __forceinline__ void operator()(const f32x4 (&acc)[2][2][4][2], const Unit& u, int wr, int wc, int fr, int fq) const {
        const int row0 = u.pm * BM + wr * 64 + fr, col0 = (u.pn & 3) * BM + wc * 32 + 8 * fq;
#pragma unroll
        for (int ai = 0; ai < 2; ++ai)
#pragma unroll
            for (int m = 0; m < 4; ++m) { const int row = row0 + ai * HALF + m * 16; const float gt = GATE[row]; bf16_t* rowp = Y + (size_t)row * 1024 + col0;
#pragma unroll
                for (int bj = 0; bj < 2; ++bj) { const f32x4 v0 = acc[ai][bj][m][0] * gt, v1 = acc[ai][bj][m][1] * gt;
                    u32x4 w; w.x = cvt_pk_bf16(v0[0], v0[1]); w.y = cvt_pk_bf16(v0[2], v0[3]); w.z = cvt_pk_bf16(v1[0], v1[1]); w.w = cvt_pk_bf16(v1[2], v1[3]);
                    *(u32x4*)(rowp + bj * HALF) = w; } }
    }
};
template <int WHICH> struct MoeOrder {
    int G, c;
    __device__ bool next(int i, Unit& u) const {
        constexpr int NWG = WHICH == 1 ? 2048 : 512;
        const int L = i * G + c; if (L >= NWG) return false;
        const int Ux = (G % 8 == 0 && NWG % 8 == 0) ? (L % 8) * (NWG / 8) + L / 8 : L;
        if (WHICH == 1) { const int e = Ux >> 7, jg = (Ux & 127) >> 5, b = (Ux & 31) >> 2, jj = Ux & 3; u.pm = b * 16 + e; u.pn = e * 16 + jg * 4 + jj; }
        else { const int e = Ux >> 5, b = (Ux & 31) >> 2, j = Ux & 3; u.pm = b * 16 + e; u.pn = e * 4 + j; }
        return true;
    }
    __device__ __forceinline__ void a_ready(const Unit&) const {}
    __device__ __forceinline__ void done(const Unit&) const {}
};
template <class Epi, class Sched, bool ALIGN_EPI = false, bool SP2 = false>
__device__ __forceinline__ void gemm_phase(PG8_LAS unsigned char* lds, const Gemm g, const Sched& S, const Epi& E) {
    const int tid = threadIdx.x, wid = __builtin_amdgcn_readfirstlane(tid >> 6), lane = tid & 63, wr = wid >> 2, wc = wid & 3, fr = lane & 15, fq = lane >> 4;
    const int K = g.K, nt = K / BK;
    unsigned voffA[2], voffB[2];
#pragma unroll
    for (int i = 0; i < 2; ++i) { int R, C; stage_rc(tid * 16 + i * 8192, R, C); const int Rb = Epi::PERM ? ((R & ~31) + perm32(R & 31)) : R;
        voffA[i] = (unsigned)(R * K + C) * 2u; voffB[i] = (unsigned)(Rb * K + C) * 2u; }
    const size_t kstep = (size_t)(BK * 2);
    const size_t hstep = (size_t)HALF * K * 2;
    const size_t tstep = 2 * hstep;
    const unsigned ldsw = (unsigned)wid * 1024u;
    const int aoff = lds_byte(wr * 64 + fr, fq * 8), boff = lds_byte(wc * 32 + fr, fq * 8);
#define PG8_SA(b, h) (((b) * 2 + (h)) * HTB)
#define PG8_SB(b, h) ((4 + (b) * 2 + (h)) * HTB)
#define PG8_STAGE(bufoff, gbase, voff) do { _Pragma("unroll") for (int _i = 0; _i < 2; ++_i) \
        __builtin_amdgcn_global_load_lds((const unsigned*)((const char*)(gbase) + (voff)[_i]), (PG8_LAS unsigned*)(lds + (bufoff) + ldsw + _i * 8192), 16, 0, 0); } while (0)
#define PG8_LDA(dst, b, h) do { _Pragma("unroll") for (int m = 0; m < 4; ++m) _Pragma("unroll") for (int k = 0; k < 2; ++k) dst[m][k] = *(const PG8_LAS bf16x8*)(lds + PG8_SA(b, h) + aoff + m * 2048 + k * 1024); } while (0)
#define PG8_LDB(dst, b, h) do { _Pragma("unroll") for (int n = 0; n < 2; ++n) _Pragma("unroll") for (int k = 0; k < 2; ++k) dst[n][k] = *(const PG8_LAS bf16x8*)(lds + PG8_SB(b, h) + boff + n * 2048 + k * 1024); } while (0)
#define PG8_MMA(ai, bj, At, Bt) do { __builtin_amdgcn_s_setprio(1); _Pragma("unroll") for (int m = 0; m < 4; ++m) _Pragma("unroll") for (int n = 0; n < 2; ++n) _Pragma("unroll") for (int k = 0; k < 2; ++k) \
        acc[ai][bj][m][n] = __builtin_amdgcn_mfma_f32_16x16x32_bf16(Bt[n][k], At[m][k], acc[ai][bj][m][n], 0, 0, 0); __builtin_amdgcn_s_setprio(0); } while (0)
#define PG8_WAIT_V(n) asm volatile("s_waitcnt vmcnt(" #n ")" ::: "memory")
#define PG8_WAIT_L(n) asm volatile("s_waitcnt lgkmcnt(" #n ")" ::: "memory")
#define PG8_BAR __builtin_amdgcn_s_barrier()
#define PG8_SCHED __builtin_amdgcn_sched_barrier(0)
    Unit cur, nxt; int ui = 0;
    if (!S.next(0, cur)) return;
    f32x4 acc[2][2][4][2];
#pragma unroll
    for (int a = 0; a < 2; ++a)
#pragma unroll
        for (int b = 0; b < 2; ++b)
#pragma unroll
            for (int m = 0; m < 4; ++m)
#pragma unroll
                for (int n = 0; n < 2; ++n) acc[a][b][m][n] = (f32x4){0.f, 0.f, 0.f, 0.f};
    bf16x8 At[4][2], B0[2][2], B1[2][2];
    const char* cA = (const char*)g.A + (size_t)cur.pm * tstep; const char* cB = (const char*)g.Bt + (size_t)cur.pn * tstep;
    S.a_ready(cur);
    if constexpr (SP2) {
        PG8_STAGE(PG8_SB(0, 0), cB, voffB); PG8_STAGE(PG8_SB(0, 1), cB + hstep, voffB); PG8_STAGE(PG8_SA(0, 0), cA, voffA); PG8_STAGE(PG8_SA(0, 1), cA + hstep, voffA);
        if (wr == 1) PG8_BAR;
        PG8_WAIT_V(2); PG8_BAR;
        PG8_STAGE(PG8_SB(1, 0), cB + kstep, voffB); PG8_STAGE(PG8_SA(1, 0), cA + kstep, voffA); PG8_STAGE(PG8_SB(1, 1), cB + hstep + kstep, voffB);
        PG8_WAIT_V(6); PG8_BAR;
    } else {
        PG8_STAGE(PG8_SB(0, 0), cB, voffB); PG8_STAGE(PG8_SA(0, 0), cA, voffA); PG8_STAGE(PG8_SB(0, 1), cB + hstep, voffB); PG8_STAGE(PG8_SA(0, 1), cA + hstep, voffA);
        if (wr == 1) PG8_BAR;
        PG8_WAIT_V(4); PG8_BAR;
        PG8_STAGE(PG8_SB(1, 0), cB + kstep, voffB); PG8_STAGE(PG8_SA(1, 0), cA + kstep, voffA); PG8_STAGE(PG8_SB(1, 1), cB + hstep + kstep, voffB);
        PG8_WAIT_V(6); PG8_BAR;
    }
    for (;;) {
        const bool has_next = S.next(ui + 1, nxt);
        const char* nA = has_next ? (const char*)g.A + (size_t)nxt.pm * tstep : cA; const char* nB = has_next ? (const char*)g.Bt + (size_t)nxt.pn * tstep : cB;
        for (int t = 0; t < nt; t += 2) {
            const bool last = (t == nt - 2);
            const char* a1 = cA + (size_t)(t + 1) * kstep;
            const char* a2 = last ? nA : cA + (size_t)(t + 2) * kstep; const char* b2 = last ? nB : cB + (size_t)(t + 2) * kstep;
            const char* a3 = a2 + kstep; const char* b3 = b2 + kstep;
            if (last && has_next) S.a_ready(nxt);
            if constexpr (SP2) {
            PG8_LDB(B0, 0, 0); PG8_LDB(B1, 0, 1); PG8_SCHED; PG8_LDA(At, 0, 0); PG8_STAGE(PG8_SA(1, 1), a1 + hstep, voffA);
            PG8_WAIT_V(8); PG8_WAIT_L(0); PG8_BAR; PG8_MMA(0, 0, At, B0); PG8_MMA(0, 1, At, B1); PG8_BAR; PG8_SCHED;
            PG8_LDA(At, 0, 1); PG8_STAGE(PG8_SB(0, 0), b2, voffB); PG8_STAGE(PG8_SB(0, 1), b2 + hstep, voffB); PG8_STAGE(PG8_SA(0, 0), a2, voffA);
            PG8_WAIT_V(8); PG8_WAIT_L(0); PG8_BAR; PG8_MMA(1, 0, At, B0); PG8_MMA(1, 1, At, B1); PG8_BAR; PG8_SCHED;
            PG8_LDB(B0, 1, 0); PG8_LDB(B1, 1, 1); PG8_SCHED; PG8_LDA(At, 1, 0); PG8_STAGE(PG8_SA(0, 1), a2 + hstep, voffA);
            PG8_WAIT_V(8); PG8_WAIT_L(0); PG8_BAR; PG8_MMA(0, 0, At, B0); PG8_MMA(0, 1, At, B1); PG8_BAR; PG8_SCHED;
            PG8_LDA(At, 1, 1); PG8_STAGE(PG8_SB(1, 0), b3, voffB); PG8_STAGE(PG8_SB(1, 1), b3 + hstep, voffB); PG8_STAGE(PG8_SA(1, 0), a3, voffA);
            PG8_WAIT_V(8); PG8_WAIT_L(0); PG8_BAR; PG8_MMA(1, 0, At, B0); PG8_MMA(1, 1, At, B1); PG8_BAR; PG8_SCHED;
            } else {
            PG8_LDB(B0, 0, 0); PG8_SCHED; PG8_LDA(At, 0, 0); PG8_STAGE(PG8_SA(1, 1), a1 + hstep, voffA);
            PG8_WAIT_L(8); PG8_BAR; PG8_WAIT_L(0); PG8_MMA(0, 0, At, B0); PG8_BAR; PG8_SCHED;
            PG8_LDB(B1, 0, 1); PG8_STAGE(PG8_SB(0, 0), b2, voffB);
            PG8_BAR; PG8_WAIT_L(0); PG8_MMA(0, 1, At, B1); PG8_BAR;
            PG8_LDA(At, 0, 1); PG8_STAGE(PG8_SA(0, 0), a2, voffA);
            PG8_BAR; PG8_WAIT_L(0); PG8_MMA(1, 0, At, B0); PG8_BAR; PG8_SCHED;
            PG8_STAGE(PG8_SB(0, 1), b2 + hstep, voffB);
            PG8_WAIT_V(6); PG8_BAR; PG8_MMA(1, 1, At, B1); PG8_BAR;
            PG8_LDB(B0, 1, 0); PG8_SCHED; PG8_LDA(At, 1, 0); PG8_STAGE(PG8_SA(0, 1), a2 + hstep, voffA);
            PG8_WAIT_L(8); PG8_BAR; PG8_WAIT_L(0); PG8_MMA(0, 0, At, B0); PG8_BAR; PG8_SCHED;
            PG8_LDB(B1, 1, 1); PG8_STAGE(PG8_SB(1, 0), b3, voffB);
            PG8_BAR; PG8_WAIT_L(0); PG8_MMA(0, 1, At, B1); PG8_BAR;
            PG8_LDA(At, 1, 1); PG8_STAGE(PG8_SA(1, 0), a3, voffA);
            PG8_BAR; PG8_WAIT_L(0); PG8_MMA(1, 0, At, B0); PG8_BAR; PG8_SCHED;
            PG8_STAGE(PG8_SB(1, 1), b3 + hstep, voffB);
            PG8_WAIT_V(6); PG8_BAR; PG8_MMA(1, 1, At, B1); PG8_BAR;
            }
        }
        if constexpr (ALIGN_EPI) { if (wr == 0) PG8_BAR; }
        if constexpr (!Epi::AFTER_DRAIN) { E(acc, cur, wr, wc, fr, fq); S.done(cur); }
        if (!has_next) break;
#pragma unroll
        for (int a = 0; a < 2; ++a)
#pragma unroll
            for (int b = 0; b < 2; ++b)
#pragma unroll
                for (int m = 0; m < 4; ++m)
#pragma unroll
                    for (int n = 0; n < 2; ++n) acc[a][b][m][n] = (f32x4){0.f, 0.f, 0.f, 0.f};
        cur = nxt; cA = nA; cB = nB; ++ui;
        if constexpr (ALIGN_EPI) { if (wr == 1) PG8_BAR; }
    }
    PG8_WAIT_V(0);
    if constexpr (!ALIGN_EPI) { if (wr == 0) PG8_BAR; }
    PG8_BAR;
    if constexpr (Epi::AFTER_DRAIN) { E.fused(acc, cur, wr, wc, fr, fq, lds, wid, lane); S.done(cur); }
#undef PG8_SA
#undef PG8_SB
#undef PG8_STAGE
#undef PG8_LDA
#undef PG8_LDB
#undef PG8_MMA
#undef PG8_WAIT_V
#undef PG8_WAIT_L
#undef PG8_BAR
#undef PG8_SCHED
}
}
namespace da {
#define DA_LAS __attribute__((address_space(3)))
typedef short bf16x8 __attribute__((ext_vector_type(8)));
typedef short s16x4 __attribute__((ext_vector_type(4)));
typedef float f32x16 __attribute__((ext_vector_type(16)));
typedef float f32x4 __attribute__((ext_vector_type(4)));
typedef unsigned u32x4 __attribute__((ext_vector_type(4)));
typedef unsigned u32x2 __attribute__((ext_vector_type(2)));
constexpr int KSTR = 144, VSTR = 320;
constexpr int K_BYTES = 64 * KSTR, V_BYTES = 64 * VSTR, STAGE = 2 * K_BYTES + V_BYTES;
constexpr float THR = 4.0f;
__device__ __forceinline__ unsigned cvt_pk(float lo, float hi) { unsigned r; asm volatile("v_cvt_pk_bf16_f32 %0, %1, %2" : "=v"(r) : "v"(lo), "v"(hi)); return r; }
__device__ __forceinline__ s16x4 vtr(const DA_LAS unsigned char* p) { typedef short v4i16_t __attribute__((ext_vector_type(4)));
    return __builtin_bit_cast(s16x4, __builtin_amdgcn_ds_read_tr16_b64_v4i16((DA_LAS v4i16_t*)p)); }

__device__ __forceinline__ void dattn_phase(DA_LAS unsigned char* lds, const bf16_t* U, const float* lamp, const float* subln_g, bf16_t* MIX, int vcu, int G) {
    const int tid = threadIdx.x, lane = tid & 63, wave = __builtin_amdgcn_readfirstlane(tid >> 6), comp = wave >> 2, qs = wave & 3;
    const int r32 = lane & 31, hh = lane >> 5, gi = lane >> 4, li = lane & 15;
    const float lam = lamp[0];
    const int krow = tid >> 3, kch = tid & 7, vrow0 = tid >> 4, vch = tid & 15;
    const int kdst = krow * KSTR + kch * 16, vdst0 = vrow0 * VSTR + vch * 16, vdst1 = (vrow0 + 32) * VSTR + vch * 16;
    const int kfrag = r32 * KSTR + hh * 16;
    const int vfrag = (4 * hh + (li >> 2)) * VSTR + (16 * (gi & 1) + 4 * (li & 3)) * 2;
    for (int u = vcu; u < BATCH * 4 * 16; u += G) {
        const int qb = u & 15, h = (u >> 4) & 3, b = u >> 6;
        const bf16_t* Ub = U + (size_t)b * SEQ * NU;
        const bf16_t* ksrc0 = Ub + (size_t)krow * NU + U_DK + (2 * h) * 64 + kch * 8;
        const bf16_t* ksrc1 = ksrc0 + 64;
        const bf16_t* vsrc0 = Ub + (size_t)vrow0 * NU + U_DV + h * 128 + vch * 8;
        const bf16_t* vsrc1 = vsrc0 + (size_t)32 * NU;
        bf16x8 qf[4];
        { const bf16_t* qp = Ub + (size_t)(qb * 128 + qs * 32 + r32) * NU + U_DQ + (2 * h + comp) * 64 + hh * 8;
#pragma unroll
          for (int ds = 0; ds < 4; ++ds) qf[ds] = *(const bf16x8*)(qp + ds * 16); }
        f32x16 o[4];
#pragma unroll
        for (int d0 = 0; d0 < 4; ++d0)
#pragma unroll
            for (int r = 0; r < 16; ++r) o[d0][r] = 0.f;
        float m = -INFINITY, l = 0.f;
        u32x4 rk0 = *(const u32x4*)ksrc0, rk1 = *(const u32x4*)ksrc1, rv0 = *(const u32x4*)vsrc0, rv1 = *(const u32x4*)vsrc1;
        *(DA_LAS u32x4*)(lds + kdst) = rk0; *(DA_LAS u32x4*)(lds + K_BYTES + kdst) = rk1; *(DA_LAS u32x4*)(lds + 2 * K_BYTES + vdst0) = rv0; *(DA_LAS u32x4*)(lds + 2 * K_BYTES + vdst1) = rv1;
        __syncthreads();
        for (int t = 0; t < SEQ / 64; ++t) {
            const DA_LAS unsigned char* st = lds + (t & 1) * STAGE;
            DA_LAS unsigned char* nst = lds + ((t + 1) & 1) * STAGE;
            if (t + 1 < SEQ / 64) { const size_t go = (size_t)(t + 1) * 64 * NU; rk0 = *(const u32x4*)(ksrc0 + go); rk1 = *(const u32x4*)(ksrc1 + go); rv0 = *(const u32x4*)(vsrc0 + go); rv1 = *(const u32x4*)(vsrc1 + go); }
            const DA_LAS unsigned char* Kt = st + comp * K_BYTES + kfrag;
            f32x16 p0, p1;
#pragma unroll
            for (int r = 0; r < 16; ++r) { p0[r] = 0.f; p1[r] = 0.f; }
#pragma unroll
            for (int ds = 0; ds < 4; ++ds) {
                const bf16x8 a0 = *(const DA_LAS bf16x8*)(Kt + ds * 32), a1 = *(const DA_LAS bf16x8*)(Kt + 32 * KSTR + ds * 32);
                p0 = __builtin_amdgcn_mfma_f32_32x32x16_bf16(a0, qf[ds], p0, 0, 0, 0);
                p1 = __builtin_amdgcn_mfma_f32_32x32x16_bf16(a1, qf[ds], p1, 0, 0, 0);
            }
            float mx = fmaxf(p0[0], p1[0]);
#pragma unroll
            for (int r = 1; r < 16; ++r) mx = fmaxf(mx, fmaxf(p0[r], p1[r]));
            mx = fmaxf(mx, __shfl_xor(mx, 32));
            if (!__all(mx - m <= THR)) {
                const float mn = fmaxf(m, mx), alpha = __builtin_amdgcn_exp2f(m - mn);
                m = mn; l *= alpha;
#pragma unroll
                for (int d0 = 0; d0 < 4; ++d0) o[d0] = o[d0] * alpha;
            }
            float rs = 0.f;
#pragma unroll
            for (int r = 0; r < 16; ++r) { p0[r] = __builtin_amdgcn_exp2f(p0[r] - m); p1[r] = __builtin_amdgcn_exp2f(p1[r] - m); rs += p0[r] + p1[r]; }
            l += rs;
            bf16x8 pf[4];
#pragma unroll
            for (int s = 0; s < 2; ++s) {
                u32x4 w0, w1;
                w0.x = cvt_pk(p0[8 * s + 0], p0[8 * s + 1]); w0.y = cvt_pk(p0[8 * s + 2], p0[8 * s + 3]); w0.z = cvt_pk(p0[8 * s + 4], p0[8 * s + 5]); w0.w = cvt_pk(p0[8 * s + 6], p0[8 * s + 7]);
                w1.x = cvt_pk(p1[8 * s + 0], p1[8 * s + 1]); w1.y = cvt_pk(p1[8 * s + 2], p1[8 * s + 3]); w1.z = cvt_pk(p1[8 * s + 4], p1[8 * s + 5]); w1.w = cvt_pk(p1[8 * s + 6], p1[8 * s + 7]);
                pf[s] = __builtin_bit_cast(bf16x8, w0); pf[2 + s] = __builtin_bit_cast(bf16x8, w1);
            }
            const DA_LAS unsigned char* Vt = st + 2 * K_BYTES + vfrag;
#pragma unroll
            for (int d0 = 0; d0 < 4; ++d0)
#pragma unroll
                for (int ks = 0; ks < 4; ++ks) {
                    const s16x4 lo = vtr(Vt + (16 * ks) * VSTR + 64 * d0), hi = vtr(Vt + (16 * ks + 8) * VSTR + 64 * d0);
                    const bf16x8 av = (bf16x8){lo[0], lo[1], lo[2], lo[3], hi[0], hi[1], hi[2], hi[3]};
                    o[d0] = __builtin_amdgcn_mfma_f32_32x32x16_bf16(av, pf[ks], o[d0], 0, 0, 0);
                }
            if (t + 1 < SEQ / 64) { *(DA_LAS u32x4*)(nst + kdst) = rk0; *(DA_LAS u32x4*)(nst + K_BYTES + kdst) = rk1; *(DA_LAS u32x4*)(nst + 2 * K_BYTES + vdst0) = rv0; *(DA_LAS u32x4*)(nst + 2 * K_BYTES + vdst1) = rv1; }
            __syncthreads();
        }
        l += __shfl_xor(l, 32);
        const float il = 1.f / l;
        DA_LAS float* xch = (DA_LAS float*)lds + (size_t)qs * 64 * 64 + lane;
        if (comp == 1) {
#pragma unroll
            for (int d0 = 0; d0 < 4; ++d0)
#pragma unroll
                for (int r = 0; r < 16; ++r) xch[(d0 * 16 + r) * 64] = o[d0][r] * il;
        }
        __syncthreads();
        if (comp == 0) {
            float ss = 0.f;
#pragma unroll
            for (int d0 = 0; d0 < 4; ++d0)
#pragma unroll
                for (int r = 0; r < 16; ++r) { const float v = o[d0][r] * il - lam * xch[(d0 * 16 + r) * 64]; o[d0][r] = v; ss += v * v; }
            ss += __shfl_xor(ss, 32);
            const float rn = (1.f - LAMBDA_INIT) / sqrtf(ss * (1.f / 128.f) + RMS_EPS);
            bf16_t* orow = MIX + (size_t)(b * SEQ + qb * 128 + qs * 32 + r32) * DM + 512 + h * 128 + 4 * hh;
#pragma unroll
            for (int d0 = 0; d0 < 4; ++d0)
#pragma unroll
                for (int rq = 0; rq < 4; ++rq) {
                    const f32x4 g4 = *(const f32x4*)(subln_g + 32 * d0 + 8 * rq + 4 * hh);
                    u32x2 w; w.x = cvt_pk(o[d0][4 * rq] * rn * g4[0], o[d0][4 * rq + 1] * rn * g4[1]); w.y = cvt_pk(o[d0][4 * rq + 2] * rn * g4[2], o[d0][4 * rq + 3] * rn * g4[3]);
                    *(u32x2*)(orow + 32 * d0 + 8 * rq) = w;
                }
        }
        __syncthreads();
    }
}
}
namespace cg = cooperative_groups;
#ifndef USE_MFMA_DATTN
#define USE_MFMA_DATTN 1
#endif
constexpr int NWAVES = 8;
constexpr int LDS_BYTES = 147456;
enum { PH_PROLOGUE = 0, PH_INPROJ, PH_HGRN, PH_HGRN_COMB, PH_DATTN, PH_DATTN_COMB, PH_MIXGEMM, PH_LN1, PH_QPROJ, PH_XA_SCORES, PH_XA_SOFTMAX, PH_XA_PV, PH_XA_CVT,
       PH_WOGEMM, PH_LN2, PH_TOPK, PH_MOE1, PH_MOE2, PH_FINAL, PH_COUNT };
struct MKArgs { const float* in[27]; float* out; unsigned char* ws; int ph_lo, ph_hi; };

__global__ void __launch_bounds__(NWAVES * 64, 2) mk_fwd(MKArgs a) {
    extern __shared__ __attribute__((aligned(16))) unsigned char lds_raw[];
    PG8_LAS unsigned char* lds = (PG8_LAS unsigned char*)lds_raw;
    float* smem = (float*)lds_raw;
    unsigned char* ws = a.ws;
    const int G = gridDim.x, bx = blockIdx.x;
    const int vcu = (G % 8 == 0) ? (bx % 8) * (G / 8) + bx / 8 : bx;
    const int lo = a.ph_lo, hi = a.ph_hi;
#define IN(k) (lo <= (k) && (k) < hi)
#define SEAM(k) do { if (IN(k) && IN((k) + 1)) cg::this_grid().sync(); } while (0)
    float* H = a.out;
    float* ROPE = (float*)(ws + WS_ROPE); float* LB = (float*)(ws + WS_LB); float* LAM = LB + 1024;
    float* AFF = (float*)(ws + WS_AFF); int* INV = (int*)(ws + WS_INV); int* IDX = (int*)(ws + WS_IDX); float* GATE = (float*)(ws + WS_GATE);
    bf16_t* XN = (bf16_t*)(ws + WS_XN); bf16_t* MIX = (bf16_t*)(ws + WS_MIX); bf16_t* U = (bf16_t*)(ws + WS_U); bf16_t* XS = (bf16_t*)(ws + WS_XS);
    bf16_t* KV = (bf16_t*)(ws + WS_KV); bf16_t* MEMB = (bf16_t*)(ws + WS_MEMB);
    float* SC_XS = (float*)(ws + WS_XS);
    bf16_t* P = XN;

    if (IN(PH_PROLOGUE)) {
        sp_prep_small(a.in[5], a.in[7], a.in[8], a.in[9], a.in[10], ROPE, LB);
        sp_transpose(smem, a.in[4], DM, NU, (bf16_t*)(ws + WS_WIN), 0, 0, 0, 1);
        sp_transpose(smem, a.in[16], DM, DM, (bf16_t*)(ws + WS_WKV), 0, 0, 0, 1);
        sp_transpose(smem, a.in[17], DM, DM, (bf16_t*)(ws + WS_WKV) + (size_t)DM * DM, 0, 0, 0, 1);
        sp_transpose(smem, a.in[12], DM, DM, (bf16_t*)(ws + WS_WMIX), 0, 0, 0, 1);
        sp_transpose(smem, a.in[15], DM, DM, (bf16_t*)(ws + WS_WQ), 0, 0, 0, 1);
        sp_transpose(smem, a.in[18], DM, DM, (bf16_t*)(ws + WS_WO), 0, 0, 0, 1);
        sp_transpose(smem, a.in[22], DM, DFF, (bf16_t*)(ws + WS_WGU), 1, (long)DM * DFF, (long)2 * DFF * DM, NEXP);
        sp_transpose(smem, a.in[23], DM, DFF, (bf16_t*)(ws + WS_WGU), 2, (long)DM * DFF, (long)2 * DFF * DM, NEXP);
        sp_transpose(smem, a.in[24], DFF, DM, (bf16_t*)(ws + WS_WD), 0, (long)DFF * DM, (long)DFF * DM, NEXP);
        sp_cvt_bf16(a.in[1], MEMB, (long)NMEM * DM);
        sp_ln_rows<0>(a.in[0], a.in[2], a.in[3], H, XN, nullptr, nullptr);
    }
    SEAM(PH_PROLOGUE);
    if (IN(PH_INPROJ)) {
        {
            pg8::Gemm g{XN, (const bf16_t*)(ws + WS_WIN), NTOK, NU, DM}; pg8::StaticOrder S; S.init(NTOK, NU, G, bx);
            pg8::EpiStore E{U, NU, 1.f, 1, ROPE};
            pg8::gemm_phase<pg8::EpiStore, pg8::StaticOrder, true, true>(lds, g, S, E);
        }
        {
            pg8::Gemm g{MEMB, (const bf16_t*)(ws + WS_WKV), NMEM, 2048, DM}; pg8::StaticOrder S; S.init(NMEM, 2048, G, bx);
            pg8::EpiStore E{KV, 2048, 1.f, 0, nullptr};
            pg8::gemm_phase<pg8::EpiStore, pg8::StaticOrder, true, true>(lds, g, S, E);
        }
    }
    SEAM(PH_INPROJ);
    if (IN(PH_HGRN)) sp_hgrn(smem, U, LB, SC_XS);
    SEAM(PH_HGRN);
    if (IN(PH_HGRN_COMB)) sp_hgrn_combine(SC_XS, U, a.in[6], MIX);
    SEAM(PH_HGRN_COMB);
#if USE_MFMA_DATTN
    if (IN(PH_DATTN)) da::dattn_phase(lds, U, LAM, a.in[11], MIX, vcu, G);
    SEAM(PH_DATTN);
    SEAM(PH_DATTN_COMB);
#else
    if (IN(PH_DATTN)) sp_dattn(smem, U, SC_XS);
    SEAM(PH_DATTN);
    if (IN(PH_DATTN_COMB)) sp_dattn_combine(SC_XS, LAM, a.in[11], MIX);
    SEAM(PH_DATTN_COMB);
#endif
    if (IN(PH_MIXGEMM)) {
        pg8::Gemm g{MIX, (const bf16_t*)(ws + WS_WMIX), NTOK, DM, DM}; pg8::StaticOrder S; S.init(NTOK, DM, G, bx);
        pg8::EpiResid E{H, ALPHA};
        pg8::gemm_phase<pg8::EpiResid, pg8::StaticOrder, true, true>(lds, g, S, E);
    }
    SEAM(PH_MIXGEMM);
    if (IN(PH_LN1)) sp_ln_rows<1>(nullptr, a.in[13], a.in[14], H, XN, nullptr, nullptr);
    SEAM(PH_LN1);
    if (IN(PH_QPROJ)) {
        pg8::Gemm g{XN, (const bf16_t*)(ws + WS_WQ), NTOK, DM, DM}; pg8::StaticOrder S; S.init(NTOK, DM, G, bx);
        pg8::EpiStore E{MIX, DM, pg8::QSCALE_XA, 0, nullptr};
        pg8::gemm_phase<pg8::EpiStore, pg8::StaticOrder, true, true>(lds, g, S, E);
    }
    SEAM(PH_QPROJ);
    if (IN(PH_XA_SCORES))
        for (int b = 0; b < BATCH; ++b)
            sp_gemm(smem, MIX + (size_t)b * SEQ * DM, 256, DM, KV + (size_t)b * MEML * 2048, 256, 2048, 1, SC_XS + (size_t)b * 4 * SEQ * 256, (long)SEQ * 256, 256, SEQ, 256, 256, 4);
    SEAM(PH_XA_SCORES);
    if (IN(PH_XA_SOFTMAX)) sp_softmax256(SC_XS, P, (long)BATCH * 4 * SEQ);
    SEAM(PH_XA_SOFTMAX);
    if (IN(PH_XA_PV))
        for (int b = 0; b < BATCH; ++b)
            sp_gemm(smem, P + (size_t)b * 4 * SEQ * 256, (long)SEQ * 256, 256, KV + (size_t)b * MEML * 2048 + 1024, 256, 1, 2048, SC_XS + (size_t)b * SEQ * DM, 256, DM, SEQ, 256, 256, 4);
    SEAM(PH_XA_PV);
    if (IN(PH_XA_CVT)) sp_cvt2d(SC_XS, DM, MIX, DM, NTOK, DM);
    SEAM(PH_XA_CVT);
    if (IN(PH_WOGEMM)) {
        pg8::Gemm g{MIX, (const bf16_t*)(ws + WS_WO), NTOK, DM, DM}; pg8::StaticOrder S; S.init(NTOK, DM, G, bx);
        pg8::EpiResid E{H, ALPHA};
        pg8::gemm_phase<pg8::EpiResid, pg8::StaticOrder, true, true>(lds, g, S, E);
    }
    SEAM(PH_WOGEMM);
    if (IN(PH_LN2)) sp_ln_rows<2>(nullptr, a.in[19], a.in[20], H, XN, a.in[21], AFF);
    SEAM(PH_LN2);
    if (IN(PH_TOPK)) sp_topk_gather(smem, AFF, XN, IDX, GATE, INV, XS);
    SEAM(PH_TOPK);
    if (IN(PH_MOE1)) {
        pg8::Gemm g{XS, (const bf16_t*)(ws + WS_WGU), NGRP * CAP, NEXP * 4096, DM}; pg8::MoeOrder<1> S{G, bx};
        pg8::EpiSwiglu E{U};
        pg8::gemm_phase<pg8::EpiSwiglu, pg8::MoeOrder<1>, true, true>(lds, g, S, E);
    }
    SEAM(PH_MOE1);
    if (IN(PH_MOE2)) {
        pg8::Gemm g{U, (const bf16_t*)(ws + WS_WD), NGRP * CAP, NEXP * DM, DFF}; pg8::MoeOrder<2> S{G, bx};
        pg8::EpiYGate E{XS, GATE};
        pg8::gemm_phase<pg8::EpiYGate, pg8::MoeOrder<2>, true, true>(lds, g, S, E);
    }
    SEAM(PH_MOE2);
    if (IN(PH_FINAL)) sp_final(H, XS, INV, a.in[25], a.in[26]);
#undef IN
#undef SEAM
}

#ifndef MK_PER_PHASE
#define MK_PER_PHASE 0
#endif
extern "C" void kernel_launch(void* const* d_in, const int* in_sizes, int n_in, void* d_out, int out_size, void* d_ws, size_t ws_size, hipStream_t stream) {
    if (n_in != 27 || out_size != NTOK * DM || ws_size < WS_END) { fprintf(stderr, "kernel_launch: unexpected shapes (n_in %d out %d ws %zu)\n", n_in, out_size, ws_size); return; }
    static int grid = 0;
    if (grid == 0) {
        int dev = 0, cus = 0, per_cu = 0;
        (void)hipGetDevice(&dev); (void)hipDeviceGetAttribute(&cus, hipDeviceAttributeMultiprocessorCount, dev);
        (void)hipFuncSetAttribute((const void*)mk_fwd, hipFuncAttributeMaxDynamicSharedMemorySize, LDS_BYTES);
        (void)hipOccupancyMaxActiveBlocksPerMultiprocessor(&per_cu, (const void*)mk_fwd, NWAVES * 64, LDS_BYTES);
        (void)hipGetLastError();
        if (per_cu < 1) { fprintf(stderr, "kernel_launch: occupancy query says %d blocks/CU\n", per_cu); per_cu = 1; }
        grid = cus;
    }
    MKArgs ka{};
    for (int i = 0; i < 27; ++i) ka.in[i] = (const float*)d_in[i];
    ka.out = (float*)d_out; ka.ws = (unsigned char*)d_ws;
#if MK_PER_PHASE
    for (int p = 0; p < PH_COUNT; ++p) { MKArgs k2 = ka; k2.ph_lo = p; k2.ph_hi = p + 1; hipLaunchKernelGGL(mk_fwd, dim3(grid), dim3(NWAVES * 64), LDS_BYTES, stream, k2); }
#else
    ka.ph_lo = 0; ka.ph_hi = PH_COUNT;
    void* args[] = {&ka};
    hipError_t e = hipLaunchCooperativeKernel((const void*)mk_fwd, dim3(grid), dim3(NWAVES * 64), args, LDS_BYTES, stream);
    if (e != hipSuccess) fprintf(stderr, "kernel_launch: cooperative launch failed: %s (grid %d)\n", hipGetErrorString(e), grid);
#endif
}
```

```cpp
#include <hip/hip_runtime.h>
#include <hip/hip_cooperative_groups.h>
#include <cstdint>
#include <cstdio>

typedef unsigned short bf16_t;

constexpr int BATCH = 8, SEQ = 2048, DM = 1024, NTOK = BATCH * SEQ;
constexpr int MEML = 256, NMEM = BATCH * MEML;
constexpr int NU = 4096;
constexpr int U_HQ = 0, U_HI = 512, U_HG = 1024, U_HFF = 1536, U_HFB = 2048, U_DQ = 2560, U_DK = 3072, U_DV = 3584;
constexpr int NEXP = 16, CAP = 256, DFF = 2048, NGRP = BATCH * NEXP;
constexpr float ALPHA = 1.189207115002721f;
constexpr float LN_EPS = 1e-5f, RMS_EPS = 1e-6f;
constexpr float LAMBDA_INIT = 0.2f;

constexpr size_t MiB = 1u << 20;
constexpr size_t WS_CTL = 0;
constexpr size_t WS_ROPE = 1 * MiB;
constexpr size_t WS_LB = WS_ROPE + 256 * 1024;
constexpr size_t WS_AFF = 2 * MiB;
constexpr size_t WS_INV = 3 * MiB;
constexpr size_t WS_IDX = 4 * MiB;
constexpr size_t WS_GATE = 4 * MiB + 512 * 1024;
constexpr size_t WS_WIN = 5 * MiB;
constexpr size_t WS_WKV = 13 * MiB;
constexpr size_t WS_WMIX = 17 * MiB;
constexpr size_t WS_WQ = 19 * MiB;
constexpr size_t WS_WO = 21 * MiB;
constexpr size_t WS_WGU = 23 * MiB;
constexpr size_t WS_WD = 151 * MiB;
constexpr size_t WS_U = 215 * MiB;
constexpr size_t WS_XN = 343 * MiB;
constexpr size_t WS_MIX = 375 * MiB;
constexpr size_t WS_KV = 407 * MiB;
constexpr size_t WS_XS = 415 * MiB;
constexpr size_t WS_MEMB = 479 * MiB;
constexpr size_t WS_END = 483 * MiB;

__device__ __forceinline__ unsigned f2bf(float f) { unsigned u = __builtin_bit_cast(unsigned, f); return (u + 0x7fffu + ((u >> 16) & 1u)) >> 16; }
__device__ __forceinline__ float bf2f(bf16_t b) { return __builtin_bit_cast(float, (unsigned)b << 16); }
__device__ __forceinline__ float wave_sum(float v) {
#pragma unroll
    for (int o = 1; o < 64; o <<= 1) v += __shfl_xor(v, o);
    return v;
}
__device__ __forceinline__ float silu_f(float x) { return x / (1.f + expf(-x)); }
__device__ __forceinline__ float sigmoid_f(float x) { return 1.f / (1.f + expf(-x)); }

#define VB_LOOP(NT, nvb, vb, valid, tid, sub) \
    for (int _r = 0, _sub = (int)threadIdx.x / (NT), tid = (int)threadIdx.x % (NT), sub = _sub, _pr = (int)gridDim.x * (512 / (NT)), _nr = ((nvb) + _pr - 1) / _pr, vb = 0, valid = 0; \
         _r < _nr && ((vb = (_r * (int)gridDim.x + (int)blockIdx.x) * (512 / (NT)) + _sub), (valid = vb < (nvb)), true); ++_r)

__device__ __forceinline__ void sp_prep_small(const float* lb_logits, const float* lq1, const float* lk1, const float* lq2, const float* lk2, float* rope, float* lb) {
    for (int i = blockIdx.x * 512 + threadIdx.x; i < SEQ * 8; i += gridDim.x * 512) {
        const int t = i / 8, j = i % 8;
        const float inv = (float)(1.0 / pow(500000.0, (double)j / 8.0));
        const float ang = (float)t * inv;
        rope[t * 16 + j] = (float)cos((double)ang);
        rope[t * 16 + 8 + j] = (float)sin((double)ang);
        if (i < 1024) {
            const int d = i / 512, c = i % 512;
            const float l0 = lb_logits[d * 1024 + c], l1 = lb_logits[d * 1024 + 512 + c];
            const float m = fmaxf(l0, l1); const float e0 = expf(l0 - m), e1 = expf(l1 - m);
            lb[i] = e0 / (e0 + e1);
        }
        if (i == 0) {
            float s1 = 0.f, s2 = 0.f;
            for (int k = 0; k < 64; ++k) { s1 += lq1[k] * lk1[k]; s2 += lq2[k] * lk2[k]; }
            lb[1024] = expf(s1) - expf(s2) + LAMBDA_INIT;
        }
    }
}
__device__ __forceinline__ void sp_transpose(float* smem, const float* W, int K, int N, bf16_t* WT, int mode, long src_zs, long dst_zs, int nz) {
    const int nbx = N / 32, nby = K / 32, nvb = nbx * nby * nz;
    VB_LOOP(256, nvb, vb, valid, tid, sub) {
        float* t = smem + sub * (32 * 33);
        const int z = vb / (nbx * nby), rem = vb % (nbx * nby), by = rem / nbx, bxx = rem % nbx;
        const float* Wz = W + (long)z * src_zs; bf16_t* WTz = WT + (long)z * dst_zs;
        const int k0 = by * 32, n0 = bxx * 32, tx = tid & 31, ty = tid >> 5;
        if (valid) for (int i = ty; i < 32; i += 8) t[i * 33 + tx] = Wz[(long)(k0 + i) * N + n0 + tx];
        __syncthreads();
        if (valid) for (int i = ty; i < 32; i += 8) {
            const int n = n0 + i; long r = n;
            if (mode == 1) r = (long)(n / 128) * 256 + (n % 128);
            if (mode == 2) r = (long)(n / 128) * 256 + 128 + (n % 128);
            WTz[r * K + k0 + tx] = (bf16_t)f2bf(t[tx * 33 + i]);
        }
        __syncthreads();
    }
}
__device__ __forceinline__ void sp_cvt_bf16(const float* src, bf16_t* dst, long n) {
    for (long i = (long)blockIdx.x * 512 + threadIdx.x; i < n; i += (long)gridDim.x * 512) dst[i] = (bf16_t)f2bf(src[i]);
}

template <int MODE>
__device__ __forceinline__ void sp_ln_rows(const float* X, const float* g, const float* b, float* H, bf16_t* XN, const float* wr, float* AFF) {
    const int lane = threadIdx.x & 63;
    for (int row = blockIdx.x * 8 + (threadIdx.x >> 6); row < NTOK; row += gridDim.x * 8) {
        float4 v[4]; float s = 0.f;
#pragma unroll
        for (int j = 0; j < 4; ++j) {
            const long off = (long)row * DM + 4 * lane + 256 * j;
            v[j] = (MODE == 0) ? *(const float4*)(X + off) : *(const float4*)(H + off);
            s += (v[j].x + v[j].y) + (v[j].z + v[j].w);
        }
        const float mean = wave_sum(s) * (1.f / DM); float s2 = 0.f;
#pragma unroll
        for (int j = 0; j < 4; ++j) { v[j].x -= mean; v[j].y -= mean; v[j].z -= mean; v[j].w -= mean; s2 += (v[j].x * v[j].x + v[j].y * v[j].y) + (v[j].z * v[j].z + v[j].w * v[j].w); }
        const float rstd = 1.f / sqrtf(wave_sum(s2) * (1.f / DM) + LN_EPS);
#pragma unroll
        for (int j = 0; j < 4; ++j) {
            const int c = 4 * lane + 256 * j; const float4 gg = *(const float4*)(g + c), bb = *(const float4*)(b + c);
            v[j].x = v[j].x * rstd * gg.x + bb.x; v[j].y = v[j].y * rstd * gg.y + bb.y; v[j].z = v[j].z * rstd * gg.z + bb.z; v[j].w = v[j].w * rstd * gg.w + bb.w;
            *(float4*)(H + (long)row * DM + c) = v[j];
            uint2 o; o.x = f2bf(v[j].x) | (f2bf(v[j].y) << 16); o.y = f2bf(v[j].z) | (f2bf(v[j].w) << 16);
            *(uint2*)(XN + (long)row * DM + c) = o;
        }
        if (MODE == 2) {
            float acc[16];
#pragma unroll
            for (int e = 0; e < 16; ++e) acc[e] = 0.f;
#pragma unroll
            for (int j = 0; j < 4; ++j) {
                const float vv[4] = {v[j].x, v[j].y, v[j].z, v[j].w};
#pragma unroll
                for (int i = 0; i < 4; ++i) {
                    const float4* w4 = (const float4*)(wr + (long)(4 * lane + 256 * j + i) * 16);
#pragma unroll
                    for (int q = 0; q < 4; ++q) { const float4 w = w4[q]; acc[4 * q] += vv[i] * w.x; acc[4 * q + 1] += vv[i] * w.y; acc[4 * q + 2] += vv[i] * w.z; acc[4 * q + 3] += vv[i] * w.w; }
                }
            }
            float m = -INFINITY;
#pragma unroll
            for (int e = 0; e < 16; ++e) { acc[e] = wave_sum(acc[e]); m = fmaxf(m, acc[e]); }
            float sum = 0.f;
#pragma unroll
            for (int e = 0; e < 16; ++e) { acc[e] = expf(acc[e] - m); sum += acc[e]; }
            if (lane == 0) {
#pragma unroll
                for (int q = 0; q < 4; ++q) *(float4*)(AFF + (long)row * 16 + 4 * q) = make_float4(acc[4 * q] / sum, acc[4 * q + 1] / sum, acc[4 * q + 2] / sum, acc[4 * q + 3] / sum);
            }
        }
    }
}

__device__ __forceinline__ void sp_gemm(float* smem, const bf16_t* A0, long sa_z, int lda, const bf16_t* B0, long sb_z, long sbn, long sbk, float* C0, long sc_z, int ldc, int M, int N, int K, int Z) {
    const int nbx = N / 64, nby = M / 64, nvb = nbx * nby * Z;
    VB_LOOP(256, nvb, vb, valid, tid, sub) {
        float* As = smem + sub * (2 * 16 * 65); float* Bs = As + 16 * 65;
        const int z = vb / (nbx * nby), rem = vb % (nbx * nby), by = rem / nbx, bxx = rem % nbx;
        const bf16_t* A = A0 + (long)z * sa_z; const bf16_t* B = B0 + (long)z * sb_z; float* C = C0 + (long)z * sc_z;
        const int m0 = by * 64, n0 = bxx * 64, tx = tid & 15, ty = tid >> 4;
        float acc[4][4];
#pragma unroll
        for (int i = 0; i < 4; ++i)
#pragma unroll
            for (int j = 0; j < 4; ++j) acc[i][j] = 0.f;
        for (int k0 = 0; k0 < K; k0 += 16) {
            if (valid) {
                for (int i = tid; i < 1024; i += 256) { const int m = i >> 4, k = i & 15; As[k * 65 + m] = bf2f(A[(long)(m0 + m) * lda + k0 + k]); }
                for (int i = tid; i < 1024; i += 256) { const int n = i >> 4, k = i & 15; Bs[k * 65 + n] = bf2f(B[(long)(n0 + n) * sbn + (long)(k0 + k) * sbk]); }
            }
            __syncthreads();
#pragma unroll
            for (int k = 0; k < 16; ++k) {
                float a[4], bb[4];
#pragma unroll
                for (int i = 0; i < 4; ++i) { a[i] = As[k * 65 + ty * 4 + i]; bb[i] = Bs[k * 65 + tx * 4 + i]; }
#pragma unroll
                for (int i = 0; i < 4; ++i)
#pragma unroll
                    for (int j = 0; j < 4; ++j) acc[i][j] += a[i] * bb[j];
            }
            __syncthreads();
        }
        if (valid) {
#pragma unroll
            for (int i = 0; i < 4; ++i)
#pragma unroll
                for (int j = 0; j < 4; ++j) C[(long)(m0 + ty * 4 + i) * ldc + n0 + tx * 4 + j] = acc[i][j];
        }
    }
}
__device__ __forceinline__ void sp_cvt2d(const float* SC, int ldsc, bf16_t* dst, int ldd, int rows, int cols) {
    const long n = (long)rows * cols;
    for (long i = (long)blockIdx.x * 512 + threadIdx.x; i < n; i += (long)gridDim.x * 512) { const int r = (int)(i / cols), c = (int)(i % cols); dst[(long)r * ldd + c] = (bf16_t)f2bf(SC[(long)r * ldsc + c]); }
}

__device__ __forceinline__ void sp_hgrn(float* smem, const bf16_t* U, const float* LB, float* OSC) {
    VB_LOOP(128, 8 * 4 * 16, vb, valid, k, sub) {
        float* red = smem + sub * 32;
        const int dvs = vb & 7, h = (vb >> 3) & 3, bz = vb >> 5, b = bz >> 1, dir = bz & 1;
        float S[16];
#pragma unroll
        for (int j = 0; j < 16; ++j) S[j] = 0.f;
        const float lbv = valid ? LB[dir * 512 + h * 128 + k] : 0.5f;
        for (int step = 0; step < SEQ; ++step) {
            const int t = dir ? (SEQ - 1 - step) : step; const long row = (long)(valid ? b : 0) * SEQ + t;
            const bf16_t* ur = U + row * NU;
            const float qv = bf2f(ur[U_HQ + h * 128 + k]);
            const float uf = bf2f(ur[(dir ? U_HFB : U_HFF) + h * 128 + k]);
            const float f = lbv + (1.f - lbv) * sigmoid_f(uf), kk = 1.f - f;
            float part[16];
#pragma unroll
            for (int j = 0; j < 16; ++j) { const float vv = bf2f(ur[U_HI + h * 128 + dvs * 16 + j]); S[j] = f * S[j] + kk * vv; part[j] = wave_sum(S[j] * qv); }
            if ((k & 63) == 0) {
#pragma unroll
                for (int j = 0; j < 16; ++j) red[(k >> 6) * 16 + j] = part[j];
            }
            __syncthreads();
            if (valid && k < 16) OSC[((long)dir * NTOK + row) * 512 + h * 128 + dvs * 16 + k] = red[k] + red[16 + k];
            __syncthreads();
        }
    }
}
__device__ __forceinline__ void sp_hgrn_combine(const float* OSC, const bf16_t* U, const float* ng, bf16_t* MIX) {
    const int lane = threadIdx.x & 63;
    for (long w = (long)blockIdx.x * 8 + (threadIdx.x >> 6); w < (long)NTOK * 4; w += (long)gridDim.x * 8) {
        const long row = w >> 2; const int h = (int)(w & 3);
        float o[2]; float ss = 0.f;
#pragma unroll
        for (int i = 0; i < 2; ++i) { const int d = lane + 64 * i; o[i] = OSC[row * 512 + h * 128 + d] + OSC[((long)NTOK + row) * 512 + h * 128 + d]; ss += o[i] * o[i]; }
        const float r = 1.f / sqrtf(wave_sum(ss) * (1.f / 128.f) + RMS_EPS);
#pragma unroll
        for (int i = 0; i < 2; ++i) { const int d = lane + 64 * i; const float y = o[i] * r * ng[h * 128 + d] * bf2f(U[row * NU + U_HG + h * 128 + d]); MIX[row * DM + h * 128 + d] = (bf16_t)f2bf(y); }
    }
}

__device__ __forceinline__ void sp_dattn(float* smem, const bf16_t* U, float* OSC) {
    VB_LOOP(256, 32 * 8 * 8, vb, valid, tid, sub) {
        float* Ks = smem + sub * (16 * 64 + 16 * 128); float* Vs = Ks + 16 * 64;
        const int qb = vb & 31, g = (vb >> 5) & 7, b = valid ? (vb >> 8) : 0, h = g >> 1, r = tid & 63, qt = tid >> 6;
        const long row = (long)b * SEQ + qb * 64 + r;
        float q[64], o[32];
#pragma unroll
        for (int d = 0; d < 64; ++d) q[d] = bf2f(U[row * NU + U_DQ + g * 64 + d]);
#pragma unroll
        for (int d = 0; d < 32; ++d) o[d] = 0.f;
        float m = -INFINITY, l = 0.f;
        for (int k0 = 0; k0 < SEQ; k0 += 16) {
            for (int i = tid; i < 16 * 64; i += 256) { const int kk = i >> 6, d = i & 63; Ks[kk * 64 + d] = bf2f(U[((long)b * SEQ + k0 + kk) * NU + U_DK + g * 64 + d]); }
            for (int i = tid; i < 16 * 128; i += 256) { const int kk = i >> 7, d = i & 127; Vs[kk * 128 + d] = bf2f(U[((long)b * SEQ + k0 + kk) * NU + U_DV + h * 128 + d]); }
            __syncthreads();
            float s[16]; float tm = m;
#pragma unroll
            for (int kk = 0; kk < 16; ++kk) { float a = 0.f;
#pragma unroll
                for (int d = 0; d < 64; ++d) a += q[d] * Ks[kk * 64 + d];
                s[kk] = a; tm = fmaxf(tm, a); }
            const float corr = exp2f(m - tm); m = tm; l *= corr;
#pragma unroll
            for (int d = 0; d < 32; ++d) o[d] *= corr;
#pragma unroll
            for (int kk = 0; kk < 16; ++kk) { const float p = exp2f(s[kk] - m); l += p;
#pragma unroll
                for (int d = 0; d < 32; ++d) o[d] += p * Vs[kk * 128 + qt * 32 + d]; }
            __syncthreads();
        }
        const float il = 1.f / l;
        if (valid) {
#pragma unroll
            for (int d = 0; d < 32; ++d) OSC[(row * 8 + g) * 128 + qt * 32 + d] = o[d] * il;
        }
    }
}
__device__ __forceinline__ void sp_dattn_combine(const float* OSC, const float* lamp, const float* sg, bf16_t* MIX) {
    const int lane = threadIdx.x & 63; const float lam = lamp[0];
    for (long w = (long)blockIdx.x * 8 + (threadIdx.x >> 6); w < (long)NTOK * 4; w += (long)gridDim.x * 8) {
        const long row = w >> 2; const int h = (int)(w & 3);
        float o[2]; float ss = 0.f;
#pragma unroll
        for (int i = 0; i < 2; ++i) { const int d = lane + 64 * i; o[i] = OSC[(row * 8 + 2 * h) * 128 + d] - lam * OSC[(row * 8 + 2 * h + 1) * 128 + d]; ss += o[i] * o[i]; }
        const float r = 1.f / sqrtf(wave_sum(ss) * (1.f / 128.f) + RMS_EPS);
#pragma unroll
        for (int i = 0; i < 2; ++i) { const int d = lane + 64 * i; MIX[row * DM + 512 + h * 128 + d] = (bf16_t)f2bf(o[i] * r * sg[d] * (1.f - LAMBDA_INIT)); }
    }
}

__device__ __forceinline__ void sp_softmax256(const float* S, bf16_t* P, long nrows) {
    const int lane = threadIdx.x & 63;
    for (long row = (long)blockIdx.x * 8 + (threadIdx.x >> 6); row < nrows; row += (long)gridDim.x * 8) {
        float4 v = *(const float4*)(S + row * 256 + 4 * lane);
        float m = fmaxf(fmaxf(v.x, v.y), fmaxf(v.z, v.w));
#pragma unroll
        for (int o = 1; o < 64; o <<= 1) m = fmaxf(m, __shfl_xor(m, o));
        v.x = exp2f(v.x - m); v.y = exp2f(v.y - m); v.z = exp2f(v.z - m); v.w = exp2f(v.w - m);
        const float il = 1.f / wave_sum((v.x + v.y) + (v.z + v.w));
        uint2 o; o.x = f2bf(v.x * il) | (f2bf(v.y * il) << 16); o.y = f2bf(v.z * il) | (f2bf(v.w * il) << 16);
        *(uint2*)(P + row * 256 + 4 * lane) = o;
    }
}

__device__ __forceinline__ void sp_topk_gather(float* smem, const float* AFF, const bf16_t* XN, int* IDX, float* GATE, int* INV, bf16_t* XS) {
    VB_LOOP(256, NGRP, grp, valid, tid, sub) {
        float* a = smem + sub * (SEQ + CAP); int* sel = (int*)(a + SEQ);
        const int b = valid ? (grp >> 4) : 0, e = grp & 15;
        for (int t = tid; t < SEQ; t += 256) a[t] = AFF[((long)b * SEQ + t) * 16 + e];
        __syncthreads();
        if (valid) for (int t = tid; t < SEQ; t += 256) {
            const float mine = a[t]; int rank = 0;
            for (int u = 0; u < SEQ; ++u) { const float x = a[u]; rank += (x > mine || (x == mine && u < t)) ? 1 : 0; }
            if (rank < CAP) { sel[rank] = t; IDX[grp * CAP + rank] = t; GATE[grp * CAP + rank] = mine; INV[((long)b * SEQ + t) * 16 + e] = rank; }
            else INV[((long)b * SEQ + t) * 16 + e] = -1;
        }
        __syncthreads();
        const int lane = tid & 63, wv = tid >> 6;
        if (valid) for (int r = wv; r < CAP; r += 4) {
            const uint4* src = (const uint4*)(XN + ((long)b * SEQ + sel[r]) * DM); uint4* dst = (uint4*)(XS + ((long)grp * CAP + r) * DM);
            dst[lane] = src[lane]; dst[lane + 64] = src[lane + 64];
        }
        __syncthreads();
    }
}

__device__ __forceinline__ void sp_final(float* H, const bf16_t* Y, const int* INV, const float* g, const float* b) {
    const int lane = threadIdx.x & 63;
    for (long row = (long)blockIdx.x * 8 + (threadIdx.x >> 6); row < NTOK; row += (long)gridDim.x * 8) {
        const int bt = (int)(row / SEQ);
        float4 v[4];
#pragma unroll
        for (int j = 0; j < 4; ++j) { const float4 h = *(const float4*)(H + row * DM + 4 * lane + 256 * j); v[j] = make_float4(ALPHA * h.x, ALPHA * h.y, ALPHA * h.z, ALPHA * h.w); }
        for (int e = 0; e < 16; ++e) {
            const int slot = INV[row * 16 + e];
            if (slot >= 0) {
                const bf16_t* yr = Y + ((long)(bt * 16 + e) * CAP + slot) * DM;
#pragma unroll
                for (int j = 0; j < 4; ++j) { const uint2 p = *(const uint2*)(yr + 4 * lane + 256 * j);
                    v[j].x += bf2f((bf16_t)(p.x & 0xffff)); v[j].y += bf2f((bf16_t)(p.x >> 16)); v[j].z += bf2f((bf16_t)(p.y & 0xffff)); v[j].w += bf2f((bf16_t)(p.y >> 16)); }
            }
        }
        float s = 0.f;
#pragma unroll
        for (int j = 0; j < 4; ++j) s += (v[j].x + v[j].y) + (v[j].z + v[j].w);
        const float mean = wave_sum(s) * (1.f / DM); float s2 = 0.f;
#pragma unroll
        for (int j = 0; j < 4; ++j) { v[j].x -= mean; v[j].y -= mean; v[j].z -= mean; v[j].w -= mean; s2 += (v[j].x * v[j].x + v[j].y * v[j].y) + (v[j].z * v[j].z + v[j].w * v[j].w); }
        const float rstd = 1.f / sqrtf(wave_sum(s2) * (1.f / DM) + LN_EPS);
#pragma unroll
        for (int j = 0; j < 4; ++j) {
            const int c = 4 * lane + 256 * j; const float4 gg = *(const float4*)(g + c), bb = *(const float4*)(b + c);
            float4 o; o.x = v[j].x * rstd * gg.x + bb.x; o.y = v[j].y * rstd * gg.y + bb.y; o.z = v[j].z * rstd * gg.z + bb.z; o.w = v[j].w * rstd * gg.w + bb.w;
            *(float4*)(H + row * DM + c) = o;
        }
    }
}
namespace pg8 {
#define PG8_LAS __attribute__((address_space(3)))
typedef unsigned short bf16_t;
typedef short bf16x8 __attribute__((ext_vector_type(8)));
typedef float f32x4 __attribute__((ext_vector_type(4)));
typedef unsigned u32x4 __attribute__((ext_vector_type(4)));
constexpr int BM = 256, BK = 64, HALF = 128, HTB = HALF * BK * 2  , STAGE_BYTES = 8 * HTB, NXCD = 8, WGM = 8;

__host__ __device__ __forceinline__ int lds_byte(int r, int c) { const int st = (r >> 4) * 2 + (c >> 5), rr = r & 15, cc = c & 31, ob = rr * 64 + cc * 2; return st * 1024 + (ob ^ (((ob >> 9) & 1) << 5)); }
__host__ __device__ __forceinline__ void stage_rc(int b, int& R, int& C) { const int st = b / 1024, sb = b % 1024, swz = sb ^ (((sb >> 9) & 1) << 5); R = (st >> 1) * 16 + swz / 64; C = (st & 1) * 32 + (swz % 64) / 2; }
__host__ __device__ __forceinline__ int perm32(int rho) { const int n = rho >> 4, i = rho & 15; return 8 * (i >> 2) + 4 * n + (i & 3); }

struct Unit { int pm, pn; };
struct Gemm { const bf16_t* A; const bf16_t* Bt; int M, N, K; };

struct StaticOrder {
    int nM, nN, nwg, G, c;
    __host__ __device__ void init(int M, int N, int G_, int c_) { nM = M / BM; nN = N / BM; nwg = nM * nN; G = G_; c = c_; }
    __host__ __device__ bool next(int i, Unit& u) const {
        const long L = (long)i * G + c; if (L >= nwg) return false;
        int wgid = (int)L; { const int q = nwg / NXCD, r = nwg % NXCD, xcd = wgid % NXCD, off = wgid / NXCD; wgid = (xcd < r ? xcd * (q + 1) : r * (q + 1) + (xcd - r) * q) + off; }
        const int nig = WGM * nN, gid = wgid / nig, fm = gid * WGM, gsz = (nM - fm) < WGM ? (nM - fm) : WGM;
        u.pm = fm + ((wgid % nig) % gsz); u.pn = (wgid % nig) / gsz; return true;
    }
    __device__ __forceinline__ void a_ready(const Unit&) const {}
    __device__ __forceinline__ void done(const Unit&) const {}
};

__device__ __forceinline__ unsigned cvt_pk_bf16(float lo, float hi) { unsigned r; asm volatile("v_cvt_pk_bf16_f32 %0, %1, %2" : "=v"(r) : "v"(lo), "v"(hi)); return r; }
typedef float f32x2 __attribute__((ext_vector_type(2)));
typedef unsigned u32x4 __attribute__((ext_vector_type(4)));
constexpr float QSCALE_DA = 0.125f * 1.4426950408889634f;
constexpr float QSCALE_XA = 0.0625f * 1.4426950408889634f;
__device__ __forceinline__ float silu_fast(float x) { return x * __builtin_amdgcn_rcpf(1.f + __builtin_amdgcn_exp2f(-1.4426950408889634f * x)); }

struct EpiStore {
    static constexpr bool PERM = true, AFTER_DRAIN = false;
    bf16_t* O; int ldc; float scale; int mode; const float* rope;
    __device__ __forceinline__ void operator()(const f32x4 (&acc)[2][2][4][2], const Unit& u, int wr, int wc, int fr, int fq) const {
        const int row0 = u.pm * BM + wr * 64 + fr, col0 = u.pn * BM + wc * 32 + 8 * fq;
        int op = 0; float sc = scale;
        if (mode == 1) { const int seg = u.pn >> 1; op = (seg == 0 || seg == 2) ? 1 : (seg == 5 ? 2 : (seg == 6 ? 3 : 0)); if (seg == 5) sc = QSCALE_DA; }
        const bool do_rope = (op >= 2) && !(wc & 1);
#pragma unroll
        for (int ai = 0; ai < 2; ++ai)
#pragma unroll
            for (int m = 0; m < 4; ++m) {
                const int row = row0 + ai * HALF + m * 16; bf16_t* rowp = O + (size_t)row * ldc + col0;
                f32x4 c0 = {1.f, 1.f, 1.f, 1.f}, c1 = c0, s0 = {0.f, 0.f, 0.f, 0.f}, s1 = s0;
                if (do_rope) { const float* rp = rope + (row & 2047) * 16; c0 = *(const f32x4*)rp; c1 = *(const f32x4*)(rp + 4); s0 = *(const f32x4*)(rp + 8); s1 = *(const f32x4*)(rp + 12);
                    if (fq == 0) { s0 = -s0; s1 = -s1; } else if (fq >= 2) { c0 = (f32x4){1.f, 1.f, 1.f, 1.f}; c1 = c0; s0 = (f32x4){0.f, 0.f, 0.f, 0.f}; s1 = s0; } }
#pragma unroll
                for (int bj = 0; bj < 2; ++bj) {
                    f32x4 v0 = acc[ai][bj][m][0], v1 = acc[ai][bj][m][1];
                    if (op == 1) {
#pragma unroll
                        for (int j = 0; j < 4; ++j) { v0[j] = silu_fast(v0[j]); v1[j] = silu_fast(v1[j]); }
                    }
                    if (do_rope) {
                        f32x4 p0, p1;
#pragma unroll
                        for (int j = 0; j < 4; ++j) { p0[j] = __shfl_xor(v0[j], 16); p1[j] = __shfl_xor(v1[j], 16); }
                        v0 = v0 * c0 + p0 * s0; v1 = v1 * c1 + p1 * s1;
                    }
                    v0 = v0 * sc; v1 = v1 * sc;
                    u32x4 w; w.x = cvt_pk_bf16(v0[0], v0[1]); w.y = cvt_pk_bf16(v0[2], v0[3]); w.z = cvt_pk_bf16(v1[0], v1[1]); w.w = cvt_pk_bf16(v1[2], v1[3]);
                    *(u32x4*)(rowp + bj * HALF) = w;
                }
            }
    }
};
struct EpiResid {
    static constexpr bool PERM = false, AFTER_DRAIN = false;
    float* H; float alpha;
    __device__ __forceinline__ void operator()(const f32x4 (&acc)[2][2][4][2], const Unit& u, int wr, int wc, int fr, int fq) const {
        const int row0 = u.pm * BM + wr * 64 + fr, col0 = u.pn * BM + wc * 32 + 4 * fq;
#pragma unroll
        for (int ai = 0; ai < 2; ++ai)
#pragma unroll
            for (int m = 0; m < 4; ++m) { float* rowp = H + (size_t)(row0 + ai * HALF + m * 16) * 1024 + col0;
#pragma unroll
                for (int bj = 0; bj < 2; ++bj)
#pragma unroll
                    for (int n = 0; n < 2; ++n) { f32x4* p = (f32x4*)(rowp + bj * HALF + n * 16); const f32x4 h = *p; *p = h * alpha + acc[ai][bj][m][n]; } }
    }
};
struct EpiSwiglu {
    static constexpr bool PERM = true, AFTER_DRAIN = false;
    bf16_t* ACT;
    __device__ __forceinline__ void operator()(const f32x4 (&acc)[2][2][4][2], const Unit& u, int wr, int wc, int fr, int fq) const {
        const int row0 = u.pm * BM + wr * 64 + fr, col0 = (u.pn & 15) * 128 + wc * 32 + 8 * fq;
#pragma unroll
        for (int ai = 0; ai < 2; ++ai)
#pragma unroll
            for (int m = 0; m < 4; ++m) {
                f32x4 v0 = acc[ai][0][m][0], v1 = acc[ai][0][m][1]; const f32x4 u0 = acc[ai][1][m][0], u1 = acc[ai][1][m][1];
#pragma unroll
                for (int j = 0; j < 4; ++j) { v0[j] = silu_fast(v0[j]) * u0[j]; v1[j] = silu_fast(v1[j]) * u1[j]; }
                u32x4 w; w.x = cvt_pk_bf16(v0[0], v0[1]); w.y = cvt_pk_bf16(v0[2], v0[3]); w.z = cvt_pk_bf16(v1[0], v1[1]); w.w = cvt_pk_bf16(v1[2], v1[3]);
                *(u32x4*)(ACT + (size_t)(row0 + ai * HALF + m * 16) * 2048 + col0) = w;
            }
    }
};
struct EpiYGate {
    static constexpr bool PERM = true, AFTER_DRAIN = false;
    bf16_t* Y; const float* GATE;
    __device__ __forceinline__ void operator()(const f32x4 (&acc)[2][2][4][2], const Unit& u, int wr, int wc, int fr, int fq) const {
        const int row0 = u.pm * BM + wr * 64 + fr, col0 = (u.pn & 3) * BM + wc * 32 + 8 * fq;
#pragma unroll
        for (int ai = 0; ai < 2; ++ai)
#pragma unroll
            for (int m = 0; m < 4; ++m) { const int row = row0 + ai * HALF + m * 16; const float gt = GATE[row]; bf16_t* rowp = Y + (size_t)row * 1024 + col0;
#pragma unroll
                for (int bj = 0; bj < 2; ++bj) { const f32x4 v0 = acc[ai][bj][m][0] * gt, v1 = acc[ai][bj][m][1] * gt;
                    u32x4 w; w.x = cvt_pk_bf16(v0[0], v0[1]); w.y = cvt_pk_bf16(v0[2], v0[3]); w.z = cvt_pk_bf16(v1[0], v1[1]); w.w = cvt_pk_bf16(v1[2], v1[3]);
                    *(u32x4*)(rowp + bj * HALF) = w; } }
    }
};
template <int WHICH> struct MoeOrder {
    int G, c;
    __device__ bool next(int i, Unit& u) const {
        constexpr int NWG = WHICH == 1 ? 2048 : 512;
        const int L = i * G + c; if (L >= NWG) return false;
        const int Ux = (G % 8 == 0 && NWG % 8 == 0) ? (L % 8) * (NWG / 8) + L / 8 : L;
        if (WHICH == 1) { const int e = Ux >> 7, jg = (Ux & 127) >> 5, b = (Ux & 31) >> 2, jj = Ux & 3; u.pm = b * 16 + e; u.pn = e * 16 + jg * 4 + jj; }
        else { const int e = Ux >> 5, b = (Ux & 31) >> 2, j = Ux & 3; u.pm = b * 16 + e; u.pn = e * 4 + j; }
        return true;
    }
    __device__ __forceinline__ void a_ready(const Unit&) const {}
    __device__ __forceinline__ void done(const Unit&) const {}
};
template <class Epi, class Sched, bool ALIGN_EPI = false, bool SP2 = false>
__device__ __forceinline__ void gemm_phase(PG8_LAS unsigned char* lds, const Gemm g, const Sched& S, const Epi& E) {
    const int tid = threadIdx.x, wid = __builtin_amdgcn_readfirstlane(tid >> 6), lane = tid & 63, wr = wid >> 2, wc = wid & 3, fr = lane & 15, fq = lane >> 4;
    const int K = g.K, nt = K / BK;
    unsigned voffA[2], voffB[2];
#pragma unroll
    for (int i = 0; i < 2; ++i) { int R, C; stage_rc(tid * 16 + i * 8192, R, C); const int Rb = Epi::PERM ? ((R & ~31) + perm32(R & 31)) : R;
        voffA[i] = (unsigned)(R * K + C) * 2u; voffB[i] = (unsigned)(Rb * K + C) * 2u; }
    const size_t kstep = (size_t)(BK * 2);
    const size_t hstep = (size_t)HALF * K * 2;
    const size_t tstep = 2 * hstep;
    const unsigned ldsw = (unsigned)wid * 1024u;
    const int aoff = lds_byte(wr * 64 + fr, fq * 8), boff = lds_byte(wc * 32 + fr, fq * 8);
#define PG8_SA(b, h) (((b) * 2 + (h)) * HTB)
#define PG8_SB(b, h) ((4 + (b) * 2 + (h)) * HTB)
#define PG8_STAGE(bufoff, gbase, voff) do { _Pragma("unroll") for (int _i = 0; _i < 2; ++_i) \
        __builtin_amdgcn_global_load_lds((const unsigned*)((const char*)(gbase) + (voff)[_i]), (PG8_LAS unsigned*)(lds + (bufoff) + ldsw + _i * 8192), 16, 0, 0); } while (0)
#define PG8_LDA(dst, b, h) do { _Pragma("unroll") for (int m = 0; m < 4; ++m) _Pragma("unroll") for (int k = 0; k < 2; ++k) dst[m][k] = *(const PG8_LAS bf16x8*)(lds + PG8_SA(b, h) + aoff + m * 2048 + k * 1024); } while (0)
#define PG8_LDB(dst, b, h) do { _Pragma("unroll") for (int n = 0; n < 2; ++n) _Pragma("unroll") for (int k = 0; k < 2; ++k) dst[n][k] = *(const PG8_LAS bf16x8*)(lds + PG8_SB(b, h) + boff + n * 2048 + k * 1024); } while (0)
#define PG8_MMA(ai, bj, At, Bt) do { __builtin_amdgcn_s_setprio(1); _Pragma("unroll") for (int m = 0; m < 4; ++m) _Pragma("unroll") for (int n = 0; n < 2; ++n) _Pragma("unroll") for (int k = 0; k < 2; ++k) \
        acc[ai][bj][m][n] = __builtin_amdgcn_mfma_f32_16x16x32_bf16(Bt[n][k], At[m][k], acc[ai][bj][m][n], 0, 0, 0); __builtin_amdgcn_s_setprio(0); } while (0)
#define PG8_WAIT_V(n) asm volatile("s_waitcnt vmcnt(" #n ")" ::: "memory")
#define PG8_WAIT_L(n) asm volatile("s_waitcnt lgkmcnt(" #n ")" ::: "memory")
#define PG8_BAR __builtin_amdgcn_s_barrier()
#define PG8_SCHED __builtin_amdgcn_sched_barrier(0)
    Unit cur, nxt; int ui = 0;
    if (!S.next(0, cur)) return;
    f32x4 acc[2][2][4][2];
#pragma unroll
    for (int a = 0; a < 2; ++a)
#pragma unroll
        for (int b = 0; b < 2; ++b)
#pragma unroll
            for (int m = 0; m < 4; ++m)
#pragma unroll
                for (int n = 0; n < 2; ++n) acc[a][b][m][n] = (f32x4){0.f, 0.f, 0.f, 0.f};
    bf16x8 At[4][2], B0[2][2], B1[2][2];
    const char* cA = (const char*)g.A + (size_t)cur.pm * tstep; const char* cB = (const char*)g.Bt + (size_t)cur.pn * tstep;
    S.a_ready(cur);
    if constexpr (SP2) {
        PG8_STAGE(PG8_SB(0, 0), cB, voffB); PG8_STAGE(PG8_SB(0, 1), cB + hstep, voffB); PG8_STAGE(PG8_SA(0, 0), cA, voffA); PG8_STAGE(PG8_SA(0, 1), cA + hstep, voffA);
        if (wr == 1) PG8_BAR;
        PG8_WAIT_V(2); PG8_BAR;
        PG8_STAGE(PG8_SB(1, 0), cB + kstep, voffB); PG8_STAGE(PG8_SA(1, 0), cA + kstep, voffA); PG8_STAGE(PG8_SB(1, 1), cB + hstep + kstep, voffB);
        PG8_WAIT_V(6); PG8_BAR;
    } else {
        PG8_STAGE(PG8_SB(0, 0), cB, voffB); PG8_STAGE(PG8_SA(0, 0), cA, voffA); PG8_STAGE(PG8_SB(0, 1), cB + hstep, voffB); PG8_STAGE(PG8_SA(0, 1), cA + hstep, voffA);
        if (wr == 1) PG8_BAR;
        PG8_WAIT_V(4); PG8_BAR;
        PG8_STAGE(PG8_SB(1, 0), cB + kstep, voffB); PG8_STAGE(PG8_SA(1, 0), cA + kstep, voffA); PG8_STAGE(PG8_SB(1, 1), cB + hstep + kstep, voffB);
        PG8_WAIT_V(6); PG8_BAR;
    }
    for (;;) {
        const bool has_next = S.next(ui + 1, nxt);
        const char* nA = has_next ? (const char*)g.A + (size_t)nxt.pm * tstep : cA; const char* nB = has_next ? (const char*)g.Bt + (size_t)nxt.pn * tstep : cB;
        for (int t = 0; t < nt; t += 2) {
            const bool last = (t == nt - 2);
            const char* a1 = cA + (size_t)(t + 1) * kstep;
            const char* a2 = last ? nA : cA + (size_t)(t + 2) * kstep; const char* b2 = last ? nB : cB + (size_t)(t + 2) * kstep;
            const char* a3 = a2 + kstep; const char* b3 = b2 + kstep;
            if (last && has_next) S.a_ready(nxt);
            if constexpr (SP2) {
            PG8_LDB(B0, 0, 0); PG8_LDB(B1, 0, 1); PG8_SCHED; PG8_LDA(At, 0, 0); PG8_STAGE(PG8_SA(1, 1), a1 + hstep, voffA);
            PG8_WAIT_V(8); PG8_WAIT_L(0); PG8_BAR; PG8_MMA(0, 0, At, B0); PG8_MMA(0, 1, At, B1); PG8_BAR; PG8_SCHED;
            PG8_LDA(At, 0, 1); PG8_STAGE(PG8_SB(0, 0), b2, voffB); PG8_STAGE(PG8_SB(0, 1), b2 + hstep, voffB); PG8_STAGE(PG8_SA(0, 0), a2, voffA);
            PG8_WAIT_V(8); PG8_WAIT_L(0); PG8_BAR; PG8_MMA(1, 0, At, B0); PG8_MMA(1, 1, At, B1); PG8_BAR; PG8_SCHED;
            PG8_LDB(B0, 1, 0); PG8_LDB(B1, 1, 1); PG8_SCHED; PG8_LDA(At, 1, 0); PG8_STAGE(PG8_SA(0, 1), a2 + hstep, voffA);
            PG8_WAIT_V(8); PG8_WAIT_L(0); PG8_BAR; PG8_MMA(0, 0, At, B0); PG8_MMA(0, 1, At, B1); PG8_BAR; PG8_SCHED;
            PG8_LDA(At, 1, 1); PG8_STAGE(PG8_SB(1, 0), b3, voffB); PG8_STAGE(PG8_SB(1, 1), b3 + hstep, voffB); PG8_STAGE(PG8_SA(1, 0), a3, voffA);
            PG8_WAIT_V(8); PG8_WAIT_L(0); PG8_BAR; PG8_MMA(1, 0, At, B0); PG8_MMA(1, 1, At, B1); PG8_BAR; PG8_SCHED;
            } else {
            PG8_LDB(B0, 0, 0); PG8_SCHED; PG8_LDA(At, 0, 0); PG8_STAGE(PG8_SA(1, 1), a1 + hstep, voffA);
            PG8_WAIT_L(8); PG8_BAR; PG8_WAIT_L(0); PG8_MMA(0, 0, At, B0); PG8_BAR; PG8_SCHED;
            PG8_LDB(B1, 0, 1); PG8_STAGE(PG8_SB(0, 0), b2, voffB);
            PG8_BAR; PG8_WAIT_L(0); PG8_MMA(0, 1, At, B1); PG8_BAR;
            PG8_LDA(At, 0, 1); PG8_STAGE(PG8_SA(0, 0), a2, voffA);
            PG8_BAR; PG8_WAIT_L(0); PG8_MMA(1, 0, At, B0); PG8_BAR; PG8_SCHED;
            PG8_STAGE(PG8_SB(0, 1), b2 + hstep, voffB);
            PG8_WAIT_V(6); PG8_BAR; PG8_MMA(1, 1, At, B1); PG8_BAR;
            PG8_LDB(B0, 1, 0); PG8_SCHED; PG8_LDA(At, 1, 0); PG8_STAGE(PG8_SA(0, 1), a2 + hstep, voffA);
            PG8_WAIT_L(8); PG8_BAR; PG8_WAIT_L(0); PG8_MMA(0, 0, At, B0); PG8_BAR; PG8_SCHED;
            PG8_LDB(B1, 1, 1); PG8_STAGE(PG8_SB(1, 0), b3, voffB);
            PG8_BAR; PG8_WAIT_L(0); PG8_MMA(0, 1, At, B1); PG8_BAR;
            PG8_LDA(At, 1, 1); PG8_STAGE(PG8_SA(1, 0), a3, voffA);
            PG8_BAR; PG8_WAIT_L(0); PG8_MMA(1, 0, At, B0); PG8_BAR; PG8_SCHED;
            PG8_STAGE(PG8_SB(1, 1), b3 + hstep, voffB);
            PG8_WAIT_V(6); PG8_BAR; PG8_MMA(1, 1, At, B1); PG8_BAR;
            }
        }
        if constexpr (ALIGN_EPI) { if (wr == 0) PG8_BAR; }
        if constexpr (!Epi::AFTER_DRAIN) { E(acc, cur, wr, wc, fr, fq); S.done(cur); }
        if (!has_next) break;
#pragma unroll
        for (int a = 0; a < 2; ++a)
#pragma unroll
            for (int b = 0; b < 2; ++b)
#pragma unroll
                for (int m = 0; m < 4; ++m)
#pragma unroll
                    for (int n = 0; n < 2; ++n) acc[a][b][m][n] = (f32x4){0.f, 0.f, 0.f, 0.f};
        cur = nxt; cA = nA; cB = nB; ++ui;
        if constexpr (ALIGN_EPI) { if (wr == 1) PG8_BAR; }
    }
    PG8_WAIT_V(0);
    if constexpr (!ALIGN_EPI) { if (wr == 0) PG8_BAR; }
    PG8_BAR;
    if constexpr (Epi::AFTER_DRAIN) { E.fused(acc, cur, wr, wc, fr, fq, lds, wid, lane); S.done(cur); }
#undef PG8_SA
#undef PG8_SB
#undef PG8_STAGE
#undef PG8_LDA
#undef PG8_LDB
#undef PG8_MMA
#undef PG8_WAIT_V
#undef PG8_WAIT_L
#undef PG8_BAR
#undef PG8_SCHED
}
}
namespace da {
#define DA_LAS __attribute__((address_space(3)))
typedef short bf16x8 __attribute__((ext_vector_type(8)));
typedef short s16x4 __attribute__((ext_vector_type(4)));
typedef float f32x16 __attribute__((ext_vector_type(16)));
typedef float f32x4 __attribute__((ext_vector_type(4)));
typedef unsigned u32x4 __attribute__((ext_vector_type(4)));
typedef unsigned u32x2 __attribute__((ext_vector_type(2)));
constexpr int KSTR = 144, VSTR = 320;
constexpr int K_BYTES = 64 * KSTR, V_BYTES = 64 * VSTR, STAGE = 2 * K_BYTES + V_BYTES;
constexpr float THR = 4.0f;
__device__ __forceinline__ unsigned cvt_pk(float lo, float hi) { unsigned r; asm volatile("v_cvt_pk_bf16_f32 %0, %1, %2" : "=v"(r) : "v"(lo), "v"(hi)); return r; }
__device__ __forceinline__ s16x4 vtr(const DA_LAS unsigned char* p) { typedef short v4i16_t __attribute__((ext_vector_type(4)));
    return __builtin_bit_cast(s16x4, __builtin_amdgcn_ds_read_tr16_b64_v4i16((DA_LAS v4i16_t*)p)); }

__device__ __forceinline__ void dattn_phase(DA_LAS unsigned char* lds, const bf16_t* U, const float* lamp, const float* subln_g, bf16_t* MIX, int vcu, int G) {
    const int tid = threadIdx.x, lane = tid & 63, wave = __builtin_amdgcn_readfirstlane(tid >> 6), comp = wave >> 2, qs = wave & 3;
    const int r32 = lane & 31, hh = lane >> 5, gi = lane >> 4, li = lane & 15;
    const float lam = lamp[0];
    const int krow = tid >> 3, kch = tid & 7, vrow0 = tid >> 4, vch = tid & 15;
    const int kdst = krow * KSTR + kch * 16, vdst0 = vrow0 * VSTR + vch * 16, vdst1 = (vrow0 + 32) * VSTR + vch * 16;
    const int kfrag = r32 * KSTR + hh * 16;
    const int vfrag = (4 * hh + (li >> 2)) * VSTR + (16 * (gi & 1) + 4 * (li & 3)) * 2;
    for (int u = vcu; u < BATCH * 4 * 16; u += G) {
        const int qb = u & 15, h = (u >> 4) & 3, b = u >> 6;
        const bf16_t* Ub = U + (size_t)b * SEQ * NU;
        const bf16_t* ksrc0 = Ub + (size_t)krow * NU + U_DK + (2 * h) * 64 + kch * 8;
        const bf16_t* ksrc1 = ksrc0 + 64;
        const bf16_t* vsrc0 = Ub + (size_t)vrow0 * NU + U_DV + h * 128 + vch * 8;
        const bf16_t* vsrc1 = vsrc0 + (size_t)32 * NU;
        bf16x8 qf[4];
        { const bf16_t* qp = Ub + (size_t)(qb * 128 + qs * 32 + r32) * NU + U_DQ + (2 * h + comp) * 64 + hh * 8;
#pragma unroll
          for (int ds = 0; ds < 4; ++ds) qf[ds] = *(const bf16x8*)(qp + ds * 16); }
        f32x16 o[4];
#pragma unroll
        for (int d0 = 0; d0 < 4; ++d0)
#pragma unroll
            for (int r = 0; r < 16; ++r) o[d0][r] = 0.f;
        float m = -INFINITY, l = 0.f;
        u32x4 rk0 = *(const u32x4*)ksrc0, rk1 = *(const u32x4*)ksrc1, rv0 = *(const u32x4*)vsrc0, rv1 = *(const u32x4*)vsrc1;
        *(DA_LAS u32x4*)(lds + kdst) = rk0; *(DA_LAS u32x4*)(lds + K_BYTES + kdst) = rk1; *(DA_LAS u32x4*)(lds + 2 * K_BYTES + vdst0) = rv0; *(DA_LAS u32x4*)(lds + 2 * K_BYTES + vdst1) = rv1;
        __syncthreads();
        for (int t = 0; t < SEQ / 64; ++t) {
            const DA_LAS unsigned char* st = lds + (t & 1) * STAGE;
            DA_LAS unsigned char* nst = lds + ((t + 1) & 1) * STAGE;
            if (t + 1 < SEQ / 64) { const size_t go = (size_t)(t + 1) * 64 * NU; rk0 = *(const u32x4*)(ksrc0 + go); rk1 = *(const u32x4*)(ksrc1 + go); rv0 = *(const u32x4*)(vsrc0 + go); rv1 = *(const u32x4*)(vsrc1 + go); }
            const DA_LAS unsigned char* Kt = st + comp * K_BYTES + kfrag;
            f32x16 p0, p1;
#pragma unroll
            for (int r = 0; r < 16; ++r) { p0[r] = 0.f; p1[r] = 0.f; }
#pragma unroll
            for (int ds = 0; ds < 4; ++ds) {
                const bf16x8 a0 = *(const DA_LAS bf16x8*)(Kt + ds * 32), a1 = *(const DA_LAS bf16x8*)(Kt + 32 * KSTR + ds * 32);
                p0 = __builtin_amdgcn_mfma_f32_32x32x16_bf16(a0, qf[ds], p0, 0, 0, 0);
                p1 = __builtin_amdgcn_mfma_f32_32x32x16_bf16(a1, qf[ds], p1, 0, 0, 0);
            }
            float mx = fmaxf(p0[0], p1[0]);
#pragma unroll
            for (int r = 1; r < 16; ++r) mx = fmaxf(mx, fmaxf(p0[r], p1[r]));
            mx = fmaxf(mx, __shfl_xor(mx, 32));
            if (!__all(mx - m <= THR)) {
                const float mn = fmaxf(m, mx), alpha = __builtin_amdgcn_exp2f(m - mn);
                m = mn; l *= alpha;
#pragma unroll
                for (int d0 = 0; d0 < 4; ++d0) o[d0] = o[d0] * alpha;
            }
            float rs = 0.f;
#pragma unroll
            for (int r = 0; r < 16; ++r) { p0[r] = __builtin_amdgcn_exp2f(p0[r] - m); p1[r] = __builtin_amdgcn_exp2f(p1[r] - m); rs += p0[r] + p1[r]; }
            l += rs;
            bf16x8 pf[4];
#pragma unroll
            for (int s = 0; s < 2; ++s) {
                u32x4 w0, w1;
                w0.x = cvt_pk(p0[8 * s + 0], p0[8 * s + 1]); w0.y = cvt_pk(p0[8 * s + 2], p0[8 * s + 3]); w0.z = cvt_pk(p0[8 * s + 4], p0[8 * s + 5]); w0.w = cvt_pk(p0[8 * s + 6], p0[8 * s + 7]);
                w1.x = cvt_pk(p1[8 * s + 0], p1[8 * s + 1]); w1.y = cvt_pk(p1[8 * s + 2], p1[8 * s + 3]); w1.z = cvt_pk(p1[8 * s + 4], p1[8 * s + 5]); w1.w = cvt_pk(p1[8 * s + 6], p1[8 * s + 7]);
                pf[s] = __builtin_bit_cast(bf16x8, w0); pf[2 + s] = __builtin_bit_cast(bf16x8, w1);
            }
            const DA_LAS unsigned char* Vt = st + 2 * K_BYTES + vfrag;
#pragma unroll
            for (int d0 = 0; d0 < 4; ++d0)
#pragma unroll
                for (int ks = 0; ks < 4; ++ks) {
                    const s16x4 lo = vtr(Vt + (16 * ks) * VSTR + 64 * d0), hi = vtr(Vt + (16 * ks + 8) * VSTR + 64 * d0);
                    const bf16x8 av = (bf16x8){lo[0], lo[1], lo[2], lo[3], hi[0], hi[1], hi[2], hi[3]};
                    o[d0] = __builtin_amdgcn_mfma_f32_32x32x16_bf16(av, pf[ks], o[d0], 0, 0, 0);
                }
            if (t + 1 < SEQ / 64) { *(DA_LAS u32x4*)(nst + kdst) = rk0; *(DA_LAS u32x4*)(nst + K_BYTES + kdst) = rk1; *(DA_LAS u32x4*)(nst + 2 * K_BYTES + vdst0) = rv0; *(DA_LAS u32x4*)(nst + 2 * K_BYTES + vdst1) = rv1; }
            __syncthreads();
        }
        l += __shfl_xor(l, 32);
        const float il = 1.f / l;
        DA_LAS float* xch = (DA_LAS float*)lds + (size_t)qs * 64 * 64 + lane;
        if (comp == 1) {
#pragma unroll
            for (int d0 = 0; d0 < 4; ++d0)
#pragma unroll
                for (int r = 0; r < 16; ++r) xch[(d0 * 16 + r) * 64] = o[d0][r] * il;
        }
        __syncthreads();
        if (comp == 0) {
            float ss = 0.f;
#pragma unroll
            for (int d0 = 0; d0 < 4; ++d0)
#pragma unroll
                for (int r = 0; r < 16; ++r) { const float v = o[d0][r] * il - lam * xch[(d0 * 16 + r) * 64]; o[d0][r] = v; ss += v * v; }
            ss += __shfl_xor(ss, 32);
            const float rn = (1.f - LAMBDA_INIT) / sqrtf(ss * (1.f / 128.f) + RMS_EPS);
            bf16_t* orow = MIX + (size_t)(b * SEQ + qb * 128 + qs * 32 + r32) * DM + 512 + h * 128 + 4 * hh;
#pragma unroll
            for (int d0 = 0; d0 < 4; ++d0)
#pragma unroll
                for (int rq = 0; rq < 4; ++rq) {
                    const f32x4 g4 = *(const f32x4*)(subln_g + 32 * d0 + 8 * rq + 4 * hh);
                    u32x2 w; w.x = cvt_pk(o[d0][4 * rq] * rn * g4[0], o[d0][4 * rq + 1] * rn * g4[1]); w.y = cvt_pk(o[d0][4 * rq + 2] * rn * g4[2], o[d0][4 * rq + 3] * rn * g4[3]);
                    *(u32x2*)(orow + 32 * d0 + 8 * rq) = w;
                }
        }
        __syncthreads();
    }
}
}
namespace hg {
#define HG_LAS __attribute__((address_space(3)))
typedef short bf16x8 __attribute__((ext_vector_type(8)));
typedef short s16x4 __attribute__((ext_vector_type(4)));
typedef float f32x16 __attribute__((ext_vector_type(16)));
typedef float f32x4 __attribute__((ext_vector_type(4)));
typedef unsigned u32x4 __attribute__((ext_vector_type(4)));
typedef unsigned u32x2 __attribute__((ext_vector_type(2)));
typedef float f32x2 __attribute__((ext_vector_type(2)));
constexpr int RSTR = 272, TSTR = 320;
constexpr int L_QIN = 0, L_KIN = L_QIN + 64 * RSTR, L_KINT = L_KIN + 64 * RSTR, L_VT = L_KINT + 64 * TSTR, L_SBT = L_VT + 64 * TSTR, L_DEC = L_SBT + 128 * RSTR, L_SEGT = L_DEC + 512, L_END = L_SEGT + 8 * 128 * 4;
static_assert(L_END <= 131072, "hgrn LDS map");
constexpr float LOG2E = 1.4426950408889634f;
__device__ __forceinline__ unsigned cvt_pk(float lo, float hi) { unsigned r; asm volatile("v_cvt_pk_bf16_f32 %0, %1, %2" : "=v"(r) : "v"(lo), "v"(hi)); return r; }
__device__ __forceinline__ s16x4 vtr(const HG_LAS unsigned char* p) { typedef short v4i16_t __attribute__((ext_vector_type(4)));
    return __builtin_bit_cast(s16x4, __builtin_amdgcn_ds_read_tr16_b64_v4i16((HG_LAS v4i16_t*)p)); }
__device__ __forceinline__ float bflo(unsigned w) { return __builtin_bit_cast(float, w << 16); }
__device__ __forceinline__ float bfhi(unsigned w) { return __builtin_bit_cast(float, w & 0xffff0000u); }

__device__ __forceinline__ void hgrn_phase(HG_LAS unsigned char* lds, const bf16_t* U, const float* LB, float* OSC, int first, int stride) {
    const int tid = threadIdx.x, lane = tid & 63, wave = __builtin_amdgcn_readfirstlane(tid >> 6);
    const int r32 = lane & 31, hh = lane >> 5, gi = lane >> 4, li = lane & 15;
    const int vt = wave >> 1, ct = wave & 1, kt = wave >> 1, vpair = wave & 1;
    const int kp = lane, seg = wave;
    const int vrow0 = tid >> 4, vch = tid & 15;
    const int trp = (li >> 2) * TSTR + (16 * (gi & 1) + 4 * (li & 3)) * 2;
    for (int item = first; item < BATCH * 4 * 2; item += stride) {
        const int dir = item & 1, h = (item >> 1) & 3, b = item >> 3;
        const bf16_t* Ub = U + (size_t)b * SEQ * NU;
        const int qcol = U_HQ + h * 128 + 2 * kp, fcol = (dir ? U_HFB : U_HFF) + h * 128 + 2 * kp, vcol = U_HI + h * 128 + vch * 8;
        const float lb0 = LB[dir * 512 + h * 128 + 2 * kp], lb1 = LB[dir * 512 + h * 128 + 2 * kp + 1];
        for (int i = tid; i < 128 * RSTR / 4; i += 512) ((HG_LAS unsigned*)(lds + L_SBT))[i] = 0u;
        f32x16 S[2];
#pragma unroll
        for (int r = 0; r < 16; ++r) { S[0][r] = 0.f; S[1][r] = 0.f; }
        unsigned rq[8], rf[8]; u32x4 rv0, rv1;
#define HG_TIME(p) (dir ? (SEQ - 1 - (p)) : (p))
#define HG_LOAD(n) do { _Pragma("unroll") for (int i = 0; i < 8; ++i) { const bf16_t* rp = Ub + (size_t)HG_TIME(64 * (n) + 8 * seg + i) * NU; rq[i] = *(const unsigned*)(rp + qcol); rf[i] = *(const unsigned*)(rp + fcol); } \
        rv0 = *(const u32x4*)(Ub + (size_t)HG_TIME(64 * (n) + vrow0) * NU + vcol); rv1 = *(const u32x4*)(Ub + (size_t)HG_TIME(64 * (n) + vrow0 + 32) * NU + vcol); } while (0)
        HG_LOAD(0);
        __syncthreads();
        for (int n = 0; n < SEQ / 64; ++n) {
            float c0[8], c1[8], k0[8], k1[8]; float a0 = 0.f, a1 = 0.f;
#pragma unroll
            for (int i = 0; i < 8; ++i) {
                const float u0 = bflo(rf[i]), u1 = bfhi(rf[i]);
                const float f0 = lb0 + (1.f - lb0) * __builtin_amdgcn_rcpf(1.f + __builtin_amdgcn_exp2f(-LOG2E * u0));
                const float f1 = lb1 + (1.f - lb1) * __builtin_amdgcn_rcpf(1.f + __builtin_amdgcn_exp2f(-LOG2E * u1));
                k0[i] = 1.f - f0; k1[i] = 1.f - f1;
                a0 += __builtin_amdgcn_logf(f0); a1 += __builtin_amdgcn_logf(f1);
                c0[i] = a0; c1[i] = a1;
            }
            *(HG_LAS f32x2*)(lds + L_SEGT + (seg * 128 + 2 * kp) * 4) = (f32x2){a0, a1};
            __syncthreads();
            float off0 = 0.f, off1 = 0.f, tot0 = 0.f, tot1 = 0.f;
#pragma unroll
            for (int s2 = 0; s2 < 8; ++s2) { const f32x2 tq = *(const HG_LAS f32x2*)(lds + L_SEGT + (s2 * 128 + 2 * kp) * 4); if (s2 < seg) { off0 += tq.x; off1 += tq.y; } tot0 += tq.x; tot1 += tq.y; }
            if (seg == 0) *(HG_LAS f32x2*)(lds + L_DEC + 2 * kp * 4) = (f32x2){__builtin_amdgcn_exp2f(tot0), __builtin_amdgcn_exp2f(tot1)};
#pragma unroll
            for (int i = 0; i < 8; ++i) {
                const int c = 8 * seg + i; const float b0 = off0 + c0[i], b1 = off1 + c1[i];
                const unsigned qi = cvt_pk(bflo(rq[i]) * __builtin_amdgcn_exp2f(b0), bfhi(rq[i]) * __builtin_amdgcn_exp2f(b1));
                const unsigned ki = cvt_pk(k0[i] * __builtin_amdgcn_exp2f(-b0), k1[i] * __builtin_amdgcn_exp2f(-b1));
                *(HG_LAS unsigned*)(lds + L_QIN + c * RSTR + 4 * kp) = qi;
                *(HG_LAS unsigned*)(lds + L_KIN + c * RSTR + 4 * kp) = ki;
                *(HG_LAS unsigned*)(lds + L_KINT + c * TSTR + 4 * kp) = ki;
            }
            *(HG_LAS u32x4*)(lds + L_VT + vrow0 * TSTR + vch * 16) = rv0; *(HG_LAS u32x4*)(lds + L_VT + (vrow0 + 32) * TSTR + vch * 16) = rv1;
            if (n + 1 < SEQ / 64) HG_LOAD(n + 1);
            __syncthreads();
            bf16x8 qfr[8];
#pragma unroll
            for (int ks = 0; ks < 8; ++ks) qfr[ks] = *(const HG_LAS bf16x8*)(lds + L_QIN + (32 * ct + r32) * RSTR + ks * 32 + hh * 16);
            f32x16 o;
#pragma unroll
            for (int r = 0; r < 16; ++r) o[r] = 0.f;
#pragma unroll
            for (int ks = 0; ks < 8; ++ks) {
                const bf16x8 as = *(const HG_LAS bf16x8*)(lds + L_SBT + (32 * vt + r32) * RSTR + ks * 32 + hh * 16);
                o = __builtin_amdgcn_mfma_f32_32x32x16_bf16(as, qfr[ks], o, 0, 0, 0);
            }
#pragma unroll
            for (int st = 0; st < 2; ++st) {
                if (st <= ct) {
                    f32x16 at;
#pragma unroll
                    for (int r = 0; r < 16; ++r) at[r] = 0.f;
#pragma unroll
                    for (int ks = 0; ks < 8; ++ks) {
                        const bf16x8 ak = *(const HG_LAS bf16x8*)(lds + L_KIN + (32 * st + r32) * RSTR + ks * 32 + hh * 16);
                        at = __builtin_amdgcn_mfma_f32_32x32x16_bf16(ak, qfr[ks], at, 0, 0, 0);
                    }
                    if (st == ct) {
#pragma unroll
                        for (int r = 0; r < 16; ++r) { const int srow = (r & 3) + 8 * (r >> 2) + 4 * hh; at[r] = (srow <= r32) ? at[r] : 0.f; }
                    }
#pragma unroll
                    for (int s2 = 0; s2 < 2; ++s2) {
                        u32x4 w; w.x = cvt_pk(at[8 * s2 + 0], at[8 * s2 + 1]); w.y = cvt_pk(at[8 * s2 + 2], at[8 * s2 + 3]); w.z = cvt_pk(at[8 * s2 + 4], at[8 * s2 + 5]); w.w = cvt_pk(at[8 * s2 + 6], at[8 * s2 + 7]);
                        const HG_LAS unsigned char* vp = lds + L_VT + (32 * st + 16 * s2 + 4 * hh) * TSTR + 64 * vt + trp;
                        const s16x4 lo = vtr(vp), hi = vtr(vp + 8 * TSTR);
                        const bf16x8 av = (bf16x8){lo[0], lo[1], lo[2], lo[3], hi[0], hi[1], hi[2], hi[3]};
                        o = __builtin_amdgcn_mfma_f32_32x32x16_bf16(av, __builtin_bit_cast(bf16x8, w), o, 0, 0, 0);
                    }
                }
            }
#pragma unroll
            for (int cs = 0; cs < 4; ++cs) {
                const HG_LAS unsigned char* kp_ = lds + L_KINT + (16 * cs + 8 * hh) * TSTR + 64 * kt + trp;
                const s16x4 klo = vtr(kp_), khi = vtr(kp_ + 4 * TSTR);
                const bf16x8 ak = (bf16x8){klo[0], klo[1], klo[2], klo[3], khi[0], khi[1], khi[2], khi[3]};
#pragma unroll
                for (int vv = 0; vv < 2; ++vv) {
                    const HG_LAS unsigned char* vp = lds + L_VT + (16 * cs + 8 * hh) * TSTR + 64 * (2 * vpair + vv) + trp;
                    const s16x4 vlo = vtr(vp), vhi = vtr(vp + 4 * TSTR);
                    const bf16x8 bv = (bf16x8){vlo[0], vlo[1], vlo[2], vlo[3], vhi[0], vhi[1], vhi[2], vhi[3]};
                    S[vv] = __builtin_amdgcn_mfma_f32_32x32x16_bf16(ak, bv, S[vv], 0, 0, 0);
                }
            }
#pragma unroll
            for (int rq4 = 0; rq4 < 4; ++rq4) {
                const f32x4 d4 = *(const HG_LAS f32x4*)(lds + L_DEC + (32 * kt + 8 * rq4 + 4 * hh) * 4);
#pragma unroll
                for (int j = 0; j < 4; ++j) { S[0][4 * rq4 + j] *= d4[j]; S[1][4 * rq4 + j] *= d4[j]; }
            }
            __syncthreads();
#pragma unroll
            for (int vv = 0; vv < 2; ++vv)
#pragma unroll
                for (int rq4 = 0; rq4 < 4; ++rq4) {
                    u32x2 w; w.x = cvt_pk(S[vv][4 * rq4], S[vv][4 * rq4 + 1]); w.y = cvt_pk(S[vv][4 * rq4 + 2], S[vv][4 * rq4 + 3]);
                    *(HG_LAS u32x2*)(lds + L_SBT + (32 * (2 * vpair + vv) + r32) * RSTR + (32 * kt + 8 * rq4 + 4 * hh) * 2) = w;
                }
            {
                const int tok = HG_TIME(64 * n + 32 * ct + r32);
                float* op = OSC + ((size_t)dir * NTOK + (size_t)b * SEQ + tok) * 512 + h * 128 + 32 * vt + 4 * hh;
#pragma unroll
                for (int rq4 = 0; rq4 < 4; ++rq4) *(f32x4*)(op + 8 * rq4) = (f32x4){o[4 * rq4], o[4 * rq4 + 1], o[4 * rq4 + 2], o[4 * rq4 + 3]};
            }
        }
        __syncthreads();
#undef HG_LOAD
#undef HG_TIME
    }
}
}
namespace cg = cooperative_groups;
#ifndef USE_MFMA_HGRN
#define USE_MFMA_HGRN 1
#endif
#ifndef USE_MFMA_DATTN
#define USE_MFMA_DATTN 1
#endif
constexpr int NWAVES = 8;
constexpr int LDS_BYTES = 147456;
enum { PH_PROLOGUE = 0, PH_INPROJ, PH_HGRN, PH_HGRN_COMB, PH_DATTN, PH_DATTN_COMB, PH_MIXGEMM, PH_LN1, PH_QPROJ, PH_XA_SCORES, PH_XA_SOFTMAX, PH_XA_PV, PH_XA_CVT,
       PH_WOGEMM, PH_LN2, PH_TOPK, PH_MOE1, PH_MOE2, PH_FINAL, PH_COUNT };
struct MKArgs { const float* in[27]; float* out; unsigned char* ws; int ph_lo, ph_hi; };

__global__ void __launch_bounds__(NWAVES * 64, 2) mk_fwd(MKArgs a) {
    extern __shared__ __attribute__((aligned(16))) unsigned char lds_raw[];
    PG8_LAS unsigned char* lds = (PG8_LAS unsigned char*)lds_raw;
    float* smem = (float*)lds_raw;
    unsigned char* ws = a.ws;
    const int G = gridDim.x, bx = blockIdx.x;
    const int vcu = (G % 8 == 0) ? (bx % 8) * (G / 8) + bx / 8 : bx;
    const int lo = a.ph_lo, hi = a.ph_hi;
#define IN(k) (lo <= (k) && (k) < hi)
#define SEAM(k) do { if (IN(k) && IN((k) + 1)) cg::this_grid().sync(); } while (0)
    float* H = a.out;
    float* ROPE = (float*)(ws + WS_ROPE); float* LB = (float*)(ws + WS_LB); float* LAM = LB + 1024;
    float* AFF = (float*)(ws + WS_AFF); int* INV = (int*)(ws + WS_INV); int* IDX = (int*)(ws + WS_IDX); float* GATE = (float*)(ws + WS_GATE);
    bf16_t* XN = (bf16_t*)(ws + WS_XN); bf16_t* MIX = (bf16_t*)(ws + WS_MIX); bf16_t* U = (bf16_t*)(ws + WS_U); bf16_t* XS = (bf16_t*)(ws + WS_XS);
    bf16_t* KV = (bf16_t*)(ws + WS_KV); bf16_t* MEMB = (bf16_t*)(ws + WS_MEMB);
    float* SC_XS = (float*)(ws + WS_XS);
    bf16_t* P = XN;

    if (IN(PH_PROLOGUE)) {
        sp_prep_small(a.in[5], a.in[7], a.in[8], a.in[9], a.in[10], ROPE, LB);
        sp_transpose(smem, a.in[4], DM, NU, (bf16_t*)(ws + WS_WIN), 0, 0, 0, 1);
        sp_transpose(smem, a.in[16], DM, DM, (bf16_t*)(ws + WS_WKV), 0, 0, 0, 1);
        sp_transpose(smem, a.in[17], DM, DM, (bf16_t*)(ws + WS_WKV) + (size_t)DM * DM, 0, 0, 0, 1);
        sp_transpose(smem, a.in[12], DM, DM, (bf16_t*)(ws + WS_WMIX), 0, 0, 0, 1);
        sp_transpose(smem, a.in[15], DM, DM, (bf16_t*)(ws + WS_WQ), 0, 0, 0, 1);
        sp_transpose(smem, a.in[18], DM, DM, (bf16_t*)(ws + WS_WO), 0, 0, 0, 1);
        sp_transpose(smem, a.in[22], DM, DFF, (bf16_t*)(ws + WS_WGU), 1, (long)DM * DFF, (long)2 * DFF * DM, NEXP);
        sp_transpose(smem, a.in[23], DM, DFF, (bf16_t*)(ws + WS_WGU), 2, (long)DM * DFF, (long)2 * DFF * DM, NEXP);
        sp_transpose(smem, a.in[24], DFF, DM, (bf16_t*)(ws + WS_WD), 0, (long)DFF * DM, (long)DFF * DM, NEXP);
        sp_cvt_bf16(a.in[1], MEMB, (long)NMEM * DM);
        sp_ln_rows<0>(a.in[0], a.in[2], a.in[3], H, XN, nullptr, nullptr);
    }
    SEAM(PH_PROLOGUE);
    if (IN(PH_INPROJ)) {
        {
            pg8::Gemm g{XN, (const bf16_t*)(ws + WS_WIN), NTOK, NU, DM}; pg8::StaticOrder S; S.init(NTOK, NU, G, bx);
            pg8::EpiStore E{U, NU, 1.f, 1, ROPE};
            pg8::gemm_phase<pg8::EpiStore, pg8::StaticOrder, true, true>(lds, g, S, E);
        }
        {
            pg8::Gemm g{MEMB, (const bf16_t*)(ws + WS_WKV), NMEM, 2048, DM}; pg8::StaticOrder S; S.init(NMEM, 2048, G, bx);
            pg8::EpiStore E{KV, 2048, 1.f, 0, nullptr};
            pg8::gemm_phase<pg8::EpiStore, pg8::StaticOrder, true, true>(lds, g, S, E);
        }
    }
    SEAM(PH_INPROJ);
#if USE_MFMA_HGRN
    if (IN(PH_HGRN)) hg::hgrn_phase(lds, U, LB, SC_XS, vcu, G);
#else
    if (IN(PH_HGRN)) sp_hgrn(smem, U, LB, SC_XS);
#endif
    SEAM(PH_HGRN);
    if (IN(PH_HGRN_COMB)) sp_hgrn_combine(SC_XS, U, a.in[6], MIX);
    SEAM(PH_HGRN_COMB);
#if USE_MFMA_DATTN
    if (IN(PH_DATTN)) da::dattn_phase(lds, U, LAM, a.in[11], MIX, vcu, G);
    SEAM(PH_DATTN);
    SEAM(PH_DATTN_COMB);
#else
    if (IN(PH_DATTN)) sp_dattn(smem, U, SC_XS);
    SEAM(PH_DATTN);
    if (IN(PH_DATTN_COMB)) sp_dattn_combine(SC_XS, LAM, a.in[11], MIX);
    SEAM(PH_DATTN_COMB);
#endif
    if (IN(PH_MIXGEMM)) {
        pg8::Gemm g{MIX, (const bf16_t*)(ws + WS_WMIX), NTOK, DM, DM}; pg8::StaticOrder S; S.init(NTOK, DM, G, bx);
        pg8::EpiResid E{H, ALPHA};
        pg8::gemm_phase<pg8::EpiResid, pg8::StaticOrder, true, true>(lds, g, S, E);
    }
    SEAM(PH_MIXGEMM);
    if (IN(PH_LN1)) sp_ln_rows<1>(nullptr, a.in[13], a.in[14], H, XN, nullptr, nullptr);
    SEAM(PH_LN1);
    if (IN(PH_QPROJ)) {
        pg8::Gemm g{XN, (const bf16_t*)(ws + WS_WQ), NTOK, DM, DM}; pg8::StaticOrder S; S.init(NTOK, DM, G, bx);
        pg8::EpiStore E{MIX, DM, pg8::QSCALE_XA, 0, nullptr};
        pg8::gemm_phase<pg8::EpiStore, pg8::StaticOrder, true, true>(lds, g, S, E);
    }
    SEAM(PH_QPROJ);
    if (IN(PH_XA_SCORES))
        for (int b = 0; b < BATCH; ++b)
            sp_gemm(smem, MIX + (size_t)b * SEQ * DM, 256, DM, KV + (size_t)b * MEML * 2048, 256, 2048, 1, SC_XS + (size_t)b * 4 * SEQ * 256, (long)SEQ * 256, 256, SEQ, 256, 256, 4);
    SEAM(PH_XA_SCORES);
    if (IN(PH_XA_SOFTMAX)) sp_softmax256(SC_XS, P, (long)BATCH * 4 * SEQ);
    SEAM(PH_XA_SOFTMAX);
    if (IN(PH_XA_PV))
        for (int b = 0; b < BATCH; ++b)
            sp_gemm(smem, P + (size_t)b * 4 * SEQ * 256, (long)SEQ * 256, 256, KV + (size_t)b * MEML * 2048 + 1024, 256, 1, 2048, SC_XS + (size_t)b * SEQ * DM, 256, DM, SEQ, 256, 256, 4);
    SEAM(PH_XA_PV);
    if (IN(PH_XA_CVT)) sp_cvt2d(SC_XS, DM, MIX, DM, NTOK, DM);
    SEAM(PH_XA_CVT);
    if (IN(PH_WOGEMM)) {
        pg8::Gemm g{MIX, (const bf16_t*)(ws + WS_WO), NTOK, DM, DM}; pg8::StaticOrder S; S.init(NTOK, DM, G, bx);
        pg8::EpiResid E{H, ALPHA};
        pg8::gemm_phase<pg8::EpiResid, pg8::StaticOrder, true, true>(lds, g, S, E);
    }
    SEAM(PH_WOGEMM);
    if (IN(PH_LN2)) sp_ln_rows<2>(nullptr, a.in[19], a.in[20], H, XN, a.in[21], AFF);
    SEAM(PH_LN2);
    if (IN(PH_TOPK)) sp_topk_gather(smem, AFF, XN, IDX, GATE, INV, XS);
    SEAM(PH_TOPK);
    if (IN(PH_MOE1)) {
        pg8::Gemm g{XS, (const bf16_t*)(ws + WS_WGU), NGRP * CAP, NEXP * 4096, DM}; pg8::MoeOrder<1> S{G, bx};
        pg8::EpiSwiglu E{U};
        pg8::gemm_phase<pg8::EpiSwiglu, pg8::MoeOrder<1>, true, true>(lds, g, S, E);
    }
    SEAM(PH_MOE1);
    if (IN(PH_MOE2)) {
        pg8::Gemm g{U, (const bf16_t*)(ws + WS_WD), NGRP * CAP, NEXP * DM, DFF}; pg8::MoeOrder<2> S{G, bx};
        pg8::EpiYGate E{XS, GATE};
        pg8::gemm_phase<pg8::EpiYGate, pg8::MoeOrder<2>, true, true>(lds, g, S, E);
    }
    SEAM(PH_MOE2);
    if (IN(PH_FINAL)) sp_final(H, XS, INV, a.in[25], a.in[26]);
#undef IN
#undef SEAM
}

#ifndef MK_PER_PHASE
#define MK_PER_PHASE 0
#endif
extern "C" void kernel_launch(void* const* d_in, const int* in_sizes, int n_in, void* d_out, int out_size, void* d_ws, size_t ws_size, hipStream_t stream) {
    if (n_in != 27 || out_size != NTOK * DM || ws_size < WS_END) { fprintf(stderr, "kernel_launch: unexpected shapes (n_in %d out %d ws %zu)\n", n_in, out_size, ws_size); return; }
    static int grid = 0;
    if (grid == 0) {
        int dev = 0, cus = 0, per_cu = 0;
        (void)hipGetDevice(&dev); (void)hipDeviceGetAttribute(&cus, hipDeviceAttributeMultiprocessorCount, dev);
        (void)hipFuncSetAttribute((const void*)mk_fwd, hipFuncAttributeMaxDynamicSharedMemorySize, LDS_BYTES);
        (void)hipOccupancyMaxActiveBlocksPerMultiprocessor(&per_cu, (const void*)mk_fwd, NWAVES * 64, LDS_BYTES);
        (void)hipGetLastError();
        if (per_cu < 1) { fprintf(stderr, "kernel_launch: occupancy query says %d blocks/CU\n", per_cu); per_cu = 1; }
        grid = cus;
    }
    MKArgs ka{};
    for (int i = 0; i < 27; ++i) ka.in[i] = (const float*)d_in[i];
    ka.out = (float*)d_out; ka.ws = (unsigned char*)d_ws;
#if MK_PER_PHASE
    for (int p = 0; p < PH_COUNT; ++p) { MKArgs k2 = ka; k2.ph_lo = p; k2.ph_hi = p + 1; hipLaunchKernelGGL(mk_fwd, dim3(grid), dim3(NWAVES * 64), LDS_BYTES, stream, k2); }
#else
    ka.ph_lo = 0; ka.ph_hi = PH_COUNT;
    void* args[] = {&ka};
    hipError_t e = hipLaunchCooperativeKernel((const void*)mk_fwd, dim3(grid), dim3(NWAVES * 64), args, LDS_BYTES, stream);
    if (e != hipSuccess) fprintf(stderr, "kernel_launch: cooperative launch failed: %s (grid %d)\n", hipGetErrorString(e), grid);
#endif
}
```

```cpp
#include <hip/hip_runtime.h>
#include <hip/hip_cooperative_groups.h>
#include <cstdint>
#include <cstdio>

typedef unsigned short bf16_t;

constexpr int BATCH = 8, SEQ = 2048, DM = 1024, NTOK = BATCH * SEQ;
constexpr int MEML = 256, NMEM = BATCH * MEML;
constexpr int NU = 4096;
constexpr int U_HQ = 0, U_HI = 512, U_HG = 1024, U_HFF = 1536, U_HFB = 2048, U_DQ = 2560, U_DK = 3072, U_DV = 3584;
constexpr int NEXP = 16, CAP = 256, DFF = 2048, NGRP = BATCH * NEXP;
constexpr float ALPHA = 1.189207115002721f;
constexpr float LN_EPS = 1e-5f, RMS_EPS = 1e-6f;
constexpr float LAMBDA_INIT = 0.2f;

constexpr size_t MiB = 1u << 20;
constexpr size_t WS_CTL = 0;
constexpr size_t WS_ROPE = 1 * MiB;
constexpr size_t WS_LB = WS_ROPE + 256 * 1024;
constexpr size_t WS_AFF = 2 * MiB;
constexpr size_t WS_INV = 3 * MiB;
constexpr size_t WS_IDX = 4 * MiB;
constexpr size_t WS_GATE = 4 * MiB + 512 * 1024;
constexpr size_t WS_WIN = 5 * MiB;
constexpr size_t WS_WKV = 13 * MiB;
constexpr size_t WS_WMIX = 17 * MiB;
constexpr size_t WS_WQ = 19 * MiB;
constexpr size_t WS_WO = 21 * MiB;
constexpr size_t WS_WGU = 23 * MiB;
constexpr size_t WS_WD = 151 * MiB;
constexpr size_t WS_U = 215 * MiB;
constexpr size_t WS_XN = 343 * MiB;
constexpr size_t WS_MIX = 375 * MiB;
constexpr size_t WS_KV = 407 * MiB;
constexpr size_t WS_XS = 415 * MiB;
constexpr size_t WS_MEMB = 479 * MiB;
constexpr size_t WS_END = 483 * MiB;

__device__ __forceinline__ unsigned f2bf(float f) { unsigned u = __builtin_bit_cast(unsigned, f); return (u + 0x7fffu + ((u >> 16) & 1u)) >> 16; }
__device__ __forceinline__ float bf2f(bf16_t b) { return __builtin_bit_cast(float, (unsigned)b << 16); }
__device__ __forceinline__ float wave_sum(float v) {
#pragma unroll
    for (int o = 1; o < 64; o <<= 1) v += __shfl_xor(v, o);
    return v;
}
__device__ __forceinline__ float silu_f(float x) { return x / (1.f + expf(-x)); }
__device__ __forceinline__ float sigmoid_f(float x) { return 1.f / (1.f + expf(-x)); }

#define VB_LOOP(NT, nvb, vb, valid, tid, sub) \
    for (int _r = 0, _sub = (int)threadIdx.x / (NT), tid = (int)threadIdx.x % (NT), sub = _sub, _pr = (int)gridDim.x * (512 / (NT)), _nr = ((nvb) + _pr - 1) / _pr, vb = 0, valid = 0; \
         _r < _nr && ((vb = (_r * (int)gridDim.x + (int)blockIdx.x) * (512 / (NT)) + _sub), (valid = vb < (nvb)), true); ++_r)

__device__ __forceinline__ void sp_prep_small(const float* lb_logits, const float* lq1, const float* lk1, const float* lq2, const float* lk2, float* rope, float* lb) {
    for (int i = blockIdx.x * 512 + threadIdx.x; i < SEQ * 8; i += gridDim.x * 512) {
        const int t = i / 8, j = i % 8;
        const float inv = (float)(1.0 / pow(500000.0, (double)j / 8.0));
        const float ang = (float)t * inv;
        rope[t * 16 + j] = (float)cos((double)ang);
        rope[t * 16 + 8 + j] = (float)sin((double)ang);
        if (i < 1024) {
            const int d = i / 512, c = i % 512;
            const float l0 = lb_logits[d * 1024 + c], l1 = lb_logits[d * 1024 + 512 + c];
            const float m = fmaxf(l0, l1); const float e0 = expf(l0 - m), e1 = expf(l1 - m);
            lb[i] = e0 / (e0 + e1);
        }
        if (i == 0) {
            float s1 = 0.f, s2 = 0.f;
            for (int k = 0; k < 64; ++k) { s1 += lq1[k] * lk1[k]; s2 += lq2[k] * lk2[k]; }
            lb[1024] = expf(s1) - expf(s2) + LAMBDA_INIT;
        }
    }
}
__device__ __forceinline__ void sp_transpose(float* smem, const float* W, int K, int N, bf16_t* WT, int mode, long src_zs, long dst_zs, int nz) {
    const int nbx = N / 32, nby = K / 32, nvb = nbx * nby * nz;
    VB_LOOP(256, nvb, vb, valid, tid, sub) {
        float* t = smem + sub * (32 * 33);
        const int z = vb / (nbx * nby), rem = vb % (nbx * nby), by = rem / nbx, bxx = rem % nbx;
        const float* Wz = W + (long)z * src_zs; bf16_t* WTz = WT + (long)z * dst_zs;
        const int k0 = by * 32, n0 = bxx * 32, tx = tid & 31, ty = tid >> 5;
        if (valid) for (int i = ty; i < 32; i += 8) t[i * 33 + tx] = Wz[(long)(k0 + i) * N + n0 + tx];
        __syncthreads();
        if (valid) for (int i = ty; i < 32; i += 8) {
            const int n = n0 + i; long r = n;
            if (mode == 1) r = (long)(n / 128) * 256 + (n % 128);
            if (mode == 2) r = (long)(n / 128) * 256 + 128 + (n % 128);
            WTz[r * K + k0 + tx] = (bf16_t)f2bf(t[tx * 33 + i]);
        }
        __syncthreads();
    }
}
__device__ __forceinline__ void sp_cvt_bf16(const float* src, bf16_t* dst, long n) {
    for (long i = (long)blockIdx.x * 512 + threadIdx.x; i < n; i += (long)gridDim.x * 512) dst[i] = (bf16_t)f2bf(src[i]);
}

template <int MODE>
__device__ __forceinline__ void sp_ln_rows(const float* X, const float* g, const float* b, float* H, bf16_t* XN, const float* wr, float* AFF) {
    const int lane = threadIdx.x & 63;
    for (int row = blockIdx.x * 8 + (threadIdx.x >> 6); row < NTOK; row += gridDim.x * 8) {
        float4 v[4]; float s = 0.f;
#pragma unroll
        for (int j = 0; j < 4; ++j) {
            const long off = (long)row * DM + 4 * lane + 256 * j;
            v[j] = (MODE == 0) ? *(const float4*)(X + off) : *(const float4*)(H + off);
            s += (v[j].x + v[j].y) + (v[j].z + v[j].w);
        }
        const float mean = wave_sum(s) * (1.f / DM); float s2 = 0.f;
#pragma unroll
        for (int j = 0; j < 4; ++j) { v[j].x -= mean; v[j].y -= mean; v[j].z -= mean; v[j].w -= mean; s2 += (v[j].x * v[j].x + v[j].y * v[j].y) + (v[j].z * v[j].z + v[j].w * v[j].w); }
        const float rstd = 1.f / sqrtf(wave_sum(s2) * (1.f / DM) + LN_EPS);
#pragma unroll
        for (int j = 0; j < 4; ++j) {
            const int c = 4 * lane + 256 * j; const float4 gg = *(const float4*)(g + c), bb = *(const float4*)(b + c);
            v[j].x = v[j].x * rstd * gg.x + bb.x; v[j].y = v[j].y * rstd * gg.y + bb.y; v[j].z = v[j].z * rstd * gg.z + bb.z; v[j].w = v[j].w * rstd * gg.w + bb.w;
            *(float4*)(H + (long)row * DM + c) = v[j];
            uint2 o; o.x = f2bf(v[j].x) | (f2bf(v[j].y) << 16); o.y = f2bf(v[j].z) | (f2bf(v[j].w) << 16);
            *(uint2*)(XN + (long)row * DM + c) = o;
        }
        if (MODE == 2) {
            float acc[16];
#pragma unroll
            for (int e = 0; e < 16; ++e) acc[e] = 0.f;
#pragma unroll
            for (int j = 0; j < 4; ++j) {
                const float vv[4] = {v[j].x, v[j].y, v[j].z, v[j].w};
#pragma unroll
                for (int i = 0; i < 4; ++i) {
                    const float4* w4 = (const float4*)(wr + (long)(4 * lane + 256 * j + i) * 16);
#pragma unroll
                    for (int q = 0; q < 4; ++q) { const float4 w = w4[q]; acc[4 * q] += vv[i] * w.x; acc[4 * q + 1] += vv[i] * w.y; acc[4 * q + 2] += vv[i] * w.z; acc[4 * q + 3] += vv[i] * w.w; }
                }
            }
            float m = -INFINITY;
#pragma unroll
            for (int e = 0; e < 16; ++e) { acc[e] = wave_sum(acc[e]); m = fmaxf(m, acc[e]); }
            float sum = 0.f;
#pragma unroll
            for (int e = 0; e < 16; ++e) { acc[e] = expf(acc[e] - m); sum += acc[e]; }
            if (lane == 0) {
#pragma unroll
                for (int q = 0; q < 4; ++q) *(float4*)(AFF + (long)row * 16 + 4 * q) = make_float4(acc[4 * q] / sum, acc[4 * q + 1] / sum, acc[4 * q + 2] / sum, acc[4 * q + 3] / sum);
            }
        }
    }
}

__device__ __forceinline__ void sp_gemm(float* smem, const bf16_t* A0, long sa_z, int lda, const bf16_t* B0, long sb_z, long sbn, long sbk, float* C0, long sc_z, int ldc, int M, int N, int K, int Z) {
    const int nbx = N / 64, nby = M / 64, nvb = nbx * nby * Z;
    VB_LOOP(256, nvb, vb, valid, tid, sub) {
        float* As = smem + sub * (2 * 16 * 65); float* Bs = As + 16 * 65;
        const int z = vb / (nbx * nby), rem = vb % (nbx * nby), by = rem / nbx, bxx = rem % nbx;
        const bf16_t* A = A0 + (long)z * sa_z; const bf16_t* B = B0 + (long)z * sb_z; float* C = C0 + (long)z * sc_z;
        const int m0 = by * 64, n0 = bxx * 64, tx = tid & 15, ty = tid >> 4;
        float acc[4][4];
#pragma unroll
        for (int i = 0; i < 4; ++i)
#pragma unroll
            for (int j = 0; j < 4; ++j) acc[i][j] = 0.f;
        for (int k0 = 0; k0 < K; k0 += 16) {
            if (valid) {
                for (int i = tid; i < 1024; i += 256) { const int m = i >> 4, k = i & 15; As[k * 65 + m] = bf2f(A[(long)(m0 + m) * lda + k0 + k]); }
                for (int i = tid; i < 1024; i += 256) { const int n = i >> 4, k = i & 15; Bs[k * 65 + n] = bf2f(B[(long)(n0 + n) * sbn + (long)(k0 + k) * sbk]); }
            }
            __syncthreads();
#pragma unroll
            for (int k = 0; k < 16; ++k) {
                float a[4], bb[4];
#pragma unroll
                for (int i = 0; i < 4; ++i) { a[i] = As[k * 65 + ty * 4 + i]; bb[i] = Bs[k * 65 + tx * 4 + i]; }
#pragma unroll
                for (int i = 0; i < 4; ++i)
#pragma unroll
                    for (int j = 0; j < 4; ++j) acc[i][j] += a[i] * bb[j];
            }
            __syncthreads();
        }
        if (valid) {
#pragma unroll
            for (int i = 0; i < 4; ++i)
#pragma unroll
                for (int j = 0; j < 4; ++j) C[(long)(m0 + ty * 4 + i) * ldc + n0 + tx * 4 + j] = acc[i][j];
        }
    }
}
__device__ __forceinline__ void sp_cvt2d(const float* SC, int ldsc, bf16_t* dst, int ldd, int rows, int cols) {
    const long n = (long)rows * cols;
    for (long i = (long)blockIdx.x * 512 + threadIdx.x; i < n; i += (long)gridDim.x * 512) { const int r = (int)(i / cols), c = (int)(i % cols); dst[(long)r * ldd + c] = (bf16_t)f2bf(SC[(long)r * ldsc + c]); }
}

__device__ __forceinline__ void sp_hgrn(float* smem, const bf16_t* U, const float* LB, float* OSC) {
    VB_LOOP(128, 8 * 4 * 16, vb, valid, k, sub) {
        float* red = smem + sub * 32;
        const int dvs = vb & 7, h = (vb >> 3) & 3, bz = vb >> 5, b = bz >> 1, dir = bz & 1;
        float S[16];
#pragma unroll
        for (int j = 0; j < 16; ++j) S[j] = 0.f;
        const float lbv = valid ? LB[dir * 512 + h * 128 + k] : 0.5f;
        for (int step = 0; step < SEQ; ++step) {
            const int t = dir ? (SEQ - 1 - step) : step; const long row = (long)(valid ? b : 0) * SEQ + t;
            const bf16_t* ur = U + row * NU;
            const float qv = bf2f(ur[U_HQ + h * 128 + k]);
            const float uf = bf2f(ur[(dir ? U_HFB : U_HFF) + h * 128 + k]);
            const float f = lbv + (1.f - lbv) * sigmoid_f(uf), kk = 1.f - f;
            float part[16];
#pragma unroll
            for (int j = 0; j < 16; ++j) { const float vv = bf2f(ur[U_HI + h * 128 + dvs * 16 + j]); S[j] = f * S[j] + kk * vv; part[j] = wave_sum(S[j] * qv); }
            if ((k & 63) == 0) {
#pragma unroll
                for (int j = 0; j < 16; ++j) red[(k >> 6) * 16 + j] = part[j];
            }
            __syncthreads();
            if (valid && k < 16) OSC[((long)dir * NTOK + row) * 512 + h * 128 + dvs * 16 + k] = red[k] + red[16 + k];
            __syncthreads();
        }
    }
}
__device__ __forceinline__ void sp_hgrn_combine(const float* OSC, const bf16_t* U, const float* ng, bf16_t* MIX) {
    const int lane = threadIdx.x & 63;
    for (long w = (long)blockIdx.x * 8 + (threadIdx.x >> 6); w < (long)NTOK * 4; w += (long)gridDim.x * 8) {
        const long row = w >> 2; const int h = (int)(w & 3);
        float o[2]; float ss = 0.f;
#pragma unroll
        for (int i = 0; i < 2; ++i) { const int d = lane + 64 * i; o[i] = OSC[row * 512 + h * 128 + d] + OSC[((long)NTOK + row) * 512 + h * 128 + d]; ss += o[i] * o[i]; }
        const float r = 1.f / sqrtf(wave_sum(ss) * (1.f / 128.f) + RMS_EPS);
#pragma unroll
        for (int i = 0; i < 2; ++i) { const int d = lane + 64 * i; const float y = o[i] * r * ng[h * 128 + d] * bf2f(U[row * NU + U_HG + h * 128 + d]); MIX[row * DM + h * 128 + d] = (bf16_t)f2bf(y); }
    }
}

__device__ __forceinline__ void sp_dattn(float* smem, const bf16_t* U, float* OSC) {
    VB_LOOP(256, 32 * 8 * 8, vb, valid, tid, sub) {
        float* Ks = smem + sub * (16 * 64 + 16 * 128); float* Vs = Ks + 16 * 64;
        const int qb = vb & 31, g = (vb >> 5) & 7, b = valid ? (vb >> 8) : 0, h = g >> 1, r = tid & 63, qt = tid >> 6;
        const long row = (long)b * SEQ + qb * 64 + r;
        float q[64], o[32];
#pragma unroll
        for (int d = 0; d < 64; ++d) q[d] = bf2f(U[row * NU + U_DQ + g * 64 + d]);
#pragma unroll
        for (int d = 0; d < 32; ++d) o[d] = 0.f;
        float m = -INFINITY, l = 0.f;
        for (int k0 = 0; k0 < SEQ; k0 += 16) {
            for (int i = tid; i < 16 * 64; i += 256) { const int kk = i >> 6, d = i & 63; Ks[kk * 64 + d] = bf2f(U[((long)b * SEQ + k0 + kk) * NU + U_DK + g * 64 + d]); }
            for (int i = tid; i < 16 * 128; i += 256) { const int kk = i >> 7, d = i & 127; Vs[kk * 128 + d] = bf2f(U[((long)b * SEQ + k0 + kk) * NU + U_DV + h * 128 + d]); }
            __syncthreads();
            float s[16]; float tm = m;
#pragma unroll
            for (int kk = 0; kk < 16; ++kk) { float a = 0.f;
#pragma unroll
                for (int d = 0; d < 64; ++d) a += q[d] * Ks[kk * 64 + d];
                s[kk] = a; tm = fmaxf(tm, a); }
            const float corr = exp2f(m - tm); m = tm; l *= corr;
#pragma unroll
            for (int d = 0; d < 32; ++d) o[d] *= corr;
#pragma unroll
            for (int kk = 0; kk < 16; ++kk) { const float p = exp2f(s[kk] - m); l += p;
#pragma unroll
                for (int d = 0; d < 32; ++d) o[d] += p * Vs[kk * 128 + qt * 32 + d]; }
            __syncthreads();
        }
        const float il = 1.f / l;
        if (valid) {
#pragma unroll
            for (int d = 0; d < 32; ++d) OSC[(row * 8 + g) * 128 + qt * 32 + d] = o[d] * il;
        }
    }
}
__device__ __forceinline__ void sp_dattn_combine(const float* OSC, const float* lamp, const float* sg, bf16_t* MIX) {
    const int lane = threadIdx.x & 63; const float lam = lamp[0];
    for (long w = (long)blockIdx.x * 8 + (threadIdx.x >> 6); w < (long)NTOK * 4; w += (long)gridDim.x * 8) {
        const long row = w >> 2; const int h = (int)(w & 3);
        float o[2]; float ss = 0.f;
#pragma unroll
        for (int i = 0; i < 2; ++i) { const int d = lane + 64 * i; o[i] = OSC[(row * 8 + 2 * h) * 128 + d] - lam * OSC[(row * 8 + 2 * h + 1) * 128 + d]; ss += o[i] * o[i]; }
        const float r = 1.f / sqrtf(wave_sum(ss) * (1.f / 128.f) + RMS_EPS);
#pragma unroll
        for (int i = 0; i < 2; ++i) { const int d = lane + 64 * i; MIX[row * DM + 512 + h * 128 + d] = (bf16_t)f2bf(o[i] * r * sg[d] * (1.f - LAMBDA_INIT)); }
    }
}

__device__ __forceinline__ void sp_softmax256(const float* S, bf16_t* P, long nrows) {
    const int lane = threadIdx.x & 63;
    for (long row = (long)blockIdx.x * 8 + (threadIdx.x >> 6); row < nrows; row += (long)gridDim.x * 8) {
        float4 v = *(const float4*)(S + row * 256 + 4 * lane);
        float m = fmaxf(fmaxf(v.x, v.y), fmaxf(v.z, v.w));
#pragma unroll
        for (int o = 1; o < 64; o <<= 1) m = fmaxf(m, __shfl_xor(m, o));
        v.x = exp2f(v.x - m); v.y = exp2f(v.y - m); v.z = exp2f(v.z - m); v.w = exp2f(v.w - m);
        const float il = 1.f / wave_sum((v.x + v.y) + (v.z + v.w));
        uint2 o; o.x = f2bf(v.x * il) | (f2bf(v.y * il) << 16); o.y = f2bf(v.z * il) | (f2bf(v.w * il) << 16);
        *(uint2*)(P + row * 256 + 4 * lane) = o;
    }
}

__device__ __forceinline__ void sp_topk_gather(float* smem, const float* AFF, const bf16_t* XN, int* IDX, float* GATE, int* INV, bf16_t* XS) {
    VB_LOOP(256, NGRP, grp, valid, tid, sub) {
        float* a = smem + sub * (SEQ + CAP); int* sel = (int*)(a + SEQ);
        const int b = valid ? (grp >> 4) : 0, e = grp & 15;
        for (int t = tid; t < SEQ; t += 256) a[t] = AFF[((long)b * SEQ + t) * 16 + e];
        __syncthreads();
        if (valid) for (int t = tid; t < SEQ; t += 256) {
            const float mine = a[t]; int rank = 0;
            for (int u = 0; u < SEQ; ++u) { const float x = a[u]; rank += (x > mine || (x == mine && u < t)) ? 1 : 0; }
            if (rank < CAP) { sel[rank] = t; IDX[grp * CAP + rank] = t; GATE[grp * CAP + rank] = mine; INV[((long)b * SEQ + t) * 16 + e] = rank; }
            else INV[((long)b * SEQ + t) * 16 + e] = -1;
        }
        __syncthreads();
        const int lane = tid & 63, wv = tid >> 6;
        if (valid) for (int r = wv; r < CAP; r += 4) {
            const uint4* src = (const uint4*)(XN + ((long)b * SEQ + sel[r]) * DM); uint4* dst = (uint4*)(XS + ((long)grp * CAP + r) * DM);
            dst[lane] = src[lane]; dst[lane + 64] = src[lane + 64];
        }
        __syncthreads();
    }
}

__device__ __forceinline__ void sp_final(float* H, const bf16_t* Y, const int* INV, const float* g, const float* b) {
    const int lane = threadIdx.x & 63;
    for (long row = (long)blockIdx.x * 8 + (threadIdx.x >> 6); row < NTOK; row += (long)gridDim.x * 8) {
        const int bt = (int)(row / SEQ);
        float4 v[4];
#pragma unroll
        for (int j = 0; j < 4; ++j) { const float4 h = *(const float4*)(H + row * DM + 4 * lane + 256 * j); v[j] = make_float4(ALPHA * h.x, ALPHA * h.y, ALPHA * h.z, ALPHA * h.w); }
        for (int e = 0; e < 16; ++e) {
            const int slot = INV[row * 16 + e];
            if (slot >= 0) {
                const bf16_t* yr = Y + ((long)(bt * 16 + e) * CAP + slot) * DM;
#pragma unroll
                for (int j = 0; j < 4; ++j) { const uint2 p = *(const uint2*)(yr + 4 * lane + 256 * j);
                    v[j].x += bf2f((bf16_t)(p.x & 0xffff)); v[j].y += bf2f((bf16_t)(p.x >> 16)); v[j].z += bf2f((bf16_t)(p.y & 0xffff)); v[j].w += bf2f((bf16_t)(p.y >> 16)); }
            }
        }
        float s = 0.f;
#pragma unroll
        for (int j = 0; j < 4; ++j) s += (v[j].x + v[j].y) + (v[j].z + v[j].w);
        const float mean = wave_sum(s) * (1.f / DM); float s2 = 0.f;
#pragma unroll
        for (int j = 0; j < 4; ++j) { v[j].x -= mean; v[j].y -= mean; v[j].z -= mean; v[j].w -= mean; s2 += (v[j].x * v[j].x + v[j].y * v[j].y) + (v[j].z * v[j].z + v[j].w * v[j].w); }
        const float rstd = 1.f / sqrtf(wave_sum(s2) * (1.f / DM) + LN_EPS);
#pragma unroll
        for (int j = 0; j < 4; ++j) {
            const int c = 4 * lane + 256 * j; const float4 gg = *(const float4*)(g + c), bb = *(const float4*)(b + c);
            float4 o; o.x = v[j].x * rstd * gg.x + bb.x; o.y = v[j].y * rstd * gg.y + bb.y; o.z = v[j].z * rstd * gg.z + bb.z; o.w = v[j].w * rstd * gg.w + bb.w;
            *(float4*)(H + row * DM + c) = o;
        }
    }
}
namespace pg8 {
#define PG8_LAS __attribute__((address_space(3)))
typedef unsigned short bf16_t;
typedef short bf16x8 __attribute__((ext_vector_type(8)));
typedef float f32x4 __attribute__((ext_vector_type(4)));
typedef unsigned u32x4 __attribute__((ext_vector_type(4)));
constexpr int BM = 256, BK = 64, HALF = 128, HTB = HALF * BK * 2  , STAGE_BYTES = 8 * HTB, NXCD = 8, WGM = 8;

__host__ __device__ __forceinline__ int lds_byte(int r, int c) { const int st = (r >> 4) * 2 + (c >> 5), rr = r & 15, cc = c & 31, ob = rr * 64 + cc * 2; return st * 1024 + (ob ^ (((ob >> 9) & 1) << 5)); }
__host__ __device__ __forceinline__ void stage_rc(int b, int& R, int& C) { const int st = b / 1024, sb = b % 1024, swz = sb ^ (((sb >> 9) & 1) << 5); R = (st >> 1) * 16 + swz / 64; C = (st & 1) * 32 + (swz % 64) / 2; }
__host__ __device__ __forceinline__ int perm32(int rho) { const int n = rho >> 4, i = rho & 15; return 8 * (i >> 2) + 4 * n + (i & 3); }

struct Unit { int pm, pn; };
struct Gemm { const bf16_t* A; const bf16_t* Bt; int M, N, K; };

struct StaticOrder {
    int nM, nN, nwg, G, c;
    __host__ __device__ void init(int M, int N, int G_, int c_) { nM = M / BM; nN = N / BM; nwg = nM * nN; G = G_; c = c_; }
    __host__ __device__ bool next(int i, Unit& u) const {
        const long L = (long)i * G + c; if (L >= nwg) return false;
        int wgid = (int)L; { const int q = nwg / NXCD, r = nwg % NXCD, xcd = wgid % NXCD, off = wgid / NXCD; wgid = (xcd < r ? xcd * (q + 1) : r * (q + 1) + (xcd - r) * q) + off; }
        const int nig = WGM * nN, gid = wgid / nig, fm = gid * WGM, gsz = (nM - fm) < WGM ? (nM - fm) : WGM;
        u.pm = fm + ((wgid % nig) % gsz); u.pn = (wgid % nig) / gsz; return true;
    }
    __device__ __forceinline__ void a_ready(const Unit&) const {}
    __device__ __forceinline__ void done(const Unit&) const {}
};

__device__ __forceinline__ unsigned cvt_pk_bf16(float lo, float hi) { unsigned r; asm volatile("v_cvt_pk_bf16_f32 %0, %1, %2" : "=v"(r) : "v"(lo), "v"(hi)); return r; }
typedef float f32x2 __attribute__((ext_vector_type(2)));
typedef unsigned u32x4 __attribute__((ext_vector_type(4)));
constexpr float QSCALE_DA = 0.125f * 1.4426950408889634f;
constexpr float QSCALE_XA = 0.0625f * 1.4426950408889634f;
__device__ __forceinline__ float silu_fast(float x) { return x * __builtin_amdgcn_rcpf(1.f + __builtin_amdgcn_exp2f(-1.4426950408889634f * x)); }

struct EpiStore {
    static constexpr bool PERM = true, AFTER_DRAIN = false;
    bf16_t* O; int ldc; float scale; int mode; const float* rope;
    __device__ __forceinline__ void operator()(const f32x4 (&acc)[2][2][4][2], const Unit& u, int wr, int wc, int fr, int fq) const {
        const int row0 = u.pm * BM + wr * 64 + fr, col0 = u.pn * BM + wc * 32 + 8 * fq;
        int op = 0; float sc = scale;
        if (mode == 1) { const int seg = u.pn >> 1; op = (seg == 0 || seg == 2) ? 1 : (seg == 5 ? 2 : (seg == 6 ? 3 : 0)); if (seg == 5) sc = QSCALE_DA; }
        const bool do_rope = (op >= 2) && !(wc & 1);
#pragma unroll
        for (int ai = 0; ai < 2; ++ai)
#pragma unroll
            for (int m = 0; m < 4; ++m) {
                const int row = row0 + ai * HALF + m * 16; bf16_t* rowp = O + (size_t)row * ldc + col0;
                f32x4 c0 = {1.f, 1.f, 1.f, 1.f}, c1 = c0, s0 = {0.f, 0.f, 0.f, 0.f}, s1 = s0;
                if (do_rope) { const float* rp = rope + (row & 2047) * 16; c0 = *(const f32x4*)rp; c1 = *(const f32x4*)(rp + 4); s0 = *(const f32x4*)(rp + 8); s1 = *(const f32x4*)(rp + 12);
                    if (fq == 0) { s0 = -s0; s1 = -s1; } else if (fq >= 2) { c0 = (f32x4){1.f, 1.f, 1.f, 1.f}; c1 = c0; s0 = (f32x4){0.f, 0.f, 0.f, 0.f}; s1 = s0; } }
#pragma unroll
                for (int bj = 0; bj < 2; ++bj) {
                    f32x4 v0 = acc[ai][bj][m][0], v1 = acc[ai][bj][m][1];
                    if (op == 1) {
#pragma unroll
                        for (int j = 0; j < 4; ++j) { v0[j] = silu_fast(v0[j]); v1[j] = silu_fast(v1[j]); }
                    }
                    if (do_rope) {
                        f32x4 p0, p1;
#pragma unroll
                        for (int j = 0; j < 4; ++j) { p0[j] = __shfl_xor(v0[j], 16); p1[j] = __shfl_xor(v1[j], 16); }
                        v0 = v0 * c0 + p0 * s0; v1 = v1 * c1 + p1 * s1;
                    }
                    v0 = v0 * sc; v1 = v1 * sc;
                    u32x4 w; w.x = cvt_pk_bf16(v0[0], v0[1]); w.y = cvt_pk_bf16(v0[2], v0[3]); w.z = cvt_pk_bf16(v1[0], v1[1]); w.w = cvt_pk_bf16(v1[2], v1[3]);
                    *(u32x4*)(rowp + bj * HALF) = w;
                }
            }
    }
};
struct EpiResid {
    static constexpr bool PERM = false, AFTER_DRAIN = false;
    float* H; float alpha;
    __device__ __forceinline__ void operator()(const f32x4 (&acc)[2][2][4][2], const Unit& u, int wr, int wc, int fr, int fq) const {
        const int row0 = u.pm * BM + wr * 64 + fr, col0 = u.pn * BM + wc * 32 + 4 * fq;
#pragma unroll
        for (int ai = 0; ai < 2; ++ai)
#pragma unroll
            for (int m = 0; m < 4; ++m) { float* rowp = H + (size_t)(row0 + ai * HALF + m * 16) * 1024 + col0;
#pragma unroll
                for (int bj = 0; bj < 2; ++bj)
#pragma unroll
                    for (int n = 0; n < 2; ++n) { f32x4* p = (f32x4*)(rowp + bj * HALF + n * 16); const f32x4 h = *p; *p = h * alpha + acc[ai][bj][m][n]; } }
    }
};
struct EpiSwiglu {
    static constexpr bool PERM = true, AFTER_DRAIN = false;
    bf16_t* ACT;
    __device__ __forceinline__ void operator()(const f32x4 (&acc)[2][2][4][2], const Unit& u, int wr, int wc, int fr, int fq) const {
        const int row0 = u.pm * BM + wr * 64 + fr, col0 = (u.pn & 15) * 128 + wc * 32 + 8 * fq;
#pragma unroll
        for (int ai = 0; ai < 2; ++ai)
#pragma unroll
            for (int m = 0; m < 4; ++m) {
                f32x4 v0 = acc[ai][0][m][0], v1 = acc[ai][0][m][1]; const f32x4 u0 = acc[ai][1][m][0], u1 = acc[ai][1][m][1];
#pragma unroll
                for (int j = 0; j < 4; ++j) { v0[j] = silu_fast(v0[j]) * u0[j]; v1[j] = silu_fast(v1[j]) * u1[j]; }
                u32x4 w; w.x = cvt_pk_bf16(v0[0], v0[1]); w.y = cvt_pk_bf16(v0[2], v0[3]); w.z = cvt_pk_bf16(v1[0], v1[1]); w.w = cvt_pk_bf16(v1[2], v1[3]);
                *(u32x4*)(ACT + (size_t)(row0 + ai * HALF + m * 16) * 2048 + col0) = w;
            }
    }
};
struct EpiYGate {
    static constexpr bool PERM = true, AFTER_DRAIN = false;
    bf16_t* Y; const float* GATE;
    __device__ __forceinline__ void operator()(const f32x4 (&acc)[2][2][4][2], const Unit& u, int wr, int wc, int fr, int fq) const {
        const int row0 = u.pm * BM + wr * 64 + fr, col0 = (u.pn & 3) * BM + wc * 32 + 8 * fq;
#pragma unroll
        for (int ai = 0; ai < 2; ++ai)
#pragma unroll
            for (int m = 0; m < 4; ++m) { const int row = row0 + ai * HALF + m * 16; const float gt = GATE[row]; bf16_t* rowp = Y + (size_t)row * 1024 + col0;
#pragma unroll
                for (int bj = 0; bj < 2; ++bj) { const f32x4 v0 = acc[ai][bj][m][0] * gt, v1 = acc[ai][bj][m][1] * gt;
                    u32x4 w; w.x = cvt_pk_bf16(v0[0], v0[1]); w.y = cvt_pk_bf16(v0[2], v0[3]); w.z = cvt_pk_bf16(v1[0], v1[1]); w.w = cvt_pk_bf16(v1[2], v1[3]);
                    *(u32x4*)(rowp + bj * HALF) = w; } }
    }
};
template <int WHICH> struct MoeOrder {
    int G, c;
    __device__ bool next(int i, Unit& u) const {
        constexpr int NWG = WHICH == 1 ? 2048 : 512;
        const int L = i * G + c; if (L >= NWG) return false;
        const int Ux = (G % 8 == 0 && NWG % 8 == 0) ? (L % 8) * (NWG / 8) + L / 8 : L;
        if (WHICH == 1) { const int e = Ux >> 7, jg = (Ux & 127) >> 5, b = (Ux & 31) >> 2, jj = Ux & 3; u.pm = b * 16 + e; u.pn = e * 16 + jg * 4 + jj; }
        else { const int e = Ux >> 5, b = (Ux & 31) >> 2, j = Ux & 3; u.pm = b * 16 + e; u.pn = e * 4 + j; }
        return true;
    }
    __device__ __forceinline__ void a_ready(const Unit&) const {}
    __device__ __forceinline__ void done(const Unit&) const {}
};
template <class Epi, class Sched, bool ALIGN_EPI = false, bool SP2 = false>
__device__ __forceinline__ void gemm_phase(PG8_LAS unsigned char* lds, const Gemm g, const Sched& S, const Epi& E) {
    const int tid = threadIdx.x, wid = __builtin_amdgcn_readfirstlane(tid >> 6), lane = tid & 63, wr = wid >> 2, wc = wid & 3, fr = lane & 15, fq = lane >> 4;
    const int K = g.K, nt = K / BK;
    unsigned voffA[2], voffB[2];
#pragma unroll
    for (int i = 0; i < 2; ++i) { int R, C; stage_rc(tid * 16 + i * 8192, R, C); const int Rb = Epi::PERM ? ((R & ~31) + perm32(R & 31)) : R;
        voffA[i] = (unsigned)(R * K + C) * 2u; voffB[i] = (unsigned)(Rb * K + C) * 2u; }
    const size_t kstep = (size_t)(BK * 2);
    const size_t hstep = (size_t)HALF * K * 2;
    const size_t tstep = 2 * hstep;
    const unsigned ldsw = (unsigned)wid * 1024u;
    const int aoff = lds_byte(wr * 64 + fr, fq * 8), boff = lds_byte(wc * 32 + fr, fq * 8);
#define PG8_SA(b, h) (((b) * 2 + (h)) * HTB)
#define PG8_SB(b, h) ((4 + (b) * 2 + (h)) * HTB)
#define PG8_STAGE(bufoff, gbase, voff) do { _Pragma("unroll") for (int _i = 0; _i < 2; ++_i) \
        __builtin_amdgcn_global_load_lds((const unsigned*)((const char*)(gbase) + (voff)[_i]), (PG8_LAS unsigned*)(lds + (bufoff) + ldsw + _i * 8192), 16, 0, 0); } while (0)
#define PG8_LDA(dst, b, h) do { _Pragma("unroll") for (int m = 0; m < 4; ++m) _Pragma("unroll") for (int k = 0; k < 2; ++k) dst[m][k] = *(const PG8_LAS bf16x8*)(lds + PG8_SA(b, h) + aoff + m * 2048 + k * 1024); } while (0)
#define PG8_LDB(dst, b, h) do { _Pragma("unroll") for (int n = 0; n < 2; ++n) _Pragma("unroll") for (int k = 0; k < 2; ++k) dst[n][k] = *(const PG8_LAS bf16x8*)(lds + PG8_SB(b, h) + boff + n * 2048 + k * 1024); } while (0)
#define PG8_MMA(ai, bj, At, Bt) do { __builtin_amdgcn_s_setprio(1); _Pragma("unroll") for (int m = 0; m < 4; ++m) _Pragma("unroll") for (int n = 0; n < 2; ++n) _Pragma("unroll") for (int k = 0; k < 2; ++k) \
        acc[ai][bj][m][n] = __builtin_amdgcn_mfma_f32_16x16x32_bf16(Bt[n][k], At[m][k], acc[ai][bj][m][n], 0, 0, 0); __builtin_amdgcn_s_setprio(0); } while (0)
#define PG8_WAIT_V(n) asm volatile("s_waitcnt vmcnt(" #n ")" ::: "memory")
#define PG8_WAIT_L(n) asm volatile("s_waitcnt lgkmcnt(" #n ")" ::: "memory")
#define PG8_BAR __builtin_amdgcn_s_barrier()
#define PG8_SCHED __builtin_amdgcn_sched_barrier(0)
    Unit cur, nxt; int ui = 0;
    if (!S.next(0, cur)) return;
    f32x4 acc[2][2][4][2];
#pragma unroll
    for (int a = 0; a < 2; ++a)
#pragma unroll
        for (int b = 0; b < 2; ++b)
#pragma unroll
            for (int m = 0; m < 4; ++m)
#pragma unroll
                for (int n = 0; n < 2; ++n) acc[a][b][m][n] = (f32x4){0.f, 0.f, 0.f, 0.f};
    bf16x8 At[4][2], B0[2][2], B1[2][2];
    const char* cA = (const char*)g.A + (size_t)cur.pm * tstep; const char* cB = (const char*)g.Bt + (size_t)cur.pn * tstep;
    S.a_ready(cur);
    if constexpr (SP2) {
        PG8_STAGE(PG8_SB(0, 0), cB, voffB); PG8_STAGE(PG8_SB(0, 1), cB + hstep, voffB); PG8_STAGE(PG8_SA(0, 0), cA, voffA); PG8_STAGE(PG8_SA(0, 1), cA + hstep, voffA);
        if (wr == 1) PG8_BAR;
        PG8_WAIT_V(2); PG8_BAR;
        PG8_STAGE(PG8_SB(1, 0), cB + kstep, voffB); PG8_STAGE(PG8_SA(1, 0), cA + kstep, voffA); PG8_STAGE(PG8_SB(1, 1), cB + hstep + kstep, voffB);
        PG8_WAIT_V(6); PG8_BAR;
    } else {
        PG8_STAGE(PG8_SB(0, 0), cB, voffB); PG8_STAGE(PG8_SA(0, 0), cA, voffA); PG8_STAGE(PG8_SB(0, 1), cB + hstep, voffB); PG8_STAGE(PG8_SA(0, 1), cA + hstep, voffA);
        if (wr == 1) PG8_BAR;
        PG8_WAIT_V(4); PG8_BAR;
        PG8_STAGE(PG8_SB(1, 0), cB + kstep, voffB); PG8_STAGE(PG8_SA(1, 0), cA + kstep, voffA); PG8_STAGE(PG8_SB(1, 1), cB + hstep + kstep, voffB);
        PG8_WAIT_V(6); PG8_BAR;
    }
    for (;;) {
        const bool has_next = S.next(ui + 1, nxt);
        const char* nA = has_next ? (const char*)g.A + (size_t)nxt.pm * tstep : cA; const char* nB = has_next ? (const char*)g.Bt + (size_t)nxt.pn * tstep : cB;
        for (int t = 0; t < nt; t += 2) {
            const bool last = (t == nt - 2);
            const char* a1 = cA + (size_t)(t + 1) * kstep;
            const char* a2 = last ? nA : cA + (size_t)(t + 2) * kstep; const char* b2 = last ? nB : cB + (size_t)(t + 2) * kstep;
            const char* a3 = a2 + kstep; const char* b3 = b2 + kstep;
            if (last && has_next) S.a_ready(nxt);
            if constexpr (SP2) {
            PG8_LDB(B0, 0, 0); PG8_LDB(B1, 0, 1); PG8_SCHED; PG8_LDA(At, 0, 0); PG8_STAGE(PG8_SA(1, 1), a1 + hstep, voffA);
            PG8_WAIT_V(8); PG8_WAIT_L(0); PG8_BAR; PG8_MMA(0, 0, At, B0); PG8_MMA(0, 1, At, B1); PG8_BAR; PG8_SCHED;
            PG8_LDA(At, 0, 1); PG8_STAGE(PG8_SB(0, 0), b2, voffB); PG8_STAGE(PG8_SB(0, 1), b2 + hstep, voffB); PG8_STAGE(PG8_SA(0, 0), a2, voffA);
            PG8_WAIT_V(8); PG8_WAIT_L(0); PG8_BAR; PG8_MMA(1, 0, At, B0); PG8_MMA(1, 1, At, B1); PG8_BAR; PG8_SCHED;
            PG8_LDB(B0, 1, 0); PG8_LDB(B1, 1, 1); PG8_SCHED; PG8_LDA(At, 1, 0); PG8_STAGE(PG8_SA(0, 1), a2 + hstep, voffA);
            PG8_WAIT_V(8); PG8_WAIT_L(0); PG8_BAR; PG8_MMA(0, 0, At, B0); PG8_MMA(0, 1, At, B1); PG8_BAR; PG8_SCHED;
            PG8_LDA(At, 1, 1); PG8_STAGE(PG8_SB(1, 0), b3, voffB); PG8_STAGE(PG8_SB(1, 1), b3 + hstep, voffB); PG8_STAGE(PG8_SA(1, 0), a3, voffA);
            PG8_WAIT_V(8); PG8_WAIT_L(0); PG8_BAR; PG8_MMA(1, 0, At, B0); PG8_MMA(1, 1, At, B1); PG8_BAR; PG8_SCHED;
            } else {
            PG8_LDB(B0, 0, 0); PG8_SCHED; PG8_LDA(At, 0, 0); PG8_STAGE(PG8_SA(1, 1), a1 + hstep, voffA);
            PG8_WAIT_L(8); PG8_BAR; PG8_WAIT_L(0); PG8_MMA(0, 0, At, B0); PG8_BAR; PG8_SCHED;
            PG8_LDB(B1, 0, 1); PG8_STAGE(PG8_SB(0, 0), b2, voffB);
            PG8_BAR; PG8_WAIT_L(0); PG8_MMA(0, 1, At, B1); PG8_BAR;
            PG8_LDA(At, 0, 1); PG8_STAGE(PG8_SA(0, 0), a2, voffA);
            PG8_BAR; PG8_WAIT_L(0); PG8_MMA(1, 0, At, B0); PG8_BAR; PG8_SCHED;
            PG8_STAGE(PG8_SB(0, 1), b2 + hstep, voffB);
            PG8_WAIT_V(6); PG8_BAR; PG8_MMA(1, 1, At, B1); PG8_BAR;
            PG8_LDB(B0, 1, 0); PG8_SCHED; PG8_LDA(At, 1, 0); PG8_STAGE(PG8_SA(0, 1), a2 + hstep, voffA);
            PG8_WAIT_L(8); PG8_BAR; PG8_WAIT_L(0); PG8_MMA(0, 0, At, B0); PG8_BAR; PG8_SCHED;
            PG8_LDB(B1, 1, 1); PG8_STAGE(PG8_SB(1, 0), b3, voffB);
            PG8_BAR; PG8_WAIT_L(0); PG8_MMA(0, 1, At, B1); PG8_BAR;
            PG8_LDA(At, 1, 1); PG8_STAGE(PG8_SA(1, 0), a3, voffA);
            PG8_BAR; PG8_WAIT_L(0); PG8_MMA(1, 0, At, B0); PG8_BAR; PG8_SCHED;
            PG8_STAGE(PG8_SB(1, 1), b3 + hstep, voffB);
            PG8_WAIT_V(6); PG8_BAR; PG8_MMA(1, 1, At, B1); PG8_BAR;
            }
        }
        if constexpr (ALIGN_EPI) { if (wr == 0) PG8_BAR; }
        if constexpr (!Epi::AFTER_DRAIN) { E(acc, cur, wr, wc, fr, fq); S.done(cur); }
        if (!has_next) break;
#pragma unroll
        for (int a = 0; a < 2; ++a)
#pragma unroll
            for (int b = 0; b < 2; ++b)
#pragma unroll
                for (int m = 0; m < 4; ++m)
#pragma unroll
                    for (int n = 0; n < 2; ++n) acc[a][b][m][n] = (f32x4){0.f, 0.f, 0.f, 0.f};
        cur = nxt; cA = nA; cB = nB; ++ui;
        if constexpr (ALIGN_EPI) { if (wr == 1) PG8_BAR; }
    }
    PG8_WAIT_V(0);
    if constexpr (!ALIGN_EPI) { if (wr == 0) PG8_BAR; }
    PG8_BAR;
    if constexpr (Epi::AFTER_DRAIN) { E.fused(acc, cur, wr, wc, fr, fq, lds, wid, lane); S.done(cur); }
#undef PG8_SA
#undef PG8_SB
#undef PG8_STAGE
#undef PG8_LDA
#undef PG8_LDB
#undef PG8_MMA
#undef PG8_WAIT_V
#undef PG8_WAIT_L
#undef PG8_BAR
#undef PG8_SCHED
}
}
namespace da {
#define DA_LAS __attribute__((address_space(3)))
typedef short bf16x8 __attribute__((ext_vector_type(8)));
typedef short s16x4 __attribute__((ext_vector_type(4)));
typedef float f32x16 __attribute__((ext_vector_type(16)));
typedef float f32x4 __attribute__((ext_vector_type(4)));
typedef unsigned u32x4 __attribute__((ext_vector_type(4)));
typedef unsigned u32x2 __attribute__((ext_vector_type(2)));
constexpr int KSTR = 144, VSTR = 320;
constexpr int K_BYTES = 64 * KSTR, V_BYTES = 64 * VSTR, STAGE = 2 * K_BYTES + V_BYTES;
constexpr float THR = 4.0f;
__device__ __forceinline__ unsigned cvt_pk(float lo, float hi) { unsigned r; asm volatile("v_cvt_pk_bf16_f32 %0, %1, %2" : "=v"(r) : "v"(lo), "v"(hi)); return r; }
__device__ __forceinline__ s16x4 vtr(const DA_LAS unsigned char* p) { typedef short v4i16_t __attribute__((ext_vector_type(4)));
    return __builtin_bit_cast(s16x4, __builtin_amdgcn_ds_read_tr16_b64_v4i16((DA_LAS v4i16_t*)p)); }

__device__ __forceinline__ void dattn_phase(DA_LAS unsigned char* lds, const bf16_t* U, const float* lamp, const float* subln_g, bf16_t* MIX, int vcu, int G) {
    const int tid = threadIdx.x, lane = tid & 63, wave = __builtin_amdgcn_readfirstlane(tid >> 6), comp = wave >> 2, qs = wave & 3;
    const int r32 = lane & 31, hh = lane >> 5, gi = lane >> 4, li = lane & 15;
    const float lam = lamp[0];
    const int krow = tid >> 3, kch = tid & 7, vrow0 = tid >> 4, vch = tid & 15;
    const int kdst = krow * KSTR + kch * 16, vdst0 = vrow0 * VSTR + vch * 16, vdst1 = (vrow0 + 32) * VSTR + vch * 16;
    const int kfrag = r32 * KSTR + hh * 16;
    const int vfrag = (4 * hh + (li >> 2)) * VSTR + (16 * (gi & 1) + 4 * (li & 3)) * 2;
    for (int u = vcu; u < BATCH * 4 * 16; u += G) {
        const int qb = u & 15, h = (u >> 4) & 3, b = u >> 6;
        const bf16_t* Ub = U + (size_t)b * SEQ * NU;
        const bf16_t* ksrc0 = Ub + (size_t)krow * NU + U_DK + (2 * h) * 64 + kch * 8;
        const bf16_t* ksrc1 = ksrc0 + 64;
        const bf16_t* vsrc0 = Ub + (size_t)vrow0 * NU + U_DV + h * 128 + vch * 8;
        const bf16_t* vsrc1 = vsrc0 + (size_t)32 * NU;
        bf16x8 qf[4];
        { const bf16_t* qp = Ub + (size_t)(qb * 128 + qs * 32 + r32) * NU + U_DQ + (2 * h + comp) * 64 + hh * 8;
#pragma unroll
          for (int ds = 0; ds < 4; ++ds) qf[ds] = *(const bf16x8*)(qp + ds * 16); }
        f32x16 o[4];
#pragma unroll
        for (int d0 = 0; d0 < 4; ++d0)
#pragma unroll
            for (int r = 0; r < 16; ++r) o[d0][r] = 0.f;
        float m = -INFINITY, l = 0.f;
        u32x4 rk0 = *(const u32x4*)ksrc0, rk1 = *(const u32x4*)ksrc1, rv0 = *(const u32x4*)vsrc0, rv1 = *(const u32x4*)vsrc1;
        *(DA_LAS u32x4*)(lds + kdst) = rk0; *(DA_LAS u32x4*)(lds + K_BYTES + kdst) = rk1; *(DA_LAS u32x4*)(lds + 2 * K_BYTES + vdst0) = rv0; *(DA_LAS u32x4*)(lds + 2 * K_BYTES + vdst1) = rv1;
        __syncthreads();
        for (int t = 0; t < SEQ / 64; ++t) {
            const DA_LAS unsigned char* st = lds + (t & 1) * STAGE;
            DA_LAS unsigned char* nst = lds + ((t + 1) & 1) * STAGE;
            if (t + 1 < SEQ / 64) { const size_t go = (size_t)(t + 1) * 64 * NU; rk0 = *(const u32x4*)(ksrc0 + go); rk1 = *(const u32x4*)(ksrc1 + go); rv0 = *(const u32x4*)(vsrc0 + go); rv1 = *(const u32x4*)(vsrc1 + go); }
            const DA_LAS unsigned char* Kt = st + comp * K_BYTES + kfrag;
            f32x16 p0, p1;
#pragma unroll
            for (int r = 0; r < 16; ++r) { p0[r] = 0.f; p1[r] = 0.f; }
#pragma unroll
            for (int ds = 0; ds < 4; ++ds) {
                const bf16x8 a0 = *(const DA_LAS bf16x8*)(Kt + ds * 32), a1 = *(const DA_LAS bf16x8*)(Kt + 32 * KSTR + ds * 32);
                p0 = __builtin_amdgcn_mfma_f32_32x32x16_bf16(a0, qf[ds], p0, 0, 0, 0);
                p1 = __builtin_amdgcn_mfma_f32_32x32x16_bf16(a1, qf[ds], p1, 0, 0, 0);
            }
            float mx = fmaxf(p0[0], p1[0]);
#pragma unroll
            for (int r = 1; r < 16; ++r) mx = fmaxf(mx, fmaxf(p0[r], p1[r]));
            mx = fmaxf(mx, __shfl_xor(mx, 32));
            if (!__all(mx - m <= THR)) {
                const float mn = fmaxf(m, mx), alpha = __builtin_amdgcn_exp2f(m - mn);
                m = mn; l *= alpha;
#pragma unroll
                for (int d0 = 0; d0 < 4; ++d0) o[d0] = o[d0] * alpha;
            }
            float rs = 0.f;
#pragma unroll
            for (int r = 0; r < 16; ++r) { p0[r] = __builtin_amdgcn_exp2f(p0[r] - m); p1[r] = __builtin_amdgcn_exp2f(p1[r] - m); rs += p0[r] + p1[r]; }
            l += rs;
            bf16x8 pf[4];
#pragma unroll
            for (int s = 0; s < 2; ++s) {
                u32x4 w0, w1;
                w0.x = cvt_pk(p0[8 * s + 0], p0[8 * s + 1]); w0.y = cvt_pk(p0[8 * s + 2], p0[8 * s + 3]); w0.z = cvt_pk(p0[8 * s + 4], p0[8 * s + 5]); w0.w = cvt_pk(p0[8 * s + 6], p0[8 * s + 7]);
                w1.x = cvt_pk(p1[8 * s + 0], p1[8 * s + 1]); w1.y = cvt_pk(p1[8 * s + 2], p1[8 * s + 3]); w1.z = cvt_pk(p1[8 * s + 4], p1[8 * s + 5]); w1.w = cvt_pk(p1[8 * s + 6], p1[8 * s + 7]);
                pf[s] = __builtin_bit_cast(bf16x8, w0); pf[2 + s] = __builtin_bit_cast(bf16x8, w1);
            }
            const DA_LAS unsigned char* Vt = st + 2 * K_BYTES + vfrag;
#pragma unroll
            for (int d0 = 0; d0 < 4; ++d0)
#pragma unroll
                for (int ks = 0; ks < 4; ++ks) {
                    const s16x4 lo = vtr(Vt + (16 * ks) * VSTR + 64 * d0), hi = vtr(Vt + (16 * ks + 8) * VSTR + 64 * d0);
                    const bf16x8 av = (bf16x8){lo[0], lo[1], lo[2], lo[3], hi[0], hi[1], hi[2], hi[3]};
                    o[d0] = __builtin_amdgcn_mfma_f32_32x32x16_bf16(av, pf[ks], o[d0], 0, 0, 0);
                }
            if (t + 1 < SEQ / 64) { *(DA_LAS u32x4*)(nst + kdst) = rk0; *(DA_LAS u32x4*)(nst + K_BYTES + kdst) = rk1; *(DA_LAS u32x4*)(nst + 2 * K_BYTES + vdst0) = rv0; *(DA_LAS u32x4*)(nst + 2 * K_BYTES + vdst1) = rv1; }
            __syncthreads();
        }
        l += __shfl_xor(l, 32);
        const float il = 1.f / l;
        DA_LAS float* xch = (DA_LAS float*)lds + (size_t)qs * 64 * 64 + lane;
        if (comp == 1) {
#pragma unroll
            for (int d0 = 0; d0 < 4; ++d0)
#pragma unroll
                for (int r = 0; r < 16; ++r) xch[(d0 * 16 + r) * 64] = o[d0][r] * il;
        }
        __syncthreads();
        if (comp == 0) {
            float ss = 0.f;
#pragma unroll
            for (int d0 = 0; d0 < 4; ++d0)
#pragma unroll
                for (int r = 0; r < 16; ++r) { const float v = o[d0][r] * il - lam * xch[(d0 * 16 + r) * 64]; o[d0][r] = v; ss += v * v; }
            ss += __shfl_xor(ss, 32);
            const float rn = (1.f - LAMBDA_INIT) / sqrtf(ss * (1.f / 128.f) + RMS_EPS);
            bf16_t* orow = MIX + (size_t)(b * SEQ + qb * 128 + qs * 32 + r32) * DM + 512 + h * 128 + 4 * hh;
#pragma unroll
            for (int d0 = 0; d0 < 4; ++d0)
#pragma unroll
                for (int rq = 0; rq < 4; ++rq) {
                    const f32x4 g4 = *(const f32x4*)(subln_g + 32 * d0 + 8 * rq + 4 * hh);
                    u32x2 w; w.x = cvt_pk(o[d0][4 * rq] * rn * g4[0], o[d0][4 * rq + 1] * rn * g4[1]); w.y = cvt_pk(o[d0][4 * rq + 2] * rn * g4[2], o[d0][4 * rq + 3] * rn * g4[3]);
                    *(u32x2*)(orow + 32 * d0 + 8 * rq) = w;
                }
        }
        __syncthreads();
    }
}
}
namespace hg {
#define HG_LAS __attribute__((address_space(3)))
typedef short bf16x8 __attribute__((ext_vector_type(8)));
typedef short s16x4 __attribute__((ext_vector_type(4)));
typedef float f32x16 __attribute__((ext_vector_type(16)));
typedef float f32x4 __attribute__((ext_vector_type(4)));
typedef unsigned u32x4 __attribute__((ext_vector_type(4)));
typedef unsigned u32x2 __attribute__((ext_vector_type(2)));
typedef float f32x2 __attribute__((ext_vector_type(2)));
constexpr int RSTR = 272, TSTR = 320;
constexpr int L_QIN = 0, L_KIN = L_QIN + 64 * RSTR, L_KINT = L_KIN + 64 * RSTR, L_VT = L_KINT + 64 * TSTR, L_SBT = L_VT + 64 * TSTR, L_DEC = L_SBT + 128 * RSTR, L_SEGT = L_DEC + 512, L_END = L_SEGT + 8 * 128 * 4;
static_assert(L_END <= 131072, "hgrn LDS map");
constexpr float LOG2E = 1.4426950408889634f;
__device__ __forceinline__ unsigned cvt_pk(float lo, float hi) { unsigned r; asm volatile("v_cvt_pk_bf16_f32 %0, %1, %2" : "=v"(r) : "v"(lo), "v"(hi)); return r; }
__device__ __forceinline__ s16x4 vtr(const HG_LAS unsigned char* p) { typedef short v4i16_t __attribute__((ext_vector_type(4)));
    return __builtin_bit_cast(s16x4, __builtin_amdgcn_ds_read_tr16_b64_v4i16((HG_LAS v4i16_t*)p)); }
__device__ __forceinline__ float bflo(unsigned w) { return __builtin_bit_cast(float, w << 16); }
__device__ __forceinline__ float bfhi(unsigned w) { return __builtin_bit_cast(float, w & 0xffff0000u); }

__device__ __forceinline__ void hgrn_phase(HG_LAS unsigned char* lds, const bf16_t* U, const float* LB, float* OSC, int first, int stride) {
    const int tid = threadIdx.x, lane = tid & 63, wave = __builtin_amdgcn_readfirstlane(tid >> 6);
    const int r32 = lane & 31, hh = lane >> 5, gi = lane >> 4, li = lane & 15;
    const int vt = wave >> 1, ct = wave & 1, kt = wave >> 1, vpair = wave & 1;
    const int kp = lane, seg = wave;
    const int vrow0 = tid >> 4, vch = tid & 15;
    const int trp = (li >> 2) * TSTR + (16 * (gi & 1) + 4 * (li & 3)) * 2;
    for (int item = first; item < BATCH * 4 * 2; item += stride) {
        const int dir = item & 1, h = (item >> 1) & 3, b = item >> 3;
        const bf16_t* Ub = U + (size_t)b * SEQ * NU;
        const int qcol = U_HQ + h * 128 + 2 * kp, fcol = (dir ? U_HFB : U_HFF) + h * 128 + 2 * kp, vcol = U_HI + h * 128 + vch * 8;
        const float lb0 = LB[dir * 512 + h * 128 + 2 * kp], lb1 = LB[dir * 512 + h * 128 + 2 * kp + 1];
        for (int i = tid; i < 128 * RSTR / 4; i += 512) ((HG_LAS unsigned*)(lds + L_SBT))[i] = 0u;
        f32x16 S[2];
#pragma unroll
        for (int r = 0; r < 16; ++r) { S[0][r] = 0.f; S[1][r] = 0.f; }
        unsigned rq[8], rf[8]; u32x4 rv0, rv1;
#define HG_TIME(p) (dir ? (SEQ - 1 - (p)) : (p))
#define HG_LOAD(n) do { _Pragma("unroll") for (int i = 0; i < 8; ++i) { const bf16_t* rp = Ub + (size_t)HG_TIME(64 * (n) + 8 * seg + i) * NU; rq[i] = *(const unsigned*)(rp + qcol); rf[i] = *(const unsigned*)(rp + fcol); } \
        rv0 = *(const u32x4*)(Ub + (size_t)HG_TIME(64 * (n) + vrow0) * NU + vcol); rv1 = *(const u32x4*)(Ub + (size_t)HG_TIME(64 * (n) + vrow0 + 32) * NU + vcol); } while (0)
        HG_LOAD(0);
        __syncthreads();
        for (int n = 0; n < SEQ / 64; ++n) {
            float c0[8], c1[8], k0[8], k1[8]; float a0 = 0.f, a1 = 0.f;
#pragma unroll
            for (int i = 0; i < 8; ++i) {
                const float u0 = bflo(rf[i]), u1 = bfhi(rf[i]);
                const float f0 = lb0 + (1.f - lb0) * __builtin_amdgcn_rcpf(1.f + __builtin_amdgcn_exp2f(-LOG2E * u0));
                const float f1 = lb1 + (1.f - lb1) * __builtin_amdgcn_rcpf(1.f + __builtin_amdgcn_exp2f(-LOG2E * u1));
                k0[i] = 1.f - f0; k1[i] = 1.f - f1;
                a0 += __builtin_amdgcn_logf(f0); a1 += __builtin_amdgcn_logf(f1);
                c0[i] = a0; c1[i] = a1;
            }
            *(HG_LAS f32x2*)(lds + L_SEGT + (seg * 128 + 2 * kp) * 4) = (f32x2){a0, a1};
            __syncthreads();
            float off0 = 0.f, off1 = 0.f, tot0 = 0.f, tot1 = 0.f;
#pragma unroll
            for (int s2 = 0; s2 < 8; ++s2) { const f32x2 tq = *(const HG_LAS f32x2*)(lds + L_SEGT + (s2 * 128 + 2 * kp) * 4); if (s2 < seg) { off0 += tq.x; off1 += tq.y; } tot0 += tq.x; tot1 += tq.y; }
            if (seg == 0) *(HG_LAS f32x2*)(lds + L_DEC + 2 * kp * 4) = (f32x2){__builtin_amdgcn_exp2f(tot0), __builtin_amdgcn_exp2f(tot1)};
#pragma unroll
            for (int i = 0; i < 8; ++i) {
                const int c = 8 * seg + i; const float b0 = off0 + c0[i], b1 = off1 + c1[i];
                const unsigned qi = cvt_pk(bflo(rq[i]) * __builtin_amdgcn_exp2f(b0), bfhi(rq[i]) * __builtin_amdgcn_exp2f(b1));
                const unsigned ki = cvt_pk(k0[i] * __builtin_amdgcn_exp2f(-b0), k1[i] * __builtin_amdgcn_exp2f(-b1));
                *(HG_LAS unsigned*)(lds + L_QIN + c * RSTR + 4 * kp) = qi;
                *(HG_LAS unsigned*)(lds + L_KIN + c * RSTR + 4 * kp) = ki;
                *(HG_LAS unsigned*)(lds + L_KINT + c * TSTR + 4 * kp) = ki;
            }
            *(HG_LAS u32x4*)(lds + L_VT + vrow0 * TSTR + vch * 16) = rv0; *(HG_LAS u32x4*)(lds + L_VT + (vrow0 + 32) * TSTR + vch * 16) = rv1;
            if (n + 1 < SEQ / 64) HG_LOAD(n + 1);
            __syncthreads();
            bf16x8 qfr[8];
#pragma unroll
            for (int ks = 0; ks < 8; ++ks) qfr[ks] = *(const HG_LAS bf16x8*)(lds + L_QIN + (32 * ct + r32) * RSTR + ks * 32 + hh * 16);
            f32x16 o;
#pragma unroll
            for (int r = 0; r < 16; ++r) o[r] = 0.f;
#pragma unroll
            for (int ks = 0; ks < 8; ++ks) {
                const bf16x8 as = *(const HG_LAS bf16x8*)(lds + L_SBT + (32 * vt + r32) * RSTR + ks * 32 + hh * 16);
                o = __builtin_amdgcn_mfma_f32_32x32x16_bf16(as, qfr[ks], o, 0, 0, 0);
            }
#pragma unroll
            for (int st = 0; st < 2; ++st) {
                if (st <= ct) {
                    f32x16 at;
#pragma unroll
                    for (int r = 0; r < 16; ++r) at[r] = 0.f;
#pragma unroll
                    for (int ks = 0; ks < 8; ++ks) {
                        const bf16x8 ak = *(const HG_LAS bf16x8*)(lds + L_KIN + (32 * st + r32) * RSTR + ks * 32 + hh * 16);
                        at = __builtin_amdgcn_mfma_f32_32x32x16_bf16(ak, qfr[ks], at, 0, 0, 0);
                    }
                    if (st == ct) {
#pragma unroll
                        for (int r = 0; r < 16; ++r) { const int srow = (r & 3) + 8 * (r >> 2) + 4 * hh; at[r] = (srow <= r32) ? at[r] : 0.f; }
                    }
#pragma unroll
                    for (int s2 = 0; s2 < 2; ++s2) {
                        u32x4 w; w.x = cvt_pk(at[8 * s2 + 0], at[8 * s2 + 1]); w.y = cvt_pk(at[8 * s2 + 2], at[8 * s2 + 3]); w.z = cvt_pk(at[8 * s2 + 4], at[8 * s2 + 5]); w.w = cvt_pk(at[8 * s2 + 6], at[8 * s2 + 7]);
                        const HG_LAS unsigned char* vp = lds + L_VT + (32 * st + 16 * s2 + 4 * hh) * TSTR + 64 * vt + trp;
                        const s16x4 lo = vtr(vp), hi = vtr(vp + 8 * TSTR);
                        const bf16x8 av = (bf16x8){lo[0], lo[1], lo[2], lo[3], hi[0], hi[1], hi[2], hi[3]};
                        o = __builtin_amdgcn_mfma_f32_32x32x16_bf16(av, __builtin_bit_cast(bf16x8, w), o, 0, 0, 0);
                    }
                }
            }
#pragma unroll
            for (int cs = 0; cs < 4; ++cs) {
                const HG_LAS unsigned char* kp_ = lds + L_KINT + (16 * cs + 8 * hh) * TSTR + 64 * kt + trp;
                const s16x4 klo = vtr(kp_), khi = vtr(kp_ + 4 * TSTR);
                const bf16x8 ak = (bf16x8){klo[0], klo[1], klo[2], klo[3], khi[0], khi[1], khi[2], khi[3]};
#pragma unroll
                for (int vv = 0; vv < 2; ++vv) {
                    const HG_LAS unsigned char* vp = lds + L_VT + (16 * cs + 8 * hh) * TSTR + 64 * (2 * vpair + vv) + trp;
                    const s16x4 vlo = vtr(vp), vhi = vtr(vp + 4 * TSTR);
                    const bf16x8 bv = (bf16x8){vlo[0], vlo[1], vlo[2], vlo[3], vhi[0], vhi[1], vhi[2], vhi[3]};
                    S[vv] = __builtin_amdgcn_mfma_f32_32x32x16_bf16(ak, bv, S[vv], 0, 0, 0);
                }
            }
#pragma unroll
            for (int rq4 = 0; rq4 < 4; ++rq4) {
                const f32x4 d4 = *(const HG_LAS f32x4*)(lds + L_DEC + (32 * kt + 8 * rq4 + 4 * hh) * 4);
#pragma unroll
                for (int j = 0; j < 4; ++j) { S[0][4 * rq4 + j] *= d4[j]; S[1][4 * rq4 + j] *= d4[j]; }
            }
            __syncthreads();
#pragma unroll
            for (int vv = 0; vv < 2; ++vv)
#pragma unroll
                for (int rq4 = 0; rq4 < 4; ++rq4) {
                    u32x2 w; w.x = cvt_pk(S[vv][4 * rq4], S[vv][4 * rq4 + 1]); w.y = cvt_pk(S[vv][4 * rq4 + 2], S[vv][4 * rq4 + 3]);
                    *(HG_LAS u32x2*)(lds + L_SBT + (32 * (2 * vpair + vv) + r32) * RSTR + (32 * kt + 8 * rq4 + 4 * hh) * 2) = w;
                }
            {
                const int tok = HG_TIME(64 * n + 32 * ct + r32);
                float* op = OSC + ((size_t)dir * NTOK + (size_t)b * SEQ + tok) * 512 + h * 128 + 32 * vt + 4 * hh;
#pragma unroll
                for (int rq4 = 0; rq4 < 4; ++rq4) *(f32x4*)(op + 8 * rq4) = (f32x4){o[4 * rq4], o[4 * rq4 + 1], o[4 * rq4 + 2], o[4 * rq4 + 3]};
            }
        }
        __syncthreads();
#undef HG_LOAD
#undef HG_TIME
    }
}
}
namespace xa {
#define XA_LAS __attribute__((address_space(3)))
typedef short bf16x8 __attribute__((ext_vector_type(8)));
typedef short s16x4 __attribute__((ext_vector_type(4)));
typedef float f32x16 __attribute__((ext_vector_type(16)));
typedef unsigned u32x4 __attribute__((ext_vector_type(4)));
typedef unsigned u32x2 __attribute__((ext_vector_type(2)));
constexpr int KSTR = 528, VSTR = 576;
constexpr int K_BYTES = 64 * KSTR, V_BYTES = 64 * VSTR;
constexpr float THR = 4.0f;
__device__ __forceinline__ unsigned cvt_pk(float lo, float hi) { unsigned r; asm volatile("v_cvt_pk_bf16_f32 %0, %1, %2" : "=v"(r) : "v"(lo), "v"(hi)); return r; }
__device__ __forceinline__ s16x4 vtr(const XA_LAS unsigned char* p) { typedef short v4i16_t __attribute__((ext_vector_type(4)));
    return __builtin_bit_cast(s16x4, __builtin_amdgcn_ds_read_tr16_b64_v4i16((XA_LAS v4i16_t*)p)); }

__device__ __forceinline__ void xattn_phase(XA_LAS unsigned char* lds, bf16_t* QO, const bf16_t* KV, int vcu, int G) {
    const int tid = threadIdx.x, lane = tid & 63, wave = __builtin_amdgcn_readfirstlane(tid >> 6), qs = wave >> 2, dq = wave & 3;
    const int r32 = lane & 31, hh = lane >> 5, gi = lane >> 4, li = lane & 15;
    const int srow = tid >> 5, sch = tid & 31;
    const int kfrag = r32 * KSTR + hh * 16;
    const int vfrag = (4 * hh + (li >> 2)) * VSTR + (16 * (gi & 1) + 4 * (li & 3)) * 2 + 128 * dq;
    for (int u = vcu; u < BATCH * 4 * 32; u += G) {
        const int qb = u & 31, h = (u >> 5) & 3, b = u >> 7;
        const bf16_t* ksrc = KV + (size_t)(b * MEML + srow) * 2048 + h * 256 + sch * 8;
        const bf16_t* vsrc = ksrc + 1024;
        bf16_t* qrow = QO + (size_t)(b * SEQ + qb * 64 + qs * 32 + r32) * DM + h * 256;
        bf16x8 qf[16];
#pragma unroll
        for (int ds = 0; ds < 16; ++ds) qf[ds] = *(const bf16x8*)(qrow + ds * 16 + hh * 8);
        f32x16 o[2];
#pragma unroll
        for (int r = 0; r < 16; ++r) { o[0][r] = 0.f; o[1][r] = 0.f; }
        float m = -INFINITY, l = 0.f;
        u32x4 rk[4], rv[4];
#pragma unroll
        for (int i = 0; i < 4; ++i) { rk[i] = *(const u32x4*)(ksrc + (size_t)(16 * i) * 2048); rv[i] = *(const u32x4*)(vsrc + (size_t)(16 * i) * 2048); }
        for (int t = 0; t < MEML / 64; ++t) {
#pragma unroll
            for (int i = 0; i < 4; ++i) { *(XA_LAS u32x4*)(lds + (srow + 16 * i) * KSTR + sch * 16) = rk[i]; *(XA_LAS u32x4*)(lds + K_BYTES + (srow + 16 * i) * VSTR + sch * 16) = rv[i]; }
            if (t + 1 < MEML / 64) {
#pragma unroll
                for (int i = 0; i < 4; ++i) { rk[i] = *(const u32x4*)(ksrc + (size_t)(64 * (t + 1) + 16 * i) * 2048); rv[i] = *(const u32x4*)(vsrc + (size_t)(64 * (t + 1) + 16 * i) * 2048); }
            }
            __syncthreads();
            const XA_LAS unsigned char* Kt = lds + kfrag;
            f32x16 p0, p1;
#pragma unroll
            for (int r = 0; r < 16; ++r) { p0[r] = 0.f; p1[r] = 0.f; }
#pragma unroll
            for (int ds = 0; ds < 16; ++ds) {
                const bf16x8 a0 = *(const XA_LAS bf16x8*)(Kt + ds * 32), a1 = *(const XA_LAS bf16x8*)(Kt + 32 * KSTR + ds * 32);
                p0 = __builtin_amdgcn_mfma_f32_32x32x16_bf16(a0, qf[ds], p0, 0, 0, 0);
                p1 = __builtin_amdgcn_mfma_f32_32x32x16_bf16(a1, qf[ds], p1, 0, 0, 0);
                if ((ds & 3) == 3) __builtin_amdgcn_sched_barrier(0);
            }
            float mx = fmaxf(p0[0], p1[0]);
#pragma unroll
            for (int r = 1; r < 16; ++r) mx = fmaxf(mx, fmaxf(p0[r], p1[r]));
            mx = fmaxf(mx, __shfl_xor(mx, 32));
            if (!__all(mx - m <= THR)) {
                const float mn = fmaxf(m, mx), alpha = __builtin_amdgcn_exp2f(m - mn);
                m = mn; l *= alpha; o[0] = o[0] * alpha; o[1] = o[1] * alpha;
            }
            float rs = 0.f;
#pragma unroll
            for (int r = 0; r < 16; ++r) { p0[r] = __builtin_amdgcn_exp2f(p0[r] - m); p1[r] = __builtin_amdgcn_exp2f(p1[r] - m); rs += p0[r] + p1[r]; }
            l += rs;
            bf16x8 pf[4];
#pragma unroll
            for (int s = 0; s < 2; ++s) {
                u32x4 w0, w1;
                w0.x = cvt_pk(p0[8 * s + 0], p0[8 * s + 1]); w0.y = cvt_pk(p0[8 * s + 2], p0[8 * s + 3]); w0.z = cvt_pk(p0[8 * s + 4], p0[8 * s + 5]); w0.w = cvt_pk(p0[8 * s + 6], p0[8 * s + 7]);
                w1.x = cvt_pk(p1[8 * s + 0], p1[8 * s + 1]); w1.y = cvt_pk(p1[8 * s + 2], p1[8 * s + 3]); w1.z = cvt_pk(p1[8 * s + 4], p1[8 * s + 5]); w1.w = cvt_pk(p1[8 * s + 6], p1[8 * s + 7]);
                pf[s] = __builtin_bit_cast(bf16x8, w0); pf[2 + s] = __builtin_bit_cast(bf16x8, w1);
            }
            const XA_LAS unsigned char* Vt = lds + K_BYTES + vfrag;
#pragma unroll
            for (int d0 = 0; d0 < 2; ++d0)
#pragma unroll
                for (int ks = 0; ks < 4; ++ks) {
                    const s16x4 lo = vtr(Vt + (16 * ks) * VSTR + 64 * d0), hi = vtr(Vt + (16 * ks + 8) * VSTR + 64 * d0);
                    const bf16x8 av = (bf16x8){lo[0], lo[1], lo[2], lo[3], hi[0], hi[1], hi[2], hi[3]};
                    o[d0] = __builtin_amdgcn_mfma_f32_32x32x16_bf16(av, pf[ks], o[d0], 0, 0, 0);
                }
            __syncthreads();
        }
        l += __shfl_xor(l, 32);
        const float il = 1.f / l;
        bf16_t* orow = qrow + 64 * dq + 4 * hh;
#pragma unroll
        for (int d0 = 0; d0 < 2; ++d0)
#pragma unroll
            for (int rq = 0; rq < 4; ++rq) {
                u32x2 w; w.x = cvt_pk(o[d0][4 * rq] * il, o[d0][4 * rq + 1] * il); w.y = cvt_pk(o[d0][4 * rq + 2] * il, o[d0][4 * rq + 3] * il);
                *(u32x2*)(orow + 32 * d0 + 8 * rq) = w;
            }
    }
}
}
namespace cg = cooperative_groups;
#ifndef USE_MFMA_HGRN
#define USE_MFMA_HGRN 1
#endif
#ifndef USE_MFMA_XATTN
#define USE_MFMA_XATTN 1
#endif
#ifndef USE_MFMA_DATTN
#define USE_MFMA_DATTN 1
#endif
constexpr int NWAVES = 8;
constexpr int LDS_BYTES = 147456;
enum { PH_PROLOGUE = 0, PH_INPROJ, PH_HGRN, PH_HGRN_COMB, PH_DATTN, PH_DATTN_COMB, PH_MIXGEMM, PH_LN1, PH_QPROJ, PH_XA_SCORES, PH_XA_SOFTMAX, PH_XA_PV, PH_XA_CVT,
       PH_WOGEMM, PH_LN2, PH_TOPK, PH_MOE1, PH_MOE2, PH_FINAL, PH_COUNT };
struct MKArgs { const float* in[27]; float* out; unsigned char* ws; int ph_lo, ph_hi; };

__global__ void __launch_bounds__(NWAVES * 64, 2) mk_fwd(MKArgs a) {
    extern __shared__ __attribute__((aligned(16))) unsigned char lds_raw[];
    PG8_LAS unsigned char* lds = (PG8_LAS unsigned char*)lds_raw;
    float* smem = (float*)lds_raw;
    unsigned char* ws = a.ws;
    const int G = gridDim.x, bx = blockIdx.x;
    const int vcu = (G % 8 == 0) ? (bx % 8) * (G / 8) + bx / 8 : bx;
    const int lo = a.ph_lo, hi = a.ph_hi;
#define IN(k) (lo <= (k) && (k) < hi)
#define SEAM(k) do { if (IN(k) && IN((k) + 1)) cg::this_grid().sync(); } while (0)
    float* H = a.out;
    float* ROPE = (float*)(ws + WS_ROPE); float* LB = (float*)(ws + WS_LB); float* LAM = LB + 1024;
    float* AFF = (float*)(ws + WS_AFF); int* INV = (int*)(ws + WS_INV); int* IDX = (int*)(ws + WS_IDX); float* GATE = (float*)(ws + WS_GATE);
    bf16_t* XN = (bf16_t*)(ws + WS_XN); bf16_t* MIX = (bf16_t*)(ws + WS_MIX); bf16_t* U = (bf16_t*)(ws + WS_U); bf16_t* XS = (bf16_t*)(ws + WS_XS);
    bf16_t* KV = (bf16_t*)(ws + WS_KV); bf16_t* MEMB = (bf16_t*)(ws + WS_MEMB);
    float* SC_XS = (float*)(ws + WS_XS);
    bf16_t* P = XN;

    if (IN(PH_PROLOGUE)) {
        sp_prep_small(a.in[5], a.in[7], a.in[8], a.in[9], a.in[10], ROPE, LB);
        sp_transpose(smem, a.in[4], DM, NU, (bf16_t*)(ws + WS_WIN), 0, 0, 0, 1);
        sp_transpose(smem, a.in[16], DM, DM, (bf16_t*)(ws + WS_WKV), 0, 0, 0, 1);
        sp_transpose(smem, a.in[17], DM, DM, (bf16_t*)(ws + WS_WKV) + (size_t)DM * DM, 0, 0, 0, 1);
        sp_transpose(smem, a.in[12], DM, DM, (bf16_t*)(ws + WS_WMIX), 0, 0, 0, 1);
        sp_transpose(smem, a.in[15], DM, DM, (bf16_t*)(ws + WS_WQ), 0, 0, 0, 1);
        sp_transpose(smem, a.in[18], DM, DM, (bf16_t*)(ws + WS_WO), 0, 0, 0, 1);
        sp_transpose(smem, a.in[22], DM, DFF, (bf16_t*)(ws + WS_WGU), 1, (long)DM * DFF, (long)2 * DFF * DM, NEXP);
        sp_transpose(smem, a.in[23], DM, DFF, (bf16_t*)(ws + WS_WGU), 2, (long)DM * DFF, (long)2 * DFF * DM, NEXP);
        sp_transpose(smem, a.in[24], DFF, DM, (bf16_t*)(ws + WS_WD), 0, (long)DFF * DM, (long)DFF * DM, NEXP);
        sp_cvt_bf16(a.in[1], MEMB, (long)NMEM * DM);
        sp_ln_rows<0>(a.in[0], a.in[2], a.in[3], H, XN, nullptr, nullptr);
    }
    SEAM(PH_PROLOGUE);
    if (IN(PH_INPROJ)) {
        {
            pg8::Gemm g{XN, (const bf16_t*)(ws + WS_WIN), NTOK, NU, DM}; pg8::StaticOrder S; S.init(NTOK, NU, G, bx);
            pg8::EpiStore E{U, NU, 1.f, 1, ROPE};
            pg8::gemm_phase<pg8::EpiStore, pg8::StaticOrder, true, true>(lds, g, S, E);
        }
        {
            pg8::Gemm g{MEMB, (const bf16_t*)(ws + WS_WKV), NMEM, 2048, DM}; pg8::StaticOrder S; S.init(NMEM, 2048, G, bx);
            pg8::EpiStore E{KV, 2048, 1.f, 0, nullptr};
            pg8::gemm_phase<pg8::EpiStore, pg8::StaticOrder, true, true>(lds, g, S, E);
        }
    }
    SEAM(PH_INPROJ);
#if USE_MFMA_HGRN
    if (IN(PH_HGRN)) hg::hgrn_phase(lds, U, LB, SC_XS, vcu, G);
#else
    if (IN(PH_HGRN)) sp_hgrn(smem, U, LB, SC_XS);
#endif
    SEAM(PH_HGRN);
    if (IN(PH_HGRN_COMB)) sp_hgrn_combine(SC_XS, U, a.in[6], MIX);
    SEAM(PH_HGRN_COMB);
#if USE_MFMA_DATTN
    if (IN(PH_DATTN)) da::dattn_phase(lds, U, LAM, a.in[11], MIX, vcu, G);
    SEAM(PH_DATTN);
    SEAM(PH_DATTN_COMB);
#else
    if (IN(PH_DATTN)) sp_dattn(smem, U, SC_XS);
    SEAM(PH_DATTN);
    if (IN(PH_DATTN_COMB)) sp_dattn_combine(SC_XS, LAM, a.in[11], MIX);
    SEAM(PH_DATTN_COMB);
#endif
    if (IN(PH_MIXGEMM)) {
        pg8::Gemm g{MIX, (const bf16_t*)(ws + WS_WMIX), NTOK, DM, DM}; pg8::StaticOrder S; S.init(NTOK, DM, G, bx);
        pg8::EpiResid E{H, ALPHA};
        pg8::gemm_phase<pg8::EpiResid, pg8::StaticOrder, true, true>(lds, g, S, E);
    }
    SEAM(PH_MIXGEMM);
    if (IN(PH_LN1)) sp_ln_rows<1>(nullptr, a.in[13], a.in[14], H, XN, nullptr, nullptr);
    SEAM(PH_LN1);
    if (IN(PH_QPROJ)) {
        pg8::Gemm g{XN, (const bf16_t*)(ws + WS_WQ), NTOK, DM, DM}; pg8::StaticOrder S; S.init(NTOK, DM, G, bx);
        pg8::EpiStore E{MIX, DM, pg8::QSCALE_XA, 0, nullptr};
        pg8::gemm_phase<pg8::EpiStore, pg8::StaticOrder, true, true>(lds, g, S, E);
    }
    SEAM(PH_QPROJ);
#if USE_MFMA_XATTN
    if (IN(PH_XA_SCORES)) xa::xattn_phase(lds, MIX, KV, vcu, G);
    SEAM(PH_XA_SCORES); SEAM(PH_XA_SOFTMAX); SEAM(PH_XA_PV);
#else
    if (IN(PH_XA_SCORES))
        for (int b = 0; b < BATCH; ++b)
            sp_gemm(smem, MIX + (size_t)b * SEQ * DM, 256, DM, KV + (size_t)b * MEML * 2048, 256, 2048, 1, SC_XS + (size_t)b * 4 * SEQ * 256, (long)SEQ * 256, 256, SEQ, 256, 256, 4);
    SEAM(PH_XA_SCORES);
    if (IN(PH_XA_SOFTMAX)) sp_softmax256(SC_XS, P, (long)BATCH * 4 * SEQ);
    SEAM(PH_XA_SOFTMAX);
    if (IN(PH_XA_PV))
        for (int b = 0; b < BATCH; ++b)
            sp_gemm(smem, P + (size_t)b * 4 * SEQ * 256, (long)SEQ * 256, 256, KV + (size_t)b * MEML * 2048 + 1024, 256, 1, 2048, SC_XS + (size_t)b * SEQ * DM, 256, DM, SEQ, 256, 256, 4);
    SEAM(PH_XA_PV);
    if (IN(PH_XA_CVT)) sp_cvt2d(SC_XS, DM, MIX, DM, NTOK, DM);
#endif
    SEAM(PH_XA_CVT);
    if (IN(PH_WOGEMM)) {
        pg8::Gemm g{MIX, (const bf16_t*)(ws + WS_WO), NTOK, DM, DM}; pg8::StaticOrder S; S.init(NTOK, DM, G, bx);
        pg8::EpiResid E{H, ALPHA};
        pg8::gemm_phase<pg8::EpiResid, pg8::StaticOrder, true, true>(lds, g, S, E);
    }
    SEAM(PH_WOGEMM);
    if (IN(PH_LN2)) sp_ln_rows<2>(nullptr, a.in[19], a.in[20], H, XN, a.in[21], AFF);
    SEAM(PH_LN2);
    if (IN(PH_TOPK)) sp_topk_gather(smem, AFF, XN, IDX, GATE, INV, XS);
    SEAM(PH_TOPK);
    if (IN(PH_MOE1)) {
        pg8::Gemm g{XS, (const bf16_t*)(ws + WS_WGU), NGRP * CAP, NEXP * 4096, DM}; pg8::MoeOrder<1> S{G, bx};
        pg8::EpiSwiglu E{U};
        pg8::gemm_phase<pg8::EpiSwiglu, pg8::MoeOrder<1>, true, true>(lds, g, S, E);
    }
    SEAM(PH_MOE1);
    if (IN(PH_MOE2)) {
        pg8::Gemm g{U, (const bf16_t*)(ws + WS_WD), NGRP * CAP, NEXP * DM, DFF}; pg8::MoeOrder<2> S{G, bx};
        pg8::EpiYGate E{XS, GATE};
        pg8::gemm_phase<pg8::EpiYGate, pg8::MoeOrder<2>, true, true>(lds, g, S, E);
    }
    SEAM(PH_MOE2);
    if (IN(PH_FINAL)) sp_final(H, XS, INV, a.in[25], a.in[26]);
#undef IN
#undef SEAM
}

#ifndef MK_PER_PHASE
#define MK_PER_PHASE 0
#endif
extern "C" void kernel_launch(void* const* d_in, const int* in_sizes, int n_in, void* d_out, int out_size, void* d_ws, size_t ws_size, hipStream_t stream) {
    if (n_in != 27 || out_size != NTOK * DM || ws_size < WS_END) { fprintf(stderr, "kernel_launch: unexpected shapes (n_in %d out %d ws %zu)\n", n_in, out_size, ws_size); return; }
    static int grid = 0;
    if (grid == 0) {
        int dev = 0, cus = 0, per_cu = 0;
        (void)hipGetDevice(&dev); (void)hipDeviceGetAttribute(&cus, hipDeviceAttributeMultiprocessorCount, dev);
        (void)hipFuncSetAttribute((const void*)mk_fwd, hipFuncAttributeMaxDynamicSharedMemorySize, LDS_BYTES);
        (void)hipOccupancyMaxActiveBlocksPerMultiprocessor(&per_cu, (const void*)mk_fwd, NWAVES * 64, LDS_BYTES);
        (void)hipGetLastError();
        if (per_cu < 1) { fprintf(stderr, "kernel_launch: occupancy query says %d blocks/CU\n", per_cu); per_cu = 1; }
        grid = cus;
    }
    MKArgs ka{};
    for (int i = 0; i < 27; ++i) ka.in[i] = (const float*)d_in[i];
    ka.out = (float*)d_out; ka.ws = (unsigned char*)d_ws;
#if MK_PER_PHASE
    for (int p = 0; p < PH_COUNT; ++p) { MKArgs k2 = ka; k2.ph_lo = p; k2.ph_hi = p + 1; hipLaunchKernelGGL(mk_fwd, dim3(grid), dim3(NWAVES * 64), LDS_BYTES, stream, k2); }
#else
    ka.ph_lo = 0; ka.ph_hi = PH_COUNT;
    void* args[] = {&ka};
    hipError_t e = hipLaunchCooperativeKernel((const void*)mk_fwd, dim3(grid), dim3(NWAVES * 64), args, LDS_BYTES, stream);
    if (e != hipSuccess) fprintf(stderr, "kernel_launch: cooperative launch failed: %s (grid %d)\n", hipGetErrorString(e), grid);
#endif
}
```

```cpp
#include <hip/hip_runtime.h>
#include <hip/hip_cooperative_groups.h>
#include <cstdint>
#include <cstdio>

typedef unsigned short bf16_t;

constexpr int BATCH = 8, SEQ = 2048, DM = 1024, NTOK = BATCH * SEQ;
constexpr int MEML = 256, NMEM = BATCH * MEML;
constexpr int NU = 4096;
constexpr int U_HQ = 0, U_HI = 512, U_HG = 1024, U_HFF = 1536, U_HFB = 2048, U_DQ = 2560, U_DK = 3072, U_DV = 3584;
constexpr int NEXP = 16, CAP = 256, DFF = 2048, NGRP = BATCH * NEXP;
constexpr float ALPHA = 1.189207115002721f;
constexpr float LN_EPS = 1e-5f, RMS_EPS = 1e-6f;
constexpr float LAMBDA_INIT = 0.2f;

constexpr size_t MiB = 1u << 20;
constexpr size_t WS_CTL = 0;
constexpr size_t WS_ROPE = 1 * MiB;
constexpr size_t WS_LB = WS_ROPE + 256 * 1024;
constexpr size_t WS_AFF = 2 * MiB;
constexpr size_t WS_INV = 3 * MiB;
constexpr size_t WS_IDX = 4 * MiB;
constexpr size_t WS_GATE = 4 * MiB + 512 * 1024;
constexpr size_t WS_WIN = 5 * MiB;
constexpr size_t WS_WKV = 13 * MiB;
constexpr size_t WS_WMIX = 17 * MiB;
constexpr size_t WS_WQ = 19 * MiB;
constexpr size_t WS_WO = 21 * MiB;
constexpr size_t WS_WGU = 23 * MiB;
constexpr size_t WS_WD = 151 * MiB;
constexpr size_t WS_U = 215 * MiB;
constexpr size_t WS_XN = 343 * MiB;
constexpr size_t WS_MIX = 375 * MiB;
constexpr size_t WS_KV = 407 * MiB;
constexpr size_t WS_XS = 415 * MiB;
constexpr size_t WS_MEMB = 479 * MiB;
constexpr size_t WS_END = 483 * MiB;

__device__ __forceinline__ unsigned f2bf(float f) { unsigned u = __builtin_bit_cast(unsigned, f); return (u + 0x7fffu + ((u >> 16) & 1u)) >> 16; }
__device__ __forceinline__ float bf2f(bf16_t b) { return __builtin_bit_cast(float, (unsigned)b << 16); }
__device__ __forceinline__ float wave_sum(float v) {
#pragma unroll
    for (int o = 1; o < 64; o <<= 1) v += __shfl_xor(v, o);
    return v;
}
__device__ __forceinline__ float silu_f(float x) { return x / (1.f + expf(-x)); }
__device__ __forceinline__ float sigmoid_f(float x) { return 1.f / (1.f + expf(-x)); }

#define VB_LOOP(NT, nvb, vb, valid, tid, sub) \
    for (int _r = 0, _sub = (int)threadIdx.x / (NT), tid = (int)threadIdx.x % (NT), sub = _sub, _pr = (int)gridDim.x * (512 / (NT)), _nr = ((nvb) + _pr - 1) / _pr, vb = 0, valid = 0; \
         _r < _nr && ((vb = (_r * (int)gridDim.x + (int)blockIdx.x) * (512 / (NT)) + _sub), (valid = vb < (nvb)), true); ++_r)

__device__ __forceinline__ void sp_prep_small(const float* lb_logits, const float* lq1, const float* lk1, const float* lq2, const float* lk2, float* rope, float* lb) {
    for (int i = blockIdx.x * 512 + threadIdx.x; i < SEQ * 8; i += gridDim.x * 512) {
        const int t = i / 8, j = i % 8;
        const float inv = (float)(1.0 / pow(500000.0, (double)j / 8.0));
        const float ang = (float)t * inv;
        rope[t * 16 + j] = (float)cos((double)ang);
        rope[t * 16 + 8 + j] = (float)sin((double)ang);
        if (i < 1024) {
            const int d = i / 512, c = i % 512;
            const float l0 = lb_logits[d * 1024 + c], l1 = lb_logits[d * 1024 + 512 + c];
            const float m = fmaxf(l0, l1); const float e0 = expf(l0 - m), e1 = expf(l1 - m);
            lb[i] = e0 / (e0 + e1);
        }
        if (i == 0) {
            float s1 = 0.f, s2 = 0.f;
            for (int k = 0; k < 64; ++k) { s1 += lq1[k] * lk1[k]; s2 += lq2[k] * lk2[k]; }
            lb[1024] = expf(s1) - expf(s2) + LAMBDA_INIT;
        }
    }
}
__device__ __forceinline__ void sp_transpose(float* smem, const float* W, int K, int N, bf16_t* WT, int mode, long src_zs, long dst_zs, int nz) {
    const int nbx = N / 32, nby = K / 32, nvb = nbx * nby * nz;
    VB_LOOP(256, nvb, vb, valid, tid, sub) {
        float* t = smem + sub * (32 * 33);
        const int z = vb / (nbx * nby), rem = vb % (nbx * nby), by = rem / nbx, bxx = rem % nbx;
        const float* Wz = W + (long)z * src_zs; bf16_t* WTz = WT + (long)z * dst_zs;
        const int k0 = by * 32, n0 = bxx * 32, tx = tid & 31, ty = tid >> 5;
        if (valid) for (int i = ty; i < 32; i += 8) t[i * 33 + tx] = Wz[(long)(k0 + i) * N + n0 + tx];
        __syncthreads();
        if (valid) for (int i = ty; i < 32; i += 8) {
            const int n = n0 + i; long r = n;
            if (mode == 1) r = (long)(n / 128) * 256 + (n % 128);
            if (mode == 2) r = (long)(n / 128) * 256 + 128 + (n % 128);
            WTz[r * K + k0 + tx] = (bf16_t)f2bf(t[tx * 33 + i]);
        }
        __syncthreads();
    }
}
__device__ __forceinline__ void sp_cvt_bf16(const float* src, bf16_t* dst, long n) {
    for (long i = (long)blockIdx.x * 512 + threadIdx.x; i < n; i += (long)gridDim.x * 512) dst[i] = (bf16_t)f2bf(src[i]);
}

template <int MODE>
__device__ __forceinline__ void sp_ln_rows(const float* X, const float* g, const float* b, float* H, bf16_t* XN, const float* wr, float* AFF) {
    const int lane = threadIdx.x & 63;
    for (int row = blockIdx.x * 8 + (threadIdx.x >> 6); row < NTOK; row += gridDim.x * 8) {
        float4 v[4]; float s = 0.f;
#pragma unroll
        for (int j = 0; j < 4; ++j) {
            const long off = (long)row * DM + 4 * lane + 256 * j;
            v[j] = (MODE == 0) ? *(const float4*)(X + off) : *(const float4*)(H + off);
            s += (v[j].x + v[j].y) + (v[j].z + v[j].w);
        }
        const float mean = wave_sum(s) * (1.f / DM); float s2 = 0.f;
#pragma unroll
        for (int j = 0; j < 4; ++j) { v[j].x -= mean; v[j].y -= mean; v[j].z -= mean; v[j].w -= mean; s2 += (v[j].x * v[j].x + v[j].y * v[j].y) + (v[j].z * v[j].z + v[j].w * v[j].w); }
        const float rstd = 1.f / sqrtf(wave_sum(s2) * (1.f / DM) + LN_EPS);
#pragma unroll
        for (int j = 0; j < 4; ++j) {
            const int c = 4 * lane + 256 * j; const float4 gg = *(const float4*)(g + c), bb = *(const float4*)(b + c);
            v[j].x = v[j].x * rstd * gg.x + bb.x; v[j].y = v[j].y * rstd * gg.y + bb.y; v[j].z = v[j].z * rstd * gg.z + bb.z; v[j].w = v[j].w * rstd * gg.w + bb.w;
            *(float4*)(H + (long)row * DM + c) = v[j];
            uint2 o; o.x = f2bf(v[j].x) | (f2bf(v[j].y) << 16); o.y = f2bf(v[j].z) | (f2bf(v[j].w) << 16);
            *(uint2*)(XN + (long)row * DM + c) = o;
        }
        if (MODE == 2) {
            float acc[16];
#pragma unroll
            for (int e = 0; e < 16; ++e) acc[e] = 0.f;
#pragma unroll
            for (int j = 0; j < 4; ++j) {
                const float vv[4] = {v[j].x, v[j].y, v[j].z, v[j].w};
#pragma unroll
                for (int i = 0; i < 4; ++i) {
                    const float4* w4 = (const float4*)(wr + (long)(4 * lane + 256 * j + i) * 16);
#pragma unroll
                    for (int q = 0; q < 4; ++q) { const float4 w = w4[q]; acc[4 * q] += vv[i] * w.x; acc[4 * q + 1] += vv[i] * w.y; acc[4 * q + 2] += vv[i] * w.z; acc[4 * q + 3] += vv[i] * w.w; }
                }
            }
            float m = -INFINITY;
#pragma unroll
            for (int e = 0; e < 16; ++e) { acc[e] = wave_sum(acc[e]); m = fmaxf(m, acc[e]); }
            float sum = 0.f;
#pragma unroll
            for (int e = 0; e < 16; ++e) { acc[e] = expf(acc[e] - m); sum += acc[e]; }
            if (lane == 0) {
#pragma unroll
                for (int q = 0; q < 4; ++q) *(float4*)(AFF + (long)row * 16 + 4 * q) = make_float4(acc[4 * q] / sum, acc[4 * q + 1] / sum, acc[4 * q + 2] / sum, acc[4 * q + 3] / sum);
            }
        }
    }
}

__device__ __forceinline__ void sp_gemm(float* smem, const bf16_t* A0, long sa_z, int lda, const bf16_t* B0, long sb_z, long sbn, long sbk, float* C0, long sc_z, int ldc, int M, int N, int K, int Z) {
    const int nbx = N / 64, nby = M / 64, nvb = nbx * nby * Z;
    VB_LOOP(256, nvb, vb, valid, tid, sub) {
        float* As = smem + sub * (2 * 16 * 65); float* Bs = As + 16 * 65;
        const int z = vb / (nbx * nby), rem = vb % (nbx * nby), by = rem / nbx, bxx = rem % nbx;
        const bf16_t* A = A0 + (long)z * sa_z; const bf16_t* B = B0 + (long)z * sb_z; float* C = C0 + (long)z * sc_z;
        const int m0 = by * 64, n0 = bxx * 64, tx = tid & 15, ty = tid >> 4;
        float acc[4][4];
#pragma unroll
        for (int i = 0; i < 4; ++i)
#pragma unroll
            for (int j = 0; j < 4; ++j) acc[i][j] = 0.f;
        for (int k0 = 0; k0 < K; k0 += 16) {
            if (valid) {
                for (int i = tid; i < 1024; i += 256) { const int m = i >> 4, k = i & 15; As[k * 65 + m] = bf2f(A[(long)(m0 + m) * lda + k0 + k]); }
                for (int i = tid; i < 1024; i += 256) { const int n = i >> 4, k = i & 15; Bs[k * 65 + n] = bf2f(B[(long)(n0 + n) * sbn + (long)(k0 + k) * sbk]); }
            }
            __syncthreads();
#pragma unroll
            for (int k = 0; k < 16; ++k) {
                float a[4], bb[4];
#pragma unroll
                for (int i = 0; i < 4; ++i) { a[i] = As[k * 65 + ty * 4 + i]; bb[i] = Bs[k * 65 + tx * 4 + i]; }
#pragma unroll
                for (int i = 0; i < 4; ++i)
#pragma unroll
                    for (int j = 0; j < 4; ++j) acc[i][j] += a[i] * bb[j];
            }
            __syncthreads();
        }
        if (valid) {
#pragma unroll
            for (int i = 0; i < 4; ++i)
#pragma unroll
                for (int j = 0; j < 4; ++j) C[(long)(m0 + ty * 4 + i) * ldc + n0 + tx * 4 + j] = acc[i][j];
        }
    }
}
__device__ __forceinline__ void sp_cvt2d(const float* SC, int ldsc, bf16_t* dst, int ldd, int rows, int cols) {
    const long n = (long)rows * cols;
    for (long i = (long)blockIdx.x * 512 + threadIdx.x; i < n; i += (long)gridDim.x * 512) { const int r = (int)(i / cols), c = (int)(i % cols); dst[(long)r * ldd + c] = (bf16_t)f2bf(SC[(long)r * ldsc + c]); }
}

__device__ __forceinline__ void sp_hgrn(float* smem, const bf16_t* U, const float* LB, float* OSC) {
    VB_LOOP(128, 8 * 4 * 16, vb, valid, k, sub) {
        float* red = smem + sub * 32;
        const int dvs = vb & 7, h = (vb >> 3) & 3, bz = vb >> 5, b = bz >> 1, dir = bz & 1;
        float S[16];
#pragma unroll
        for (int j = 0; j < 16; ++j) S[j] = 0.f;
        const float lbv = valid ? LB[dir * 512 + h * 128 + k] : 0.5f;
        for (int step = 0; step < SEQ; ++step) {
            const int t = dir ? (SEQ - 1 - step) : step; const long row = (long)(valid ? b : 0) * SEQ + t;
            const bf16_t* ur = U + row * NU;
            const float qv = bf2f(ur[U_HQ + h * 128 + k]);
            const float uf = bf2f(ur[(dir ? U_HFB : U_HFF) + h * 128 + k]);
            const float f = lbv + (1.f - lbv) * sigmoid_f(uf), kk = 1.f - f;
            float part[16];
#pragma unroll
            for (int j = 0; j < 16; ++j) { const float vv = bf2f(ur[U_HI + h * 128 + dvs * 16 + j]); S[j] = f * S[j] + kk * vv; part[j] = wave_sum(S[j] * qv); }
            if ((k & 63) == 0) {
#pragma unroll
                for (int j = 0; j < 16; ++j) red[(k >> 6) * 16 + j] = part[j];
            }
            __syncthreads();
            if (valid && k < 16) OSC[((long)dir * NTOK + row) * 512 + h * 128 + dvs * 16 + k] = red[k] + red[16 + k];
            __syncthreads();
        }
    }
}
__device__ __forceinline__ void sp_hgrn_combine(const float* OSC, const bf16_t* U, const float* ng, bf16_t* MIX) {
    const int lane = threadIdx.x & 63;
    for (long w = (long)blockIdx.x * 8 + (threadIdx.x >> 6); w < (long)NTOK * 4; w += (long)gridDim.x * 8) {
        const long row = w >> 2; const int h = (int)(w & 3);
        float o[2]; float ss = 0.f;
#pragma unroll
        for (int i = 0; i < 2; ++i) { const int d = lane + 64 * i; o[i] = OSC[row * 512 + h * 128 + d] + OSC[((long)NTOK + row) * 512 + h * 128 + d]; ss += o[i] * o[i]; }
        const float r = 1.f / sqrtf(wave_sum(ss) * (1.f / 128.f) + RMS_EPS);
#pragma unroll
        for (int i = 0; i < 2; ++i) { const int d = lane + 64 * i; const float y = o[i] * r * ng[h * 128 + d] * bf2f(U[row * NU + U_HG + h * 128 + d]); MIX[row * DM + h * 128 + d] = (bf16_t)f2bf(y); }
    }
}

__device__ __forceinline__ void sp_dattn(float* smem, const bf16_t* U, float* OSC) {
    VB_LOOP(256, 32 * 8 * 8, vb, valid, tid, sub) {
        float* Ks = smem + sub * (16 * 64 + 16 * 128); float* Vs = Ks + 16 * 64;
        const int qb = vb & 31, g = (vb >> 5) & 7, b = valid ? (vb >> 8) : 0, h = g >> 1, r = tid & 63, qt = tid >> 6;
        const long row = (long)b * SEQ + qb * 64 + r;
        float q[64], o[32];
#pragma unroll
        for (int d = 0; d < 64; ++d) q[d] = bf2f(U[row * NU + U_DQ + g * 64 + d]);
#pragma unroll
        for (int d = 0; d < 32; ++d) o[d] = 0.f;
        float m = -INFINITY, l = 0.f;
        for (int k0 = 0; k0 < SEQ; k0 += 16) {
            for (int i = tid; i < 16 * 64; i += 256) { const int kk = i >> 6, d = i & 63; Ks[kk * 64 + d] = bf2f(U[((long)b * SEQ + k0 + kk) * NU + U_DK + g * 64 + d]); }
            for (int i = tid; i < 16 * 128; i += 256) { const int kk = i >> 7, d = i & 127; Vs[kk * 128 + d] = bf2f(U[((long)b * SEQ + k0 + kk) * NU + U_DV + h * 128 + d]); }
            __syncthreads();
            float s[16]; float tm = m;
#pragma unroll
            for (int kk = 0; kk < 16; ++kk) { float a = 0.f;
#pragma unroll
                for (int d = 0; d < 64; ++d) a += q[d] * Ks[kk * 64 + d];
                s[kk] = a; tm = fmaxf(tm, a); }
            const float corr = exp2f(m - tm); m = tm; l *= corr;
#pragma unroll
            for (int d = 0; d < 32; ++d) o[d] *= corr;
#pragma unroll
            for (int kk = 0; kk < 16; ++kk) { const float p = exp2f(s[kk] - m); l += p;
#pragma unroll
                for (int d = 0; d < 32; ++d) o[d] += p * Vs[kk * 128 + qt * 32 + d]; }
            __syncthreads();
        }
        const float il = 1.f / l;
        if (valid) {
#pragma unroll
            for (int d = 0; d < 32; ++d) OSC[(row * 8 + g) * 128 + qt * 32 + d] = o[d] * il;
        }
    }
}
__device__ __forceinline__ void sp_dattn_combine(const float* OSC, const float* lamp, const float* sg, bf16_t* MIX) {
    const int lane = threadIdx.x & 63; const float lam = lamp[0];
    for (long w = (long)blockIdx.x * 8 + (threadIdx.x >> 6); w < (long)NTOK * 4; w += (long)gridDim.x * 8) {
        const long row = w >> 2; const int h = (int)(w & 3);
        float o[2]; float ss = 0.f;
#pragma unroll
        for (int i = 0; i < 2; ++i) { const int d = lane + 64 * i; o[i] = OSC[(row * 8 + 2 * h) * 128 + d] - lam * OSC[(row * 8 + 2 * h + 1) * 128 + d]; ss += o[i] * o[i]; }
        const float r = 1.f / sqrtf(wave_sum(ss) * (1.f / 128.f) + RMS_EPS);
#pragma unroll
        for (int i = 0; i < 2; ++i) { const int d = lane + 64 * i; MIX[row * DM + 512 + h * 128 + d] = (bf16_t)f2bf(o[i] * r * sg[d] * (1.f - LAMBDA_INIT)); }
    }
}

__device__ __forceinline__ void sp_softmax256(const float* S, bf16_t* P, long nrows) {
    const int lane = threadIdx.x & 63;
    for (long row = (long)blockIdx.x * 8 + (threadIdx.x >> 6); row < nrows; row += (long)gridDim.x * 8) {
        float4 v = *(const float4*)(S + row * 256 + 4 * lane);
        float m = fmaxf(fmaxf(v.x, v.y), fmaxf(v.z, v.w));
#pragma unroll
        for (int o = 1; o < 64; o <<= 1) m = fmaxf(m, __shfl_xor(m, o));
        v.x = exp2f(v.x - m); v.y = exp2f(v.y - m); v.z = exp2f(v.z - m); v.w = exp2f(v.w - m);
        const float il = 1.f / wave_sum((v.x + v.y) + (v.z + v.w));
        uint2 o; o.x = f2bf(v.x * il) | (f2bf(v.y * il) << 16); o.y = f2bf(v.z * il) | (f2bf(v.w * il) << 16);
        *(uint2*)(P + row * 256 + 4 * lane) = o;
    }
}

__device__ __forceinline__ void sp_topk_gather(float* smem, const float* AFF, const bf16_t* XN, int* IDX, float* GATE, int* INV, bf16_t* XS) {
    VB_LOOP(256, NGRP, grp, valid, tid, sub) {
        float* a = smem + sub * (SEQ + CAP); int* sel = (int*)(a + SEQ);
        const int b = valid ? (grp >> 4) : 0, e = grp & 15;
        for (int t = tid; t < SEQ; t += 256) a[t] = AFF[((long)b * SEQ + t) * 16 + e];
        __syncthreads();
        if (valid) for (int t = tid; t < SEQ; t += 256) {
            const float mine = a[t]; int rank = 0;
            for (int u = 0; u < SEQ; ++u) { const float x = a[u]; rank += (x > mine || (x == mine && u < t)) ? 1 : 0; }
            if (rank < CAP) { sel[rank] = t; IDX[grp * CAP + rank] = t; GATE[grp * CAP + rank] = mine; INV[((long)b * SEQ + t) * 16 + e] = rank; }
            else INV[((long)b * SEQ + t) * 16 + e] = -1;
        }
        __syncthreads();
        const int lane = tid & 63, wv = tid >> 6;
        if (valid) for (int r = wv; r < CAP; r += 4) {
            const uint4* src = (const uint4*)(XN + ((long)b * SEQ + sel[r]) * DM); uint4* dst = (uint4*)(XS + ((long)grp * CAP + r) * DM);
            dst[lane] = src[lane]; dst[lane + 64] = src[lane + 64];
        }
        __syncthreads();
    }
}

__device__ __forceinline__ void sp_final(float* H, const bf16_t* Y, const int* INV, const float* g, const float* b) {
    const int lane = threadIdx.x & 63;
    for (long row = (long)blockIdx.x * 8 + (threadIdx.x >> 6); row < NTOK; row += (long)gridDim.x * 8) {
        const int bt = (int)(row / SEQ);
        float4 v[4];
#pragma unroll
        for (int j = 0; j < 4; ++j) { const float4 h = *(const float4*)(H + row * DM + 4 * lane + 256 * j); v[j] = make_float4(ALPHA * h.x, ALPHA * h.y, ALPHA * h.z, ALPHA * h.w); }
        for (int e = 0; e < 16; ++e) {
            const int slot = INV[row * 16 + e];
            if (slot >= 0) {
                const bf16_t* yr = Y + ((long)(bt * 16 + e) * CAP + slot) * DM;
#pragma unroll
                for (int j = 0; j < 4; ++j) { const uint2 p = *(const uint2*)(yr + 4 * lane + 256 * j);
                    v[j].x += bf2f((bf16_t)(p.x & 0xffff)); v[j].y += bf2f((bf16_t)(p.x >> 16)); v[j].z += bf2f((bf16_t)(p.y & 0xffff)); v[j].w += bf2f((bf16_t)(p.y >> 16)); }
            }
        }
        float s = 0.f;
#pragma unroll
        for (int j = 0; j < 4; ++j) s += (v[j].x + v[j].y) + (v[j].z + v[j].w);
        const float mean = wave_sum(s) * (1.f / DM); float s2 = 0.f;
#pragma unroll
        for (int j = 0; j < 4; ++j) { v[j].x -= mean; v[j].y -= mean; v[j].z -= mean; v[j].w -= mean; s2 += (v[j].x * v[j].x + v[j].y * v[j].y) + (v[j].z * v[j].z + v[j].w * v[j].w); }
        const float rstd = 1.f / sqrtf(wave_sum(s2) * (1.f / DM) + LN_EPS);
#pragma unroll
        for (int j = 0; j < 4; ++j) {
            const int c = 4 * lane + 256 * j; const float4 gg = *(const float4*)(g + c), bb = *(const float4*)(b + c);
            float4 o; o.x = v[j].x * rstd * gg.x + bb.x; o.y = v[j].y * rstd * gg.y + bb.y; o.z = v[j].z * rstd * gg.z + bb.z; o.w = v[j].w * rstd * gg.w + bb.w;
            *(float4*)(H + row * DM + c) = o;
        }
    }
}

__device__ __forceinline__ void tp_item(const float* W, int K, int N, bf16_t* WT, long rbase, int k0, int n0, float* scr, int lane) {
#pragma unroll 8
    for (int i = 0; i < 32; ++i) { const int kk = 2 * i + (lane >> 5); scr[kk * 33 + (lane & 31)] = W[(size_t)(k0 + kk) * N + n0 + (lane & 31)]; }
    asm volatile("s_waitcnt lgkmcnt(0)" ::: "memory");
    const int c = lane & 7;
#pragma unroll
    for (int j = 0; j < 4; ++j) {
        const int n = (lane >> 3) + 8 * j; const float* s = scr + (8 * c) * 33 + n;
        uint4 o; o.x = f2bf(s[0]) | (f2bf(s[33]) << 16); o.y = f2bf(s[2 * 33]) | (f2bf(s[3 * 33]) << 16); o.z = f2bf(s[4 * 33]) | (f2bf(s[5 * 33]) << 16); o.w = f2bf(s[6 * 33]) | (f2bf(s[7 * 33]) << 16);
        *(uint4*)(WT + (size_t)(rbase + n) * K + k0 + 8 * c) = o;
    }
    asm volatile("s_waitcnt lgkmcnt(0)" ::: "memory");
}
__device__ __forceinline__ void tp_all(float* smem, const float* const* in, unsigned char* ws, int vcu, int G) {
    const int lane = threadIdx.x & 63, wave = threadIdx.x >> 6;
    float* scr = smem + wave * 4096;
    constexpr int I_IN = (DM / 64) * (NU / 32), I_SQ = (DM / 64) * (DM / 32), I_GU = (DM / 64) * (DFF / 32), I_D = (DFF / 64) * (DM / 32);
    constexpr int NIT = I_IN + 5 * I_SQ + NEXP * (2 * I_GU + I_D);
    for (int it = vcu * 8 + wave; it < NIT; it += G * 8) {
        int r = it;
        if (r < I_IN) { const int nb = NU / 32; tp_item(in[4], DM, NU, (bf16_t*)(ws + WS_WIN), 32 * (r % nb), 64 * (r / nb), 32 * (r % nb), scr, lane); continue; }
        r -= I_IN;
        if (r < 5 * I_SQ) {
            const int which = r / I_SQ, q = r % I_SQ, nb = DM / 32; const int k0 = 64 * (q / nb), n0 = 32 * (q % nb);
            const float* W = which == 0 ? in[16] : which == 1 ? in[17] : which == 2 ? in[12] : which == 3 ? in[15] : in[18];
            bf16_t* WT = which == 0 ? (bf16_t*)(ws + WS_WKV) : which == 1 ? (bf16_t*)(ws + WS_WKV) + (size_t)DM * DM : which == 2 ? (bf16_t*)(ws + WS_WMIX) : which == 3 ? (bf16_t*)(ws + WS_WQ) : (bf16_t*)(ws + WS_WO);
            tp_item(W, DM, DM, WT, n0, k0, n0, scr, lane); continue;
        }
        r -= 5 * I_SQ;
        const int e = r / (2 * I_GU + I_D); int q = r % (2 * I_GU + I_D);
        if (q < 2 * I_GU) {
            const int up = q / I_GU; q %= I_GU; const int nb = DFF / 32; const int k0 = 64 * (q / nb), n0 = 32 * (q % nb);
            tp_item((up ? in[23] : in[22]) + (size_t)e * DM * DFF, DM, DFF, (bf16_t*)(ws + WS_WGU) + (size_t)e * 2 * DFF * DM, (long)(n0 / 128) * 256 + (n0 % 128) + 128 * up, k0, n0, scr, lane);
        } else {
            q -= 2 * I_GU; const int nb = DM / 32; const int k0 = 64 * (q / nb), n0 = 32 * (q % nb);
            tp_item(in[24] + (size_t)e * DFF * DM, DFF, DM, (bf16_t*)(ws + WS_WD) + (size_t)e * DM * DFF, n0, k0, n0, scr, lane);
        }
    }
}
namespace pg8 {
#define PG8_LAS __attribute__((address_space(3)))
typedef unsigned short bf16_t;
typedef short bf16x8 __attribute__((ext_vector_type(8)));
typedef float f32x4 __attribute__((ext_vector_type(4)));
typedef unsigned u32x4 __attribute__((ext_vector_type(4)));
constexpr int BM = 256, BK = 64, HALF = 128, HTB = HALF * BK * 2  , STAGE_BYTES = 8 * HTB, NXCD = 8, WGM = 8;

__host__ __device__ __forceinline__ int lds_byte(int r, int c) { const int st = (r >> 4) * 2 + (c >> 5), rr = r & 15, cc = c & 31, ob = rr * 64 + cc * 2; return st * 1024 + (ob ^ (((ob >> 9) & 1) << 5)); }
__host__ __device__ __forceinline__ void stage_rc(int b, int& R, int& C) { const int st = b / 1024, sb = b % 1024, swz = sb ^ (((sb >> 9) & 1) << 5); R = (st >> 1) * 16 + swz / 64; C = (st & 1) * 32 + (swz % 64) / 2; }
__host__ __device__ __forceinline__ int perm32(int rho) { const int n = rho >> 4, i = rho & 15; return 8 * (i >> 2) + 4 * n + (i & 3); }

struct Unit { int pm, pn; };
struct Gemm { const bf16_t* A; const bf16_t* Bt; int M, N, K; };

struct StaticOrder {
    int nM, nN, nwg, G, c;
    __host__ __device__ void init(int M, int N, int G_, int c_) { nM = M / BM; nN = N / BM; nwg = nM * nN; G = G_; c = c_; }
    __host__ __device__ bool next(int i, Unit& u) const {
        const long L = (long)i * G + c; if (L >= nwg) return false;
        int wgid = (int)L; { const int q = nwg / NXCD, r = nwg % NXCD, xcd = wgid % NXCD, off = wgid / NXCD; wgid = (xcd < r ? xcd * (q + 1) : r * (q + 1) + (xcd - r) * q) + off; }
        const int nig = WGM * nN, gid = wgid / nig, fm = gid * WGM, gsz = (nM - fm) < WGM ? (nM - fm) : WGM;
        u.pm = fm + ((wgid % nig) % gsz); u.pn = (wgid % nig) / gsz; return true;
    }
    __device__ __forceinline__ void a_ready(const Unit&) const {}
    __device__ __forceinline__ void done(const Unit&) const {}
};

__device__ __forceinline__ unsigned cvt_pk_bf16(float lo, float hi) { unsigned r; asm volatile("v_cvt_pk_bf16_f32 %0, %1, %2" : "=v"(r) : "v"(lo), "v"(hi)); return r; }
typedef float f32x2 __attribute__((ext_vector_type(2)));
typedef unsigned u32x4 __attribute__((ext_vector_type(4)));
constexpr float QSCALE_DA = 0.125f * 1.4426950408889634f;
constexpr float QSCALE_XA = 0.0625f * 1.4426950408889634f;
__device__ __forceinline__ float silu_fast(float x) { return x * __builtin_amdgcn_rcpf(1.f + __builtin_amdgcn_exp2f(-1.4426950408889634f * x)); }

struct EpiStore {
    static constexpr bool PERM = true, AFTER_DRAIN = false;
    bf16_t* O; int ldc; float scale; int mode; const float* rope;
    __device__ __forceinline__ void operator()(const f32x4 (&acc)[2][2][4][2], const Unit& u, int wr, int wc, int fr, int fq) const {
        const int row0 = u.pm * BM + wr * 64 + fr, col0 = u.pn * BM + wc * 32 + 8 * fq;
        int op = 0; float sc = scale;
        if (mode == 1) { const int seg = u.pn >> 1; op = (seg == 0 || seg == 2) ? 1 : (seg == 5 ? 2 : (seg == 6 ? 3 : 0)); if (seg == 5) sc = QSCALE_DA; }
        const bool do_rope = (op >= 2) && !(wc & 1);
#pragma unroll
        for (int ai = 0; ai < 2; ++ai)
#pragma unroll
            for (int m = 0; m < 4; ++m) {
                const int row = row0 + ai * HALF + m * 16; bf16_t* rowp = O + (size_t)row * ldc + col0;
                f32x4 c0 = {1.f, 1.f, 1.f, 1.f}, c1 = c0, s0 = {0.f, 0.f, 0.f, 0.f}, s1 = s0;
                if (do_rope) { const float* rp = rope + (row & 2047) * 16; c0 = *(const f32x4*)rp; c1 = *(const f32x4*)(rp + 4); s0 = *(const f32x4*)(rp + 8); s1 = *(const f32x4*)(rp + 12);
                    if (fq == 0) { s0 = -s0; s1 = -s1; } else if (fq >= 2) { c0 = (f32x4){1.f, 1.f, 1.f, 1.f}; c1 = c0; s0 = (f32x4){0.f, 0.f, 0.f, 0.f}; s1 = s0; } }
#pragma unroll
                for (int bj = 0; bj < 2; ++bj) {
                    f32x4 v0 = acc[ai][bj][m][0], v1 = acc[ai][bj][m][1];
                    if (op == 1) {
#pragma unroll
                        for (int j = 0; j < 4; ++j) { v0[j] = silu_fast(v0[j]); v1[j] = silu_fast(v1[j]); }
                    }
                    if (do_rope) {
                        f32x4 p0, p1;
#pragma unroll
                        for (int j = 0; j < 4; ++j) { p0[j] = __shfl_xor(v0[j], 16); p1[j] = __shfl_xor(v1[j], 16); }
                        v0 = v0 * c0 + p0 * s0; v1 = v1 * c1 + p1 * s1;
                    }
                    v0 = v0 * sc; v1 = v1 * sc;
                    u32x4 w; w.x = cvt_pk_bf16(v0[0], v0[1]); w.y = cvt_pk_bf16(v0[2], v0[3]); w.z = cvt_pk_bf16(v1[0], v1[1]); w.w = cvt_pk_bf16(v1[2], v1[3]);
                    *(u32x4*)(rowp + bj * HALF) = w;
                }
            }
    }
};
struct EpiResid {
    static constexpr bool PERM = false, AFTER_DRAIN = false;
    float* H; float alpha;
    __device__ __forceinline__ void operator()(const f32x4 (&acc)[2][2][4][2], const Unit& u, int wr, int wc, int fr, int fq) const {
        const int row0 = u.pm * BM + wr * 64 + fr, col0 = u.pn * BM + wc * 32 + 4 * fq;
#pragma unroll
        for (int ai = 0; ai < 2; ++ai)
#pragma unroll
            for (int m = 0; m < 4; ++m) { float* rowp = H + (size_t)(row0 + ai * HALF + m * 16) * 1024 + col0;
#pragma unroll
                for (int bj = 0; bj < 2; ++bj)
#pragma unroll
                    for (int n = 0; n < 2; ++n) { f32x4* p = (f32x4*)(rowp + bj * HALF + n * 16); const f32x4 h = *p; *p = h * alpha + acc[ai][bj][m][n]; } }
    }
};
struct EpiSwiglu {
    static constexpr bool PERM = true, AFTER_DRAIN = false;
    bf16_t* ACT;
    __device__ __forceinline__ void operator()(const f32x4 (&acc)[2][2][4][2], const Unit& u, int wr, int wc, int fr, int fq) const {
        const int row0 = u.pm * BM + wr * 64 + fr, col0 = (u.pn & 15) * 128 + wc * 32 + 8 * fq;
#pragma unroll
        for (int ai = 0; ai < 2; ++ai)
#pragma unroll
            for (int m = 0; m < 4; ++m) {
                f32x4 v0 = acc[ai][0][m][0], v1 = acc[ai][0][m][1]; const f32x4 u0 = acc[ai][1][m][0], u1 = acc[ai][1][m][1];
#pragma unroll
                for (int j = 0; j < 4; ++j) { v0[j] = silu_fast(v0[j]) * u0[j]; v1[j] = silu_fast(v1[j]) * u1[j]; }
                u32x4 w; w.x = cvt_pk_bf16(v0[0], v0[1]); w.y = cvt_pk_bf16(v0[2], v0[3]); w.z = cvt_pk_bf16(v1[0], v1[1]); w.w = cvt_pk_bf16(v1[2], v1[3]);
                *(u32x4*)(ACT + (size_t)(row0 + ai * HALF + m * 16) * 2048 + col0) = w;
            }
    }
};
struct EpiYGate {
    static constexpr bool PERM = true, AFTER_DRAIN = false;
    bf16_t* Y; const float* GATE;
    __device__ __forceinline__ void operator()(const f32x4 (&acc)[2][2][4][2], const Unit& u, int wr, int wc, int fr, int fq) const {
        const int row0 = u.pm * BM + wr * 64 + fr, col0 = (u.pn & 3) * BM + wc * 32 + 8 * fq;
#pragma unroll
        for (int ai = 0; ai < 2; ++ai)
#pragma unroll
            for (int m = 0; m < 4; ++m) { const int row = row0 + ai * HALF + m * 16; const float gt = GATE[row]; bf16_t* rowp = Y + (size_t)row * 1024 + col0;
#pragma unroll
                for (int bj = 0; bj < 2; ++bj) { const f32x4 v0 = acc[ai][bj][m][0] * gt, v1 = acc[ai][bj][m][1] * gt;
                    u32x4 w; w.x = cvt_pk_bf16(v0[0], v0[1]); w.y = cvt_pk_bf16(v0[2], v0[3]); w.z = cvt_pk_bf16(v1[0], v1[1]); w.w = cvt_pk_bf16(v1[2], v1[3]);
                    *(u32x4*)(rowp + bj * HALF) = w; } }
    }
};
template <int WHICH> struct MoeOrder {
    int G, c;
    __device__ bool next(int i, Unit& u) const {
        constexpr int NWG = WHICH == 1 ? 2048 : 512;
        const int L = i * G + c; if (L >= NWG) return false;
        const int Ux = (G % 8 == 0 && NWG % 8 == 0) ? (L % 8) * (NWG / 8) + L / 8 : L;
        if (WHICH == 1) { const int e = Ux >> 7, jg = (Ux & 127) >> 5, b = (Ux & 31) >> 2, jj = Ux & 3; u.pm = b * 16 + e; u.pn = e * 16 + jg * 4 + jj; }
        else { const int e = Ux >> 5, b = (Ux & 31) >> 2, j = Ux & 3; u.pm = b * 16 + e; u.pn = e * 4 + j; }
        return true;
    }
    __device__ __forceinline__ void a_ready(const Unit&) const {}
    __device__ __forceinline__ void done(const Unit&) const {}
};
template <class Epi, class Sched, bool ALIGN_EPI = false, bool SP2 = false>
__device__ __forceinline__ void gemm_phase(PG8_LAS unsigned char* lds, const Gemm g, const Sched& S, const Epi& E) {
    const int tid = threadIdx.x, wid = __builtin_amdgcn_readfirstlane(tid >> 6), lane = tid & 63, wr = wid >> 2, wc = wid & 3, fr = lane & 15, fq = lane >> 4;
    const int K = g.K, nt = K / BK;
    unsigned voffA[2], voffB[2];
#pragma unroll
    for (int i = 0; i < 2; ++i) { int R, C; stage_rc(tid * 16 + i * 8192, R, C); const int Rb = Epi::PERM ? ((R & ~31) + perm32(R & 31)) : R;
        voffA[i] = (unsigned)(R * K + C) * 2u; voffB[i] = (unsigned)(Rb * K + C) * 2u; }
    const size_t kstep = (size_t)(BK * 2);
    const size_t hstep = (size_t)HALF * K * 2;
    const size_t tstep = 2 * hstep;
    const unsigned ldsw = (unsigned)wid * 1024u;
    const int aoff = lds_byte(wr * 64 + fr, fq * 8), boff = lds_byte(wc * 32 + fr, fq * 8);
#define PG8_SA(b, h) (((b) * 2 + (h)) * HTB)
#define PG8_SB(b, h) ((4 + (b) * 2 + (h)) * HTB)
#define PG8_STAGE(bufoff, gbase, voff) do { _Pragma("unroll") for (int _i = 0; _i < 2; ++_i) \
        __builtin_amdgcn_global_load_lds((const unsigned*)((const char*)(gbase) + (voff)[_i]), (PG8_LAS unsigned*)(lds + (bufoff) + ldsw + _i * 8192), 16, 0, 0); } while (0)
#define PG8_LDA(dst, b, h) do { _Pragma("unroll") for (int m = 0; m < 4; ++m) _Pragma("unroll") for (int k = 0; k < 2; ++k) dst[m][k] = *(const PG8_LAS bf16x8*)(lds + PG8_SA(b, h) + aoff + m * 2048 + k * 1024); } while (0)
#define PG8_LDB(dst, b, h) do { _Pragma("unroll") for (int n = 0; n < 2; ++n) _Pragma("unroll") for (int k = 0; k < 2; ++k) dst[n][k] = *(const PG8_LAS bf16x8*)(lds + PG8_SB(b, h) + boff + n * 2048 + k * 1024); } while (0)
#define PG8_MMA(ai, bj, At, Bt) do { __builtin_amdgcn_s_setprio(1); _Pragma("unroll") for (int m = 0; m < 4; ++m) _Pragma("unroll") for (int n = 0; n < 2; ++n) _Pragma("unroll") for (int k = 0; k < 2; ++k) \
        acc[ai][bj][m][n] = __builtin_amdgcn_mfma_f32_16x16x32_bf16(Bt[n][k], At[m][k], acc[ai][bj][m][n], 0, 0, 0); __builtin_amdgcn_s_setprio(0); } while (0)
#define PG8_WAIT_V(n) asm volatile("s_waitcnt vmcnt(" #n ")" ::: "memory")
#define PG8_WAIT_L(n) asm volatile("s_waitcnt lgkmcnt(" #n ")" ::: "memory")
#define PG8_BAR __builtin_amdgcn_s_barrier()
#define PG8_SCHED __builtin_amdgcn_sched_barrier(0)
    Unit cur, nxt; int ui = 0;
    if (!S.next(0, cur)) return;
    f32x4 acc[2][2][4][2];
#pragma unroll
    for (int a = 0; a < 2; ++a)
#pragma unroll
        for (int b = 0; b < 2; ++b)
#pragma unroll
            for (int m = 0; m < 4; ++m)
#pragma unroll
                for (int n = 0; n < 2; ++n) acc[a][b][m][n] = (f32x4){0.f, 0.f, 0.f, 0.f};
    bf16x8 At[4][2], B0[2][2], B1[2][2];
    const char* cA = (const char*)g.A + (size_t)cur.pm * tstep; const char* cB = (const char*)g.Bt + (size_t)cur.pn * tstep;
    S.a_ready(cur);
    if constexpr (SP2) {
        PG8_STAGE(PG8_SB(0, 0), cB, voffB); PG8_STAGE(PG8_SB(0, 1), cB + hstep, voffB); PG8_STAGE(PG8_SA(0, 0), cA, voffA); PG8_STAGE(PG8_SA(0, 1), cA + hstep, voffA);
        if (wr == 1) PG8_BAR;
        PG8_WAIT_V(2); PG8_BAR;
        PG8_STAGE(PG8_SB(1, 0), cB + kstep, voffB); PG8_STAGE(PG8_SA(1, 0), cA + kstep, voffA); PG8_STAGE(PG8_SB(1, 1), cB + hstep + kstep, voffB);
        PG8_WAIT_V(6); PG8_BAR;
    } else {
        PG8_STAGE(PG8_SB(0, 0), cB, voffB); PG8_STAGE(PG8_SA(0, 0), cA, voffA); PG8_STAGE(PG8_SB(0, 1), cB + hstep, voffB); PG8_STAGE(PG8_SA(0, 1), cA + hstep, voffA);
        if (wr == 1) PG8_BAR;
        PG8_WAIT_V(4); PG8_BAR;
        PG8_STAGE(PG8_SB(1, 0), cB + kstep, voffB); PG8_STAGE(PG8_SA(1, 0), cA + kstep, voffA); PG8_STAGE(PG8_SB(1, 1), cB + hstep + kstep, voffB);
        PG8_WAIT_V(6); PG8_BAR;
    }
    for (;;) {
        const bool has_next = S.next(ui + 1, nxt);
        const char* nA = has_next ? (const char*)g.A + (size_t)nxt.pm * tstep : cA; const char* nB = has_next ? (const char*)g.Bt + (size_t)nxt.pn * tstep : cB;
        for (int t = 0; t < nt; t += 2) {
            const bool last = (t == nt - 2);
            const char* a1 = cA + (size_t)(t + 1) * kstep;
            const char* a2 = last ? nA : cA + (size_t)(t + 2) * kstep; const char* b2 = last ? nB : cB + (size_t)(t + 2) * kstep;
            const char* a3 = a2 + kstep; const char* b3 = b2 + kstep;
            if (last && has_next) S.a_ready(nxt);
            if constexpr (SP2) {
            PG8_LDB(B0, 0, 0); PG8_LDB(B1, 0, 1); PG8_SCHED; PG8_LDA(At, 0, 0); PG8_STAGE(PG8_SA(1, 1), a1 + hstep, voffA);
            PG8_WAIT_V(8); PG8_WAIT_L(0); PG8_BAR; PG8_MMA(0, 0, At, B0); PG8_MMA(0, 1, At, B1); PG8_BAR; PG8_SCHED;
            PG8_LDA(At, 0, 1); PG8_STAGE(PG8_SB(0, 0), b2, voffB); PG8_STAGE(PG8_SB(0, 1), b2 + hstep, voffB); PG8_STAGE(PG8_SA(0, 0), a2, voffA);
            PG8_WAIT_V(8); PG8_WAIT_L(0); PG8_BAR; PG8_MMA(1, 0, At, B0); PG8_MMA(1, 1, At, B1); PG8_BAR; PG8_SCHED;
            PG8_LDB(B0, 1, 0); PG8_LDB(B1, 1, 1); PG8_SCHED; PG8_LDA(At, 1, 0); PG8_STAGE(PG8_SA(0, 1), a2 + hstep, voffA);
            PG8_WAIT_V(8); PG8_WAIT_L(0); PG8_BAR; PG8_MMA(0, 0, At, B0); PG8_MMA(0, 1, At, B1); PG8_BAR; PG8_SCHED;
            PG8_LDA(At, 1, 1); PG8_STAGE(PG8_SB(1, 0), b3, voffB); PG8_STAGE(PG8_SB(1, 1), b3 + hstep, voffB); PG8_STAGE(PG8_SA(1, 0), a3, voffA);
            PG8_WAIT_V(8); PG8_WAIT_L(0); PG8_BAR; PG8_MMA(1, 0, At, B0); PG8_MMA(1, 1, At, B1); PG8_BAR; PG8_SCHED;
            } else {
            PG8_LDB(B0, 0, 0); PG8_SCHED; PG8_LDA(At, 0, 0); PG8_STAGE(PG8_SA(1, 1), a1 + hstep, voffA);
            PG8_WAIT_L(8); PG8_BAR; PG8_WAIT_L(0); PG8_MMA(0, 0, At, B0); PG8_BAR; PG8_SCHED;
            PG8_LDB(B1, 0, 1); PG8_STAGE(PG8_SB(0, 0), b2, voffB);
            PG8_BAR; PG8_WAIT_L(0); PG8_MMA(0, 1, At, B1); PG8_BAR;
            PG8_LDA(At, 0, 1); PG8_STAGE(PG8_SA(0, 0), a2, voffA);
            PG8_BAR; PG8_WAIT_L(0); PG8_MMA(1, 0, At, B0); PG8_BAR; PG8_SCHED;
            PG8_STAGE(PG8_SB(0, 1), b2 + hstep, voffB);
            PG8_WAIT_V(6); PG8_BAR; PG8_MMA(1, 1, At, B1); PG8_BAR;
            PG8_LDB(B0, 1, 0); PG8_SCHED; PG8_LDA(At, 1, 0); PG8_STAGE(PG8_SA(0, 1), a2 + hstep, voffA);
            PG8_WAIT_L(8); PG8_BAR; PG8_WAIT_L(0); PG8_MMA(0, 0, At, B0); PG8_BAR; PG8_SCHED;
            PG8_LDB(B1, 1, 1); PG8_STAGE(PG8_SB(1, 0), b3, voffB);
            PG8_BAR; PG8_WAIT_L(0); PG8_MMA(0, 1, At, B1); PG8_BAR;
            PG8_LDA(At, 1, 1); PG8_STAGE(PG8_SA(1, 0), a3, voffA);
            PG8_BAR; PG8_WAIT_L(0); PG8_MMA(1, 0, At, B0); PG8_BAR; PG8_SCHED;
            PG8_STAGE(PG8_SB(1, 1), b3 + hstep, voffB);
            PG8_WAIT_V(6); PG8_BAR; PG8_MMA(1, 1, At, B1); PG8_BAR;
            }
        }
        if constexpr (ALIGN_EPI) { if (wr == 0) PG8_BAR; }
        if constexpr (!Epi::AFTER_DRAIN) { E(acc, cur, wr, wc, fr, fq); S.done(cur); }
        if (!has_next) break;
#pragma unroll
        for (int a = 0; a < 2; ++a)
#pragma unroll
            for (int b = 0; b < 2; ++b)
#pragma unroll
                for (int m = 0; m < 4; ++m)
#pragma unroll
                    for (int n = 0; n < 2; ++n) acc[a][b][m][n] = (f32x4){0.f, 0.f, 0.f, 0.f};
        cur = nxt; cA = nA; cB = nB; ++ui;
        if constexpr (ALIGN_EPI) { if (wr == 1) PG8_BAR; }
    }
    PG8_WAIT_V(0);
    if constexpr (!ALIGN_EPI) { if (wr == 0) PG8_BAR; }
    PG8_BAR;
    if constexpr (Epi::AFTER_DRAIN) { E.fused(acc, cur, wr, wc, fr, fq, lds, wid, lane); S.done(cur); }
#undef PG8_SA
#undef PG8_SB
#undef PG8_STAGE
#undef PG8_LDA
#undef PG8_LDB
#undef PG8_MMA
#undef PG8_WAIT_V
#undef PG8_WAIT_L
#undef PG8_BAR
#undef PG8_SCHED
}
}
#define LAS __attribute__((address_space(3)))
#define XB_TMO      128
#define XB_XCNT(j)  (256  + 64 * (j))
#define XB_XSUB(j)  (1280 + 64 * (j))
#define XB_XGEN(j)  (2304 + 64 * (j))
#define XB_TOP      3328
#define XB_TOPGEN   3392
#define XCD_BAR_WORDS 3456
#define XB_SPIN_CAP (1u << 18)

__device__ __forceinline__ unsigned xb_ld(unsigned* p)              { return __hip_atomic_load(p, __ATOMIC_RELAXED, __HIP_MEMORY_SCOPE_AGENT); }
__device__ __forceinline__ unsigned xb_add(unsigned* p, unsigned v) { return __hip_atomic_fetch_add(p, v, __ATOMIC_RELAXED, __HIP_MEMORY_SCOPE_AGENT); }
__device__ __forceinline__ unsigned xb_xcc_id() { return (unsigned)__builtin_amdgcn_s_getreg((3 << 11) | 20) & 0xFu; }
#define XB_SPIN(cond, bar) do { unsigned _sp = 0; while (cond) { __builtin_amdgcn_s_sleep(1); \
    if ((++_sp & 255u) == 0u) { if (xb_ld(&(bar)[XB_TMO])) break; if (_sp > XB_SPIN_CAP) { atomicAdd(&(bar)[XB_TMO], 1u); break; } } } } while (0)

struct XcdBarrier {
    unsigned* bar; unsigned x;
    volatile LAS unsigned* st;
};

__device__ __forceinline__ XcdBarrier xcd_barrier_post(unsigned* bar, volatile LAS unsigned* st) {
    XcdBarrier b; b.bar = bar; b.x = xb_xcc_id(); b.st = st;
    if (threadIdx.x == 0) (void)xb_add(&bar[XB_XCNT(b.x)], 1u);
    return b;
}
__device__ __forceinline__ void xcd_barrier_complete(unsigned* bar, unsigned x, unsigned& nloc, unsigned& nx) {
    const unsigned G = gridDim.x * gridDim.y * gridDim.z;
    unsigned sum, cnt, mine, sp = 0u;
    for (;;) {
        sum = 0u; cnt = 0u; mine = 0u;
#pragma unroll
        for (unsigned j = 0; j < 16; ++j) { const unsigned c = xb_ld(&bar[XB_XCNT(j)]); sum += c; cnt += (c > 0u) ? 1u : 0u; mine = (j == x) ? c : mine; }
        if (sum == G) break;
        __builtin_amdgcn_s_sleep(1);
        if ((++sp & 255u) == 0u) { if (xb_ld(&bar[XB_TMO])) break; if (sp > XB_SPIN_CAP) { atomicAdd(&bar[XB_TMO], 1u); break; } }
    }
    nloc = mine > 0u ? mine : 1u; nx = cnt > 0u ? cnt : 1u;
}

__device__ __forceinline__ void xcd_barrier(const XcdBarrier& b) {
    asm volatile("s_waitcnt vmcnt(0)" ::: "memory");
    __syncthreads();
    if (threadIdx.x == 0) {
        unsigned* bar = b.bar;
        __builtin_amdgcn_s_waitcnt(0);
        unsigned nloc = b.st[0], nx = b.st[1];
        if (nloc == 0u) { xcd_barrier_complete(bar, b.x, nloc, nx); b.st[0] = nloc; b.st[1] = nx; }
        const unsigned old = xb_add(&bar[XB_XSUB(b.x)], 1u);
        const unsigned gen = old / nloc;
        if (old + 1u == (gen + 1u) * nloc) {
            __builtin_amdgcn_fence(__ATOMIC_RELEASE, "agent");
            asm volatile("s_waitcnt vmcnt(0)" ::: "memory");
            const unsigned og = xb_add(&bar[XB_TOP], 1u);
            const unsigned tg = og / nx;
            if (og + 1u == (tg + 1u) * nx) xb_add(&bar[XB_TOPGEN], 1u);
            else XB_SPIN(xb_ld(&bar[XB_TOPGEN]) == tg, bar);
            __builtin_amdgcn_fence(__ATOMIC_ACQUIRE, "agent");
            xb_add(&bar[XB_XGEN(b.x)], 1u);
            asm volatile("s_waitcnt vmcnt(0)" ::: "memory");
        } else {
            XB_SPIN(xb_ld(&bar[XB_XGEN(b.x)]) == gen, bar);
            __builtin_amdgcn_fence(__ATOMIC_ACQUIRE, "agent");
            asm volatile("s_waitcnt vmcnt(0)" ::: "memory");
        }
    }
    __syncthreads();
}
namespace da {
#define DA_LAS __attribute__((address_space(3)))
typedef short bf16x8 __attribute__((ext_vector_type(8)));
typedef short s16x4 __attribute__((ext_vector_type(4)));
typedef float f32x16 __attribute__((ext_vector_type(16)));
typedef float f32x4 __attribute__((ext_vector_type(4)));
typedef unsigned u32x4 __attribute__((ext_vector_type(4)));
typedef unsigned u32x2 __attribute__((ext_vector_type(2)));
constexpr int KSTR = 144, VSTR = 320;
constexpr int K_BYTES = 64 * KSTR, V_BYTES = 64 * VSTR, STAGE = 2 * K_BYTES + V_BYTES;
constexpr float THR = 4.0f;
__device__ __forceinline__ unsigned cvt_pk(float lo, float hi) { unsigned r; asm volatile("v_cvt_pk_bf16_f32 %0, %1, %2" : "=v"(r) : "v"(lo), "v"(hi)); return r; }
__device__ __forceinline__ s16x4 vtr(const DA_LAS unsigned char* p) { typedef short v4i16_t __attribute__((ext_vector_type(4)));
    return __builtin_bit_cast(s16x4, __builtin_amdgcn_ds_read_tr16_b64_v4i16((DA_LAS v4i16_t*)p)); }

__device__ __forceinline__ void dattn_phase(DA_LAS unsigned char* lds, const bf16_t* U, const float* lamp, const float* subln_g, bf16_t* MIX, int vcu, int G) {
    const int tid = threadIdx.x, lane = tid & 63, wave = __builtin_amdgcn_readfirstlane(tid >> 6), comp = wave >> 2, qs = wave & 3;
    const int r32 = lane & 31, hh = lane >> 5, gi = lane >> 4, li = lane & 15;
    const float lam = lamp[0];
    const int krow = tid >> 3, kch = tid & 7, vrow0 = tid >> 4, vch = tid & 15;
    const int kdst = krow * KSTR + kch * 16, vdst0 = vrow0 * VSTR + vch * 16, vdst1 = (vrow0 + 32) * VSTR + vch * 16;
    const int kfrag = r32 * KSTR + hh * 16;
    const int vfrag = (4 * hh + (li >> 2)) * VSTR + (16 * (gi & 1) + 4 * (li & 3)) * 2;
    for (int u = vcu; u < BATCH * 4 * 16; u += G) {
        const int qb = u & 15, h = (u >> 4) & 3, b = u >> 6;
        const bf16_t* Ub = U + (size_t)b * SEQ * NU;
        const bf16_t* ksrc0 = Ub + (size_t)krow * NU + U_DK + (2 * h) * 64 + kch * 8;
        const bf16_t* ksrc1 = ksrc0 + 64;
        const bf16_t* vsrc0 = Ub + (size_t)vrow0 * NU + U_DV + h * 128 + vch * 8;
        const bf16_t* vsrc1 = vsrc0 + (size_t)32 * NU;
        bf16x8 qf[4];
        { const bf16_t* qp = Ub + (size_t)(qb * 128 + qs * 32 + r32) * NU + U_DQ + (2 * h + comp) * 64 + hh * 8;
#pragma unroll
          for (int ds = 0; ds < 4; ++ds) qf[ds] = *(const bf16x8*)(qp + ds * 16); }
        f32x16 o[4];
#pragma unroll
        for (int d0 = 0; d0 < 4; ++d0)
#pragma unroll
            for (int r = 0; r < 16; ++r) o[d0][r] = 0.f;
        float m = -INFINITY, l = 0.f;
        u32x4 rk0 = *(const u32x4*)ksrc0, rk1 = *(const u32x4*)ksrc1, rv0 = *(const u32x4*)vsrc0, rv1 = *(const u32x4*)vsrc1;
        *(DA_LAS u32x4*)(lds + kdst) = rk0; *(DA_LAS u32x4*)(lds + K_BYTES + kdst) = rk1; *(DA_LAS u32x4*)(lds + 2 * K_BYTES + vdst0) = rv0; *(DA_LAS u32x4*)(lds + 2 * K_BYTES + vdst1) = rv1;
        __syncthreads();
        for (int t = 0; t < SEQ / 64; ++t) {
            const DA_LAS unsigned char* st = lds + (t & 1) * STAGE;
            DA_LAS unsigned char* nst = lds + ((t + 1) & 1) * STAGE;
            if (t + 1 < SEQ / 64) { const size_t go = (size_t)(t + 1) * 64 * NU; rk0 = *(const u32x4*)(ksrc0 + go); rk1 = *(const u32x4*)(ksrc1 + go); rv0 = *(const u32x4*)(vsrc0 + go); rv1 = *(const u32x4*)(vsrc1 + go); }
            const DA_LAS unsigned char* Kt = st + comp * K_BYTES + kfrag;
            f32x16 p0, p1;
#pragma unroll
            for (int r = 0; r < 16; ++r) { p0[r] = 0.f; p1[r] = 0.f; }
#pragma unroll
            for (int ds = 0; ds < 4; ++ds) {
                const bf16x8 a0 = *(const DA_LAS bf16x8*)(Kt + ds * 32), a1 = *(const DA_LAS bf16x8*)(Kt + 32 * KSTR + ds * 32);
                p0 = __builtin_amdgcn_mfma_f32_32x32x16_bf16(a0, qf[ds], p0, 0, 0, 0);
                p1 = __builtin_amdgcn_mfma_f32_32x32x16_bf16(a1, qf[ds], p1, 0, 0, 0);
            }
            float mx = fmaxf(p0[0], p1[0]);
#pragma unroll
            for (int r = 1; r < 16; ++r) mx = fmaxf(mx, fmaxf(p0[r], p1[r]));
            mx = fmaxf(mx, __shfl_xor(mx, 32));
            if (!__all(mx - m <= THR)) {
                const float mn = fmaxf(m, mx), alpha = __builtin_amdgcn_exp2f(m - mn);
                m = mn; l *= alpha;
#pragma unroll
                for (int d0 = 0; d0 < 4; ++d0) o[d0] = o[d0] * alpha;
            }
            float rs = 0.f;
#pragma unroll
            for (int r = 0; r < 16; ++r) { p0[r] = __builtin_amdgcn_exp2f(p0[r] - m); p1[r] = __builtin_amdgcn_exp2f(p1[r] - m); rs += p0[r] + p1[r]; }
            l += rs;
            bf16x8 pf[4];
#pragma unroll
            for (int s = 0; s < 2; ++s) {
                u32x4 w0, w1;
                w0.x = cvt_pk(p0[8 * s + 0], p0[8 * s + 1]); w0.y = cvt_pk(p0[8 * s + 2], p0[8 * s + 3]); w0.z = cvt_pk(p0[8 * s + 4], p0[8 * s + 5]); w0.w = cvt_pk(p0[8 * s + 6], p0[8 * s + 7]);
                w1.x = cvt_pk(p1[8 * s + 0], p1[8 * s + 1]); w1.y = cvt_pk(p1[8 * s + 2], p1[8 * s + 3]); w1.z = cvt_pk(p1[8 * s + 4], p1[8 * s + 5]); w1.w = cvt_pk(p1[8 * s + 6], p1[8 * s + 7]);
                pf[s] = __builtin_bit_cast(bf16x8, w0); pf[2 + s] = __builtin_bit_cast(bf16x8, w1);
            }
            const DA_LAS unsigned char* Vt = st + 2 * K_BYTES + vfrag;
#pragma unroll
            for (int d0 = 0; d0 < 4; ++d0)
#pragma unroll
                for (int ks = 0; ks < 4; ++ks) {
                    const s16x4 lo = vtr(Vt + (16 * ks) * VSTR + 64 * d0), hi = vtr(Vt + (16 * ks + 8) * VSTR + 64 * d0);
                    const bf16x8 av = (bf16x8){lo[0], lo[1], lo[2], lo[3], hi[0], hi[1], hi[2], hi[3]};
                    o[d0] = __builtin_amdgcn_mfma_f32_32x32x16_bf16(av, pf[ks], o[d0], 0, 0, 0);
                }
            if (t + 1 < SEQ / 64) { *(DA_LAS u32x4*)(nst + kdst) = rk0; *(DA_LAS u32x4*)(nst + K_BYTES + kdst) = rk1; *(DA_LAS u32x4*)(nst + 2 * K_BYTES + vdst0) = rv0; *(DA_LAS u32x4*)(nst + 2 * K_BYTES + vdst1) = rv1; }
            __syncthreads();
        }
        l += __shfl_xor(l, 32);
        const float il = 1.f / l;
        DA_LAS float* xch = (DA_LAS float*)lds + (size_t)qs * 64 * 64 + lane;
        if (comp == 1) {
#pragma unroll
            for (int d0 = 0; d0 < 4; ++d0)
#pragma unroll
                for (int r = 0; r < 16; ++r) xch[(d0 * 16 + r) * 64] = o[d0][r] * il;
        }
        __syncthreads();
        if (comp == 0) {
            float ss = 0.f;
#pragma unroll
            for (int d0 = 0; d0 < 4; ++d0)
#pragma unroll
                for (int r = 0; r < 16; ++r) { const float v = o[d0][r] * il - lam * xch[(d0 * 16 + r) * 64]; o[d0][r] = v; ss += v * v; }
            ss += __shfl_xor(ss, 32);
            const float rn = (1.f - LAMBDA_INIT) / sqrtf(ss * (1.f / 128.f) + RMS_EPS);
            bf16_t* orow = MIX + (size_t)(b * SEQ + qb * 128 + qs * 32 + r32) * DM + 512 + h * 128 + 4 * hh;
#pragma unroll
            for (int d0 = 0; d0 < 4; ++d0)
#pragma unroll
                for (int rq = 0; rq < 4; ++rq) {
                    const f32x4 g4 = *(const f32x4*)(subln_g + 32 * d0 + 8 * rq + 4 * hh);
                    u32x2 w; w.x = cvt_pk(o[d0][4 * rq] * rn * g4[0], o[d0][4 * rq + 1] * rn * g4[1]); w.y = cvt_pk(o[d0][4 * rq + 2] * rn * g4[2], o[d0][4 * rq + 3] * rn * g4[3]);
                    *(u32x2*)(orow + 32 * d0 + 8 * rq) = w;
                }
        }
        __syncthreads();
    }
}
}
namespace hg {
#define HG_LAS __attribute__((address_space(3)))
typedef short bf16x8 __attribute__((ext_vector_type(8)));
typedef short s16x4 __attribute__((ext_vector_type(4)));
typedef float f32x16 __attribute__((ext_vector_type(16)));
typedef float f32x4 __attribute__((ext_vector_type(4)));
typedef unsigned u32x4 __attribute__((ext_vector_type(4)));
typedef unsigned u32x2 __attribute__((ext_vector_type(2)));
typedef float f32x2 __attribute__((ext_vector_type(2)));
constexpr int RSTR = 272, TSTR = 320;
constexpr int L_QIN = 0, L_KIN = L_QIN + 64 * RSTR, L_KINT = L_KIN + 64 * RSTR, L_VT = L_KINT + 64 * TSTR, L_SBT = L_VT + 64 * TSTR, L_DEC = L_SBT + 128 * RSTR, L_SEGT = L_DEC + 512, L_END = L_SEGT + 8 * 128 * 4;
static_assert(L_END <= 131072, "hgrn LDS map");
constexpr float LOG2E = 1.4426950408889634f;
__device__ __forceinline__ unsigned cvt_pk(float lo, float hi) { unsigned r; asm volatile("v_cvt_pk_bf16_f32 %0, %1, %2" : "=v"(r) : "v"(lo), "v"(hi)); return r; }
__device__ __forceinline__ s16x4 vtr(const HG_LAS unsigned char* p) { typedef short v4i16_t __attribute__((ext_vector_type(4)));
    return __builtin_bit_cast(s16x4, __builtin_amdgcn_ds_read_tr16_b64_v4i16((HG_LAS v4i16_t*)p)); }
__device__ __forceinline__ float bflo(unsigned w) { return __builtin_bit_cast(float, w << 16); }
__device__ __forceinline__ float bfhi(unsigned w) { return __builtin_bit_cast(float, w & 0xffff0000u); }

__device__ __forceinline__ void hgrn_phase(HG_LAS unsigned char* lds, const bf16_t* U, const float* LB, float* OSC, int first, int stride) {
    const int tid = threadIdx.x, lane = tid & 63, wave = __builtin_amdgcn_readfirstlane(tid >> 6);
    const int r32 = lane & 31, hh = lane >> 5, gi = lane >> 4, li = lane & 15;
    const int vt = wave >> 1, ct = wave & 1, kt = wave >> 1, vpair = wave & 1;
    const int kp = lane, seg = wave;
    const int vrow0 = tid >> 4, vch = tid & 15;
    const int trp = (li >> 2) * TSTR + (16 * (gi & 1) + 4 * (li & 3)) * 2;
    for (int item = first; item < BATCH * 4 * 2; item += stride) {
        const int dir = item & 1, h = (item >> 1) & 3, b = item >> 3;
        const bf16_t* Ub = U + (size_t)b * SEQ * NU;
        const int qcol = U_HQ + h * 128 + 2 * kp, fcol = (dir ? U_HFB : U_HFF) + h * 128 + 2 * kp, vcol = U_HI + h * 128 + vch * 8;
        const float lb0 = LB[dir * 512 + h * 128 + 2 * kp], lb1 = LB[dir * 512 + h * 128 + 2 * kp + 1];
        for (int i = tid; i < 128 * RSTR / 4; i += 512) ((HG_LAS unsigned*)(lds + L_SBT))[i] = 0u;
        f32x16 S[2];
#pragma unroll
        for (int r = 0; r < 16; ++r) { S[0][r] = 0.f; S[1][r] = 0.f; }
        unsigned rq[8], rf[8]; u32x4 rv0, rv1;
#define HG_TIME(p) (dir ? (SEQ - 1 - (p)) : (p))
#define HG_LOAD(n) do { _Pragma("unroll") for (int i = 0; i < 8; ++i) { const bf16_t* rp = Ub + (size_t)HG_TIME(64 * (n) + 8 * seg + i) * NU; rq[i] = *(const unsigned*)(rp + qcol); rf[i] = *(const unsigned*)(rp + fcol); } \
        rv0 = *(const u32x4*)(Ub + (size_t)HG_TIME(64 * (n) + vrow0) * NU + vcol); rv1 = *(const u32x4*)(Ub + (size_t)HG_TIME(64 * (n) + vrow0 + 32) * NU + vcol); } while (0)
        HG_LOAD(0);
        __syncthreads();
        for (int n = 0; n < SEQ / 64; ++n) {
            float c0[8], c1[8], k0[8], k1[8]; float a0 = 0.f, a1 = 0.f;
#pragma unroll
            for (int i = 0; i < 8; ++i) {
                const float u0 = bflo(rf[i]), u1 = bfhi(rf[i]);
                const float f0 = lb0 + (1.f - lb0) * __builtin_amdgcn_rcpf(1.f + __builtin_amdgcn_exp2f(-LOG2E * u0));
                const float f1 = lb1 + (1.f - lb1) * __builtin_amdgcn_rcpf(1.f + __builtin_amdgcn_exp2f(-LOG2E * u1));
                k0[i] = 1.f - f0; k1[i] = 1.f - f1;
                a0 += __builtin_amdgcn_logf(f0); a1 += __builtin_amdgcn_logf(f1);
                c0[i] = a0; c1[i] = a1;
            }
            *(HG_LAS f32x2*)(lds + L_SEGT + (seg * 128 + 2 * kp) * 4) = (f32x2){a0, a1};
            __syncthreads();
            float off0 = 0.f, off1 = 0.f, tot0 = 0.f, tot1 = 0.f;
#pragma unroll
            for (int s2 = 0; s2 < 8; ++s2) { const f32x2 tq = *(const HG_LAS f32x2*)(lds + L_SEGT + (s2 * 128 + 2 * kp) * 4); if (s2 < seg) { off0 += tq.x; off1 += tq.y; } tot0 += tq.x; tot1 += tq.y; }
            if (seg == 0) *(HG_LAS f32x2*)(lds + L_DEC + 2 * kp * 4) = (f32x2){__builtin_amdgcn_exp2f(tot0), __builtin_amdgcn_exp2f(tot1)};
#pragma unroll
            for (int i = 0; i < 8; ++i) {
                const int c = 8 * seg + i; const float b0 = off0 + c0[i], b1 = off1 + c1[i];
                const unsigned qi = cvt_pk(bflo(rq[i]) * __builtin_amdgcn_exp2f(b0), bfhi(rq[i]) * __builtin_amdgcn_exp2f(b1));
                const unsigned ki = cvt_pk(k0[i] * __builtin_amdgcn_exp2f(-b0), k1[i] * __builtin_amdgcn_exp2f(-b1));
                *(HG_LAS unsigned*)(lds + L_QIN + c * RSTR + 4 * kp) = qi;
                *(HG_LAS unsigned*)(lds + L_KIN + c * RSTR + 4 * kp) = ki;
                *(HG_LAS unsigned*)(lds + L_KINT + c * TSTR + 4 * kp) = ki;
            }
            *(HG_LAS u32x4*)(lds + L_VT + vrow0 * TSTR + vch * 16) = rv0; *(HG_LAS u32x4*)(lds + L_VT + (vrow0 + 32) * TSTR + vch * 16) = rv1;
            if (n + 1 < SEQ / 64) HG_LOAD(n + 1);
            __syncthreads();
            bf16x8 qfr[8];
#pragma unroll
            for (int ks = 0; ks < 8; ++ks) qfr[ks] = *(const HG_LAS bf16x8*)(lds + L_QIN + (32 * ct + r32) * RSTR + ks * 32 + hh * 16);
            f32x16 o;
#pragma unroll
            for (int r = 0; r < 16; ++r) o[r] = 0.f;
#pragma unroll
            for (int ks = 0; ks < 8; ++ks) {
                const bf16x8 as = *(const HG_LAS bf16x8*)(lds + L_SBT + (32 * vt + r32) * RSTR + ks * 32 + hh * 16);
                o = __builtin_amdgcn_mfma_f32_32x32x16_bf16(as, qfr[ks], o, 0, 0, 0);
            }
#pragma unroll
            for (int st = 0; st < 2; ++st) {
                if (st <= ct) {
                    f32x16 at;
#pragma unroll
                    for (int r = 0; r < 16; ++r) at[r] = 0.f;
#pragma unroll
                    for (int ks = 0; ks < 8; ++ks) {
                        const bf16x8 ak = *(const HG_LAS bf16x8*)(lds + L_KIN + (32 * st + r32) * RSTR + ks * 32 + hh * 16);
                        at = __builtin_amdgcn_mfma_f32_32x32x16_bf16(ak, qfr[ks], at, 0, 0, 0);
                    }
                    if (st == ct) {
#pragma unroll
                        for (int r = 0; r < 16; ++r) { const int srow = (r & 3) + 8 * (r >> 2) + 4 * hh; at[r] = (srow <= r32) ? at[r] : 0.f; }
                    }
#pragma unroll
                    for (int s2 = 0; s2 < 2; ++s2) {
                        u32x4 w; w.x = cvt_pk(at[8 * s2 + 0], at[8 * s2 + 1]); w.y = cvt_pk(at[8 * s2 + 2], at[8 * s2 + 3]); w.z = cvt_pk(at[8 * s2 + 4], at[8 * s2 + 5]); w.w = cvt_pk(at[8 * s2 + 6], at[8 * s2 + 7]);
                        const HG_LAS unsigned char* vp = lds + L_VT + (32 * st + 16 * s2 + 4 * hh) * TSTR + 64 * vt + trp;
                        const s16x4 lo = vtr(vp), hi = vtr(vp + 8 * TSTR);
                        const bf16x8 av = (bf16x8){lo[0], lo[1], lo[2], lo[3], hi[0], hi[1], hi[2], hi[3]};
                        o = __builtin_amdgcn_mfma_f32_32x32x16_bf16(av, __builtin_bit_cast(bf16x8, w), o, 0, 0, 0);
                    }
                }
            }
#pragma unroll
            for (int cs = 0; cs < 4; ++cs) {
                const HG_LAS unsigned char* kp_ = lds + L_KINT + (16 * cs + 8 * hh) * TSTR + 64 * kt + trp;
                const s16x4 klo = vtr(kp_), khi = vtr(kp_ + 4 * TSTR);
                const bf16x8 ak = (bf16x8){klo[0], klo[1], klo[2], klo[3], khi[0], khi[1], khi[2], khi[3]};
#pragma unroll
                for (int vv = 0; vv < 2; ++vv) {
                    const HG_LAS unsigned char* vp = lds + L_VT + (16 * cs + 8 * hh) * TSTR + 64 * (2 * vpair + vv) + trp;
                    const s16x4 vlo = vtr(vp), vhi = vtr(vp + 4 * TSTR);
                    const bf16x8 bv = (bf16x8){vlo[0], vlo[1], vlo[2], vlo[3], vhi[0], vhi[1], vhi[2], vhi[3]};
                    S[vv] = __builtin_amdgcn_mfma_f32_32x32x16_bf16(ak, bv, S[vv], 0, 0, 0);
                }
            }
#pragma unroll
            for (int rq4 = 0; rq4 < 4; ++rq4) {
                const f32x4 d4 = *(const HG_LAS f32x4*)(lds + L_DEC + (32 * kt + 8 * rq4 + 4 * hh) * 4);
#pragma unroll
                for (int j = 0; j < 4; ++j) { S[0][4 * rq4 + j] *= d4[j]; S[1][4 * rq4 + j] *= d4[j]; }
            }
            __syncthreads();
#pragma unroll
            for (int vv = 0; vv < 2; ++vv)
#pragma unroll
                for (int rq4 = 0; rq4 < 4; ++rq4) {
                    u32x2 w; w.x = cvt_pk(S[vv][4 * rq4], S[vv][4 * rq4 + 1]); w.y = cvt_pk(S[vv][4 * rq4 + 2], S[vv][4 * rq4 + 3]);
                    *(HG_LAS u32x2*)(lds + L_SBT + (32 * (2 * vpair + vv) + r32) * RSTR + (32 * kt + 8 * rq4 + 4 * hh) * 2) = w;
                }
            {
                const int tok = HG_TIME(64 * n + 32 * ct + r32);
                float* op = OSC + ((size_t)dir * NTOK + (size_t)b * SEQ + tok) * 512 + h * 128 + 32 * vt + 4 * hh;
#pragma unroll
                for (int rq4 = 0; rq4 < 4; ++rq4) *(f32x4*)(op + 8 * rq4) = (f32x4){o[4 * rq4], o[4 * rq4 + 1], o[4 * rq4 + 2], o[4 * rq4 + 3]};
            }
        }
        __syncthreads();
#undef HG_LOAD
#undef HG_TIME
    }
}
}
namespace xa {
#define XA_LAS __attribute__((address_space(3)))
typedef short bf16x8 __attribute__((ext_vector_type(8)));
typedef short s16x4 __attribute__((ext_vector_type(4)));
typedef float f32x16 __attribute__((ext_vector_type(16)));
typedef unsigned u32x4 __attribute__((ext_vector_type(4)));
typedef unsigned u32x2 __attribute__((ext_vector_type(2)));
constexpr int KSTR = 528, VSTR = 576;
constexpr int K_BYTES = 64 * KSTR, V_BYTES = 64 * VSTR;
constexpr float THR = 4.0f;
__device__ __forceinline__ unsigned cvt_pk(float lo, float hi) { unsigned r; asm volatile("v_cvt_pk_bf16_f32 %0, %1, %2" : "=v"(r) : "v"(lo), "v"(hi)); return r; }
__device__ __forceinline__ s16x4 vtr(const XA_LAS unsigned char* p) { typedef short v4i16_t __attribute__((ext_vector_type(4)));
    return __builtin_bit_cast(s16x4, __builtin_amdgcn_ds_read_tr16_b64_v4i16((XA_LAS v4i16_t*)p)); }

__device__ __forceinline__ void xattn_phase(XA_LAS unsigned char* lds, bf16_t* QO, const bf16_t* KV, int vcu, int G) {
    const int tid = threadIdx.x, lane = tid & 63, wave = __builtin_amdgcn_readfirstlane(tid >> 6), qs = wave >> 2, dq = wave & 3;
    const int r32 = lane & 31, hh = lane >> 5, gi = lane >> 4, li = lane & 15;
    const int srow = tid >> 5, sch = tid & 31;
    const int kfrag = r32 * KSTR + hh * 16;
    const int vfrag = (4 * hh + (li >> 2)) * VSTR + (16 * (gi & 1) + 4 * (li & 3)) * 2 + 128 * dq;
    for (int u = vcu; u < BATCH * 4 * 32; u += G) {
        const int qb = u & 31, h = (u >> 5) & 3, b = u >> 7;
        const bf16_t* ksrc = KV + (size_t)(b * MEML + srow) * 2048 + h * 256 + sch * 8;
        const bf16_t* vsrc = ksrc + 1024;
        bf16_t* qrow = QO + (size_t)(b * SEQ + qb * 64 + qs * 32 + r32) * DM + h * 256;
        bf16x8 qf[16];
#pragma unroll
        for (int ds = 0; ds < 16; ++ds) qf[ds] = *(const bf16x8*)(qrow + ds * 16 + hh * 8);
        f32x16 o[2];
#pragma unroll
        for (int r = 0; r < 16; ++r) { o[0][r] = 0.f; o[1][r] = 0.f; }
        float m = -INFINITY, l = 0.f;
        u32x4 rk[4], rv[4];
#pragma unroll
        for (int i = 0; i < 4; ++i) { rk[i] = *(const u32x4*)(ksrc + (size_t)(16 * i) * 2048); rv[i] = *(const u32x4*)(vsrc + (size_t)(16 * i) * 2048); }
        for (int t = 0; t < MEML / 64; ++t) {
#pragma unroll
            for (int i = 0; i < 4; ++i) { *(XA_LAS u32x4*)(lds + (srow + 16 * i) * KSTR + sch * 16) = rk[i]; *(XA_LAS u32x4*)(lds + K_BYTES + (srow + 16 * i) * VSTR + sch * 16) = rv[i]; }
            if (t + 1 < MEML / 64) {
#pragma unroll
                for (int i = 0; i < 4; ++i) { rk[i] = *(const u32x4*)(ksrc + (size_t)(64 * (t + 1) + 16 * i) * 2048); rv[i] = *(const u32x4*)(vsrc + (size_t)(64 * (t + 1) + 16 * i) * 2048); }
            }
            __syncthreads();
            const XA_LAS unsigned char* Kt = lds + kfrag;
            f32x16 p0, p1;
#pragma unroll
            for (int r = 0; r < 16; ++r) { p0[r] = 0.f; p1[r] = 0.f; }
#pragma unroll
            for (int ds = 0; ds < 16; ++ds) {
                const bf16x8 a0 = *(const XA_LAS bf16x8*)(Kt + ds * 32), a1 = *(const XA_LAS bf16x8*)(Kt + 32 * KSTR + ds * 32);
                p0 = __builtin_amdgcn_mfma_f32_32x32x16_bf16(a0, qf[ds], p0, 0, 0, 0);
                p1 = __builtin_amdgcn_mfma_f32_32x32x16_bf16(a1, qf[ds], p1, 0, 0, 0);
                if ((ds & 3) == 3) __builtin_amdgcn_sched_barrier(0);
            }
            float mx = fmaxf(p0[0], p1[0]);
#pragma unroll
            for (int r = 1; r < 16; ++r) mx = fmaxf(mx, fmaxf(p0[r], p1[r]));
            mx = fmaxf(mx, __shfl_xor(mx, 32));
            if (!__all(mx - m <= THR)) {
                const float mn = fmaxf(m, mx), alpha = __builtin_amdgcn_exp2f(m - mn);
                m = mn; l *= alpha; o[0] = o[0] * alpha; o[1] = o[1] * alpha;
            }
            float rs = 0.f;
#pragma unroll
            for (int r = 0; r < 16; ++r) { p0[r] = __builtin_amdgcn_exp2f(p0[r] - m); p1[r] = __builtin_amdgcn_exp2f(p1[r] - m); rs += p0[r] + p1[r]; }
            l += rs;
            bf16x8 pf[4];
#pragma unroll
            for (int s = 0; s < 2; ++s) {
                u32x4 w0, w1;
                w0.x = cvt_pk(p0[8 * s + 0], p0[8 * s + 1]); w0.y = cvt_pk(p0[8 * s + 2], p0[8 * s + 3]); w0.z = cvt_pk(p0[8 * s + 4], p0[8 * s + 5]); w0.w = cvt_pk(p0[8 * s + 6], p0[8 * s + 7]);
                w1.x = cvt_pk(p1[8 * s + 0], p1[8 * s + 1]); w1.y = cvt_pk(p1[8 * s + 2], p1[8 * s + 3]); w1.z = cvt_pk(p1[8 * s + 4], p1[8 * s + 5]); w1.w = cvt_pk(p1[8 * s + 6], p1[8 * s + 7]);
                pf[s] = __builtin_bit_cast(bf16x8, w0); pf[2 + s] = __builtin_bit_cast(bf16x8, w1);
            }
            const XA_LAS unsigned char* Vt = lds + K_BYTES + vfrag;
#pragma unroll
            for (int d0 = 0; d0 < 2; ++d0)
#pragma unroll
                for (int ks = 0; ks < 4; ++ks) {
                    const s16x4 lo = vtr(Vt + (16 * ks) * VSTR + 64 * d0), hi = vtr(Vt + (16 * ks + 8) * VSTR + 64 * d0);
                    const bf16x8 av = (bf16x8){lo[0], lo[1], lo[2], lo[3], hi[0], hi[1], hi[2], hi[3]};
                    o[d0] = __builtin_amdgcn_mfma_f32_32x32x16_bf16(av, pf[ks], o[d0], 0, 0, 0);
                }
            __syncthreads();
        }
        l += __shfl_xor(l, 32);
        const float il = 1.f / l;
        bf16_t* orow = qrow + 64 * dq + 4 * hh;
#pragma unroll
        for (int d0 = 0; d0 < 2; ++d0)
#pragma unroll
            for (int rq = 0; rq < 4; ++rq) {
                u32x2 w; w.x = cvt_pk(o[d0][4 * rq] * il, o[d0][4 * rq + 1] * il); w.y = cvt_pk(o[d0][4 * rq + 2] * il, o[d0][4 * rq + 3] * il);
                *(u32x2*)(orow + 32 * d0 + 8 * rq) = w;
            }
    }
}
}
namespace cg = cooperative_groups;
#ifndef USE_MFMA_HGRN
#define USE_MFMA_HGRN 1
#endif
#ifndef USE_MFMA_XATTN
#define USE_MFMA_XATTN 1
#endif
#ifndef USE_MFMA_DATTN
#define USE_MFMA_DATTN 1
#endif
constexpr int NWAVES = 8;
constexpr int LDS_BYTES = 147456;
enum { PH_PROLOGUE = 0, PH_INPROJ, PH_HGRN, PH_HGRN_COMB, PH_DATTN, PH_DATTN_COMB, PH_MIXGEMM, PH_LN1, PH_QPROJ, PH_XA_SCORES, PH_XA_SOFTMAX, PH_XA_PV, PH_XA_CVT,
       PH_WOGEMM, PH_LN2, PH_TOPK, PH_MOE1, PH_MOE2, PH_FINAL, PH_COUNT };
constexpr int CW_BAR = 4096;
struct MKArgs { const float* in[27]; float* out; unsigned char* ws; int ph_lo, ph_hi; };

__global__ void __launch_bounds__(NWAVES * 64, 2) mk_fwd(MKArgs a) {
    extern __shared__ __attribute__((aligned(16))) unsigned char lds_raw[];
    PG8_LAS unsigned char* lds = (PG8_LAS unsigned char*)lds_raw;
    float* smem = (float*)lds_raw;
    unsigned char* ws = a.ws;
    const int G = gridDim.x, bx = blockIdx.x;
    const int vcu = (G % 8 == 0) ? (bx % 8) * (G / 8) + bx / 8 : bx;
    const int lo = a.ph_lo, hi = a.ph_hi;
#define IN(k) (lo <= (k) && (k) < hi)
#define SEAM(k) do { if (IN(k) && IN((k) + 1)) { if ((k) == PH_PROLOGUE) cg::this_grid().sync(); else xcd_barrier(bar); } } while (0)
    float* H = a.out;
    for (int u = threadIdx.x; u < (LDS_BYTES - 131072) / 4; u += NWAVES * 64) ((PG8_LAS unsigned*)(lds + 131072))[u] = 0u;
    __syncthreads();
    XcdBarrier bar; bar.bar = (unsigned*)(ws + WS_CTL) + CW_BAR; bar.x = 0; bar.st = nullptr;
    if (hi - lo > 1) bar = xcd_barrier_post((unsigned*)(ws + WS_CTL) + CW_BAR, (volatile LAS unsigned*)(lds + 131072 + 320) + 8);
    float* ROPE = (float*)(ws + WS_ROPE); float* LB = (float*)(ws + WS_LB); float* LAM = LB + 1024;
    float* AFF = (float*)(ws + WS_AFF); int* INV = (int*)(ws + WS_INV); int* IDX = (int*)(ws + WS_IDX); float* GATE = (float*)(ws + WS_GATE);
    bf16_t* XN = (bf16_t*)(ws + WS_XN); bf16_t* MIX = (bf16_t*)(ws + WS_MIX); bf16_t* U = (bf16_t*)(ws + WS_U); bf16_t* XS = (bf16_t*)(ws + WS_XS);
    bf16_t* KV = (bf16_t*)(ws + WS_KV); bf16_t* MEMB = (bf16_t*)(ws + WS_MEMB);
    float* SC_XS = (float*)(ws + WS_XS);
    bf16_t* P = XN;

    if (IN(PH_PROLOGUE)) {
        sp_prep_small(a.in[5], a.in[7], a.in[8], a.in[9], a.in[10], ROPE, LB);
        tp_all(smem, a.in, ws, vcu, G);
        sp_cvt_bf16(a.in[1], MEMB, (long)NMEM * DM);
        sp_ln_rows<0>(a.in[0], a.in[2], a.in[3], H, XN, nullptr, nullptr);
    }
    SEAM(PH_PROLOGUE);
    if (IN(PH_INPROJ)) {
        {
            pg8::Gemm g{XN, (const bf16_t*)(ws + WS_WIN), NTOK, NU, DM}; pg8::StaticOrder S; S.init(NTOK, NU, G, bx);
            pg8::EpiStore E{U, NU, 1.f, 1, ROPE};
            pg8::gemm_phase<pg8::EpiStore, pg8::StaticOrder, true, true>(lds, g, S, E);
        }
        {
            pg8::Gemm g{MEMB, (const bf16_t*)(ws + WS_WKV), NMEM, 2048, DM}; pg8::StaticOrder S; S.init(NMEM, 2048, G, bx);
            pg8::EpiStore E{KV, 2048, 1.f, 0, nullptr};
            pg8::gemm_phase<pg8::EpiStore, pg8::StaticOrder, true, true>(lds, g, S, E);
        }
    }
    SEAM(PH_INPROJ);
#if USE_MFMA_HGRN
    if (IN(PH_HGRN)) hg::hgrn_phase(lds, U, LB, SC_XS, vcu, G);
#else
    if (IN(PH_HGRN)) sp_hgrn(smem, U, LB, SC_XS);
#endif
    SEAM(PH_HGRN);
    if (IN(PH_HGRN_COMB)) sp_hgrn_combine(SC_XS, U, a.in[6], MIX);
    SEAM(PH_HGRN_COMB);
#if USE_MFMA_DATTN
    if (IN(PH_DATTN)) da::dattn_phase(lds, U, LAM, a.in[11], MIX, vcu, G);
    SEAM(PH_DATTN);
    SEAM(PH_DATTN_COMB);
#else
    if (IN(PH_DATTN)) sp_dattn(smem, U, SC_XS);
    SEAM(PH_DATTN);
    if (IN(PH_DATTN_COMB)) sp_dattn_combine(SC_XS, LAM, a.in[11], MIX);
    SEAM(PH_DATTN_COMB);
#endif
    if (IN(PH_MIXGEMM)) {
        pg8::Gemm g{MIX, (const bf16_t*)(ws + WS_WMIX), NTOK, DM, DM}; pg8::StaticOrder S; S.init(NTOK, DM, G, bx);
        pg8::EpiResid E{H, ALPHA};
        pg8::gemm_phase<pg8::EpiResid, pg8::StaticOrder, true, true>(lds, g, S, E);
    }
    SEAM(PH_MIXGEMM);
    if (IN(PH_LN1)) sp_ln_rows<1>(nullptr, a.in[13], a.in[14], H, XN, nullptr, nullptr);
    SEAM(PH_LN1);
    if (IN(PH_QPROJ)) {
        pg8::Gemm g{XN, (const bf16_t*)(ws + WS_WQ), NTOK, DM, DM}; pg8::StaticOrder S; S.init(NTOK, DM, G, bx);
        pg8::EpiStore E{MIX, DM, pg8::QSCALE_XA, 0, nullptr};
        pg8::gemm_phase<pg8::EpiStore, pg8::StaticOrder, true, true>(lds, g, S, E);
    }
    SEAM(PH_QPROJ);
#if USE_MFMA_XATTN
    if (IN(PH_XA_SCORES)) xa::xattn_phase(lds, MIX, KV, vcu, G);
    SEAM(PH_XA_SCORES); SEAM(PH_XA_SOFTMAX); SEAM(PH_XA_PV);
#else
    if (IN(PH_XA_SCORES))
        for (int b = 0; b < BATCH; ++b)
            sp_gemm(smem, MIX + (size_t)b * SEQ * DM, 256, DM, KV + (size_t)b * MEML * 2048, 256, 2048, 1, SC_XS + (size_t)b * 4 * SEQ * 256, (long)SEQ * 256, 256, SEQ, 256, 256, 4);
    SEAM(PH_XA_SCORES);
    if (IN(PH_XA_SOFTMAX)) sp_softmax256(SC_XS, P, (long)BATCH * 4 * SEQ);
    SEAM(PH_XA_SOFTMAX);
    if (IN(PH_XA_PV))
        for (int b = 0; b < BATCH; ++b)
            sp_gemm(smem, P + (size_t)b * 4 * SEQ * 256, (long)SEQ * 256, 256, KV + (size_t)b * MEML * 2048 + 1024, 256, 1, 2048, SC_XS + (size_t)b * SEQ * DM, 256, DM, SEQ, 256, 256, 4);
    SEAM(PH_XA_PV);
    if (IN(PH_XA_CVT)) sp_cvt2d(SC_XS, DM, MIX, DM, NTOK, DM);
#endif
    SEAM(PH_XA_CVT);
    if (IN(PH_WOGEMM)) {
        pg8::Gemm g{MIX, (const bf16_t*)(ws + WS_WO), NTOK, DM, DM}; pg8::StaticOrder S; S.init(NTOK, DM, G, bx);
        pg8::EpiResid E{H, ALPHA};
        pg8::gemm_phase<pg8::EpiResid, pg8::StaticOrder, true, true>(lds, g, S, E);
    }
    SEAM(PH_WOGEMM);
    if (IN(PH_LN2)) sp_ln_rows<2>(nullptr, a.in[19], a.in[20], H, XN, a.in[21], AFF);
    SEAM(PH_LN2);
    if (IN(PH_TOPK)) sp_topk_gather(smem, AFF, XN, IDX, GATE, INV, XS);
    SEAM(PH_TOPK);
    if (IN(PH_MOE1)) {
        pg8::Gemm g{XS, (const bf16_t*)(ws + WS_WGU), NGRP * CAP, NEXP * 4096, DM}; pg8::MoeOrder<1> S{G, bx};
        pg8::EpiSwiglu E{U};
        pg8::gemm_phase<pg8::EpiSwiglu, pg8::MoeOrder<1>, true, true>(lds, g, S, E);
    }
    SEAM(PH_MOE1);
    if (IN(PH_MOE2)) {
        pg8::Gemm g{U, (const bf16_t*)(ws + WS_WD), NGRP * CAP, NEXP * DM, DFF}; pg8::MoeOrder<2> S{G, bx};
        pg8::EpiYGate E{XS, GATE};
        pg8::gemm_phase<pg8::EpiYGate, pg8::MoeOrder<2>, true, true>(lds, g, S, E);
    }
    SEAM(PH_MOE2);
    if (IN(PH_FINAL)) sp_final(H, XS, INV, a.in[25], a.in[26]);
#undef IN
#undef SEAM
}

#ifndef MK_PER_PHASE
#define MK_PER_PHASE 0
#endif
extern "C" void kernel_launch(void* const* d_in, const int* in_sizes, int n_in, void* d_out, int out_size, void* d_ws, size_t ws_size, hipStream_t stream) {
    if (n_in != 27 || out_size != NTOK * DM || ws_size < WS_END) { fprintf(stderr, "kernel_launch: unexpected shapes (n_in %d out %d ws %zu)\n", n_in, out_size, ws_size); return; }
    static int grid = 0;
    if (grid == 0) {
        int dev = 0, cus = 0, per_cu = 0;
        (void)hipGetDevice(&dev); (void)hipDeviceGetAttribute(&cus, hipDeviceAttributeMultiprocessorCount, dev);
        (void)hipFuncSetAttribute((const void*)mk_fwd, hipFuncAttributeMaxDynamicSharedMemorySize, LDS_BYTES);
        (void)hipOccupancyMaxActiveBlocksPerMultiprocessor(&per_cu, (const void*)mk_fwd, NWAVES * 64, LDS_BYTES);
        (void)hipGetLastError();
        if (per_cu < 1) { fprintf(stderr, "kernel_launch: occupancy query says %d blocks/CU\n", per_cu); per_cu = 1; }
        grid = cus;
    }
    MKArgs ka{};
    for (int i = 0; i < 27; ++i) ka.in[i] = (const float*)d_in[i];
    ka.out = (float*)d_out; ka.ws = (unsigned char*)d_ws;
#if MK_PER_PHASE
    for (int p = 0; p < PH_COUNT; ++p) { MKArgs k2 = ka; k2.ph_lo = p; k2.ph_hi = p + 1; hipLaunchKernelGGL(mk_fwd, dim3(grid), dim3(NWAVES * 64), LDS_BYTES, stream, k2); }
#else
    ka.ph_lo = 0; ka.ph_hi = PH_COUNT;
    (void)hipMemsetAsync((char*)d_ws + WS_CTL, 0, 65536, stream);
    void* args[] = {&ka};
    hipError_t e = hipLaunchCooperativeKernel((const void*)mk_fwd, dim3(grid), dim3(NWAVES * 64), args, LDS_BYTES, stream);
    if (e != hipSuccess) fprintf(stderr, "kernel_launch: cooperative launch failed: %s (grid %d)\n", hipGetErrorString(e), grid);
#endif
}
```

```cpp
#include <hip/hip_runtime.h>
#include <hip/hip_cooperative_groups.h>
#include <cstdint>
#include <cstdio>

typedef unsigned short bf16_t;

constexpr int BATCH = 8, SEQ = 2048, DM = 1024, NTOK = BATCH * SEQ;
constexpr int MEML = 256, NMEM = BATCH * MEML;
constexpr int NU = 4096;
constexpr int U_HQ = 0, U_HI = 512, U_HG = 1024, U_HFF = 1536, U_HFB = 2048, U_DQ = 2560, U_DK = 3072, U_DV = 3584;
constexpr int NEXP = 16, CAP = 256, DFF = 2048, NGRP = BATCH * NEXP;
constexpr float ALPHA = 1.189207115002721f;
constexpr float LN_EPS = 1e-5f, RMS_EPS = 1e-6f;
constexpr float LAMBDA_INIT = 0.2f;

constexpr size_t MiB = 1u << 20;
constexpr size_t WS_CTL = 0;
constexpr size_t WS_ROPE = 1 * MiB;
constexpr size_t WS_LB = WS_ROPE + 256 * 1024;
constexpr size_t WS_AFF = 2 * MiB;
constexpr size_t WS_INV = 3 * MiB;
constexpr size_t WS_IDX = 4 * MiB;
constexpr size_t WS_GATE = 4 * MiB + 512 * 1024;
constexpr size_t WS_WIN = 5 * MiB;
constexpr size_t WS_WKV = 13 * MiB;
constexpr size_t WS_WMIX = 17 * MiB;
constexpr size_t WS_WQ = 19 * MiB;
constexpr size_t WS_WO = 21 * MiB;
constexpr size_t WS_WGU = 23 * MiB;
constexpr size_t WS_WD = 151 * MiB;
constexpr size_t WS_U = 215 * MiB;
constexpr size_t WS_XN = 343 * MiB;
constexpr size_t WS_MIX = 375 * MiB;
constexpr size_t WS_KV = 407 * MiB;
constexpr size_t WS_XS = 415 * MiB;
constexpr size_t WS_MEMB = 479 * MiB;
constexpr size_t WS_END = 483 * MiB;

__device__ __forceinline__ unsigned f2bf(float f) { unsigned u = __builtin_bit_cast(unsigned, f); return (u + 0x7fffu + ((u >> 16) & 1u)) >> 16; }
__device__ __forceinline__ float bf2f(bf16_t b) { return __builtin_bit_cast(float, (unsigned)b << 16); }
__device__ __forceinline__ float wave_sum(float v) {
#pragma unroll
    for (int o = 1; o < 64; o <<= 1) v += __shfl_xor(v, o);
    return v;
}
__device__ __forceinline__ float silu_f(float x) { return x / (1.f + expf(-x)); }
__device__ __forceinline__ float sigmoid_f(float x) { return 1.f / (1.f + expf(-x)); }

#define VB_LOOP(NT, nvb, vb, valid, tid, sub) \
    for (int _r = 0, _sub = (int)threadIdx.x / (NT), tid = (int)threadIdx.x % (NT), sub = _sub, _pr = (int)gridDim.x * (512 / (NT)), _nr = ((nvb) + _pr - 1) / _pr, vb = 0, valid = 0; \
         _r < _nr && ((vb = (_r * (int)gridDim.x + (int)blockIdx.x) * (512 / (NT)) + _sub), (valid = vb < (nvb)), true); ++_r)

__device__ __forceinline__ void sp_prep_small(const float* lb_logits, const float* lq1, const float* lk1, const float* lq2, const float* lk2, float* rope, float* lb) {
    for (int i = blockIdx.x * 512 + threadIdx.x; i < SEQ * 8; i += gridDim.x * 512) {
        const int t = i / 8, j = i % 8;
        const float inv = (float)(1.0 / pow(500000.0, (double)j / 8.0));
        const float ang = (float)t * inv;
        rope[t * 16 + j] = (float)cos((double)ang);
        rope[t * 16 + 8 + j] = (float)sin((double)ang);
        if (i < 1024) {
            const int d = i / 512, c = i % 512;
            const float l0 = lb_logits[d * 1024 + c], l1 = lb_logits[d * 1024 + 512 + c];
            const float m = fmaxf(l0, l1); const float e0 = expf(l0 - m), e1 = expf(l1 - m);
            lb[i] = e0 / (e0 + e1);
        }
        if (i == 0) {
            float s1 = 0.f, s2 = 0.f;
            for (int k = 0; k < 64; ++k) { s1 += lq1[k] * lk1[k]; s2 += lq2[k] * lk2[k]; }
            lb[1024] = expf(s1) - expf(s2) + LAMBDA_INIT;
        }
    }
}
__device__ __forceinline__ void sp_transpose(float* smem, const float* W, int K, int N, bf16_t* WT, int mode, long src_zs, long dst_zs, int nz) {
    const int nbx = N / 32, nby = K / 32, nvb = nbx * nby * nz;
    VB_LOOP(256, nvb, vb, valid, tid, sub) {
        float* t = smem + sub * (32 * 33);
        const int z = vb / (nbx * nby), rem = vb % (nbx * nby), by = rem / nbx, bxx = rem % nbx;
        const float* Wz = W + (long)z * src_zs; bf16_t* WTz = WT + (long)z * dst_zs;
        const int k0 = by * 32, n0 = bxx * 32, tx = tid & 31, ty = tid >> 5;
        if (valid) for (int i = ty; i < 32; i += 8) t[i * 33 + tx] = Wz[(long)(k0 + i) * N + n0 + tx];
        __syncthreads();
        if (valid) for (int i = ty; i < 32; i += 8) {
            const int n = n0 + i; long r = n;
            if (mode == 1) r = (long)(n / 128) * 256 + (n % 128);
            if (mode == 2) r = (long)(n / 128) * 256 + 128 + (n % 128);
            WTz[r * K + k0 + tx] = (bf16_t)f2bf(t[tx * 33 + i]);
        }
        __syncthreads();
    }
}
__device__ __forceinline__ void sp_cvt_bf16(const float* src, bf16_t* dst, long n) {
    for (long i = (long)blockIdx.x * 512 + threadIdx.x; i < n; i += (long)gridDim.x * 512) dst[i] = (bf16_t)f2bf(src[i]);
}

template <int MODE>
__device__ __forceinline__ void sp_ln_rows(const float* X, const float* g, const float* b, float* H, bf16_t* XN, const float* wr, float* AFF) {
    const int lane = threadIdx.x & 63;
    for (int row = blockIdx.x * 8 + (threadIdx.x >> 6); row < NTOK; row += gridDim.x * 8) {
        float4 v[4]; float s = 0.f;
#pragma unroll
        for (int j = 0; j < 4; ++j) {
            const long off = (long)row * DM + 4 * lane + 256 * j;
            v[j] = (MODE == 0) ? *(const float4*)(X + off) : *(const float4*)(H + off);
            s += (v[j].x + v[j].y) + (v[j].z + v[j].w);
        }
        const float mean = wave_sum(s) * (1.f / DM); float s2 = 0.f;
#pragma unroll
        for (int j = 0; j < 4; ++j) { v[j].x -= mean; v[j].y -= mean; v[j].z -= mean; v[j].w -= mean; s2 += (v[j].x * v[j].x + v[j].y * v[j].y) + (v[j].z * v[j].z + v[j].w * v[j].w); }
        const float rstd = 1.f / sqrtf(wave_sum(s2) * (1.f / DM) + LN_EPS);
#pragma unroll
        for (int j = 0; j < 4; ++j) {
            const int c = 4 * lane + 256 * j; const float4 gg = *(const float4*)(g + c), bb = *(const float4*)(b + c);
            v[j].x = v[j].x * rstd * gg.x + bb.x; v[j].y = v[j].y * rstd * gg.y + bb.y; v[j].z = v[j].z * rstd * gg.z + bb.z; v[j].w = v[j].w * rstd * gg.w + bb.w;
            *(float4*)(H + (long)row * DM + c) = v[j];
            uint2 o; o.x = f2bf(v[j].x) | (f2bf(v[j].y) << 16); o.y = f2bf(v[j].z) | (f2bf(v[j].w) << 16);
            *(uint2*)(XN + (long)row * DM + c) = o;
        }
        if (MODE == 2) {
            float acc[16];
#pragma unroll
            for (int e = 0; e < 16; ++e) acc[e] = 0.f;
#pragma unroll
            for (int j = 0; j < 4; ++j) {
                const float vv[4] = {v[j].x, v[j].y, v[j].z, v[j].w};
#pragma unroll
                for (int i = 0; i < 4; ++i) {
                    const float4* w4 = (const float4*)(wr + (long)(4 * lane + 256 * j + i) * 16);
#pragma unroll
                    for (int q = 0; q < 4; ++q) { const float4 w = w4[q]; acc[4 * q] += vv[i] * w.x; acc[4 * q + 1] += vv[i] * w.y; acc[4 * q + 2] += vv[i] * w.z; acc[4 * q + 3] += vv[i] * w.w; }
                }
                __builtin_amdgcn_sched_barrier(0);
            }
            float m = -INFINITY;
#pragma unroll
            for (int e = 0; e < 16; ++e) { acc[e] = wave_sum(acc[e]); m = fmaxf(m, acc[e]); }
            float sum = 0.f;
#pragma unroll
            for (int e = 0; e < 16; ++e) { acc[e] = expf(acc[e] - m); sum += acc[e]; }
            if (lane == 0) {
#pragma unroll
                for (int q = 0; q < 4; ++q) *(float4*)(AFF + (long)row * 16 + 4 * q) = make_float4(acc[4 * q] / sum, acc[4 * q + 1] / sum, acc[4 * q + 2] / sum, acc[4 * q + 3] / sum);
            }
        }
    }
}

__device__ __forceinline__ void sp_gemm(float* smem, const bf16_t* A0, long sa_z, int lda, const bf16_t* B0, long sb_z, long sbn, long sbk, float* C0, long sc_z, int ldc, int M, int N, int K, int Z) {
    const int nbx = N / 64, nby = M / 64, nvb = nbx * nby * Z;
    VB_LOOP(256, nvb, vb, valid, tid, sub) {
        float* As = smem + sub * (2 * 16 * 65); float* Bs = As + 16 * 65;
        const int z = vb / (nbx * nby), rem = vb % (nbx * nby), by = rem / nbx, bxx = rem % nbx;
        const bf16_t* A = A0 + (long)z * sa_z; const bf16_t* B = B0 + (long)z * sb_z; float* C = C0 + (long)z * sc_z;
        const int m0 = by * 64, n0 = bxx * 64, tx = tid & 15, ty = tid >> 4;
        float acc[4][4];
#pragma unroll
        for (int i = 0; i < 4; ++i)
#pragma unroll
            for (int j = 0; j < 4; ++j) acc[i][j] = 0.f;
        for (int k0 = 0; k0 < K; k0 += 16) {
            if (valid) {
                for (int i = tid; i < 1024; i += 256) { const int m = i >> 4, k = i & 15; As[k * 65 + m] = bf2f(A[(long)(m0 + m) * lda + k0 + k]); }
                for (int i = tid; i < 1024; i += 256) { const int n = i >> 4, k = i & 15; Bs[k * 65 + n] = bf2f(B[(long)(n0 + n) * sbn + (long)(k0 + k) * sbk]); }
            }
            __syncthreads();
#pragma unroll
            for (int k = 0; k < 16; ++k) {
                float a[4], bb[4];
#pragma unroll
                for (int i = 0; i < 4; ++i) { a[i] = As[k * 65 + ty * 4 + i]; bb[i] = Bs[k * 65 + tx * 4 + i]; }
#pragma unroll
                for (int i = 0; i < 4; ++i)
#pragma unroll
                    for (int j = 0; j < 4; ++j) acc[i][j] += a[i] * bb[j];
            }
            __syncthreads();
        }
        if (valid) {
#pragma unroll
            for (int i = 0; i < 4; ++i)
#pragma unroll
                for (int j = 0; j < 4; ++j) C[(long)(m0 + ty * 4 + i) * ldc + n0 + tx * 4 + j] = acc[i][j];
        }
    }
}
__device__ __forceinline__ void sp_cvt2d(const float* SC, int ldsc, bf16_t* dst, int ldd, int rows, int cols) {
    const long n = (long)rows * cols;
    for (long i = (long)blockIdx.x * 512 + threadIdx.x; i < n; i += (long)gridDim.x * 512) { const int r = (int)(i / cols), c = (int)(i % cols); dst[(long)r * ldd + c] = (bf16_t)f2bf(SC[(long)r * ldsc + c]); }
}

__device__ __forceinline__ void sp_hgrn(float* smem, const bf16_t* U, const float* LB, float* OSC) {
    VB_LOOP(128, 8 * 4 * 16, vb, valid, k, sub) {
        float* red = smem + sub * 32;
        const int dvs = vb & 7, h = (vb >> 3) & 3, bz = vb >> 5, b = bz >> 1, dir = bz & 1;
        float S[16];
#pragma unroll
        for (int j = 0; j < 16; ++j) S[j] = 0.f;
        const float lbv = valid ? LB[dir * 512 + h * 128 + k] : 0.5f;
        for (int step = 0; step < SEQ; ++step) {
            const int t = dir ? (SEQ - 1 - step) : step; const long row = (long)(valid ? b : 0) * SEQ + t;
            const bf16_t* ur = U + row * NU;
            const float qv = bf2f(ur[U_HQ + h * 128 + k]);
            const float uf = bf2f(ur[(dir ? U_HFB : U_HFF) + h * 128 + k]);
            const float f = lbv + (1.f - lbv) * sigmoid_f(uf), kk = 1.f - f;
            float part[16];
#pragma unroll
            for (int j = 0; j < 16; ++j) { const float vv = bf2f(ur[U_HI + h * 128 + dvs * 16 + j]); S[j] = f * S[j] + kk * vv; part[j] = wave_sum(S[j] * qv); }
            if ((k & 63) == 0) {
#pragma unroll
                for (int j = 0; j < 16; ++j) red[(k >> 6) * 16 + j] = part[j];
            }
            __syncthreads();
            if (valid && k < 16) OSC[((long)dir * NTOK + row) * 512 + h * 128 + dvs * 16 + k] = red[k] + red[16 + k];
            __syncthreads();
        }
    }
}
__device__ __forceinline__ void sp_hgrn_combine(const float* OSC, const bf16_t* U, const float* ng, bf16_t* MIX) {
    const int lane = threadIdx.x & 63;
    for (long w = (long)blockIdx.x * 8 + (threadIdx.x >> 6); w < (long)NTOK * 4; w += (long)gridDim.x * 8) {
        const long row = w >> 2; const int h = (int)(w & 3);
        float o[2]; float ss = 0.f;
#pragma unroll
        for (int i = 0; i < 2; ++i) { const int d = lane + 64 * i; o[i] = OSC[row * 512 + h * 128 + d] + OSC[((long)NTOK + row) * 512 + h * 128 + d]; ss += o[i] * o[i]; }
        const float r = 1.f / sqrtf(wave_sum(ss) * (1.f / 128.f) + RMS_EPS);
#pragma unroll
        for (int i = 0; i < 2; ++i) { const int d = lane + 64 * i; const float y = o[i] * r * ng[h * 128 + d] * bf2f(U[row * NU + U_HG + h * 128 + d]); MIX[row * DM + h * 128 + d] = (bf16_t)f2bf(y); }
    }
}

__device__ __forceinline__ void sp_dattn(float* smem, const bf16_t* U, float* OSC) {
    VB_LOOP(256, 32 * 8 * 8, vb, valid, tid, sub) {
        float* Ks = smem + sub * (16 * 64 + 16 * 128); float* Vs = Ks + 16 * 64;
        const int qb = vb & 31, g = (vb >> 5) & 7, b = valid ? (vb >> 8) : 0, h = g >> 1, r = tid & 63, qt = tid >> 6;
        const long row = (long)b * SEQ + qb * 64 + r;
        float q[64], o[32];
#pragma unroll
        for (int d = 0; d < 64; ++d) q[d] = bf2f(U[row * NU + U_DQ + g * 64 + d]);
#pragma unroll
        for (int d = 0; d < 32; ++d) o[d] = 0.f;
        float m = -INFINITY, l = 0.f;
        for (int k0 = 0; k0 < SEQ; k0 += 16) {
            for (int i = tid; i < 16 * 64; i += 256) { const int kk = i >> 6, d = i & 63; Ks[kk * 64 + d] = bf2f(U[((long)b * SEQ + k0 + kk) * NU + U_DK + g * 64 + d]); }
            for (int i = tid; i < 16 * 128; i += 256) { const int kk = i >> 7, d = i & 127; Vs[kk * 128 + d] = bf2f(U[((long)b * SEQ + k0 + kk) * NU + U_DV + h * 128 + d]); }
            __syncthreads();
            float s[16]; float tm = m;
#pragma unroll
            for (int kk = 0; kk < 16; ++kk) { float a = 0.f;
#pragma unroll
                for (int d = 0; d < 64; ++d) a += q[d] * Ks[kk * 64 + d];
                s[kk] = a; tm = fmaxf(tm, a); }
            const float corr = exp2f(m - tm); m = tm; l *= corr;
#pragma unroll
            for (int d = 0; d < 32; ++d) o[d] *= corr;
#pragma unroll
            for (int kk = 0; kk < 16; ++kk) { const float p = exp2f(s[kk] - m); l += p;
#pragma unroll
                for (int d = 0; d < 32; ++d) o[d] += p * Vs[kk * 128 + qt * 32 + d]; }
            __syncthreads();
        }
        const float il = 1.f / l;
        if (valid) {
#pragma unroll
            for (int d = 0; d < 32; ++d) OSC[(row * 8 + g) * 128 + qt * 32 + d] = o[d] * il;
        }
    }
}
__device__ __forceinline__ void sp_dattn_combine(const float* OSC, const float* lamp, const float* sg, bf16_t* MIX) {
    const int lane = threadIdx.x & 63; const float lam = lamp[0];
    for (long w = (long)blockIdx.x * 8 + (threadIdx.x >> 6); w < (long)NTOK * 4; w += (long)gridDim.x * 8) {
        const long row = w >> 2; const int h = (int)(w & 3);
        float o[2]; float ss = 0.f;
#pragma unroll
        for (int i = 0; i < 2; ++i) { const int d = lane + 64 * i; o[i] = OSC[(row * 8 + 2 * h) * 128 + d] - lam * OSC[(row * 8 + 2 * h + 1) * 128 + d]; ss += o[i] * o[i]; }
        const float r = 1.f / sqrtf(wave_sum(ss) * (1.f / 128.f) + RMS_EPS);
#pragma unroll
        for (int i = 0; i < 2; ++i) { const int d = lane + 64 * i; MIX[row * DM + 512 + h * 128 + d] = (bf16_t)f2bf(o[i] * r * sg[d] * (1.f - LAMBDA_INIT)); }
    }
}

__device__ __forceinline__ void sp_softmax256(const float* S, bf16_t* P, long nrows) {
    const int lane = threadIdx.x & 63;
    for (long row = (long)blockIdx.x * 8 + (threadIdx.x >> 6); row < nrows; row += (long)gridDim.x * 8) {
        float4 v = *(const float4*)(S + row * 256 + 4 * lane);
        float m = fmaxf(fmaxf(v.x, v.y), fmaxf(v.z, v.w));
#pragma unroll
        for (int o = 1; o < 64; o <<= 1) m = fmaxf(m, __shfl_xor(m, o));
        v.x = exp2f(v.x - m); v.y = exp2f(v.y - m); v.z = exp2f(v.z - m); v.w = exp2f(v.w - m);
        const float il = 1.f / wave_sum((v.x + v.y) + (v.z + v.w));
        uint2 o; o.x = f2bf(v.x * il) | (f2bf(v.y * il) << 16); o.y = f2bf(v.z * il) | (f2bf(v.w * il) << 16);
        *(uint2*)(P + row * 256 + 4 * lane) = o;
    }
}

__device__ __forceinline__ void sp_topk_gather(float* smem, const float* AFF, const bf16_t* XN, int* IDX, float* GATE, int* INV, bf16_t* XS) {
    VB_LOOP(256, NGRP, grp, valid, tid, sub) {
        float* a = smem + sub * (SEQ + CAP); int* sel = (int*)(a + SEQ);
        const int b = valid ? (grp >> 4) : 0, e = grp & 15;
        for (int t = tid; t < SEQ; t += 256) a[t] = AFF[((long)b * SEQ + t) * 16 + e];
        __syncthreads();
        if (valid) for (int t = tid; t < SEQ; t += 256) {
            const float mine = a[t]; int rank = 0;
            for (int u = 0; u < SEQ; ++u) { const float x = a[u]; rank += (x > mine || (x == mine && u < t)) ? 1 : 0; }
            if (rank < CAP) { sel[rank] = t; IDX[grp * CAP + rank] = t; GATE[grp * CAP + rank] = mine; INV[((long)b * SEQ + t) * 16 + e] = rank; }
            else INV[((long)b * SEQ + t) * 16 + e] = -1;
        }
        __syncthreads();
        const int lane = tid & 63, wv = tid >> 6;
        if (valid) for (int r = wv; r < CAP; r += 4) {
            const uint4* src = (const uint4*)(XN + ((long)b * SEQ + sel[r]) * DM); uint4* dst = (uint4*)(XS + ((long)grp * CAP + r) * DM);
            dst[lane] = src[lane]; dst[lane + 64] = src[lane + 64];
        }
        __syncthreads();
    }
}

__device__ __forceinline__ void sp_final(float* H, const bf16_t* Y, const int* INV, const float* g, const float* b) {
    const int lane = threadIdx.x & 63;
    for (long row = (long)blockIdx.x * 8 + (threadIdx.x >> 6); row < NTOK; row += (long)gridDim.x * 8) {
        const int bt = (int)(row / SEQ);
        float4 v[4];
#pragma unroll
        for (int j = 0; j < 4; ++j) { const float4 h = *(const float4*)(H + row * DM + 4 * lane + 256 * j); v[j] = make_float4(ALPHA * h.x, ALPHA * h.y, ALPHA * h.z, ALPHA * h.w); }
        for (int e = 0; e < 16; ++e) {
            const int slot = INV[row * 16 + e];
            if (slot >= 0) {
                const bf16_t* yr = Y + ((long)(bt * 16 + e) * CAP + slot) * DM;
#pragma unroll
                for (int j = 0; j < 4; ++j) { const uint2 p = *(const uint2*)(yr + 4 * lane + 256 * j);
                    v[j].x += bf2f((bf16_t)(p.x & 0xffff)); v[j].y += bf2f((bf16_t)(p.x >> 16)); v[j].z += bf2f((bf16_t)(p.y & 0xffff)); v[j].w += bf2f((bf16_t)(p.y >> 16)); }
            }
        }
        float s = 0.f;
#pragma unroll
        for (int j = 0; j < 4; ++j) s += (v[j].x + v[j].y) + (v[j].z + v[j].w);
        const float mean = wave_sum(s) * (1.f / DM); float s2 = 0.f;
#pragma unroll
        for (int j = 0; j < 4; ++j) { v[j].x -= mean; v[j].y -= mean; v[j].z -= mean; v[j].w -= mean; s2 += (v[j].x * v[j].x + v[j].y * v[j].y) + (v[j].z * v[j].z + v[j].w * v[j].w); }
        const float rstd = 1.f / sqrtf(wave_sum(s2) * (1.f / DM) + LN_EPS);
#pragma unroll
        for (int j = 0; j < 4; ++j) {
            const int c = 4 * lane + 256 * j; const float4 gg = *(const float4*)(g + c), bb = *(const float4*)(b + c);
            float4 o; o.x = v[j].x * rstd * gg.x + bb.x; o.y = v[j].y * rstd * gg.y + bb.y; o.z = v[j].z * rstd * gg.z + bb.z; o.w = v[j].w * rstd * gg.w + bb.w;
            *(float4*)(H + row * DM + c) = o;
        }
    }
}

__device__ __forceinline__ void tp_item(const float* W, int K, int N, bf16_t* WT, long rbase, int k0, int n0, float* scr, int lane) {
#pragma unroll 8
    for (int i = 0; i < 32; ++i) { const int kk = 2 * i + (lane >> 5); scr[kk * 33 + (lane & 31)] = W[(size_t)(k0 + kk) * N + n0 + (lane & 31)]; }
    asm volatile("s_waitcnt lgkmcnt(0)" ::: "memory");
    const int c = lane & 7;
#pragma unroll
    for (int j = 0; j < 4; ++j) {
        const int n = (lane >> 3) + 8 * j; const float* s = scr + (8 * c) * 33 + n;
        uint4 o; o.x = f2bf(s[0]) | (f2bf(s[33]) << 16); o.y = f2bf(s[2 * 33]) | (f2bf(s[3 * 33]) << 16); o.z = f2bf(s[4 * 33]) | (f2bf(s[5 * 33]) << 16); o.w = f2bf(s[6 * 33]) | (f2bf(s[7 * 33]) << 16);
        *(uint4*)(WT + (size_t)(rbase + n) * K + k0 + 8 * c) = o;
    }
    asm volatile("s_waitcnt lgkmcnt(0)" ::: "memory");
}
__device__ __forceinline__ void tp_all(float* smem, const float* const* in, unsigned char* ws, int vcu, int G) {
    const int lane = threadIdx.x & 63, wave = threadIdx.x >> 6;
    float* scr = smem + wave * 4096;
    constexpr int I_IN = (DM / 64) * (NU / 32), I_SQ = (DM / 64) * (DM / 32), I_GU = (DM / 64) * (DFF / 32), I_D = (DFF / 64) * (DM / 32);
    constexpr int NIT = I_IN + 5 * I_SQ + NEXP * (2 * I_GU + I_D);
    for (int it = vcu * 8 + wave; it < NIT; it += G * 8) {
        int r = it;
        if (r < I_IN) { const int nb = NU / 32; tp_item(in[4], DM, NU, (bf16_t*)(ws + WS_WIN), 32 * (r % nb), 64 * (r / nb), 32 * (r % nb), scr, lane); continue; }
        r -= I_IN;
        if (r < 5 * I_SQ) {
            const int which = r / I_SQ, q = r % I_SQ, nb = DM / 32; const int k0 = 64 * (q / nb), n0 = 32 * (q % nb);
            const float* W = which == 0 ? in[16] : which == 1 ? in[17] : which == 2 ? in[12] : which == 3 ? in[15] : in[18];
            bf16_t* WT = which == 0 ? (bf16_t*)(ws + WS_WKV) : which == 1 ? (bf16_t*)(ws + WS_WKV) + (size_t)DM * DM : which == 2 ? (bf16_t*)(ws + WS_WMIX) : which == 3 ? (bf16_t*)(ws + WS_WQ) : (bf16_t*)(ws + WS_WO);
            tp_item(W, DM, DM, WT, n0, k0, n0, scr, lane); continue;
        }
        r -= 5 * I_SQ;
        const int e = r / (2 * I_GU + I_D); int q = r % (2 * I_GU + I_D);
        if (q < 2 * I_GU) {
            const int up = q / I_GU; q %= I_GU; const int nb = DFF / 32; const int k0 = 64 * (q / nb), n0 = 32 * (q % nb);
            tp_item((up ? in[23] : in[22]) + (size_t)e * DM * DFF, DM, DFF, (bf16_t*)(ws + WS_WGU) + (size_t)e * 2 * DFF * DM, (long)(n0 / 128) * 256 + (n0 % 128) + 128 * up, k0, n0, scr, lane);
        } else {
            q -= 2 * I_GU; const int nb = DM / 32; const int k0 = 64 * (q / nb), n0 = 32 * (q % nb);
            tp_item(in[24] + (size_t)e * DFF * DM, DFF, DM, (bf16_t*)(ws + WS_WD) + (size_t)e * DM * DFF, n0, k0, n0, scr, lane);
        }
    }
}

__device__ __forceinline__ void sp_topk2(float* smem, const float* AFF, const bf16_t* XN, int* IDX, float* GATE, int* INV, bf16_t* XS) {
    const int tid = threadIdx.x, lane = tid & 63, wave = tid >> 6;
    int* cnt = (int*)smem;
    int* wtot = (int*)smem + 16;
    int* sel = (int*)smem + 64;
    const unsigned long long lt_mask = (lane == 0) ? 0ull : (~0ull >> (64 - lane));
    for (int item = blockIdx.x; item < NGRP * 2; item += gridDim.x) {
        const int grp = item >> 1, half = item & 1, b = grp >> 4, e = grp & 15;
        unsigned key[4];
#pragma unroll
        for (int j = 0; j < 4; ++j) key[j] = __builtin_bit_cast(unsigned, AFF[((size_t)b * SEQ + 512 * j + tid) * 16 + e]);
        unsigned T = 0u;
        for (int bit = 31; bit >= 0; --bit) {
            const unsigned cand = T | (1u << bit);
            int c = 0;
#pragma unroll
            for (int j = 0; j < 4; ++j) c += __popcll(__ballot(key[j] >= cand));
            int* cb = cnt + ((bit & 1) << 3);
            if (lane == 0) cb[wave] = c;
            __syncthreads();
            int tot = 0;
#pragma unroll
            for (int w = 0; w < 8; ++w) tot += cb[w];
            if (tot >= CAP) T = cand;
        }
        unsigned long long bt[4], bg[4];
#pragma unroll
        for (int j = 0; j < 4; ++j) { bt[j] = __ballot(key[j] == T); bg[j] = __ballot(key[j] > T); }
        __syncthreads();
        if (lane == 0) {
#pragma unroll
            for (int j = 0; j < 4; ++j) { wtot[j * 8 + wave] = __popcll(bt[j]); wtot[32 + j * 8 + wave] = __popcll(bg[j]); }
        }
        __syncthreads();
        int n_gt = 0;
#pragma unroll
        for (int q = 0; q < 32; ++q) n_gt += wtot[32 + q];
        const int need = CAP - n_gt;
        unsigned long long bs[4];
#pragma unroll
        for (int j = 0; j < 4; ++j) {
            int tpre = 0;
            for (int q = 0; q < j * 8 + wave; ++q) tpre += wtot[q];
            const int trank = tpre + __popcll(bt[j] & lt_mask);
            const bool s = (key[j] > T) || (key[j] == T && trank < need);
            bs[j] = __ballot(s);
        }
        __syncthreads();
        if (lane == 0) {
#pragma unroll
            for (int j = 0; j < 4; ++j) wtot[j * 8 + wave] = __popcll(bs[j]);
        }
        __syncthreads();
#pragma unroll
        for (int j = 0; j < 4; ++j) {
            int spre = 0;
            for (int q = 0; q < j * 8 + wave; ++q) spre += wtot[q];
            const int slot = spre + __popcll(bs[j] & lt_mask);
            const bool s = (bs[j] >> lane) & 1ull;
            const int t = 512 * j + tid;
            if (s) sel[slot] = t;
            if (half == 0) {
                if (s) { IDX[grp * CAP + slot] = t; GATE[grp * CAP + slot] = __builtin_bit_cast(float, key[j]); }
                INV[((size_t)b * SEQ + t) * 16 + e] = s ? slot : -1;
            }
        }
        __syncthreads();
        for (int r = half * 128 + wave; r < half * 128 + 128; r += 8) {
            const uint4* src = (const uint4*)(XN + ((size_t)b * SEQ + sel[r]) * DM); uint4* dst = (uint4*)(XS + ((size_t)grp * CAP + r) * DM);
            dst[lane] = src[lane]; dst[lane + 64] = src[lane + 64];
        }
        __syncthreads();
    }
}
namespace pg8 {
#define PG8_LAS __attribute__((address_space(3)))
typedef unsigned short bf16_t;
typedef short bf16x8 __attribute__((ext_vector_type(8)));
typedef float f32x4 __attribute__((ext_vector_type(4)));
typedef unsigned u32x4 __attribute__((ext_vector_type(4)));
constexpr int BM = 256, BK = 64, HALF = 128, HTB = HALF * BK * 2  , STAGE_BYTES = 8 * HTB, NXCD = 8, WGM = 8;

__host__ __device__ __forceinline__ int lds_byte(int r, int c) { const int st = (r >> 4) * 2 + (c >> 5), rr = r & 15, cc = c & 31, ob = rr * 64 + cc * 2; return st * 1024 + (ob ^ (((ob >> 9) & 1) << 5)); }
__host__ __device__ __forceinline__ void stage_rc(int b, int& R, int& C) { const int st = b / 1024, sb = b % 1024, swz = sb ^ (((sb >> 9) & 1) << 5); R = (st >> 1) * 16 + swz / 64; C = (st & 1) * 32 + (swz % 64) / 2; }
__host__ __device__ __forceinline__ int perm32(int rho) { const int n = rho >> 4, i = rho & 15; return 8 * (i >> 2) + 4 * n + (i & 3); }

struct Unit { int pm, pn; };
struct Gemm { const bf16_t* A; const bf16_t* Bt; int M, N, K; };

struct StaticOrder {
    int nM, nN, nwg, G, c;
    __host__ __device__ void init(int M, int N, int G_, int c_) { nM = M / BM; nN = N / BM; nwg = nM * nN; G = G_; c = c_; }
    __host__ __device__ bool next(int i, Unit& u) const {
        const long L = (long)i * G + c; if (L >= nwg) return false;
        int wgid = (int)L; { const int q = nwg / NXCD, r = nwg % NXCD, xcd = wgid % NXCD, off = wgid / NXCD; wgid = (xcd < r ? xcd * (q + 1) : r * (q + 1) + (xcd - r) * q) + off; }
        const int nig = WGM * nN, gid = wgid / nig, fm = gid * WGM, gsz = (nM - fm) < WGM ? (nM - fm) : WGM;
        u.pm = fm + ((wgid % nig) % gsz); u.pn = (wgid % nig) / gsz; return true;
    }
    __device__ __forceinline__ void a_ready(const Unit&) const {}
    __device__ __forceinline__ void done(const Unit&) const {}
};

__device__ __forceinline__ unsigned cvt_pk_bf16(float lo, float hi) { unsigned r; asm volatile("v_cvt_pk_bf16_f32 %0, %1, %2" : "=v"(r) : "v"(lo), "v"(hi)); return r; }
typedef float f32x2 __attribute__((ext_vector_type(2)));
typedef unsigned u32x4 __attribute__((ext_vector_type(4)));
constexpr float QSCALE_DA = 0.125f * 1.4426950408889634f;
constexpr float QSCALE_XA = 0.0625f * 1.4426950408889634f;
__device__ __forceinline__ float silu_fast(float x) { return x * __builtin_amdgcn_rcpf(1.f + __builtin_amdgcn_exp2f(-1.4426950408889634f * x)); }

struct EpiStore {
    static constexpr bool PERM = true, AFTER_DRAIN = false;
    bf16_t* O; int ldc; float scale; int mode; const float* rope;
    __device__ __forceinline__ void operator()(const f32x4 (&acc)[2][2][4][2], const Unit& u, int wr, int wc, int fr, int fq) const {
        const int row0 = u.pm * BM + wr * 64 + fr, col0 = u.pn * BM + wc * 32 + 8 * fq;
        int op = 0; float sc = scale;
        if (mode == 1) { const int seg = u.pn >> 1; op = (seg == 0 || seg == 2) ? 1 : (seg == 5 ? 2 : (seg == 6 ? 3 : 0)); if (seg == 5) sc = QSCALE_DA; }
        const bool do_rope = (op >= 2) && !(wc & 1);
#pragma unroll
        for (int ai = 0; ai < 2; ++ai)
#pragma unroll
            for (int m = 0; m < 4; ++m) {
                const int row = row0 + ai * HALF + m * 16; bf16_t* rowp = O + (size_t)row * ldc + col0;
                f32x4 c0 = {1.f, 1.f, 1.f, 1.f}, c1 = c0, s0 = {0.f, 0.f, 0.f, 0.f}, s1 = s0;
                if (do_rope) { const float* rp = rope + (row & 2047) * 16; c0 = *(const f32x4*)rp; c1 = *(const f32x4*)(rp + 4); s0 = *(const f32x4*)(rp + 8); s1 = *(const f32x4*)(rp + 12);
                    if (fq == 0) { s0 = -s0; s1 = -s1; } else if (fq >= 2) { c0 = (f32x4){1.f, 1.f, 1.f, 1.f}; c1 = c0; s0 = (f32x4){0.f, 0.f, 0.f, 0.f}; s1 = s0; } }
#pragma unroll
                for (int bj = 0; bj < 2; ++bj) {
                    f32x4 v0 = acc[ai][bj][m][0], v1 = acc[ai][bj][m][1];
                    if (op == 1) {
#pragma unroll
                        for (int j = 0; j < 4; ++j) { v0[j] = silu_fast(v0[j]); v1[j] = silu_fast(v1[j]); }
                    }
                    if (do_rope) {
                        f32x4 p0, p1;
#pragma unroll
                        for (int j = 0; j < 4; ++j) { p0[j] = __shfl_xor(v0[j], 16); p1[j] = __shfl_xor(v1[j], 16); }
                        v0 = v0 * c0 + p0 * s0; v1 = v1 * c1 + p1 * s1;
                    }
                    v0 = v0 * sc; v1 = v1 * sc;
                    u32x4 w; w.x = cvt_pk_bf16(v0[0], v0[1]); w.y = cvt_pk_bf16(v0[2], v0[3]); w.z = cvt_pk_bf16(v1[0], v1[1]); w.w = cvt_pk_bf16(v1[2], v1[3]);
                    *(u32x4*)(rowp + bj * HALF) = w;
                }
            }
    }
};
struct EpiResid {
    static constexpr bool PERM = false, AFTER_DRAIN = false;
    float* H; float alpha;
    __device__ __forceinline__ void operator()(const f32x4 (&acc)[2][2][4][2], const Unit& u, int wr, int wc, int fr, int fq) const {
        const int row0 = u.pm * BM + wr * 64 + fr, col0 = u.pn * BM + wc * 32 + 4 * fq;
#pragma unroll
        for (int ai = 0; ai < 2; ++ai)
#pragma unroll
            for (int m = 0; m < 4; ++m) { float* rowp = H + (size_t)(row0 + ai * HALF + m * 16) * 1024 + col0;
#pragma unroll
                for (int bj = 0; bj < 2; ++bj)
#pragma unroll
                    for (int n = 0; n < 2; ++n) { f32x4* p = (f32x4*)(rowp + bj * HALF + n * 16); const f32x4 h = *p; *p = h * alpha + acc[ai][bj][m][n]; } }
    }
};
struct EpiSwiglu {
    static constexpr bool PERM = true, AFTER_DRAIN = false;
    bf16_t* ACT;
    __device__ __forceinline__ void operator()(const f32x4 (&acc)[2][2][4][2], const Unit& u, int wr, int wc, int fr, int fq) const {
        const int row0 = u.pm * BM + wr * 64 + fr, col0 = (u.pn & 15) * 128 + wc * 32 + 8 * fq;
#pragma unroll
        for (int ai = 0; ai < 2; ++ai)
#pragma unroll
            for (int m = 0; m < 4; ++m) {
                f32x4 v0 = acc[ai][0][m][0], v1 = acc[ai][0][m][1]; const f32x4 u0 = acc[ai][1][m][0], u1 = acc[ai][1][m][1];
#pragma unroll
                for (int j = 0; j < 4; ++j) { v0[j] = silu_fast(v0[j]) * u0[j]; v1[j] = silu_fast(v1[j]) * u1[j]; }
                u32x4 w; w.x = cvt_pk_bf16(v0[0], v0[1]); w.y = cvt_pk_bf16(v0[2], v0[3]); w.z = cvt_pk_bf16(v1[0], v1[1]); w.w = cvt_pk_bf16(v1[2], v1[3]);
                *(u32x4*)(ACT + (size_t)(row0 + ai * HALF + m * 16) * 2048 + col0) = w;
            }
    }
};
struct EpiYGate {
    static constexpr bool PERM = true, AFTER_DRAIN = false;
    bf16_t* Y; const float* GATE;
    __device__ __forceinline__ void operator()(const f32x4 (&acc)[2][2][4][2], const Unit& u, int wr, int wc, int fr, int fq) const {
        const int row0 = u.pm * BM + wr * 64 + fr, col0 = (u.pn & 3) * BM + wc * 32 + 8 * fq;
#pragma unroll
        for (int ai = 0; ai < 2; ++ai)
#pragma unroll
            for (int m = 0; m < 4; ++m) { const int row = row0 + ai * HALF + m * 16; const float gt = GATE[row]; bf16_t* rowp = Y + (size_t)row * 1024 + col0;
#pragma unroll
                for (int bj = 0; bj < 2; ++bj) { const f32x4 v0 = acc[ai][bj][m][0] * gt, v1 = acc[ai][bj][m][1] * gt;
                    u32x4 w; w.x = cvt_pk_bf16(v0[0], v0[1]); w.y = cvt_pk_bf16(v0[2], v0[3]); w.z = cvt_pk_bf16(v1[0], v1[1]); w.w = cvt_pk_bf16(v1[2], v1[3]);
                    *(u32x4*)(rowp + bj * HALF) = w; } }
    }
};
template <int WHICH> struct MoeOrder {
    int G, c;
    __device__ bool next(int i, Unit& u) const {
        constexpr int NWG = WHICH == 1 ? 2048 : 512;
        const int L = i * G + c; if (L >= NWG) return false;
        const int Ux = (G % 8 == 0 && NWG % 8 == 0) ? (L % 8) * (NWG / 8) + L / 8 : L;
        if (WHICH == 1) { const int e = Ux >> 7, jg = (Ux & 127) >> 5, b = (Ux & 31) >> 2, jj = Ux & 3; u.pm = b * 16 + e; u.pn = e * 16 + jg * 4 + jj; }
        else { const int e = Ux >> 5, b = (Ux & 31) >> 2, j = Ux & 3; u.pm = b * 16 + e; u.pn = e * 4 + j; }
        return true;
    }
    __device__ __forceinline__ void a_ready(const Unit&) const {}
    __device__ __forceinline__ void done(const Unit&) const {}
};
template <class Epi, class Sched, bool ALIGN_EPI = false, bool SP2 = false>
__device__ __forceinline__ void gemm_phase(PG8_LAS unsigned char* lds, const Gemm g, const Sched& S, const Epi& E) {
    const int tid = threadIdx.x, wid = __builtin_amdgcn_readfirstlane(tid >> 6), lane = tid & 63, wr = wid >> 2, wc = wid & 3, fr = lane & 15, fq = lane >> 4;
    const int K = g.K, nt = K / BK;
    unsigned voffA[2], voffB[2];
#pragma unroll
    for (int i = 0; i < 2; ++i) { int R, C; stage_rc(tid * 16 + i * 8192, R, C); const int Rb = Epi::PERM ? ((R & ~31) + perm32(R & 31)) : R;
        voffA[i] = (unsigned)(R * K + C) * 2u; voffB[i] = (unsigned)(Rb * K + C) * 2u; }
    const size_t kstep = (size_t)(BK * 2);
    const size_t hstep = (size_t)HALF * K * 2;
    const size_t tstep = 2 * hstep;
    const unsigned ldsw = (unsigned)wid * 1024u;
    const int aoff = lds_byte(wr * 64 + fr, fq * 8), boff = lds_byte(wc * 32 + fr, fq * 8);
#define PG8_SA(b, h) (((b) * 2 + (h)) * HTB)
#define PG8_SB(b, h) ((4 + (b) * 2 + (h)) * HTB)
#define PG8_STAGE(bufoff, gbase, voff) do { _Pragma("unroll") for (int _i = 0; _i < 2; ++_i) \
        __builtin_amdgcn_global_load_lds((const unsigned*)((const char*)(gbase) + (voff)[_i]), (PG8_LAS unsigned*)(lds + (bufoff) + ldsw + _i * 8192), 16, 0, 0); } while (0)
#define PG8_LDA(dst, b, h) do { _Pragma("unroll") for (int m = 0; m < 4; ++m) _Pragma("unroll") for (int k = 0; k < 2; ++k) dst[m][k] = *(const PG8_LAS bf16x8*)(lds + PG8_SA(b, h) + aoff + m * 2048 + k * 1024); } while (0)
#define PG8_LDB(dst, b, h) do { _Pragma("unroll") for (int n = 0; n < 2; ++n) _Pragma("unroll") for (int k = 0; k < 2; ++k) dst[n][k] = *(const PG8_LAS bf16x8*)(lds + PG8_SB(b, h) + boff + n * 2048 + k * 1024); } while (0)
#define PG8_MMA(ai, bj, At, Bt) do { __builtin_amdgcn_s_setprio(1); _Pragma("unroll") for (int m = 0; m < 4; ++m) _Pragma("unroll") for (int n = 0; n < 2; ++n) _Pragma("unroll") for (int k = 0; k < 2; ++k) \
        acc[ai][bj][m][n] = __builtin_amdgcn_mfma_f32_16x16x32_bf16(Bt[n][k], At[m][k], acc[ai][bj][m][n], 0, 0, 0); __builtin_amdgcn_s_setprio(0); } while (0)
#define PG8_WAIT_V(n) asm volatile("s_waitcnt vmcnt(" #n ")" ::: "memory")
#define PG8_WAIT_L(n) asm volatile("s_waitcnt lgkmcnt(" #n ")" ::: "memory")
#define PG8_BAR __builtin_amdgcn_s_barrier()
#define PG8_SCHED __builtin_amdgcn_sched_barrier(0)
    Unit cur, nxt; int ui = 0;
    if (!S.next(0, cur)) return;
    f32x4 acc[2][2][4][2];
#pragma unroll
    for (int a = 0; a < 2; ++a)
#pragma unroll
        for (int b = 0; b < 2; ++b)
#pragma unroll
            for (int m = 0; m < 4; ++m)
#pragma unroll
                for (int n = 0; n < 2; ++n) acc[a][b][m][n] = (f32x4){0.f, 0.f, 0.f, 0.f};
    bf16x8 At[4][2], B0[2][2], B1[2][2];
    const char* cA = (const char*)g.A + (size_t)cur.pm * tstep; const char* cB = (const char*)g.Bt + (size_t)cur.pn * tstep;
    S.a_ready(cur);
    if constexpr (SP2) {
        PG8_STAGE(PG8_SB(0, 0), cB, voffB); PG8_STAGE(PG8_SB(0, 1), cB + hstep, voffB); PG8_STAGE(PG8_SA(0, 0), cA, voffA); PG8_STAGE(PG8_SA(0, 1), cA + hstep, voffA);
        if (wr == 1) PG8_BAR;
        PG8_WAIT_V(2); PG8_BAR;
        PG8_STAGE(PG8_SB(1, 0), cB + kstep, voffB); PG8_STAGE(PG8_SA(1, 0), cA + kstep, voffA); PG8_STAGE(PG8_SB(1, 1), cB + hstep + kstep, voffB);
        PG8_WAIT_V(6); PG8_BAR;
    } else {
        PG8_STAGE(PG8_SB(0, 0), cB, voffB); PG8_STAGE(PG8_SA(0, 0), cA, voffA); PG8_STAGE(PG8_SB(0, 1), cB + hstep, voffB); PG8_STAGE(PG8_SA(0, 1), cA + hstep, voffA);
        if (wr == 1) PG8_BAR;
        PG8_WAIT_V(4); PG8_BAR;
        PG8_STAGE(PG8_SB(1, 0), cB + kstep, voffB); PG8_STAGE(PG8_SA(1, 0), cA + kstep, voffA); PG8_STAGE(PG8_SB(1, 1), cB + hstep + kstep, voffB);
        PG8_WAIT_V(6); PG8_BAR;
    }
    for (;;) {
        const bool has_next = S.next(ui + 1, nxt);
        const char* nA = has_next ? (const char*)g.A + (size_t)nxt.pm * tstep : cA; const char* nB = has_next ? (const char*)g.Bt + (size_t)nxt.pn * tstep : cB;
        for (int t = 0; t < nt; t += 2) {
            const bool last = (t == nt - 2);
            const char* a1 = cA + (size_t)(t + 1) * kstep;
            const char* a2 = last ? nA : cA + (size_t)(t + 2) * kstep; const char* b2 = last ? nB : cB + (size_t)(t + 2) * kstep;
            const char* a3 = a2 + kstep; const char* b3 = b2 + kstep;
            if (last && has_next) S.a_ready(nxt);
            if constexpr (SP2) {
            PG8_LDB(B0, 0, 0); PG8_LDB(B1, 0, 1); PG8_SCHED; PG8_LDA(At, 0, 0); PG8_STAGE(PG8_SA(1, 1), a1 + hstep, voffA);
            PG8_WAIT_V(8); PG8_WAIT_L(0); PG8_BAR; PG8_MMA(0, 0, At, B0); PG8_MMA(0, 1, At, B1); PG8_BAR; PG8_SCHED;
            PG8_LDA(At, 0, 1); PG8_STAGE(PG8_SB(0, 0), b2, voffB); PG8_STAGE(PG8_SB(0, 1), b2 + hstep, voffB); PG8_STAGE(PG8_SA(0, 0), a2, voffA);
            PG8_WAIT_V(8); PG8_WAIT_L(0); PG8_BAR; PG8_MMA(1, 0, At, B0); PG8_MMA(1, 1, At, B1); PG8_BAR; PG8_SCHED;
            PG8_LDB(B0, 1, 0); PG8_LDB(B1, 1, 1); PG8_SCHED; PG8_LDA(At, 1, 0); PG8_STAGE(PG8_SA(0, 1), a2 + hstep, voffA);
            PG8_WAIT_V(8); PG8_WAIT_L(0); PG8_BAR; PG8_MMA(0, 0, At, B0); PG8_MMA(0, 1, At, B1); PG8_BAR; PG8_SCHED;
            PG8_LDA(At, 1, 1); PG8_STAGE(PG8_SB(1, 0), b3, voffB); PG8_STAGE(PG8_SB(1, 1), b3 + hstep, voffB); PG8_STAGE(PG8_SA(1, 0), a3, voffA);
            PG8_WAIT_V(8); PG8_WAIT_L(0); PG8_BAR; PG8_MMA(1, 0, At, B0); PG8_MMA(1, 1, At, B1); PG8_BAR; PG8_SCHED;
            } else {
            PG8_LDB(B0, 0, 0); PG8_SCHED; PG8_LDA(At, 0, 0); PG8_STAGE(PG8_SA(1, 1), a1 + hstep, voffA);
            PG8_WAIT_L(8); PG8_BAR; PG8_WAIT_L(0); PG8_MMA(0, 0, At, B0); PG8_BAR; PG8_SCHED;
            PG8_LDB(B1, 0, 1); PG8_STAGE(PG8_SB(0, 0), b2, voffB);
            PG8_BAR; PG8_WAIT_L(0); PG8_MMA(0, 1, At, B1); PG8_BAR;
            PG8_LDA(At, 0, 1); PG8_STAGE(PG8_SA(0, 0), a2, voffA);
            PG8_BAR; PG8_WAIT_L(0); PG8_MMA(1, 0, At, B0); PG8_BAR; PG8_SCHED;
            PG8_STAGE(PG8_SB(0, 1), b2 + hstep, voffB);
            PG8_WAIT_V(6); PG8_BAR; PG8_MMA(1, 1, At, B1); PG8_BAR;
            PG8_LDB(B0, 1, 0); PG8_SCHED; PG8_LDA(At, 1, 0); PG8_STAGE(PG8_SA(0, 1), a2 + hstep, voffA);
            PG8_WAIT_L(8); PG8_BAR; PG8_WAIT_L(0); PG8_MMA(0, 0, At, B0); PG8_BAR; PG8_SCHED;
            PG8_LDB(B1, 1, 1); PG8_STAGE(PG8_SB(1, 0), b3, voffB);
            PG8_BAR; PG8_WAIT_L(0); PG8_MMA(0, 1, At, B1); PG8_BAR;
            PG8_LDA(At, 1, 1); PG8_STAGE(PG8_SA(1, 0), a3, voffA);
            PG8_BAR; PG8_WAIT_L(0); PG8_MMA(1, 0, At, B0); PG8_BAR; PG8_SCHED;
            PG8_STAGE(PG8_SB(1, 1), b3 + hstep, voffB);
            PG8_WAIT_V(6); PG8_BAR; PG8_MMA(1, 1, At, B1); PG8_BAR;
            }
        }
        if constexpr (ALIGN_EPI) { if (wr == 0) PG8_BAR; }
        if constexpr (!Epi::AFTER_DRAIN) { E(acc, cur, wr, wc, fr, fq); S.done(cur); }
        if (!has_next) break;
#pragma unroll
        for (int a = 0; a < 2; ++a)
#pragma unroll
            for (int b = 0; b < 2; ++b)
#pragma unroll
                for (int m = 0; m < 4; ++m)
#pragma unroll
                    for (int n = 0; n < 2; ++n) acc[a][b][m][n] = (f32x4){0.f, 0.f, 0.f, 0.f};
        cur = nxt; cA = nA; cB = nB; ++ui;
        if constexpr (ALIGN_EPI) { if (wr == 1) PG8_BAR; }
    }
    PG8_WAIT_V(0);
    if constexpr (!ALIGN_EPI) { if (wr == 0) PG8_BAR; }
    PG8_BAR;
    if constexpr (Epi::AFTER_DRAIN) { E.fused(acc, cur, wr, wc, fr, fq, lds, wid, lane); S.done(cur); }
#undef PG8_SA
#undef PG8_SB
#undef PG8_STAGE
#undef PG8_LDA
#undef PG8_LDB
#undef PG8_MMA
#undef PG8_WAIT_V
#undef PG8_WAIT_L
#undef PG8_BAR
#undef PG8_SCHED
}
}
#define LAS __attribute__((address_space(3)))
#define XB_TMO      128
#define XB_XCNT(j)  (256  + 64 * (j))
#define XB_XSUB(j)  (1280 + 64 * (j))
#define XB_XGEN(j)  (2304 + 64 * (j))
#define XB_TOP      3328
#define XB_TOPGEN   3392
#define XCD_BAR_WORDS 3456
#define XB_SPIN_CAP (1u << 18)

__device__ __forceinline__ unsigned xb_ld(unsigned* p)              { return __hip_atomic_load(p, __ATOMIC_RELAXED, __HIP_MEMORY_SCOPE_AGENT); }
__device__ __forceinline__ unsigned xb_add(unsigned* p, unsigned v) { return __hip_atomic_fetch_add(p, v, __ATOMIC_RELAXED, __HIP_MEMORY_SCOPE_AGENT); }
__device__ __forceinline__ unsigned xb_xcc_id() { return (unsigned)__builtin_amdgcn_s_getreg((3 << 11) | 20) & 0xFu; }
#define XB_SPIN(cond, bar) do { unsigned _sp = 0; while (cond) { __builtin_amdgcn_s_sleep(1); \
    if ((++_sp & 255u) == 0u) { if (xb_ld(&(bar)[XB_TMO])) break; if (_sp > XB_SPIN_CAP) { atomicAdd(&(bar)[XB_TMO], 1u); break; } } } } while (0)

struct XcdBarrier {
    unsigned* bar; unsigned x;
    volatile LAS unsigned* st;
};

__device__ __forceinline__ XcdBarrier xcd_barrier_post(unsigned* bar, volatile LAS unsigned* st) {
    XcdBarrier b; b.bar = bar; b.x = xb_xcc_id(); b.st = st;
    if (threadIdx.x == 0) (void)xb_add(&bar[XB_XCNT(b.x)], 1u);
    return b;
}
__device__ __forceinline__ void xcd_barrier_complete(unsigned* bar, unsigned x, unsigned& nloc, unsigned& nx) {
    const unsigned G = gridDim.x * gridDim.y * gridDim.z;
    unsigned sum, cnt, mine, sp = 0u;
    for (;;) {
        sum = 0u; cnt = 0u; mine = 0u;
#pragma unroll
        for (unsigned j = 0; j < 16; ++j) { const unsigned c = xb_ld(&bar[XB_XCNT(j)]); sum += c; cnt += (c > 0u) ? 1u : 0u; mine = (j == x) ? c : mine; }
        if (sum == G) break;
        __builtin_amdgcn_s_sleep(1);
        if ((++sp & 255u) == 0u) { if (xb_ld(&bar[XB_TMO])) break; if (sp > XB_SPIN_CAP) { atomicAdd(&bar[XB_TMO], 1u); break; } }
    }
    nloc = mine > 0u ? mine : 1u; nx = cnt > 0u ? cnt : 1u;
}

__device__ __forceinline__ void xcd_barrier(const XcdBarrier& b) {
    asm volatile("s_waitcnt vmcnt(0)" ::: "memory");
    __syncthreads();
    if (threadIdx.x == 0) {
        unsigned* bar = b.bar;
        __builtin_amdgcn_s_waitcnt(0);
        unsigned nloc = b.st[0], nx = b.st[1];
        if (nloc == 0u) { xcd_barrier_complete(bar, b.x, nloc, nx); b.st[0] = nloc; b.st[1] = nx; }
        const unsigned old = xb_add(&bar[XB_XSUB(b.x)], 1u);
        const unsigned gen = old / nloc;
        if (old + 1u == (gen + 1u) * nloc) {
            __builtin_amdgcn_fence(__ATOMIC_RELEASE, "agent");
            asm volatile("s_waitcnt vmcnt(0)" ::: "memory");
            const unsigned og = xb_add(&bar[XB_TOP], 1u);
            const unsigned tg = og / nx;
            if (og + 1u == (tg + 1u) * nx) xb_add(&bar[XB_TOPGEN], 1u);
            else XB_SPIN(xb_ld(&bar[XB_TOPGEN]) == tg, bar);
            __builtin_amdgcn_fence(__ATOMIC_ACQUIRE, "agent");
            xb_add(&bar[XB_XGEN(b.x)], 1u);
            asm volatile("s_waitcnt vmcnt(0)" ::: "memory");
        } else {
            XB_SPIN(xb_ld(&bar[XB_XGEN(b.x)]) == gen, bar);
            __builtin_amdgcn_fence(__ATOMIC_ACQUIRE, "agent");
            asm volatile("s_waitcnt vmcnt(0)" ::: "memory");
        }
    }
    __syncthreads();
}
namespace da {
#define DA_LAS __attribute__((address_space(3)))
typedef short bf16x8 __attribute__((ext_vector_type(8)));
typedef short s16x4 __attribute__((ext_vector_type(4)));
typedef float f32x16 __attribute__((ext_vector_type(16)));
typedef float f32x4 __attribute__((ext_vector_type(4)));
typedef unsigned u32x4 __attribute__((ext_vector_type(4)));
typedef unsigned u32x2 __attribute__((ext_vector_type(2)));
constexpr int KSTR = 144, VSTR = 320;
constexpr int K_BYTES = 64 * KSTR, V_BYTES = 64 * VSTR, STAGE = 2 * K_BYTES + V_BYTES;
constexpr float THR = 4.0f;
__device__ __forceinline__ unsigned cvt_pk(float lo, float hi) { unsigned r; asm volatile("v_cvt_pk_bf16_f32 %0, %1, %2" : "=v"(r) : "v"(lo), "v"(hi)); return r; }
__device__ __forceinline__ s16x4 vtr(const DA_LAS unsigned char* p) { typedef short v4i16_t __attribute__((ext_vector_type(4)));
    return __builtin_bit_cast(s16x4, __builtin_amdgcn_ds_read_tr16_b64_v4i16((DA_LAS v4i16_t*)p)); }

__device__ __forceinline__ void dattn_phase(DA_LAS unsigned char* lds, const bf16_t* U, const float* lamp, const float* subln_g, bf16_t* MIX, int vcu, int G) {
    const int tid = threadIdx.x, lane = tid & 63, wave = __builtin_amdgcn_readfirstlane(tid >> 6), comp = wave >> 2, qs = wave & 3;
    const int r32 = lane & 31, hh = lane >> 5, gi = lane >> 4, li = lane & 15;
    const float lam = lamp[0];
    const int krow = tid >> 3, kch = tid & 7, vrow0 = tid >> 4, vch = tid & 15;
    const int kdst = krow * KSTR + kch * 16, vdst0 = vrow0 * VSTR + vch * 16, vdst1 = (vrow0 + 32) * VSTR + vch * 16;
    const int kfrag = r32 * KSTR + hh * 16;
    const int vfrag = (4 * hh + (li >> 2)) * VSTR + (16 * (gi & 1) + 4 * (li & 3)) * 2;
    for (int u = vcu; u < BATCH * 4 * 16; u += G) {
        const int qb = u & 15, h = (u >> 4) & 3, b = u >> 6;
        const bf16_t* Ub = U + (size_t)b * SEQ * NU;
        const bf16_t* ksrc0 = Ub + (size_t)krow * NU + U_DK + (2 * h) * 64 + kch * 8;
        const bf16_t* ksrc1 = ksrc0 + 64;
        const bf16_t* vsrc0 = Ub + (size_t)vrow0 * NU + U_DV + h * 128 + vch * 8;
        const bf16_t* vsrc1 = vsrc0 + (size_t)32 * NU;
        bf16x8 qf[4];
        { const bf16_t* qp = Ub + (size_t)(qb * 128 + qs * 32 + r32) * NU + U_DQ + (2 * h + comp) * 64 + hh * 8;
#pragma unroll
          for (int ds = 0; ds < 4; ++ds) qf[ds] = *(const bf16x8*)(qp + ds * 16); }
        f32x16 o[4];
#pragma unroll
        for (int d0 = 0; d0 < 4; ++d0)
#pragma unroll
            for (int r = 0; r < 16; ++r) o[d0][r] = 0.f;
        float m = -INFINITY, l = 0.f;
        u32x4 rk0 = *(const u32x4*)ksrc0, rk1 = *(const u32x4*)ksrc1, rv0 = *(const u32x4*)vsrc0, rv1 = *(const u32x4*)vsrc1;
        *(DA_LAS u32x4*)(lds + kdst) = rk0; *(DA_LAS u32x4*)(lds + K_BYTES + kdst) = rk1; *(DA_LAS u32x4*)(lds + 2 * K_BYTES + vdst0) = rv0; *(DA_LAS u32x4*)(lds + 2 * K_BYTES + vdst1) = rv1;
        __syncthreads();
        for (int t = 0; t < SEQ / 64; ++t) {
            const DA_LAS unsigned char* st = lds + (t & 1) * STAGE;
            DA_LAS unsigned char* nst = lds + ((t + 1) & 1) * STAGE;
            if (t + 1 < SEQ / 64) { const size_t go = (size_t)(t + 1) * 64 * NU; rk0 = *(const u32x4*)(ksrc0 + go); rk1 = *(const u32x4*)(ksrc1 + go); rv0 = *(const u32x4*)(vsrc0 + go); rv1 = *(const u32x4*)(vsrc1 + go); }
            const DA_LAS unsigned char* Kt = st + comp * K_BYTES + kfrag;
            f32x16 p0, p1;
#pragma unroll
            for (int r = 0; r < 16; ++r) { p0[r] = 0.f; p1[r] = 0.f; }
#pragma unroll
            for (int ds = 0; ds < 4; ++ds) {
                const bf16x8 a0 = *(const DA_LAS bf16x8*)(Kt + ds * 32), a1 = *(const DA_LAS bf16x8*)(Kt + 32 * KSTR + ds * 32);
                p0 = __builtin_amdgcn_mfma_f32_32x32x16_bf16(a0, qf[ds], p0, 0, 0, 0);
                p1 = __builtin_amdgcn_mfma_f32_32x32x16_bf16(a1, qf[ds], p1, 0, 0, 0);
            }
            float mx = fmaxf(p0[0], p1[0]);
#pragma unroll
            for (int r = 1; r < 16; ++r) mx = fmaxf(mx, fmaxf(p0[r], p1[r]));
            mx = fmaxf(mx, __shfl_xor(mx, 32));
            if (!__all(mx - m <= THR)) {
                const float mn = fmaxf(m, mx), alpha = __builtin_amdgcn_exp2f(m - mn);
                m = mn; l *= alpha;
#pragma unroll
                for (int d0 = 0; d0 < 4; ++d0) o[d0] = o[d0] * alpha;
            }
            float rs = 0.f;
#pragma unroll
            for (int r = 0; r < 16; ++r) { p0[r] = __builtin_amdgcn_exp2f(p0[r] - m); p1[r] = __builtin_amdgcn_exp2f(p1[r] - m); rs += p0[r] + p1[r]; }
            l += rs;
            bf16x8 pf[4];
#pragma unroll
            for (int s = 0; s < 2; ++s) {
                u32x4 w0, w1;
                w0.x = cvt_pk(p0[8 * s + 0], p0[8 * s + 1]); w0.y = cvt_pk(p0[8 * s + 2], p0[8 * s + 3]); w0.z = cvt_pk(p0[8 * s + 4], p0[8 * s + 5]); w0.w = cvt_pk(p0[8 * s + 6], p0[8 * s + 7]);
                w1.x = cvt_pk(p1[8 * s + 0], p1[8 * s + 1]); w1.y = cvt_pk(p1[8 * s + 2], p1[8 * s + 3]); w1.z = cvt_pk(p1[8 * s + 4], p1[8 * s + 5]); w1.w = cvt_pk(p1[8 * s + 6], p1[8 * s + 7]);
                pf[s] = __builtin_bit_cast(bf16x8, w0); pf[2 + s] = __builtin_bit_cast(bf16x8, w1);
            }
            const DA_LAS unsigned char* Vt = st + 2 * K_BYTES + vfrag;
#pragma unroll
            for (int d0 = 0; d0 < 4; ++d0)
#pragma unroll
                for (int ks = 0; ks < 4; ++ks) {
                    const s16x4 lo = vtr(Vt + (16 * ks) * VSTR + 64 * d0), hi = vtr(Vt + (16 * ks + 8) * VSTR + 64 * d0);
                    const bf16x8 av = (bf16x8){lo[0], lo[1], lo[2], lo[3], hi[0], hi[1], hi[2], hi[3]};
                    o[d0] = __builtin_amdgcn_mfma_f32_32x32x16_bf16(av, pf[ks], o[d0], 0, 0, 0);
                }
            if (t + 1 < SEQ / 64) { *(DA_LAS u32x4*)(nst + kdst) = rk0; *(DA_LAS u32x4*)(nst + K_BYTES + kdst) = rk1; *(DA_LAS u32x4*)(nst + 2 * K_BYTES + vdst0) = rv0; *(DA_LAS u32x4*)(nst + 2 * K_BYTES + vdst1) = rv1; }
            __syncthreads();
        }
        l += __shfl_xor(l, 32);
        const float il = 1.f / l;
        DA_LAS float* xch = (DA_LAS float*)lds + (size_t)qs * 64 * 64 + lane;
        if (comp == 1) {
#pragma unroll
            for (int d0 = 0; d0 < 4; ++d0)
#pragma unroll
                for (int r = 0; r < 16; ++r) xch[(d0 * 16 + r) * 64] = o[d0][r] * il;
        }
        __syncthreads();
        if (comp == 0) {
            float ss = 0.f;
#pragma unroll
            for (int d0 = 0; d0 < 4; ++d0)
#pragma unroll
                for (int r = 0; r < 16; ++r) { const float v = o[d0][r] * il - lam * xch[(d0 * 16 + r) * 64]; o[d0][r] = v; ss += v * v; }
            ss += __shfl_xor(ss, 32);
            const float rn = (1.f - LAMBDA_INIT) / sqrtf(ss * (1.f / 128.f) + RMS_EPS);
            bf16_t* orow = MIX + (size_t)(b * SEQ + qb * 128 + qs * 32 + r32) * DM + 512 + h * 128 + 4 * hh;
#pragma unroll
            for (int d0 = 0; d0 < 4; ++d0)
#pragma unroll
                for (int rq = 0; rq < 4; ++rq) {
                    const f32x4 g4 = *(const f32x4*)(subln_g + 32 * d0 + 8 * rq + 4 * hh);
                    u32x2 w; w.x = cvt_pk(o[d0][4 * rq] * rn * g4[0], o[d0][4 * rq + 1] * rn * g4[1]); w.y = cvt_pk(o[d0][4 * rq + 2] * rn * g4[2], o[d0][4 * rq + 3] * rn * g4[3]);
                    *(u32x2*)(orow + 32 * d0 + 8 * rq) = w;
                }
        }
        __syncthreads();
    }
}
}
namespace hg {
#define HG_LAS __attribute__((address_space(3)))
typedef short bf16x8 __attribute__((ext_vector_type(8)));
typedef short s16x4 __attribute__((ext_vector_type(4)));
typedef float f32x16 __attribute__((ext_vector_type(16)));
typedef float f32x4 __attribute__((ext_vector_type(4)));
typedef unsigned u32x4 __attribute__((ext_vector_type(4)));
typedef unsigned u32x2 __attribute__((ext_vector_type(2)));
typedef float f32x2 __attribute__((ext_vector_type(2)));
constexpr int RSTR = 272, TSTR = 320;
constexpr int L_QIN = 0, L_KIN = L_QIN + 64 * RSTR, L_KINT = L_KIN + 64 * RSTR, L_VT = L_KINT + 64 * TSTR, L_SBT = L_VT + 64 * TSTR, L_DEC = L_SBT + 128 * RSTR, L_SEGT = L_DEC + 512, L_END = L_SEGT + 8 * 128 * 4;
static_assert(L_END <= 131072, "hgrn LDS map");
constexpr float LOG2E = 1.4426950408889634f;
__device__ __forceinline__ unsigned cvt_pk(float lo, float hi) { unsigned r; asm volatile("v_cvt_pk_bf16_f32 %0, %1, %2" : "=v"(r) : "v"(lo), "v"(hi)); return r; }
__device__ __forceinline__ s16x4 vtr(const HG_LAS unsigned char* p) { typedef short v4i16_t __attribute__((ext_vector_type(4)));
    return __builtin_bit_cast(s16x4, __builtin_amdgcn_ds_read_tr16_b64_v4i16((HG_LAS v4i16_t*)p)); }
__device__ __forceinline__ float bflo(unsigned w) { return __builtin_bit_cast(float, w << 16); }
__device__ __forceinline__ float bfhi(unsigned w) { return __builtin_bit_cast(float, w & 0xffff0000u); }

__device__ __forceinline__ void hgrn_phase(HG_LAS unsigned char* lds, const bf16_t* U, const float* LB, float* OSC, int first, int stride) {
    const int tid = threadIdx.x, lane = tid & 63, wave = __builtin_amdgcn_readfirstlane(tid >> 6);
    const int r32 = lane & 31, hh = lane >> 5, gi = lane >> 4, li = lane & 15;
    const int vt = wave >> 1, ct = wave & 1, kt = wave >> 1, vpair = wave & 1;
    const int kp = lane, seg = wave;
    const int vrow0 = tid >> 4, vch = tid & 15;
    const int trp = (li >> 2) * TSTR + (16 * (gi & 1) + 4 * (li & 3)) * 2;
    for (int item = first; item < BATCH * 4 * 2; item += stride) {
        const int dir = item & 1, h = (item >> 1) & 3, b = item >> 3;
        const bf16_t* Ub = U + (size_t)b * SEQ * NU;
        const int qcol = U_HQ + h * 128 + 2 * kp, fcol = (dir ? U_HFB : U_HFF) + h * 128 + 2 * kp, vcol = U_HI + h * 128 + vch * 8;
        const float lb0 = LB[dir * 512 + h * 128 + 2 * kp], lb1 = LB[dir * 512 + h * 128 + 2 * kp + 1];
        for (int i = tid; i < 128 * RSTR / 4; i += 512) ((HG_LAS unsigned*)(lds + L_SBT))[i] = 0u;
        f32x16 S[2];
#pragma unroll
        for (int r = 0; r < 16; ++r) { S[0][r] = 0.f; S[1][r] = 0.f; }
        unsigned rq[8], rf[8]; u32x4 rv0, rv1;
#define HG_TIME(p) (dir ? (SEQ - 1 - (p)) : (p))
#define HG_LOAD(n) do { _Pragma("unroll") for (int i = 0; i < 8; ++i) { const bf16_t* rp = Ub + (size_t)HG_TIME(64 * (n) + 8 * seg + i) * NU; rq[i] = *(const unsigned*)(rp + qcol); rf[i] = *(const unsigned*)(rp + fcol); } \
        rv0 = *(const u32x4*)(Ub + (size_t)HG_TIME(64 * (n) + vrow0) * NU + vcol); rv1 = *(const u32x4*)(Ub + (size_t)HG_TIME(64 * (n) + vrow0 + 32) * NU + vcol); } while (0)
        HG_LOAD(0);
        __syncthreads();
        for (int n = 0; n < SEQ / 64; ++n) {
            float c0[8], c1[8], k0[8], k1[8]; float a0 = 0.f, a1 = 0.f;
#pragma unroll
            for (int i = 0; i < 8; ++i) {
                const float u0 = bflo(rf[i]), u1 = bfhi(rf[i]);
                const float f0 = lb0 + (1.f - lb0) * __builtin_amdgcn_rcpf(1.f + __builtin_amdgcn_exp2f(-LOG2E * u0));
                const float f1 = lb1 + (1.f - lb1) * __builtin_amdgcn_rcpf(1.f + __builtin_amdgcn_exp2f(-LOG2E * u1));
                k0[i] = 1.f - f0; k1[i] = 1.f - f1;
                a0 += __builtin_amdgcn_logf(f0); a1 += __builtin_amdgcn_logf(f1);
                c0[i] = a0; c1[i] = a1;
            }
            *(HG_LAS f32x2*)(lds + L_SEGT + (seg * 128 + 2 * kp) * 4) = (f32x2){a0, a1};
            __syncthreads();
            float off0 = 0.f, off1 = 0.f, tot0 = 0.f, tot1 = 0.f;
#pragma unroll
            for (int s2 = 0; s2 < 8; ++s2) { const f32x2 tq = *(const HG_LAS f32x2*)(lds + L_SEGT + (s2 * 128 + 2 * kp) * 4); if (s2 < seg) { off0 += tq.x; off1 += tq.y; } tot0 += tq.x; tot1 += tq.y; }
            if (seg == 0) *(HG_LAS f32x2*)(lds + L_DEC + 2 * kp * 4) = (f32x2){__builtin_amdgcn_exp2f(tot0), __builtin_amdgcn_exp2f(tot1)};
#pragma unroll
            for (int i = 0; i < 8; ++i) {
                const int c = 8 * seg + i; const float b0 = off0 + c0[i], b1 = off1 + c1[i];
                const unsigned qi = cvt_pk(bflo(rq[i]) * __builtin_amdgcn_exp2f(b0), bfhi(rq[i]) * __builtin_amdgcn_exp2f(b1));
                const unsigned ki = cvt_pk(k0[i] * __builtin_amdgcn_exp2f(-b0), k1[i] * __builtin_amdgcn_exp2f(-b1));
                *(HG_LAS unsigned*)(lds + L_QIN + c * RSTR + 4 * kp) = qi;
                *(HG_LAS unsigned*)(lds + L_KIN + c * RSTR + 4 * kp) = ki;
                *(HG_LAS unsigned*)(lds + L_KINT + c * TSTR + 4 * kp) = ki;
            }
            *(HG_LAS u32x4*)(lds + L_VT + vrow0 * TSTR + vch * 16) = rv0; *(HG_LAS u32x4*)(lds + L_VT + (vrow0 + 32) * TSTR + vch * 16) = rv1;
            if (n + 1 < SEQ / 64) HG_LOAD(n + 1);
            __syncthreads();
            bf16x8 qfr[8];
#pragma unroll
            for (int ks = 0; ks < 8; ++ks) qfr[ks] = *(const HG_LAS bf16x8*)(lds + L_QIN + (32 * ct + r32) * RSTR + ks * 32 + hh * 16);
            f32x16 o;
#pragma unroll
            for (int r = 0; r < 16; ++r) o[r] = 0.f;
#pragma unroll
            for (int ks = 0; ks < 8; ++ks) {
                const bf16x8 as = *(const HG_LAS bf16x8*)(lds + L_SBT + (32 * vt + r32) * RSTR + ks * 32 + hh * 16);
                o = __builtin_amdgcn_mfma_f32_32x32x16_bf16(as, qfr[ks], o, 0, 0, 0);
            }
#pragma unroll
            for (int st = 0; st < 2; ++st) {
                if (st <= ct) {
                    f32x16 at;
#pragma unroll
                    for (int r = 0; r < 16; ++r) at[r] = 0.f;
#pragma unroll
                    for (int ks = 0; ks < 8; ++ks) {
                        const bf16x8 ak = *(const HG_LAS bf16x8*)(lds + L_KIN + (32 * st + r32) * RSTR + ks * 32 + hh * 16);
                        at = __builtin_amdgcn_mfma_f32_32x32x16_bf16(ak, qfr[ks], at, 0, 0, 0);
                    }
                    if (st == ct) {
#pragma unroll
                        for (int r = 0; r < 16; ++r) { const int srow = (r & 3) + 8 * (r >> 2) + 4 * hh; at[r] = (srow <= r32) ? at[r] : 0.f; }
                    }
#pragma unroll
                    for (int s2 = 0; s2 < 2; ++s2) {
                        u32x4 w; w.x = cvt_pk(at[8 * s2 + 0], at[8 * s2 + 1]); w.y = cvt_pk(at[8 * s2 + 2], at[8 * s2 + 3]); w.z = cvt_pk(at[8 * s2 + 4], at[8 * s2 + 5]); w.w = cvt_pk(at[8 * s2 + 6], at[8 * s2 + 7]);
                        const HG_LAS unsigned char* vp = lds + L_VT + (32 * st + 16 * s2 + 4 * hh) * TSTR + 64 * vt + trp;
                        const s16x4 lo = vtr(vp), hi = vtr(vp + 8 * TSTR);
                        const bf16x8 av = (bf16x8){lo[0], lo[1], lo[2], lo[3], hi[0], hi[1], hi[2], hi[3]};
                        o = __builtin_amdgcn_mfma_f32_32x32x16_bf16(av, __builtin_bit_cast(bf16x8, w), o, 0, 0, 0);
                    }
                }
            }
#pragma unroll
            for (int cs = 0; cs < 4; ++cs) {
                const HG_LAS unsigned char* kp_ = lds + L_KINT + (16 * cs + 8 * hh) * TSTR + 64 * kt + trp;
                const s16x4 klo = vtr(kp_), khi = vtr(kp_ + 4 * TSTR);
                const bf16x8 ak = (bf16x8){klo[0], klo[1], klo[2], klo[3], khi[0], khi[1], khi[2], khi[3]};
#pragma unroll
                for (int vv = 0; vv < 2; ++vv) {
                    const HG_LAS unsigned char* vp = lds + L_VT + (16 * cs + 8 * hh) * TSTR + 64 * (2 * vpair + vv) + trp;
                    const s16x4 vlo = vtr(vp), vhi = vtr(vp + 4 * TSTR);
                    const bf16x8 bv = (bf16x8){vlo[0], vlo[1], vlo[2], vlo[3], vhi[0], vhi[1], vhi[2], vhi[3]};
                    S[vv] = __builtin_amdgcn_mfma_f32_32x32x16_bf16(ak, bv, S[vv], 0, 0, 0);
                }
            }
#pragma unroll
            for (int rq4 = 0; rq4 < 4; ++rq4) {
                const f32x4 d4 = *(const HG_LAS f32x4*)(lds + L_DEC + (32 * kt + 8 * rq4 + 4 * hh) * 4);
#pragma unroll
                for (int j = 0; j < 4; ++j) { S[0][4 * rq4 + j] *= d4[j]; S[1][4 * rq4 + j] *= d4[j]; }
            }
            __syncthreads();
#pragma unroll
            for (int vv = 0; vv < 2; ++vv)
#pragma unroll
                for (int rq4 = 0; rq4 < 4; ++rq4) {
                    u32x2 w; w.x = cvt_pk(S[vv][4 * rq4], S[vv][4 * rq4 + 1]); w.y = cvt_pk(S[vv][4 * rq4 + 2], S[vv][4 * rq4 + 3]);
                    *(HG_LAS u32x2*)(lds + L_SBT + (32 * (2 * vpair + vv) + r32) * RSTR + (32 * kt + 8 * rq4 + 4 * hh) * 2) = w;
                }
            {
                const int tok = HG_TIME(64 * n + 32 * ct + r32);
                float* op = OSC + ((size_t)dir * NTOK + (size_t)b * SEQ + tok) * 512 + h * 128 + 32 * vt + 4 * hh;
#pragma unroll
                for (int rq4 = 0; rq4 < 4; ++rq4) *(f32x4*)(op + 8 * rq4) = (f32x4){o[4 * rq4], o[4 * rq4 + 1], o[4 * rq4 + 2], o[4 * rq4 + 3]};
            }
        }
        __syncthreads();
#undef HG_LOAD
#undef HG_TIME
    }
}
}
namespace xa {
#define XA_LAS __attribute__((address_space(3)))
typedef short bf16x8 __attribute__((ext_vector_type(8)));
typedef short s16x4 __attribute__((ext_vector_type(4)));
typedef float f32x16 __attribute__((ext_vector_type(16)));
typedef unsigned u32x4 __attribute__((ext_vector_type(4)));
typedef unsigned u32x2 __attribute__((ext_vector_type(2)));
constexpr int KSTR = 528, VSTR = 576;
constexpr int K_BYTES = 64 * KSTR, V_BYTES = 64 * VSTR;
constexpr float THR = 4.0f;
__device__ __forceinline__ unsigned cvt_pk(float lo, float hi) { unsigned r; asm volatile("v_cvt_pk_bf16_f32 %0, %1, %2" : "=v"(r) : "v"(lo), "v"(hi)); return r; }
__device__ __forceinline__ s16x4 vtr(const XA_LAS unsigned char* p) { typedef short v4i16_t __attribute__((ext_vector_type(4)));
    return __builtin_bit_cast(s16x4, __builtin_amdgcn_ds_read_tr16_b64_v4i16((XA_LAS v4i16_t*)p)); }

__device__ __forceinline__ void xattn_phase(XA_LAS unsigned char* lds, const bf16_t* Q, bf16_t* O, const bf16_t* KV, int vcu, int G) {
    const int tid = threadIdx.x, lane = tid & 63, wave = __builtin_amdgcn_readfirstlane(tid >> 6), qs = wave >> 2, dq = wave & 3;
    const int r32 = lane & 31, hh = lane >> 5, gi = lane >> 4, li = lane & 15;
    const int srow = tid >> 5, sch = tid & 31;
    const int kfrag = r32 * KSTR + hh * 16;
    const int vfrag = (4 * hh + (li >> 2)) * VSTR + (16 * (gi & 1) + 4 * (li & 3)) * 2 + 128 * dq;
    for (int u = vcu; u < BATCH * 4 * 32; u += G) {
        const int qb = u & 31, h = (u >> 5) & 3, b = u >> 7;
        const bf16_t* ksrc = KV + (size_t)(b * MEML + srow) * 2048 + h * 256 + sch * 8;
        const bf16_t* vsrc = ksrc + 1024;
        const size_t roff = (size_t)(b * SEQ + qb * 64 + qs * 32 + r32) * DM + h * 256;
        const bf16_t* qrow = Q + roff;
        bf16x8 qf[16];
#pragma unroll
        for (int ds = 0; ds < 16; ++ds) qf[ds] = *(const bf16x8*)(qrow + ds * 16 + hh * 8);
        f32x16 o[2];
#pragma unroll
        for (int r = 0; r < 16; ++r) { o[0][r] = 0.f; o[1][r] = 0.f; }
        float m = -INFINITY, l = 0.f;
        u32x4 rk[4], rv[4];
#pragma unroll
        for (int i = 0; i < 4; ++i) { rk[i] = *(const u32x4*)(ksrc + (size_t)(16 * i) * 2048); rv[i] = *(const u32x4*)(vsrc + (size_t)(16 * i) * 2048); }
        for (int t = 0; t < MEML / 64; ++t) {
#pragma unroll
            for (int i = 0; i < 4; ++i) { *(XA_LAS u32x4*)(lds + (srow + 16 * i) * KSTR + sch * 16) = rk[i]; *(XA_LAS u32x4*)(lds + K_BYTES + (srow + 16 * i) * VSTR + sch * 16) = rv[i]; }
            if (t + 1 < MEML / 64) {
#pragma unroll
                for (int i = 0; i < 4; ++i) { rk[i] = *(const u32x4*)(ksrc + (size_t)(64 * (t + 1) + 16 * i) * 2048); rv[i] = *(const u32x4*)(vsrc + (size_t)(64 * (t + 1) + 16 * i) * 2048); }
            }
            __syncthreads();
            const XA_LAS unsigned char* Kt = lds + kfrag;
            f32x16 p0, p1;
#pragma unroll
            for (int r = 0; r < 16; ++r) { p0[r] = 0.f; p1[r] = 0.f; }
#pragma unroll
            for (int ds = 0; ds < 16; ++ds) {
                const bf16x8 a0 = *(const XA_LAS bf16x8*)(Kt + ds * 32), a1 = *(const XA_LAS bf16x8*)(Kt + 32 * KSTR + ds * 32);
                p0 = __builtin_amdgcn_mfma_f32_32x32x16_bf16(a0, qf[ds], p0, 0, 0, 0);
                p1 = __builtin_amdgcn_mfma_f32_32x32x16_bf16(a1, qf[ds], p1, 0, 0, 0);
                if ((ds & 3) == 3) __builtin_amdgcn_sched_barrier(0);
            }
            float mx = fmaxf(p0[0], p1[0]);
#pragma unroll
            for (int r = 1; r < 16; ++r) mx = fmaxf(mx, fmaxf(p0[r], p1[r]));
            mx = fmaxf(mx, __shfl_xor(mx, 32));
            if (!__all(mx - m <= THR)) {
                const float mn = fmaxf(m, mx), alpha = __builtin_amdgcn_exp2f(m - mn);
                m = mn; l *= alpha; o[0] = o[0] * alpha; o[1] = o[1] * alpha;
            }
            float rs = 0.f;
#pragma unroll
            for (int r = 0; r < 16; ++r) { p0[r] = __builtin_amdgcn_exp2f(p0[r] - m); p1[r] = __builtin_amdgcn_exp2f(p1[r] - m); rs += p0[r] + p1[r]; }
            l += rs;
            bf16x8 pf[4];
#pragma unroll
            for (int s = 0; s < 2; ++s) {
                u32x4 w0, w1;
                w0.x = cvt_pk(p0[8 * s + 0], p0[8 * s + 1]); w0.y = cvt_pk(p0[8 * s + 2], p0[8 * s + 3]); w0.z = cvt_pk(p0[8 * s + 4], p0[8 * s + 5]); w0.w = cvt_pk(p0[8 * s + 6], p0[8 * s + 7]);
                w1.x = cvt_pk(p1[8 * s + 0], p1[8 * s + 1]); w1.y = cvt_pk(p1[8 * s + 2], p1[8 * s + 3]); w1.z = cvt_pk(p1[8 * s + 4], p1[8 * s + 5]); w1.w = cvt_pk(p1[8 * s + 6], p1[8 * s + 7]);
                pf[s] = __builtin_bit_cast(bf16x8, w0); pf[2 + s] = __builtin_bit_cast(bf16x8, w1);
            }
            const XA_LAS unsigned char* Vt = lds + K_BYTES + vfrag;
#pragma unroll
            for (int d0 = 0; d0 < 2; ++d0)
#pragma unroll
                for (int ks = 0; ks < 4; ++ks) {
                    const s16x4 lo = vtr(Vt + (16 * ks) * VSTR + 64 * d0), hi = vtr(Vt + (16 * ks + 8) * VSTR + 64 * d0);
                    const bf16x8 av = (bf16x8){lo[0], lo[1], lo[2], lo[3], hi[0], hi[1], hi[2], hi[3]};
                    o[d0] = __builtin_amdgcn_mfma_f32_32x32x16_bf16(av, pf[ks], o[d0], 0, 0, 0);
                }
            __syncthreads();
        }
        l += __shfl_xor(l, 32);
        const float il = 1.f / l;
        bf16_t* orow = O + roff + 64 * dq + 4 * hh;
#pragma unroll
        for (int d0 = 0; d0 < 2; ++d0)
#pragma unroll
            for (int rq = 0; rq < 4; ++rq) {
                u32x2 w; w.x = cvt_pk(o[d0][4 * rq] * il, o[d0][4 * rq + 1] * il); w.y = cvt_pk(o[d0][4 * rq + 2] * il, o[d0][4 * rq + 3] * il);
                *(u32x2*)(orow + 32 * d0 + 8 * rq) = w;
            }
    }
}
}
namespace cg = cooperative_groups;
#ifndef PROBE_PHASE
#define PROBE_PHASE -1
#endif
#define REPEAT(k) for (int _rep = 0; _rep < ((k) == PROBE_PHASE ? 3 : 1); ++_rep)
#ifndef USE_MFMA_HGRN
#define USE_MFMA_HGRN 1
#endif
#ifndef USE_MFMA_XATTN
#define USE_MFMA_XATTN 1
#endif
#ifndef USE_MFMA_DATTN
#define USE_MFMA_DATTN 1
#endif
constexpr int NWAVES = 8;
constexpr int LDS_BYTES = 147456;
enum { PH_PROLOGUE = 0, PH_INPROJ, PH_HGRN, PH_HGRN_COMB, PH_DATTN, PH_DATTN_COMB, PH_MIXGEMM, PH_LN1, PH_QPROJ, PH_XA_SCORES, PH_XA_SOFTMAX, PH_XA_PV, PH_XA_CVT,
       PH_WOGEMM, PH_LN2, PH_TOPK, PH_MOE1, PH_MOE2, PH_FINAL, PH_COUNT };
constexpr int CW_BAR = 4096;
struct MKArgs { const float* in[27]; float* out; unsigned char* ws; int ph_lo, ph_hi; };

__global__ void __launch_bounds__(NWAVES * 64, 2) mk_fwd(MKArgs a) {
    extern __shared__ __attribute__((aligned(16))) unsigned char lds_raw[];
    PG8_LAS unsigned char* lds = (PG8_LAS unsigned char*)lds_raw;
    float* smem = (float*)lds_raw;
    unsigned char* ws = a.ws;
    const int G = gridDim.x, bx = blockIdx.x;
    const int vcu = (G % 8 == 0) ? (bx % 8) * (G / 8) + bx / 8 : bx;
    const int lo = a.ph_lo, hi = a.ph_hi;
#define IN(k) (lo <= (k) && (k) < hi)
#define SEAM(k) do { if (IN(k) && IN((k) + 1)) { if ((k) == PH_PROLOGUE) cg::this_grid().sync(); else xcd_barrier(bar); } } while (0)
    float* H = a.out;
    for (int u = threadIdx.x; u < (LDS_BYTES - 131072) / 4; u += NWAVES * 64) ((PG8_LAS unsigned*)(lds + 131072))[u] = 0u;
    __syncthreads();
    XcdBarrier bar; bar.bar = (unsigned*)(ws + WS_CTL) + CW_BAR; bar.x = 0; bar.st = nullptr;
    if (hi - lo > 1) bar = xcd_barrier_post((unsigned*)(ws + WS_CTL) + CW_BAR, (volatile LAS unsigned*)(lds + 131072 + 320) + 8);
    float* ROPE = (float*)(ws + WS_ROPE); float* LB = (float*)(ws + WS_LB); float* LAM = LB + 1024;
    float* AFF = (float*)(ws + WS_AFF); int* INV = (int*)(ws + WS_INV); int* IDX = (int*)(ws + WS_IDX); float* GATE = (float*)(ws + WS_GATE);
    bf16_t* XN = (bf16_t*)(ws + WS_XN); bf16_t* MIX = (bf16_t*)(ws + WS_MIX); bf16_t* U = (bf16_t*)(ws + WS_U); bf16_t* XS = (bf16_t*)(ws + WS_XS);
    bf16_t* KV = (bf16_t*)(ws + WS_KV); bf16_t* MEMB = (bf16_t*)(ws + WS_MEMB);
    float* SC_XS = (float*)(ws + WS_XS);
    bf16_t* P = XN;

    if (IN(PH_PROLOGUE)) REPEAT(PH_PROLOGUE) {
        sp_prep_small(a.in[5], a.in[7], a.in[8], a.in[9], a.in[10], ROPE, LB);
        tp_all(smem, a.in, ws, vcu, G);
        sp_cvt_bf16(a.in[1], MEMB, (long)NMEM * DM);
        sp_ln_rows<0>(a.in[0], a.in[2], a.in[3], H, XN, nullptr, nullptr);
    }
    SEAM(PH_PROLOGUE);
    if (IN(PH_INPROJ)) REPEAT(PH_INPROJ) {
        {
            pg8::Gemm g{XN, (const bf16_t*)(ws + WS_WIN), NTOK, NU, DM}; pg8::StaticOrder S; S.init(NTOK, NU, G, bx);
            pg8::EpiStore E{U, NU, 1.f, 1, ROPE};
            pg8::gemm_phase<pg8::EpiStore, pg8::StaticOrder, true, true>(lds, g, S, E);
        }
        {
            pg8::Gemm g{MEMB, (const bf16_t*)(ws + WS_WKV), NMEM, 2048, DM}; pg8::StaticOrder S; S.init(NMEM, 2048, G, bx);
            pg8::EpiStore E{KV, 2048, 1.f, 0, nullptr};
            pg8::gemm_phase<pg8::EpiStore, pg8::StaticOrder, true, true>(lds, g, S, E);
        }
    }
    SEAM(PH_INPROJ);
#if USE_MFMA_HGRN
    if (IN(PH_HGRN)) REPEAT(PH_HGRN) hg::hgrn_phase(lds, U, LB, SC_XS, vcu, G);
#else
    if (IN(PH_HGRN)) REPEAT(PH_HGRN) sp_hgrn(smem, U, LB, SC_XS);
#endif
    SEAM(PH_HGRN);
    if (IN(PH_HGRN_COMB)) REPEAT(PH_HGRN_COMB) sp_hgrn_combine(SC_XS, U, a.in[6], MIX);
    SEAM(PH_HGRN_COMB);
#if USE_MFMA_DATTN
    if (IN(PH_DATTN)) REPEAT(PH_DATTN) da::dattn_phase(lds, U, LAM, a.in[11], MIX, vcu, G);
    SEAM(PH_DATTN);
    SEAM(PH_DATTN_COMB);
#else
    if (IN(PH_DATTN)) REPEAT(PH_DATTN) sp_dattn(smem, U, SC_XS);
    SEAM(PH_DATTN);
    if (IN(PH_DATTN_COMB)) sp_dattn_combine(SC_XS, LAM, a.in[11], MIX);
    SEAM(PH_DATTN_COMB);
#endif
    if (IN(PH_MIXGEMM)) {
        pg8::Gemm g{MIX, (const bf16_t*)(ws + WS_WMIX), NTOK, DM, DM}; pg8::StaticOrder S; S.init(NTOK, DM, G, bx);
        pg8::EpiResid E{H, ALPHA};
        pg8::gemm_phase<pg8::EpiResid, pg8::StaticOrder, true, true>(lds, g, S, E);
    }
    SEAM(PH_MIXGEMM);
    if (IN(PH_LN1)) sp_ln_rows<1>(nullptr, a.in[13], a.in[14], H, XN, nullptr, nullptr);
    SEAM(PH_LN1);
    if (IN(PH_QPROJ)) REPEAT(PH_QPROJ) {
        pg8::Gemm g{XN, (const bf16_t*)(ws + WS_WQ), NTOK, DM, DM}; pg8::StaticOrder S; S.init(NTOK, DM, G, bx);
        pg8::EpiStore E{MIX, DM, pg8::QSCALE_XA, 0, nullptr};
        pg8::gemm_phase<pg8::EpiStore, pg8::StaticOrder, true, true>(lds, g, S, E);
    }
    SEAM(PH_QPROJ);
#if USE_MFMA_XATTN
    if (IN(PH_XA_SCORES)) REPEAT(PH_XA_SCORES) xa::xattn_phase(lds, MIX, XN, KV, vcu, G);
    SEAM(PH_XA_SCORES); SEAM(PH_XA_SOFTMAX); SEAM(PH_XA_PV);
#else
    if (IN(PH_XA_SCORES)) REPEAT(PH_XA_SCORES)
        for (int b = 0; b < BATCH; ++b)
            sp_gemm(smem, MIX + (size_t)b * SEQ * DM, 256, DM, KV + (size_t)b * MEML * 2048, 256, 2048, 1, SC_XS + (size_t)b * 4 * SEQ * 256, (long)SEQ * 256, 256, SEQ, 256, 256, 4);
    SEAM(PH_XA_SCORES);
    if (IN(PH_XA_SOFTMAX)) sp_softmax256(SC_XS, P, (long)BATCH * 4 * SEQ);
    SEAM(PH_XA_SOFTMAX);
    if (IN(PH_XA_PV))
        for (int b = 0; b < BATCH; ++b)
            sp_gemm(smem, P + (size_t)b * 4 * SEQ * 256, (long)SEQ * 256, 256, KV + (size_t)b * MEML * 2048 + 1024, 256, 1, 2048, SC_XS + (size_t)b * SEQ * DM, 256, DM, SEQ, 256, 256, 4);
    SEAM(PH_XA_PV);
    if (IN(PH_XA_CVT)) sp_cvt2d(SC_XS, DM, MIX, DM, NTOK, DM);
#endif
    SEAM(PH_XA_CVT);
    if (IN(PH_WOGEMM)) {
        pg8::Gemm g{USE_MFMA_XATTN ? XN : MIX, (const bf16_t*)(ws + WS_WO), NTOK, DM, DM}; pg8::StaticOrder S; S.init(NTOK, DM, G, bx);
        pg8::EpiResid E{H, ALPHA};
        pg8::gemm_phase<pg8::EpiResid, pg8::StaticOrder, true, true>(lds, g, S, E);
    }
    SEAM(PH_WOGEMM);
    if (IN(PH_LN2)) sp_ln_rows<2>(nullptr, a.in[19], a.in[20], H, XN, a.in[21], AFF);
    SEAM(PH_LN2);
    if (IN(PH_TOPK)) REPEAT(PH_TOPK) sp_topk2(smem, AFF, XN, IDX, GATE, INV, XS);
    SEAM(PH_TOPK);
    if (IN(PH_MOE1)) REPEAT(PH_MOE1) {
        pg8::Gemm g{XS, (const bf16_t*)(ws + WS_WGU), NGRP * CAP, NEXP * 4096, DM}; pg8::MoeOrder<1> S{G, bx};
        pg8::EpiSwiglu E{U};
        pg8::gemm_phase<pg8::EpiSwiglu, pg8::MoeOrder<1>, true, true>(lds, g, S, E);
    }
    SEAM(PH_MOE1);
    if (IN(PH_MOE2)) REPEAT(PH_MOE2) {
        pg8::Gemm g{U, (const bf16_t*)(ws + WS_WD), NGRP * CAP, NEXP * DM, DFF}; pg8::MoeOrder<2> S{G, bx};
        pg8::EpiYGate E{XS, GATE};
        pg8::gemm_phase<pg8::EpiYGate, pg8::MoeOrder<2>, true, true>(lds, g, S, E);
    }
    SEAM(PH_MOE2);
    if (IN(PH_FINAL)) sp_final(H, XS, INV, a.in[25], a.in[26]);
#undef IN
#undef SEAM
}

#ifndef MK_PER_PHASE
#define MK_PER_PHASE 0
#endif
extern "C" void kernel_launch(void* const* d_in, const int* in_sizes, int n_in, void* d_out, int out_size, void* d_ws, size_t ws_size, hipStream_t stream) {
    if (n_in != 27 || out_size != NTOK * DM || ws_size < WS_END) { fprintf(stderr, "kernel_launch: unexpected shapes (n_in %d out %d ws %zu)\n", n_in, out_size, ws_size); return; }
    static int grid = 0;
    if (grid == 0) {
        int dev = 0, cus = 0, per_cu = 0;
        (void)hipGetDevice(&dev); (void)hipDeviceGetAttribute(&cus, hipDeviceAttributeMultiprocessorCount, dev);
        (void)hipFuncSetAttribute((const void*)mk_fwd, hipFuncAttributeMaxDynamicSharedMemorySize, LDS_BYTES);
        (void)hipOccupancyMaxActiveBlocksPerMultiprocessor(&per_cu, (const void*)mk_fwd, NWAVES * 64, LDS_BYTES);
        (void)hipGetLastError();
        if (per_cu < 1) { fprintf(stderr, "kernel_launch: occupancy query says %d blocks/CU\n", per_cu); per_cu = 1; }
        grid = cus;
    }
    MKArgs ka{};
    for (int i = 0; i < 27; ++i) ka.in[i] = (const float*)d_in[i];
    ka.out = (float*)d_out; ka.ws = (unsigned char*)d_ws;
#if MK_PER_PHASE
    for (int p = 0; p < PH_COUNT; ++p) { MKArgs k2 = ka; k2.ph_lo = p; k2.ph_hi = p + 1; hipLaunchKernelGGL(mk_fwd, dim3(grid), dim3(NWAVES * 64), LDS_BYTES, stream, k2); }
#else
    ka.ph_lo = 0; ka.ph_hi = PH_COUNT;
    (void)hipMemsetAsync((char*)d_ws + WS_CTL, 0, 65536, stream);
    void* args[] = {&ka};
    hipError_t e = hipLaunchCooperativeKernel((const void*)mk_fwd, dim3(grid), dim3(NWAVES * 64), args, LDS_BYTES, stream);
    if (e != hipSuccess) fprintf(stderr, "kernel_launch: cooperative launch failed: %s (grid %d)\n", hipGetErrorString(e), grid);
#endif
}
```

```cpp
#include <hip/hip_runtime.h>
#include <hip/hip_cooperative_groups.h>
#include <cstdint>
#include <cstdio>

typedef unsigned short bf16_t;

constexpr int BATCH = 8, SEQ = 2048, DM = 1024, NTOK = BATCH * SEQ;
constexpr int MEML = 256, NMEM = BATCH * MEML;
constexpr int NU = 4096;
constexpr int U_HQ = 0, U_HI = 512, U_HG = 1024, U_HFF = 1536, U_HFB = 2048, U_DQ = 2560, U_DK = 3072, U_DV = 3584;
constexpr int NEXP = 16, CAP = 256, DFF = 2048, NGRP = BATCH * NEXP;
constexpr float ALPHA = 1.189207115002721f;
constexpr float LN_EPS = 1e-5f, RMS_EPS = 1e-6f;
constexpr float LAMBDA_INIT = 0.2f;

constexpr size_t MiB = 1u << 20;
constexpr size_t WS_CTL = 0;
constexpr size_t WS_ROPE = 1 * MiB;
constexpr size_t WS_LB = WS_ROPE + 256 * 1024;
constexpr size_t WS_AFF = 2 * MiB;
constexpr size_t WS_INV = 3 * MiB;
constexpr size_t WS_IDX = 4 * MiB;
constexpr size_t WS_GATE = 4 * MiB + 512 * 1024;
constexpr size_t WS_WIN = 5 * MiB;
constexpr size_t WS_WKV = 13 * MiB;
constexpr size_t WS_WMIX = 17 * MiB;
constexpr size_t WS_WQ = 19 * MiB;
constexpr size_t WS_WO = 21 * MiB;
constexpr size_t WS_WGU = 23 * MiB;
constexpr size_t WS_WD = 151 * MiB;
constexpr size_t WS_U = 215 * MiB;
constexpr size_t WS_XN = 343 * MiB;
constexpr size_t WS_MIX = 375 * MiB;
constexpr size_t WS_KV = 407 * MiB;
constexpr size_t WS_XS = 415 * MiB;
constexpr size_t WS_MEMB = 479 * MiB;
constexpr size_t WS_END = 483 * MiB;

__device__ __forceinline__ unsigned f2bf(float f) { unsigned u = __builtin_bit_cast(unsigned, f); return (u + 0x7fffu + ((u >> 16) & 1u)) >> 16; }
__device__ __forceinline__ float bf2f(bf16_t b) { return __builtin_bit_cast(float, (unsigned)b << 16); }
__device__ __forceinline__ float wave_sum(float v) {
#pragma unroll
    for (int o = 1; o < 64; o <<= 1) v += __shfl_xor(v, o);
    return v;
}
__device__ __forceinline__ float silu_f(float x) { return x / (1.f + expf(-x)); }
__device__ __forceinline__ float sigmoid_f(float x) { return 1.f / (1.f + expf(-x)); }

#define VB_LOOP(NT, nvb, vb, valid, tid, sub) \
    for (int _r = 0, _sub = (int)threadIdx.x / (NT), tid = (int)threadIdx.x % (NT), sub = _sub, _pr = (int)gridDim.x * (512 / (NT)), _nr = ((nvb) + _pr - 1) / _pr, vb = 0, valid = 0; \
         _r < _nr && ((vb = (_r * (int)gridDim.x + (int)blockIdx.x) * (512 / (NT)) + _sub), (valid = vb < (nvb)), true); ++_r)

__device__ __forceinline__ void sp_prep_small(const float* lb_logits, const float* lq1, const float* lk1, const float* lq2, const float* lk2, float* rope, float* lb) {
    for (int i = blockIdx.x * 512 + threadIdx.x; i < SEQ * 8; i += gridDim.x * 512) {
        const int t = i / 8, j = i % 8;
        const float inv = (float)(1.0 / pow(500000.0, (double)j / 8.0));
        const float ang = (float)t * inv;
        rope[t * 16 + j] = (float)cos((double)ang);
        rope[t * 16 + 8 + j] = (float)sin((double)ang);
        if (i < 1024) {
            const int d = i / 512, c = i % 512;
            const float l0 = lb_logits[d * 1024 + c], l1 = lb_logits[d * 1024 + 512 + c];
            const float m = fmaxf(l0, l1); const float e0 = expf(l0 - m), e1 = expf(l1 - m);
            lb[i] = e0 / (e0 + e1);
        }
        if (i == 0) {
            float s1 = 0.f, s2 = 0.f;
            for (int k = 0; k < 64; ++k) { s1 += lq1[k] * lk1[k]; s2 += lq2[k] * lk2[k]; }
            lb[1024] = expf(s1) - expf(s2) + LAMBDA_INIT;
        }
    }
}
__device__ __forceinline__ void sp_transpose(float* smem, const float* W, int K, int N, bf16_t* WT, int mode, long src_zs, long dst_zs, int nz) {
    const int nbx = N / 32, nby = K / 32, nvb = nbx * nby * nz;
    VB_LOOP(256, nvb, vb, valid, tid, sub) {
        float* t = smem + sub * (32 * 33);
        const int z = vb / (nbx * nby), rem = vb % (nbx * nby), by = rem / nbx, bxx = rem % nbx;
        const float* Wz = W + (long)z * src_zs; bf16_t* WTz = WT + (long)z * dst_zs;
        const int k0 = by * 32, n0 = bxx * 32, tx = tid & 31, ty = tid >> 5;
        if (valid) for (int i = ty; i < 32; i += 8) t[i * 33 + tx] = Wz[(long)(k0 + i) * N + n0 + tx];
        __syncthreads();
        if (valid) for (int i = ty; i < 32; i += 8) {
            const int n = n0 + i; long r = n;
            if (mode == 1) r = (long)(n / 128) * 256 + (n % 128);
            if (mode == 2) r = (long)(n / 128) * 256 + 128 + (n % 128);
            WTz[r * K + k0 + tx] = (bf16_t)f2bf(t[tx * 33 + i]);
        }
        __syncthreads();
    }
}
__device__ __forceinline__ void sp_cvt_bf16(const float* src, bf16_t* dst, long n) {
    for (long i = (long)blockIdx.x * 512 + threadIdx.x; i < n; i += (long)gridDim.x * 512) dst[i] = (bf16_t)f2bf(src[i]);
}

template <int MODE>
__device__ __forceinline__ void sp_ln_rows(const float* X, const float* g, const float* b, float* H, bf16_t* XN, const float* wr, float* AFF) {
    const int lane = threadIdx.x & 63;
    for (int row = blockIdx.x * 8 + (threadIdx.x >> 6); row < NTOK; row += gridDim.x * 8) {
        float4 v[4]; float s = 0.f;
#pragma unroll
        for (int j = 0; j < 4; ++j) {
            const long off = (long)row * DM + 4 * lane + 256 * j;
            v[j] = (MODE == 0) ? *(const float4*)(X + off) : *(const float4*)(H + off);
            s += (v[j].x + v[j].y) + (v[j].z + v[j].w);
        }
        const float mean = wave_sum(s) * (1.f / DM); float s2 = 0.f;
#pragma unroll
        for (int j = 0; j < 4; ++j) { v[j].x -= mean; v[j].y -= mean; v[j].z -= mean; v[j].w -= mean; s2 += (v[j].x * v[j].x + v[j].y * v[j].y) + (v[j].z * v[j].z + v[j].w * v[j].w); }
        const float rstd = 1.f / sqrtf(wave_sum(s2) * (1.f / DM) + LN_EPS);
#pragma unroll
        for (int j = 0; j < 4; ++j) {
            const int c = 4 * lane + 256 * j; const float4 gg = *(const float4*)(g + c), bb = *(const float4*)(b + c);
            v[j].x = v[j].x * rstd * gg.x + bb.x; v[j].y = v[j].y * rstd * gg.y + bb.y; v[j].z = v[j].z * rstd * gg.z + bb.z; v[j].w = v[j].w * rstd * gg.w + bb.w;
            *(float4*)(H + (long)row * DM + c) = v[j];
            uint2 o; o.x = f2bf(v[j].x) | (f2bf(v[j].y) << 16); o.y = f2bf(v[j].z) | (f2bf(v[j].w) << 16);
            *(uint2*)(XN + (long)row * DM + c) = o;
        }
        if (MODE == 2) {
            float acc[16];
#pragma unroll
            for (int e = 0; e < 16; ++e) acc[e] = 0.f;
#pragma unroll
            for (int j = 0; j < 4; ++j) {
                const float vv[4] = {v[j].x, v[j].y, v[j].z, v[j].w};
#pragma unroll
                for (int i = 0; i < 4; ++i) {
                    const float4* w4 = (const float4*)(wr + (long)(4 * lane + 256 * j + i) * 16);
#pragma unroll
                    for (int q = 0; q < 4; ++q) { const float4 w = w4[q]; acc[4 * q] += vv[i] * w.x; acc[4 * q + 1] += vv[i] * w.y; acc[4 * q + 2] += vv[i] * w.z; acc[4 * q + 3] += vv[i] * w.w; }
                }
                __builtin_amdgcn_sched_barrier(0);
            }
            float m = -INFINITY;
#pragma unroll
            for (int e = 0; e < 16; ++e) { acc[e] = wave_sum(acc[e]); m = fmaxf(m, acc[e]); }
            float sum = 0.f;
#pragma unroll
            for (int e = 0; e < 16; ++e) { acc[e] = expf(acc[e] - m); sum += acc[e]; }
            if (lane == 0) {
#pragma unroll
                for (int q = 0; q < 4; ++q) *(float4*)(AFF + (long)row * 16 + 4 * q) = make_float4(acc[4 * q] / sum, acc[4 * q + 1] / sum, acc[4 * q + 2] / sum, acc[4 * q + 3] / sum);
            }
        }
    }
}

__device__ __forceinline__ void sp_gemm(float* smem, const bf16_t* A0, long sa_z, int lda, const bf16_t* B0, long sb_z, long sbn, long sbk, float* C0, long sc_z, int ldc, int M, int N, int K, int Z) {
    const int nbx = N / 64, nby = M / 64, nvb = nbx * nby * Z;
    VB_LOOP(256, nvb, vb, valid, tid, sub) {
        float* As = smem + sub * (2 * 16 * 65); float* Bs = As + 16 * 65;
        const int z = vb / (nbx * nby), rem = vb % (nbx * nby), by = rem / nbx, bxx = rem % nbx;
        const bf16_t* A = A0 + (long)z * sa_z; const bf16_t* B = B0 + (long)z * sb_z; float* C = C0 + (long)z * sc_z;
        const int m0 = by * 64, n0 = bxx * 64, tx = tid & 15, ty = tid >> 4;
        float acc[4][4];
#pragma unroll
        for (int i = 0; i < 4; ++i)
#pragma unroll
            for (int j = 0; j < 4; ++j) acc[i][j] = 0.f;
        for (int k0 = 0; k0 < K; k0 += 16) {
            if (valid) {
                for (int i = tid; i < 1024; i += 256) { const int m = i >> 4, k = i & 15; As[k * 65 + m] = bf2f(A[(long)(m0 + m) * lda + k0 + k]); }
                for (int i = tid; i < 1024; i += 256) { const int n = i >> 4, k = i & 15; Bs[k * 65 + n] = bf2f(B[(long)(n0 + n) * sbn + (long)(k0 + k) * sbk]); }
            }
            __syncthreads();
#pragma unroll
            for (int k = 0; k < 16; ++k) {
                float a[4], bb[4];
#pragma unroll
                for (int i = 0; i < 4; ++i) { a[i] = As[k * 65 + ty * 4 + i]; bb[i] = Bs[k * 65 + tx * 4 + i]; }
#pragma unroll
                for (int i = 0; i < 4; ++i)
#pragma unroll
                    for (int j = 0; j < 4; ++j) acc[i][j] += a[i] * bb[j];
            }
            __syncthreads();
        }
        if (valid) {
#pragma unroll
            for (int i = 0; i < 4; ++i)
#pragma unroll
                for (int j = 0; j < 4; ++j) C[(long)(m0 + ty * 4 + i) * ldc + n0 + tx * 4 + j] = acc[i][j];
        }
    }
}
__device__ __forceinline__ void sp_cvt2d(const float* SC, int ldsc, bf16_t* dst, int ldd, int rows, int cols) {
    const long n = (long)rows * cols;
    for (long i = (long)blockIdx.x * 512 + threadIdx.x; i < n; i += (long)gridDim.x * 512) { const int r = (int)(i / cols), c = (int)(i % cols); dst[(long)r * ldd + c] = (bf16_t)f2bf(SC[(long)r * ldsc + c]); }
}

__device__ __forceinline__ void sp_hgrn(float* smem, const bf16_t* U, const float* LB, float* OSC) {
    VB_LOOP(128, 8 * 4 * 16, vb, valid, k, sub) {
        float* red = smem + sub * 32;
        const int dvs = vb & 7, h = (vb >> 3) & 3, bz = vb >> 5, b = bz >> 1, dir = bz & 1;
        float S[16];
#pragma unroll
        for (int j = 0; j < 16; ++j) S[j] = 0.f;
        const float lbv = valid ? LB[dir * 512 + h * 128 + k] : 0.5f;
        for (int step = 0; step < SEQ; ++step) {
            const int t = dir ? (SEQ - 1 - step) : step; const long row = (long)(valid ? b : 0) * SEQ + t;
            const bf16_t* ur = U + row * NU;
            const float qv = bf2f(ur[U_HQ + h * 128 + k]);
            const float uf = bf2f(ur[(dir ? U_HFB : U_HFF) + h * 128 + k]);
            const float f = lbv + (1.f - lbv) * sigmoid_f(uf), kk = 1.f - f;
            float part[16];
#pragma unroll
            for (int j = 0; j < 16; ++j) { const float vv = bf2f(ur[U_HI + h * 128 + dvs * 16 + j]); S[j] = f * S[j] + kk * vv; part[j] = wave_sum(S[j] * qv); }
            if ((k & 63) == 0) {
#pragma unroll
                for (int j = 0; j < 16; ++j) red[(k >> 6) * 16 + j] = part[j];
            }
            __syncthreads();
            if (valid && k < 16) OSC[((long)dir * NTOK + row) * 512 + h * 128 + dvs * 16 + k] = red[k] + red[16 + k];
            __syncthreads();
        }
    }
}
__device__ __forceinline__ void sp_hgrn_combine(const float* OSC, const bf16_t* U, const float* ng, bf16_t* MIX) {
    const int lane = threadIdx.x & 63;
    for (long w = (long)blockIdx.x * 8 + (threadIdx.x >> 6); w < (long)NTOK * 4; w += (long)gridDim.x * 8) {
        const long row = w >> 2; const int h = (int)(w & 3);
        float o[2]; float ss = 0.f;
#pragma unroll
        for (int i = 0; i < 2; ++i) { const int d = lane + 64 * i; o[i] = OSC[row * 512 + h * 128 + d] + OSC[((long)NTOK + row) * 512 + h * 128 + d]; ss += o[i] * o[i]; }
        const float r = 1.f / sqrtf(wave_sum(ss) * (1.f / 128.f) + RMS_EPS);
#pragma unroll
        for (int i = 0; i < 2; ++i) { const int d = lane + 64 * i; const float y = o[i] * r * ng[h * 128 + d] * bf2f(U[row * NU + U_HG + h * 128 + d]); MIX[row * DM + h * 128 + d] = (bf16_t)f2bf(y); }
    }
}

__device__ __forceinline__ void sp_dattn(float* smem, const bf16_t* U, float* OSC) {
    VB_LOOP(256, 32 * 8 * 8, vb, valid, tid, sub) {
        float* Ks = smem + sub * (16 * 64 + 16 * 128); float* Vs = Ks + 16 * 64;
        const int qb = vb & 31, g = (vb >> 5) & 7, b = valid ? (vb >> 8) : 0, h = g >> 1, r = tid & 63, qt = tid >> 6;
        const long row = (long)b * SEQ + qb * 64 + r;
        float q[64], o[32];
#pragma unroll
        for (int d = 0; d < 64; ++d) q[d] = bf2f(U[row * NU + U_DQ + g * 64 + d]);
#pragma unroll
        for (int d = 0; d < 32; ++d) o[d] = 0.f;
        float m = -INFINITY, l = 0.f;
        for (int k0 = 0; k0 < SEQ; k0 += 16) {
            for (int i = tid; i < 16 * 64; i += 256) { const int kk = i >> 6, d = i & 63; Ks[kk * 64 + d] = bf2f(U[((long)b * SEQ + k0 + kk) * NU + U_DK + g * 64 + d]); }
            for (int i = tid; i < 16 * 128; i += 256) { const int kk = i >> 7, d = i & 127; Vs[kk * 128 + d] = bf2f(U[((long)b * SEQ + k0 + kk) * NU + U_DV + h * 128 + d]); }
            __syncthreads();
            float s[16]; float tm = m;
#pragma unroll
            for (int kk = 0; kk < 16; ++kk) { float a = 0.f;
#pragma unroll
                for (int d = 0; d < 64; ++d) a += q[d] * Ks[kk * 64 + d];
                s[kk] = a; tm = fmaxf(tm, a); }
            const float corr = exp2f(m - tm); m = tm; l *= corr;
#pragma unroll
            for (int d = 0; d < 32; ++d) o[d] *= corr;
#pragma unroll
            for (int kk = 0; kk < 16; ++kk) { const float p = exp2f(s[kk] - m); l += p;
#pragma unroll
                for (int d = 0; d < 32; ++d) o[d] += p * Vs[kk * 128 + qt * 32 + d]; }
            __syncthreads();
        }
        const float il = 1.f / l;
        if (valid) {
#pragma unroll
            for (int d = 0; d < 32; ++d) OSC[(row * 8 + g) * 128 + qt * 32 + d] = o[d] * il;
        }
    }
}
__device__ __forceinline__ void sp_dattn_combine(const float* OSC, const float* lamp, const float* sg, bf16_t* MIX) {
    const int lane = threadIdx.x & 63; const float lam = lamp[0];
    for (long w = (long)blockIdx.x * 8 + (threadIdx.x >> 6); w < (long)NTOK * 4; w += (long)gridDim.x * 8) {
        const long row = w >> 2; const int h = (int)(w & 3);
        float o[2]; float ss = 0.f;
#pragma unroll
        for (int i = 0; i < 2; ++i) { const int d = lane + 64 * i; o[i] = OSC[(row * 8 + 2 * h) * 128 + d] - lam * OSC[(row * 8 + 2 * h + 1) * 128 + d]; ss += o[i] * o[i]; }
        const float r = 1.f / sqrtf(wave_sum(ss) * (1.f / 128.f) + RMS_EPS);
#pragma unroll
        for (int i = 0; i < 2; ++i) { const int d = lane + 64 * i; MIX[row * DM + 512 + h * 128 + d] = (bf16_t)f2bf(o[i] * r * sg[d] * (1.f - LAMBDA_INIT)); }
    }
}

__device__ __forceinline__ void sp_softmax256(const float* S, bf16_t* P, long nrows) {
    const int lane = threadIdx.x & 63;
    for (long row = (long)blockIdx.x * 8 + (threadIdx.x >> 6); row < nrows; row += (long)gridDim.x * 8) {
        float4 v = *(const float4*)(S + row * 256 + 4 * lane);
        float m = fmaxf(fmaxf(v.x, v.y), fmaxf(v.z, v.w));
#pragma unroll
        for (int o = 1; o < 64; o <<= 1) m = fmaxf(m, __shfl_xor(m, o));
        v.x = exp2f(v.x - m); v.y = exp2f(v.y - m); v.z = exp2f(v.z - m); v.w = exp2f(v.w - m);
        const float il = 1.f / wave_sum((v.x + v.y) + (v.z + v.w));
        uint2 o; o.x = f2bf(v.x * il) | (f2bf(v.y * il) << 16); o.y = f2bf(v.z * il) | (f2bf(v.w * il) << 16);
        *(uint2*)(P + row * 256 + 4 * lane) = o;
    }
}

__device__ __forceinline__ void sp_topk_gather(float* smem, const float* AFF, const bf16_t* XN, int* IDX, float* GATE, int* INV, bf16_t* XS) {
    VB_LOOP(256, NGRP, grp, valid, tid, sub) {
        float* a = smem + sub * (SEQ + CAP); int* sel = (int*)(a + SEQ);
        const int b = valid ? (grp >> 4) : 0, e = grp & 15;
        for (int t = tid; t < SEQ; t += 256) a[t] = AFF[((long)b * SEQ + t) * 16 + e];
        __syncthreads();
        if (valid) for (int t = tid; t < SEQ; t += 256) {
            const float mine = a[t]; int rank = 0;
            for (int u = 0; u < SEQ; ++u) { const float x = a[u]; rank += (x > mine || (x == mine && u < t)) ? 1 : 0; }
            if (rank < CAP) { sel[rank] = t; IDX[grp * CAP + rank] = t; GATE[grp * CAP + rank] = mine; INV[((long)b * SEQ + t) * 16 + e] = rank; }
            else INV[((long)b * SEQ + t) * 16 + e] = -1;
        }
        __syncthreads();
        const int lane = tid & 63, wv = tid >> 6;
        if (valid) for (int r = wv; r < CAP; r += 4) {
            const uint4* src = (const uint4*)(XN + ((long)b * SEQ + sel[r]) * DM); uint4* dst = (uint4*)(XS + ((long)grp * CAP + r) * DM);
            dst[lane] = src[lane]; dst[lane + 64] = src[lane + 64];
        }
        __syncthreads();
    }
}

__device__ __forceinline__ void sp_final(float* H, const bf16_t* Y, const int* INV, const float* g, const float* b) {
    const int lane = threadIdx.x & 63;
    for (long row = (long)blockIdx.x * 8 + (threadIdx.x >> 6); row < NTOK; row += (long)gridDim.x * 8) {
        const int bt = (int)(row / SEQ);
        float4 v[4];
#pragma unroll
        for (int j = 0; j < 4; ++j) { const float4 h = *(const float4*)(H + row * DM + 4 * lane + 256 * j); v[j] = make_float4(ALPHA * h.x, ALPHA * h.y, ALPHA * h.z, ALPHA * h.w); }
        for (int e = 0; e < 16; ++e) {
            const int slot = INV[row * 16 + e];
            if (slot >= 0) {
                const bf16_t* yr = Y + ((long)(bt * 16 + e) * CAP + slot) * DM;
#pragma unroll
                for (int j = 0; j < 4; ++j) { const uint2 p = *(const uint2*)(yr + 4 * lane + 256 * j);
                    v[j].x += bf2f((bf16_t)(p.x & 0xffff)); v[j].y += bf2f((bf16_t)(p.x >> 16)); v[j].z += bf2f((bf16_t)(p.y & 0xffff)); v[j].w += bf2f((bf16_t)(p.y >> 16)); }
            }
        }
        float s = 0.f;
#pragma unroll
        for (int j = 0; j < 4; ++j) s += (v[j].x + v[j].y) + (v[j].z + v[j].w);
        const float mean = wave_sum(s) * (1.f / DM); float s2 = 0.f;
#pragma unroll
        for (int j = 0; j < 4; ++j) { v[j].x -= mean; v[j].y -= mean; v[j].z -= mean; v[j].w -= mean; s2 += (v[j].x * v[j].x + v[j].y * v[j].y) + (v[j].z * v[j].z + v[j].w * v[j].w); }
        const float rstd = 1.f / sqrtf(wave_sum(s2) * (1.f / DM) + LN_EPS);
#pragma unroll
        for (int j = 0; j < 4; ++j) {
            const int c = 4 * lane + 256 * j; const float4 gg = *(const float4*)(g + c), bb = *(const float4*)(b + c);
            float4 o; o.x = v[j].x * rstd * gg.x + bb.x; o.y = v[j].y * rstd * gg.y + bb.y; o.z = v[j].z * rstd * gg.z + bb.z; o.w = v[j].w * rstd * gg.w + bb.w;
            *(float4*)(H + row * DM + c) = o;
        }
    }
}

__device__ __forceinline__ void tp_item(const float* W, int K, int N, bf16_t* WT, long rbase, int k0, int n0, float* scr, int lane) {
#pragma unroll 8
    for (int i = 0; i < 32; ++i) { const int kk = 2 * i + (lane >> 5); scr[kk * 33 + (lane & 31)] = W[(size_t)(k0 + kk) * N + n0 + (lane & 31)]; }
    asm volatile("s_waitcnt lgkmcnt(0)" ::: "memory");
    const int c = lane & 7;
#pragma unroll
    for (int j = 0; j < 4; ++j) {
        const int n = (lane >> 3) + 8 * j; const float* s = scr + (8 * c) * 33 + n;
        uint4 o; o.x = f2bf(s[0]) | (f2bf(s[33]) << 16); o.y = f2bf(s[2 * 33]) | (f2bf(s[3 * 33]) << 16); o.z = f2bf(s[4 * 33]) | (f2bf(s[5 * 33]) << 16); o.w = f2bf(s[6 * 33]) | (f2bf(s[7 * 33]) << 16);
        *(uint4*)(WT + (size_t)(rbase + n) * K + k0 + 8 * c) = o;
    }
    asm volatile("s_waitcnt lgkmcnt(0)" ::: "memory");
}
__device__ __forceinline__ void tp_all(float* smem, const float* const* in, unsigned char* ws, int vcu, int G) {
    const int lane = threadIdx.x & 63, wave = threadIdx.x >> 6;
    float* scr = smem + wave * 4096;
    constexpr int I_IN = (DM / 64) * (NU / 32), I_SQ = (DM / 64) * (DM / 32), I_GU = (DM / 64) * (DFF / 32), I_D = (DFF / 64) * (DM / 32);
    constexpr int NIT = I_IN + 5 * I_SQ + NEXP * (2 * I_GU + I_D);
    for (int it = vcu * 8 + wave; it < NIT; it += G * 8) {
        int r = it;
        if (r < I_IN) { const int nb = NU / 32; tp_item(in[4], DM, NU, (bf16_t*)(ws + WS_WIN), 32 * (r % nb), 64 * (r / nb), 32 * (r % nb), scr, lane); continue; }
        r -= I_IN;
        if (r < 5 * I_SQ) {
            const int which = r / I_SQ, q = r % I_SQ, nb = DM / 32; const int k0 = 64 * (q / nb), n0 = 32 * (q % nb);
            const float* W = which == 0 ? in[16] : which == 1 ? in[17] : which == 2 ? in[12] : which == 3 ? in[15] : in[18];
            bf16_t* WT = which == 0 ? (bf16_t*)(ws + WS_WKV) : which == 1 ? (bf16_t*)(ws + WS_WKV) + (size_t)DM * DM : which == 2 ? (bf16_t*)(ws + WS_WMIX) : which == 3 ? (bf16_t*)(ws + WS_WQ) : (bf16_t*)(ws + WS_WO);
            tp_item(W, DM, DM, WT, n0, k0, n0, scr, lane); continue;
        }
        r -= 5 * I_SQ;
        const int e = r / (2 * I_GU + I_D); int q = r % (2 * I_GU + I_D);
        if (q < 2 * I_GU) {
            const int up = q / I_GU; q %= I_GU; const int nb = DFF / 32; const int k0 = 64 * (q / nb), n0 = 32 * (q % nb);
            tp_item((up ? in[23] : in[22]) + (size_t)e * DM * DFF, DM, DFF, (bf16_t*)(ws + WS_WGU) + (size_t)e * 2 * DFF * DM, (long)(n0 / 128) * 256 + (n0 % 128) + 128 * up, k0, n0, scr, lane);
        } else {
            q -= 2 * I_GU; const int nb = DM / 32; const int k0 = 64 * (q / nb), n0 = 32 * (q % nb);
            tp_item(in[24] + (size_t)e * DFF * DM, DFF, DM, (bf16_t*)(ws + WS_WD) + (size_t)e * DM * DFF, n0, k0, n0, scr, lane);
        }
    }
}

__device__ __forceinline__ void sp_topk2(float* smem, const float* AFF, const bf16_t* XN, int* IDX, float* GATE, int* INV, bf16_t* XS) {
    const int tid = threadIdx.x, lane = tid & 63, wave = tid >> 6;
    int* cnt = (int*)smem;
    int* wtot = (int*)smem + 16;
    int* sel = (int*)smem + 64;
    const unsigned long long lt_mask = (lane == 0) ? 0ull : (~0ull >> (64 - lane));
    for (int item = blockIdx.x; item < NGRP * 2; item += gridDim.x) {
        const int grp = item >> 1, half = item & 1, b = grp >> 4, e = grp & 15;
        unsigned key[4];
#pragma unroll
        for (int j = 0; j < 4; ++j) key[j] = __builtin_bit_cast(unsigned, AFF[((size_t)b * SEQ + 512 * j + tid) * 16 + e]);
        unsigned T = 0u;
        for (int bit = 31; bit >= 0; --bit) {
            const unsigned cand = T | (1u << bit);
            int c = 0;
#pragma unroll
            for (int j = 0; j < 4; ++j) c += __popcll(__ballot(key[j] >= cand));
            int* cb = cnt + ((bit & 1) << 3);
            if (lane == 0) cb[wave] = c;
            __syncthreads();
            int tot = 0;
#pragma unroll
            for (int w = 0; w < 8; ++w) tot += cb[w];
            if (tot >= CAP) T = cand;
        }
        unsigned long long bt[4], bg[4];
#pragma unroll
        for (int j = 0; j < 4; ++j) { bt[j] = __ballot(key[j] == T); bg[j] = __ballot(key[j] > T); }
        __syncthreads();
        if (lane == 0) {
#pragma unroll
            for (int j = 0; j < 4; ++j) { wtot[j * 8 + wave] = __popcll(bt[j]); wtot[32 + j * 8 + wave] = __popcll(bg[j]); }
        }
        __syncthreads();
        int n_gt = 0;
#pragma unroll
        for (int q = 0; q < 32; ++q) n_gt += wtot[32 + q];
        const int need = CAP - n_gt;
        unsigned long long bs[4];
#pragma unroll
        for (int j = 0; j < 4; ++j) {
            int tpre = 0;
            for (int q = 0; q < j * 8 + wave; ++q) tpre += wtot[q];
            const int trank = tpre + __popcll(bt[j] & lt_mask);
            const bool s = (key[j] > T) || (key[j] == T && trank < need);
            bs[j] = __ballot(s);
        }
        __syncthreads();
        if (lane == 0) {
#pragma unroll
            for (int j = 0; j < 4; ++j) wtot[j * 8 + wave] = __popcll(bs[j]);
        }
        __syncthreads();
#pragma unroll
        for (int j = 0; j < 4; ++j) {
            int spre = 0;
            for (int q = 0; q < j * 8 + wave; ++q) spre += wtot[q];
            const int slot = spre + __popcll(bs[j] & lt_mask);
            const bool s = (bs[j] >> lane) & 1ull;
            const int t = 512 * j + tid;
            if (s) sel[slot] = t;
            if (half == 0) {
                if (s) { IDX[grp * CAP + slot] = t; GATE[grp * CAP + slot] = __builtin_bit_cast(float, key[j]); }
                INV[((size_t)b * SEQ + t) * 16 + e] = s ? slot : -1;
            }
        }
        __syncthreads();
        for (int r = half * 128 + wave; r < half * 128 + 128; r += 8) {
            const uint4* src = (const uint4*)(XN + ((size_t)b * SEQ + sel[r]) * DM); uint4* dst = (uint4*)(XS + ((size_t)grp * CAP + r) * DM);
            dst[lane] = src[lane]; dst[lane + 64] = src[lane + 64];
        }
        __syncthreads();
    }
}
namespace pg8 {
#define PG8_LAS __attribute__((address_space(3)))
typedef unsigned short bf16_t;
typedef short bf16x8 __attribute__((ext_vector_type(8)));
typedef float f32x4 __attribute__((ext_vector_type(4)));
typedef unsigned u32x4 __attribute__((ext_vector_type(4)));
constexpr int BM = 256, BK = 64, HALF = 128, HTB = HALF * BK * 2  , STAGE_BYTES = 8 * HTB, NXCD = 8, WGM = 8;

__host__ __device__ __forceinline__ int lds_byte(int r, int c) { const int st = (r >> 4) * 2 + (c >> 5), rr = r & 15, cc = c & 31, ob = rr * 64 + cc * 2; return st * 1024 + (ob ^ (((ob >> 9) & 1) << 5)); }
__host__ __device__ __forceinline__ void stage_rc(int b, int& R, int& C) { const int st = b / 1024, sb = b % 1024, swz = sb ^ (((sb >> 9) & 1) << 5); R = (st >> 1) * 16 + swz / 64; C = (st & 1) * 32 + (swz % 64) / 2; }
__host__ __device__ __forceinline__ int perm32(int rho) { const int n = rho >> 4, i = rho & 15; return 8 * (i >> 2) + 4 * n + (i & 3); }

struct Unit { int pm, pn; };
struct Gemm { const bf16_t* A; const bf16_t* Bt; int M, N, K; };

struct StaticOrder {
    int nM, nN, nwg, G, c;
    __host__ __device__ void init(int M, int N, int G_, int c_) { nM = M / BM; nN = N / BM; nwg = nM * nN; G = G_; c = c_; }
    __host__ __device__ bool next(int i, Unit& u) const {
        const long L = (long)i * G + c; if (L >= nwg) return false;
        int wgid = (int)L; { const int q = nwg / NXCD, r = nwg % NXCD, xcd = wgid % NXCD, off = wgid / NXCD; wgid = (xcd < r ? xcd * (q + 1) : r * (q + 1) + (xcd - r) * q) + off; }
        const int nig = WGM * nN, gid = wgid / nig, fm = gid * WGM, gsz = (nM - fm) < WGM ? (nM - fm) : WGM;
        u.pm = fm + ((wgid % nig) % gsz); u.pn = (wgid % nig) / gsz; return true;
    }
    __device__ __forceinline__ void a_ready(const Unit&) const {}
    __device__ __forceinline__ void done(const Unit&) const {}
};

__device__ __forceinline__ unsigned cvt_pk_bf16(float lo, float hi) { unsigned r; asm volatile("v_cvt_pk_bf16_f32 %0, %1, %2" : "=v"(r) : "v"(lo), "v"(hi)); return r; }
typedef float f32x2 __attribute__((ext_vector_type(2)));
typedef unsigned u32x4 __attribute__((ext_vector_type(4)));
constexpr float QSCALE_DA = 0.125f * 1.4426950408889634f;
constexpr float QSCALE_XA = 0.0625f * 1.4426950408889634f;
__device__ __forceinline__ float silu_fast(float x) { return x * __builtin_amdgcn_rcpf(1.f + __builtin_amdgcn_exp2f(-1.4426950408889634f * x)); }

struct EpiStore {
    static constexpr bool PERM = true, AFTER_DRAIN = false;
    bf16_t* O; int ldc; float scale; int mode; const float* rope;
    __device__ __forceinline__ void operator()(const f32x4 (&acc)[2][2][4][2], const Unit& u, int wr, int wc, int fr, int fq) const {
        const int row0 = u.pm * BM + wr * 64 + fr, col0 = u.pn * BM + wc * 32 + 8 * fq;
        int op = 0; float sc = scale;
        if (mode == 1) { const int seg = u.pn >> 1; op = (seg == 0 || seg == 2) ? 1 : (seg == 5 ? 2 : (seg == 6 ? 3 : 0)); if (seg == 5) sc = QSCALE_DA; }
        const bool do_rope = (op >= 2) && !(wc & 1);
#pragma unroll
        for (int ai = 0; ai < 2; ++ai)
#pragma unroll
            for (int m = 0; m < 4; ++m) {
                const int row = row0 + ai * HALF + m * 16; bf16_t* rowp = O + (size_t)row * ldc + col0;
                f32x4 c0 = {1.f, 1.f, 1.f, 1.f}, c1 = c0, s0 = {0.f, 0.f, 0.f, 0.f}, s1 = s0;
                if (do_rope) { const float* rp = rope + (row & 2047) * 16; c0 = *(const f32x4*)rp; c1 = *(const f32x4*)(rp + 4); s0 = *(const f32x4*)(rp + 8); s1 = *(const f32x4*)(rp + 12);
                    if (fq == 0) { s0 = -s0; s1 = -s1; } else if (fq >= 2) { c0 = (f32x4){1.f, 1.f, 1.f, 1.f}; c1 = c0; s0 = (f32x4){0.f, 0.f, 0.f, 0.f}; s1 = s0; } }
#pragma unroll
                for (int bj = 0; bj < 2; ++bj) {
                    f32x4 v0 = acc[ai][bj][m][0], v1 = acc[ai][bj][m][1];
                    if (op == 1) {
#pragma unroll
                        for (int j = 0; j < 4; ++j) { v0[j] = silu_fast(v0[j]); v1[j] = silu_fast(v1[j]); }
                    }
                    if (do_rope) {
                        f32x4 p0, p1;
#pragma unroll
                        for (int j = 0; j < 4; ++j) { p0[j] = __shfl_xor(v0[j], 16); p1[j] = __shfl_xor(v1[j], 16); }
                        v0 = v0 * c0 + p0 * s0; v1 = v1 * c1 + p1 * s1;
                    }
                    v0 = v0 * sc; v1 = v1 * sc;
                    u32x4 w; w.x = cvt_pk_bf16(v0[0], v0[1]); w.y = cvt_pk_bf16(v0[2], v0[3]); w.z = cvt_pk_bf16(v1[0], v1[1]); w.w = cvt_pk_bf16(v1[2], v1[3]);
                    *(u32x4*)(rowp + bj * HALF) = w;
                }
            }
    }
};
struct EpiResid {
    static constexpr bool PERM = false, AFTER_DRAIN = false;
    float* H; float alpha;
    __device__ __forceinline__ void operator()(const f32x4 (&acc)[2][2][4][2], const Unit& u, int wr, int wc, int fr, int fq) const {
        const int row0 = u.pm * BM + wr * 64 + fr, col0 = u.pn * BM + wc * 32 + 4 * fq;
#pragma unroll
        for (int ai = 0; ai < 2; ++ai)
#pragma unroll
            for (int m = 0; m < 4; ++m) { float* rowp = H + (size_t)(row0 + ai * HALF + m * 16) * 1024 + col0;
#pragma unroll
                for (int bj = 0; bj < 2; ++bj)
#pragma unroll
                    for (int n = 0; n < 2; ++n) { f32x4* p = (f32x4*)(rowp + bj * HALF + n * 16); const f32x4 h = *p; *p = h * alpha + acc[ai][bj][m][n]; } }
    }
};
struct EpiSwiglu {
    static constexpr bool PERM = true, AFTER_DRAIN = false;
    bf16_t* ACT;
    __device__ __forceinline__ void operator()(const f32x4 (&acc)[2][2][4][2], const Unit& u, int wr, int wc, int fr, int fq) const {
        const int row0 = u.pm * BM + wr * 64 + fr, col0 = (u.pn & 15) * 128 + wc * 32 + 8 * fq;
#pragma unroll
        for (int ai = 0; ai < 2; ++ai)
#pragma unroll
            for (int m = 0; m < 4; ++m) {
                f32x4 v0 = acc[ai][0][m][0], v1 = acc[ai][0][m][1]; const f32x4 u0 = acc[ai][1][m][0], u1 = acc[ai][1][m][1];
#pragma unroll
                for (int j = 0; j < 4; ++j) { v0[j] = silu_fast(v0[j]) * u0[j]; v1[j] = silu_fast(v1[j]) * u1[j]; }
                u32x4 w; w.x = cvt_pk_bf16(v0[0], v0[1]); w.y = cvt_pk_bf16(v0[2], v0[3]); w.z = cvt_pk_bf16(v1[0], v1[1]); w.w = cvt_pk_bf16(v1[2], v1[3]);
                *(u32x4*)(ACT + (size_t)(row0 + ai * HALF + m * 16) * 2048 + col0) = w;
            }
    }
};
struct EpiYGate {
    static constexpr bool PERM = true, AFTER_DRAIN = false;
    bf16_t* Y; const float* GATE;
    __device__ __forceinline__ void operator()(const f32x4 (&acc)[2][2][4][2], const Unit& u, int wr, int wc, int fr, int fq) const {
        const int row0 = u.pm * BM + wr * 64 + fr, col0 = (u.pn & 3) * BM + wc * 32 + 8 * fq;
#pragma unroll
        for (int ai = 0; ai < 2; ++ai)
#pragma unroll
            for (int m = 0; m < 4; ++m) { const int row = row0 + ai * HALF + m * 16; const float gt = GATE[row]; bf16_t* rowp = Y + (size_t)row * 1024 + col0;
#pragma unroll
                for (int bj = 0; bj < 2; ++bj) { const f32x4 v0 = acc[ai][bj][m][0] * gt, v1 = acc[ai][bj][m][1] * gt;
                    u32x4 w; w.x = cvt_pk_bf16(v0[0], v0[1]); w.y = cvt_pk_bf16(v0[2], v0[3]); w.z = cvt_pk_bf16(v1[0], v1[1]); w.w = cvt_pk_bf16(v1[2], v1[3]);
                    *(u32x4*)(rowp + bj * HALF) = w; } }
    }
};
template <int WHICH> struct MoeOrder {
    int G, c;
    __device__ bool next(int i, Unit& u) const {
        constexpr int NWG = WHICH == 1 ? 2048 : 512;
        const int L = i * G + c; if (L >= NWG) return false;
        const int Ux = (G % 8 == 0 && NWG % 8 == 0) ? (L % 8) * (NWG / 8) + L / 8 : L;
        if (WHICH == 1) { const int e = Ux >> 7, jg = (Ux & 127) >> 5, b = (Ux & 31) >> 2, jj = Ux & 3; u.pm = b * 16 + e; u.pn = e * 16 + jg * 4 + jj; }
        else { const int e = Ux >> 5, b = (Ux & 31) >> 2, j = Ux & 3; u.pm = b * 16 + e; u.pn = e * 4 + j; }
        return true;
    }
    __device__ __forceinline__ void a_ready(const Unit&) const {}
    __device__ __forceinline__ void done(const Unit&) const {}
};
template <class Epi, class Sched, bool ALIGN_EPI = false, bool SP2 = false>
__device__ __forceinline__ void gemm_phase(PG8_LAS unsigned char* lds, const Gemm g, const Sched& S, const Epi& E) {
    int tid_ = threadIdx.x; asm volatile("" : "+v"(tid_));
    const int tid = tid_, wid = __builtin_amdgcn_readfirstlane(tid >> 6), lane = tid & 63, wr = wid >> 2, wc = wid & 3, fr = lane & 15, fq = lane >> 4;
    const int K = g.K, nt = K / BK;
    unsigned voffA[2], voffB[2];
#pragma unroll
    for (int i = 0; i < 2; ++i) { int R, C; stage_rc(tid * 16 + i * 8192, R, C); const int Rb = Epi::PERM ? ((R & ~31) + perm32(R & 31)) : R;
        voffA[i] = (unsigned)(R * K + C) * 2u; voffB[i] = (unsigned)(Rb * K + C) * 2u; }
    const size_t kstep = (size_t)(BK * 2);
    const size_t hstep = (size_t)HALF * K * 2;
    const size_t tstep = 2 * hstep;
    const unsigned ldsw = (unsigned)wid * 1024u;
    const int aoff = lds_byte(wr * 64 + fr, fq * 8), boff = lds_byte(wc * 32 + fr, fq * 8);
#define PG8_SA(b, h) (((b) * 2 + (h)) * HTB)
#define PG8_SB(b, h) ((4 + (b) * 2 + (h)) * HTB)
#define PG8_STAGE(bufoff, gbase, voff) do { _Pragma("unroll") for (int _i = 0; _i < 2; ++_i) \
        __builtin_amdgcn_global_load_lds((const unsigned*)((const char*)(gbase) + (voff)[_i]), (PG8_LAS unsigned*)(lds + (bufoff) + ldsw + _i * 8192), 16, 0, 0); } while (0)
#define PG8_LDA(dst, b, h) do { _Pragma("unroll") for (int m = 0; m < 4; ++m) _Pragma("unroll") for (int k = 0; k < 2; ++k) dst[m][k] = *(const PG8_LAS bf16x8*)(lds + PG8_SA(b, h) + aoff + m * 2048 + k * 1024); } while (0)
#define PG8_LDB(dst, b, h) do { _Pragma("unroll") for (int n = 0; n < 2; ++n) _Pragma("unroll") for (int k = 0; k < 2; ++k) dst[n][k] = *(const PG8_LAS bf16x8*)(lds + PG8_SB(b, h) + boff + n * 2048 + k * 1024); } while (0)
#define PG8_MMA(ai, bj, At, Bt) do { __builtin_amdgcn_s_setprio(1); _Pragma("unroll") for (int m = 0; m < 4; ++m) _Pragma("unroll") for (int n = 0; n < 2; ++n) _Pragma("unroll") for (int k = 0; k < 2; ++k) \
        acc[ai][bj][m][n] = __builtin_amdgcn_mfma_f32_16x16x32_bf16(Bt[n][k], At[m][k], acc[ai][bj][m][n], 0, 0, 0); __builtin_amdgcn_s_setprio(0); } while (0)
#define PG8_WAIT_V(n) asm volatile("s_waitcnt vmcnt(" #n ")" ::: "memory")
#define PG8_WAIT_L(n) asm volatile("s_waitcnt lgkmcnt(" #n ")" ::: "memory")
#define PG8_BAR __builtin_amdgcn_s_barrier()
#define PG8_SCHED __builtin_amdgcn_sched_barrier(0)
    Unit cur, nxt; int ui = 0;
    if (!S.next(0, cur)) return;
    f32x4 acc[2][2][4][2];
#pragma unroll
    for (int a = 0; a < 2; ++a)
#pragma unroll
        for (int b = 0; b < 2; ++b)
#pragma unroll
            for (int m = 0; m < 4; ++m)
#pragma unroll
                for (int n = 0; n < 2; ++n) acc[a][b][m][n] = (f32x4){0.f, 0.f, 0.f, 0.f};
    bf16x8 At[4][2], B0[2][2], B1[2][2];
    const char* cA = (const char*)g.A + (size_t)cur.pm * tstep; const char* cB = (const char*)g.Bt + (size_t)cur.pn * tstep;
    S.a_ready(cur);
    if constexpr (SP2) {
        PG8_STAGE(PG8_SB(0, 0), cB, voffB); PG8_STAGE(PG8_SB(0, 1), cB + hstep, voffB); PG8_STAGE(PG8_SA(0, 0), cA, voffA); PG8_STAGE(PG8_SA(0, 1), cA + hstep, voffA);
        if (wr == 1) PG8_BAR;
        PG8_WAIT_V(2); PG8_BAR;
        PG8_STAGE(PG8_SB(1, 0), cB + kstep, voffB); PG8_STAGE(PG8_SA(1, 0), cA + kstep, voffA); PG8_STAGE(PG8_SB(1, 1), cB + hstep + kstep, voffB);
        PG8_WAIT_V(6); PG8_BAR;
    } else {
        PG8_STAGE(PG8_SB(0, 0), cB, voffB); PG8_STAGE(PG8_SA(0, 0), cA, voffA); PG8_STAGE(PG8_SB(0, 1), cB + hstep, voffB); PG8_STAGE(PG8_SA(0, 1), cA + hstep, voffA);
        if (wr == 1) PG8_BAR;
        PG8_WAIT_V(4); PG8_BAR;
        PG8_STAGE(PG8_SB(1, 0), cB + kstep, voffB); PG8_STAGE(PG8_SA(1, 0), cA + kstep, voffA); PG8_STAGE(PG8_SB(1, 1), cB + hstep + kstep, voffB);
        PG8_WAIT_V(6); PG8_BAR;
    }
    for (;;) {
        const bool has_next = S.next(ui + 1, nxt);
        const char* nA = has_next ? (const char*)g.A + (size_t)nxt.pm * tstep : cA; const char* nB = has_next ? (const char*)g.Bt + (size_t)nxt.pn * tstep : cB;
        for (int t = 0; t < nt; t += 2) {
            const bool last = (t == nt - 2);
            const char* a1 = cA + (size_t)(t + 1) * kstep;
            const char* a2 = last ? nA : cA + (size_t)(t + 2) * kstep; const char* b2 = last ? nB : cB + (size_t)(t + 2) * kstep;
            const char* a3 = a2 + kstep; const char* b3 = b2 + kstep;
            if (last && has_next) S.a_ready(nxt);
            if constexpr (SP2) {
            PG8_LDB(B0, 0, 0); PG8_LDB(B1, 0, 1); PG8_SCHED; PG8_LDA(At, 0, 0); PG8_STAGE(PG8_SA(1, 1), a1 + hstep, voffA);
            PG8_WAIT_V(8); PG8_WAIT_L(0); PG8_BAR; PG8_MMA(0, 0, At, B0); PG8_MMA(0, 1, At, B1); PG8_BAR; PG8_SCHED;
            PG8_LDA(At, 0, 1); PG8_STAGE(PG8_SB(0, 0), b2, voffB); PG8_STAGE(PG8_SB(0, 1), b2 + hstep, voffB); PG8_STAGE(PG8_SA(0, 0), a2, voffA);
            PG8_WAIT_V(8); PG8_WAIT_L(0); PG8_BAR; PG8_MMA(1, 0, At, B0); PG8_MMA(1, 1, At, B1); PG8_BAR; PG8_SCHED;
            PG8_LDB(B0, 1, 0); PG8_LDB(B1, 1, 1); PG8_SCHED; PG8_LDA(At, 1, 0); PG8_STAGE(PG8_SA(0, 1), a2 + hstep, voffA);
            PG8_WAIT_V(8); PG8_WAIT_L(0); PG8_BAR; PG8_MMA(0, 0, At, B0); PG8_MMA(0, 1, At, B1); PG8_BAR; PG8_SCHED;
            PG8_LDA(At, 1, 1); PG8_STAGE(PG8_SB(1, 0), b3, voffB); PG8_STAGE(PG8_SB(1, 1), b3 + hstep, voffB); PG8_STAGE(PG8_SA(1, 0), a3, voffA);
            PG8_WAIT_V(8); PG8_WAIT_L(0); PG8_BAR; PG8_MMA(1, 0, At, B0); PG8_MMA(1, 1, At, B1); PG8_BAR; PG8_SCHED;
            } else {
            PG8_LDB(B0, 0, 0); PG8_SCHED; PG8_LDA(At, 0, 0); PG8_STAGE(PG8_SA(1, 1), a1 + hstep, voffA);
            PG8_WAIT_L(8); PG8_BAR; PG8_WAIT_L(0); PG8_MMA(0, 0, At, B0); PG8_BAR; PG8_SCHED;
            PG8_LDB(B1, 0, 1); PG8_STAGE(PG8_SB(0, 0), b2, voffB);
            PG8_BAR; PG8_WAIT_L(0); PG8_MMA(0, 1, At, B1); PG8_BAR;
            PG8_LDA(At, 0, 1); PG8_STAGE(PG8_SA(0, 0), a2, voffA);
            PG8_BAR; PG8_WAIT_L(0); PG8_MMA(1, 0, At, B0); PG8_BAR; PG8_SCHED;
            PG8_STAGE(PG8_SB(0, 1), b2 + hstep, voffB);
            PG8_WAIT_V(6); PG8_BAR; PG8_MMA(1, 1, At, B1); PG8_BAR;
            PG8_LDB(B0, 1, 0); PG8_SCHED; PG8_LDA(At, 1, 0); PG8_STAGE(PG8_SA(0, 1), a2 + hstep, voffA);
            PG8_WAIT_L(8); PG8_BAR; PG8_WAIT_L(0); PG8_MMA(0, 0, At, B0); PG8_BAR; PG8_SCHED;
            PG8_LDB(B1, 1, 1); PG8_STAGE(PG8_SB(1, 0), b3, voffB);
            PG8_BAR; PG8_WAIT_L(0); PG8_MMA(0, 1, At, B1); PG8_BAR;
            PG8_LDA(At, 1, 1); PG8_STAGE(PG8_SA(1, 0), a3, voffA);
            PG8_BAR; PG8_WAIT_L(0); PG8_MMA(1, 0, At, B0); PG8_BAR; PG8_SCHED;
            PG8_STAGE(PG8_SB(1, 1), b3 + hstep, voffB);
            PG8_WAIT_V(6); PG8_BAR; PG8_MMA(1, 1, At, B1); PG8_BAR;
            }
        }
        if constexpr (ALIGN_EPI) { if (wr == 0) PG8_BAR; }
        if constexpr (!Epi::AFTER_DRAIN) { E(acc, cur, wr, wc, fr, fq); S.done(cur); }
        if (!has_next) break;
#pragma unroll
        for (int a = 0; a < 2; ++a)
#pragma unroll
            for (int b = 0; b < 2; ++b)
#pragma unroll
                for (int m = 0; m < 4; ++m)
#pragma unroll
                    for (int n = 0; n < 2; ++n) acc[a][b][m][n] = (f32x4){0.f, 0.f, 0.f, 0.f};
        cur = nxt; cA = nA; cB = nB; ++ui;
        if constexpr (ALIGN_EPI) { if (wr == 1) PG8_BAR; }
    }
    PG8_WAIT_V(0);
    if constexpr (!ALIGN_EPI) { if (wr == 0) PG8_BAR; }
    PG8_BAR;
    if constexpr (Epi::AFTER_DRAIN) { E.fused(acc, cur, wr, wc, fr, fq, lds, wid, lane); S.done(cur); }
#undef PG8_SA
#undef PG8_SB
#undef PG8_STAGE
#undef PG8_LDA
#undef PG8_LDB
#undef PG8_MMA
#undef PG8_WAIT_V
#undef PG8_WAIT_L
#undef PG8_BAR
#undef PG8_SCHED
}
}
#define LAS __attribute__((address_space(3)))
#define XB_TMO      128
#define XB_XCNT(j)  (256  + 64 * (j))
#define XB_XSUB(j)  (1280 + 64 * (j))
#define XB_XGEN(j)  (2304 + 64 * (j))
#define XB_TOP      3328
#define XB_TOPGEN   3392
#define XCD_BAR_WORDS 3456
#define XB_SPIN_CAP (1u << 18)

__device__ __forceinline__ unsigned xb_ld(unsigned* p)              { return __hip_atomic_load(p, __ATOMIC_RELAXED, __HIP_MEMORY_SCOPE_AGENT); }
__device__ __forceinline__ unsigned xb_add(unsigned* p, unsigned v) { return __hip_atomic_fetch_add(p, v, __ATOMIC_RELAXED, __HIP_MEMORY_SCOPE_AGENT); }
__device__ __forceinline__ unsigned xb_xcc_id() { return (unsigned)__builtin_amdgcn_s_getreg((3 << 11) | 20) & 0xFu; }
#define XB_SPIN(cond, bar) do { unsigned _sp = 0; while (cond) { __builtin_amdgcn_s_sleep(1); \
    if ((++_sp & 255u) == 0u) { if (xb_ld(&(bar)[XB_TMO])) break; if (_sp > XB_SPIN_CAP) { atomicAdd(&(bar)[XB_TMO], 1u); break; } } } } while (0)

struct XcdBarrier {
    unsigned* bar; unsigned x;
    volatile LAS unsigned* st;
};

__device__ __forceinline__ XcdBarrier xcd_barrier_post(unsigned* bar, volatile LAS unsigned* st) {
    XcdBarrier b; b.bar = bar; b.x = xb_xcc_id(); b.st = st;
    if (threadIdx.x == 0) (void)xb_add(&bar[XB_XCNT(b.x)], 1u);
    return b;
}
__device__ __forceinline__ void xcd_barrier_complete(unsigned* bar, unsigned x, unsigned& nloc, unsigned& nx) {
    const unsigned G = gridDim.x * gridDim.y * gridDim.z;
    unsigned sum, cnt, mine, sp = 0u;
    for (;;) {
        sum = 0u; cnt = 0u; mine = 0u;
#pragma unroll
        for (unsigned j = 0; j < 16; ++j) { const unsigned c = xb_ld(&bar[XB_XCNT(j)]); sum += c; cnt += (c > 0u) ? 1u : 0u; mine = (j == x) ? c : mine; }
        if (sum == G) break;
        __builtin_amdgcn_s_sleep(1);
        if ((++sp & 255u) == 0u) { if (xb_ld(&bar[XB_TMO])) break; if (sp > XB_SPIN_CAP) { atomicAdd(&bar[XB_TMO], 1u); break; } }
    }
    nloc = mine > 0u ? mine : 1u; nx = cnt > 0u ? cnt : 1u;
}

__device__ __forceinline__ void xcd_barrier(const XcdBarrier& b) {
    asm volatile("s_waitcnt vmcnt(0)" ::: "memory");
    __syncthreads();
    if (threadIdx.x == 0) {
        unsigned* bar = b.bar;
        __builtin_amdgcn_s_waitcnt(0);
        unsigned nloc = b.st[0], nx = b.st[1];
        if (nloc == 0u) { xcd_barrier_complete(bar, b.x, nloc, nx); b.st[0] = nloc; b.st[1] = nx; }
        const unsigned old = xb_add(&bar[XB_XSUB(b.x)], 1u);
        const unsigned gen = old / nloc;
        if (old + 1u == (gen + 1u) * nloc) {
            __builtin_amdgcn_fence(__ATOMIC_RELEASE, "agent");
            asm volatile("s_waitcnt vmcnt(0)" ::: "memory");
            const unsigned og = xb_add(&bar[XB_TOP], 1u);
            const unsigned tg = og / nx;
            if (og + 1u == (tg + 1u) * nx) xb_add(&bar[XB_TOPGEN], 1u);
            else XB_SPIN(xb_ld(&bar[XB_TOPGEN]) == tg, bar);
            __builtin_amdgcn_fence(__ATOMIC_ACQUIRE, "agent");
            xb_add(&bar[XB_XGEN(b.x)], 1u);
            asm volatile("s_waitcnt vmcnt(0)" ::: "memory");
        } else {
            XB_SPIN(xb_ld(&bar[XB_XGEN(b.x)]) == gen, bar);
            __builtin_amdgcn_fence(__ATOMIC_ACQUIRE, "agent");
            asm volatile("s_waitcnt vmcnt(0)" ::: "memory");
        }
    }
    __syncthreads();
}
namespace da {
#define DA_LAS __attribute__((address_space(3)))
typedef short bf16x8 __attribute__((ext_vector_type(8)));
typedef short s16x4 __attribute__((ext_vector_type(4)));
typedef float f32x16 __attribute__((ext_vector_type(16)));
typedef float f32x4 __attribute__((ext_vector_type(4)));
typedef unsigned u32x4 __attribute__((ext_vector_type(4)));
typedef unsigned u32x2 __attribute__((ext_vector_type(2)));
constexpr int KSTR = 144, VSTR = 320;
constexpr int K_BYTES = 64 * KSTR, V_BYTES = 64 * VSTR, STAGE = 2 * K_BYTES + V_BYTES;
constexpr float THR = 4.0f;
__device__ __forceinline__ unsigned cvt_pk(float lo, float hi) { unsigned r; asm volatile("v_cvt_pk_bf16_f32 %0, %1, %2" : "=v"(r) : "v"(lo), "v"(hi)); return r; }
__device__ __forceinline__ s16x4 vtr(const DA_LAS unsigned char* p) { typedef short v4i16_t __attribute__((ext_vector_type(4)));
    return __builtin_bit_cast(s16x4, __builtin_amdgcn_ds_read_tr16_b64_v4i16((DA_LAS v4i16_t*)p)); }

__device__ __forceinline__ void dattn_phase(DA_LAS unsigned char* lds, const bf16_t* U, const float* lamp, const float* subln_g, bf16_t* MIX, int vcu, int G) {
    int tid_ = threadIdx.x; asm volatile("" : "+v"(tid_));
    const int tid = tid_, lane = tid & 63, wave = __builtin_amdgcn_readfirstlane(tid >> 6), comp = wave >> 2, qs = wave & 3;
    const int r32 = lane & 31, hh = lane >> 5, gi = lane >> 4, li = lane & 15;
    const float lam = lamp[0];
    const int krow = tid >> 3, kch = tid & 7, vrow0 = tid >> 4, vch = tid & 15;
    const int kdst = krow * KSTR + kch * 16, vdst0 = vrow0 * VSTR + vch * 16, vdst1 = (vrow0 + 32) * VSTR + vch * 16;
    const int kfrag = r32 * KSTR + hh * 16;
    const int vfrag = (4 * hh + (li >> 2)) * VSTR + (16 * (gi & 1) + 4 * (li & 3)) * 2;
    for (int u = vcu; u < BATCH * 4 * 16; u += G) {
        const int qb = u & 15, h = (u >> 4) & 3, b = u >> 6;
        const bf16_t* Ub = U + (size_t)b * SEQ * NU;
        const bf16_t* ksrc0 = Ub + (size_t)krow * NU + U_DK + (2 * h) * 64 + kch * 8;
        const bf16_t* ksrc1 = ksrc0 + 64;
        const bf16_t* vsrc0 = Ub + (size_t)vrow0 * NU + U_DV + h * 128 + vch * 8;
        const bf16_t* vsrc1 = vsrc0 + (size_t)32 * NU;
        bf16x8 qf[4];
        { const bf16_t* qp = Ub + (size_t)(qb * 128 + qs * 32 + r32) * NU + U_DQ + (2 * h + comp) * 64 + hh * 8;
#pragma unroll
          for (int ds = 0; ds < 4; ++ds) qf[ds] = *(const bf16x8*)(qp + ds * 16); }
        f32x16 o[4];
#pragma unroll
        for (int d0 = 0; d0 < 4; ++d0)
#pragma unroll
            for (int r = 0; r < 16; ++r) o[d0][r] = 0.f;
        float m = -INFINITY, l = 0.f;
        u32x4 rk0 = *(const u32x4*)ksrc0, rk1 = *(const u32x4*)ksrc1, rv0 = *(const u32x4*)vsrc0, rv1 = *(const u32x4*)vsrc1;
        *(DA_LAS u32x4*)(lds + kdst) = rk0; *(DA_LAS u32x4*)(lds + K_BYTES + kdst) = rk1; *(DA_LAS u32x4*)(lds + 2 * K_BYTES + vdst0) = rv0; *(DA_LAS u32x4*)(lds + 2 * K_BYTES + vdst1) = rv1;
        __syncthreads();
        for (int t = 0; t < SEQ / 64; ++t) {
            const DA_LAS unsigned char* st = lds + (t & 1) * STAGE;
            DA_LAS unsigned char* nst = lds + ((t + 1) & 1) * STAGE;
            if (t + 1 < SEQ / 64) { const size_t go = (size_t)(t + 1) * 64 * NU; rk0 = *(const u32x4*)(ksrc0 + go); rk1 = *(const u32x4*)(ksrc1 + go); rv0 = *(const u32x4*)(vsrc0 + go); rv1 = *(const u32x4*)(vsrc1 + go); }
            const DA_LAS unsigned char* Kt = st + comp * K_BYTES + kfrag;
            f32x16 p0, p1;
#pragma unroll
            for (int r = 0; r < 16; ++r) { p0[r] = 0.f; p1[r] = 0.f; }
#pragma unroll
            for (int ds = 0; ds < 4; ++ds) {
                const bf16x8 a0 = *(const DA_LAS bf16x8*)(Kt + ds * 32), a1 = *(const DA_LAS bf16x8*)(Kt + 32 * KSTR + ds * 32);
                p0 = __builtin_amdgcn_mfma_f32_32x32x16_bf16(a0, qf[ds], p0, 0, 0, 0);
                p1 = __builtin_amdgcn_mfma_f32_32x32x16_bf16(a1, qf[ds], p1, 0, 0, 0);
            }
            float mx = fmaxf(p0[0], p1[0]);
#pragma unroll
            for (int r = 1; r < 16; ++r) mx = fmaxf(mx, fmaxf(p0[r], p1[r]));
            mx = fmaxf(mx, __shfl_xor(mx, 32));
            if (!__all(mx - m <= THR)) {
                const float mn = fmaxf(m, mx), alpha = __builtin_amdgcn_exp2f(m - mn);
                m = mn; l *= alpha;
#pragma unroll
                for (int d0 = 0; d0 < 4; ++d0) o[d0] = o[d0] * alpha;
            }
            float rs = 0.f;
#pragma unroll
            for (int r = 0; r < 16; ++r) { p0[r] = __builtin_amdgcn_exp2f(p0[r] - m); p1[r] = __builtin_amdgcn_exp2f(p1[r] - m); rs += p0[r] + p1[r]; }
            l += rs;
            bf16x8 pf[4];
#pragma unroll
            for (int s = 0; s < 2; ++s) {
                u32x4 w0, w1;
                w0.x = cvt_pk(p0[8 * s + 0], p0[8 * s + 1]); w0.y = cvt_pk(p0[8 * s + 2], p0[8 * s + 3]); w0.z = cvt_pk(p0[8 * s + 4], p0[8 * s + 5]); w0.w = cvt_pk(p0[8 * s + 6], p0[8 * s + 7]);
                w1.x = cvt_pk(p1[8 * s + 0], p1[8 * s + 1]); w1.y = cvt_pk(p1[8 * s + 2], p1[8 * s + 3]); w1.z = cvt_pk(p1[8 * s + 4], p1[8 * s + 5]); w1.w = cvt_pk(p1[8 * s + 6], p1[8 * s + 7]);
                pf[s] = __builtin_bit_cast(bf16x8, w0); pf[2 + s] = __builtin_bit_cast(bf16x8, w1);
            }
            const DA_LAS unsigned char* Vt = st + 2 * K_BYTES + vfrag;
#pragma unroll
            for (int d0 = 0; d0 < 4; ++d0)
#pragma unroll
                for (int ks = 0; ks < 4; ++ks) {
                    const s16x4 lo = vtr(Vt + (16 * ks) * VSTR + 64 * d0), hi = vtr(Vt + (16 * ks + 8) * VSTR + 64 * d0);
                    const bf16x8 av = (bf16x8){lo[0], lo[1], lo[2], lo[3], hi[0], hi[1], hi[2], hi[3]};
                    o[d0] = __builtin_amdgcn_mfma_f32_32x32x16_bf16(av, pf[ks], o[d0], 0, 0, 0);
                }
            if (t + 1 < SEQ / 64) { *(DA_LAS u32x4*)(nst + kdst) = rk0; *(DA_LAS u32x4*)(nst + K_BYTES + kdst) = rk1; *(DA_LAS u32x4*)(nst + 2 * K_BYTES + vdst0) = rv0; *(DA_LAS u32x4*)(nst + 2 * K_BYTES + vdst1) = rv1; }
            __syncthreads();
        }
        l += __shfl_xor(l, 32);
        const float il = 1.f / l;
        DA_LAS float* xch = (DA_LAS float*)lds + (size_t)qs * 64 * 64 + lane;
        if (comp == 1) {
#pragma unroll
            for (int d0 = 0; d0 < 4; ++d0)
#pragma unroll
                for (int r = 0; r < 16; ++r) xch[(d0 * 16 + r) * 64] = o[d0][r] * il;
        }
        __syncthreads();
        if (comp == 0) {
            float ss = 0.f;
#pragma unroll
            for (int d0 = 0; d0 < 4; ++d0)
#pragma unroll
                for (int r = 0; r < 16; ++r) { const float v = o[d0][r] * il - lam * xch[(d0 * 16 + r) * 64]; o[d0][r] = v; ss += v * v; }
            ss += __shfl_xor(ss, 32);
            const float rn = (1.f - LAMBDA_INIT) / sqrtf(ss * (1.f / 128.f) + RMS_EPS);
            bf16_t* orow = MIX + (size_t)(b * SEQ + qb * 128 + qs * 32 + r32) * DM + 512 + h * 128 + 4 * hh;
#pragma unroll
            for (int d0 = 0; d0 < 4; ++d0)
#pragma unroll
                for (int rq = 0; rq < 4; ++rq) {
                    const f32x4 g4 = *(const f32x4*)(subln_g + 32 * d0 + 8 * rq + 4 * hh);
                    u32x2 w; w.x = cvt_pk(o[d0][4 * rq] * rn * g4[0], o[d0][4 * rq + 1] * rn * g4[1]); w.y = cvt_pk(o[d0][4 * rq + 2] * rn * g4[2], o[d0][4 * rq + 3] * rn * g4[3]);
                    *(u32x2*)(orow + 32 * d0 + 8 * rq) = w;
                }
        }
        __syncthreads();
    }
}
}
namespace hg {
#define HG_LAS __attribute__((address_space(3)))
typedef short bf16x8 __attribute__((ext_vector_type(8)));
typedef short s16x4 __attribute__((ext_vector_type(4)));
typedef float f32x16 __attribute__((ext_vector_type(16)));
typedef float f32x4 __attribute__((ext_vector_type(4)));
typedef unsigned u32x4 __attribute__((ext_vector_type(4)));
typedef unsigned u32x2 __attribute__((ext_vector_type(2)));
typedef float f32x2 __attribute__((ext_vector_type(2)));
constexpr int RSTR = 272, TSTR = 320;
constexpr int L_QIN = 0, L_KIN = L_QIN + 64 * RSTR, L_KINT = L_KIN + 64 * RSTR, L_VT = L_KINT + 64 * TSTR, L_SBT = L_VT + 64 * TSTR, L_DEC = L_SBT + 128 * RSTR, L_SEGT = L_DEC + 512, L_END = L_SEGT + 8 * 128 * 4;
static_assert(L_END <= 131072, "hgrn LDS map");
constexpr float LOG2E = 1.4426950408889634f;
__device__ __forceinline__ unsigned cvt_pk(float lo, float hi) { unsigned r; asm volatile("v_cvt_pk_bf16_f32 %0, %1, %2" : "=v"(r) : "v"(lo), "v"(hi)); return r; }
__device__ __forceinline__ s16x4 vtr(const HG_LAS unsigned char* p) { typedef short v4i16_t __attribute__((ext_vector_type(4)));
    return __builtin_bit_cast(s16x4, __builtin_amdgcn_ds_read_tr16_b64_v4i16((HG_LAS v4i16_t*)p)); }
__device__ __forceinline__ float bflo(unsigned w) { return __builtin_bit_cast(float, w << 16); }
__device__ __forceinline__ float bfhi(unsigned w) { return __builtin_bit_cast(float, w & 0xffff0000u); }

__device__ __forceinline__ void hgrn_phase(HG_LAS unsigned char* lds, const bf16_t* U, const float* LB, float* OSC, int first, int stride) {
    int tid_ = threadIdx.x; asm volatile("" : "+v"(tid_));
    const int tid = tid_, lane = tid & 63, wave = __builtin_amdgcn_readfirstlane(tid >> 6);
    const int r32 = lane & 31, hh = lane >> 5, gi = lane >> 4, li = lane & 15;
    const int vt = wave >> 1, ct = wave & 1, kt = wave >> 1, vpair = wave & 1;
    const int kp = lane, seg = wave;
    const int vrow0 = tid >> 4, vch = tid & 15;
    const int trp = (li >> 2) * TSTR + (16 * (gi & 1) + 4 * (li & 3)) * 2;
    for (int item = first; item < BATCH * 4 * 2; item += stride) {
        const int dir = item & 1, h = (item >> 1) & 3, b = item >> 3;
        const bf16_t* Ub = U + (size_t)b * SEQ * NU;
        const int qcol = U_HQ + h * 128 + 2 * kp, fcol = (dir ? U_HFB : U_HFF) + h * 128 + 2 * kp, vcol = U_HI + h * 128 + vch * 8;
        const float lb0 = LB[dir * 512 + h * 128 + 2 * kp], lb1 = LB[dir * 512 + h * 128 + 2 * kp + 1];
        for (int i = tid; i < 128 * RSTR / 4; i += 512) ((HG_LAS unsigned*)(lds + L_SBT))[i] = 0u;
        f32x16 S[2];
#pragma unroll
        for (int r = 0; r < 16; ++r) { S[0][r] = 0.f; S[1][r] = 0.f; }
        unsigned rq[8], rf[8]; u32x4 rv0, rv1;
#define HG_TIME(p) (dir ? (SEQ - 1 - (p)) : (p))
#define HG_LOAD(n) do { _Pragma("unroll") for (int i = 0; i < 8; ++i) { const bf16_t* rp = Ub + (size_t)HG_TIME(64 * (n) + 8 * seg + i) * NU; rq[i] = *(const unsigned*)(rp + qcol); rf[i] = *(const unsigned*)(rp + fcol); } \
        rv0 = *(const u32x4*)(Ub + (size_t)HG_TIME(64 * (n) + vrow0) * NU + vcol); rv1 = *(const u32x4*)(Ub + (size_t)HG_TIME(64 * (n) + vrow0 + 32) * NU + vcol); } while (0)
        HG_LOAD(0);
        __syncthreads();
        for (int n = 0; n < SEQ / 64; ++n) {
            float c0[8], c1[8], k0[8], k1[8]; float a0 = 0.f, a1 = 0.f;
#pragma unroll
            for (int i = 0; i < 8; ++i) {
                const float u0 = bflo(rf[i]), u1 = bfhi(rf[i]);
                const float f0 = lb0 + (1.f - lb0) * __builtin_amdgcn_rcpf(1.f + __builtin_amdgcn_exp2f(-LOG2E * u0));
                const float f1 = lb1 + (1.f - lb1) * __builtin_amdgcn_rcpf(1.f + __builtin_amdgcn_exp2f(-LOG2E * u1));
                k0[i] = 1.f - f0; k1[i] = 1.f - f1;
                a0 += __builtin_amdgcn_logf(f0); a1 += __builtin_amdgcn_logf(f1);
                c0[i] = a0; c1[i] = a1;
            }
            *(HG_LAS f32x2*)(lds + L_SEGT + (seg * 128 + 2 * kp) * 4) = (f32x2){a0, a1};
            __syncthreads();
            float off0 = 0.f, off1 = 0.f, tot0 = 0.f, tot1 = 0.f;
#pragma unroll
            for (int s2 = 0; s2 < 8; ++s2) { const f32x2 tq = *(const HG_LAS f32x2*)(lds + L_SEGT + (s2 * 128 + 2 * kp) * 4); if (s2 < seg) { off0 += tq.x; off1 += tq.y; } tot0 += tq.x; tot1 += tq.y; }
            if (seg == 0) *(HG_LAS f32x2*)(lds + L_DEC + 2 * kp * 4) = (f32x2){__builtin_amdgcn_exp2f(tot0), __builtin_amdgcn_exp2f(tot1)};
#pragma unroll
            for (int i = 0; i < 8; ++i) {
                const int c = 8 * seg + i; const float b0 = off0 + c0[i], b1 = off1 + c1[i];
                const unsigned qi = cvt_pk(bflo(rq[i]) * __builtin_amdgcn_exp2f(b0), bfhi(rq[i]) * __builtin_amdgcn_exp2f(b1));
                const unsigned ki = cvt_pk(k0[i] * __builtin_amdgcn_exp2f(-b0), k1[i] * __builtin_amdgcn_exp2f(-b1));
                *(HG_LAS unsigned*)(lds + L_QIN + c * RSTR + 4 * kp) = qi;
                *(HG_LAS unsigned*)(lds + L_KIN + c * RSTR + 4 * kp) = ki;
                *(HG_LAS unsigned*)(lds + L_KINT + c * TSTR + 4 * kp) = ki;
            }
            *(HG_LAS u32x4*)(lds + L_VT + vrow0 * TSTR + vch * 16) = rv0; *(HG_LAS u32x4*)(lds + L_VT + (vrow0 + 32) * TSTR + vch * 16) = rv1;
            if (n + 1 < SEQ / 64) HG_LOAD(n + 1);
            __syncthreads();
            bf16x8 qfr[8];
#pragma unroll
            for (int ks = 0; ks < 8; ++ks) qfr[ks] = *(const HG_LAS bf16x8*)(lds + L_QIN + (32 * ct + r32) * RSTR + ks * 32 + hh * 16);
            f32x16 o;
#pragma unroll
            for (int r = 0; r < 16; ++r) o[r] = 0.f;
#pragma unroll
            for (int ks = 0; ks < 8; ++ks) {
                const bf16x8 as = *(const HG_LAS bf16x8*)(lds + L_SBT + (32 * vt + r32) * RSTR + ks * 32 + hh * 16);
                o = __builtin_amdgcn_mfma_f32_32x32x16_bf16(as, qfr[ks], o, 0, 0, 0);
            }
#pragma unroll
            for (int st = 0; st < 2; ++st) {
                if (st <= ct) {
                    f32x16 at;
#pragma unroll
                    for (int r = 0; r < 16; ++r) at[r] = 0.f;
#pragma unroll
                    for (int ks = 0; ks < 8; ++ks) {
                        const bf16x8 ak = *(const HG_LAS bf16x8*)(lds + L_KIN + (32 * st + r32) * RSTR + ks * 32 + hh * 16);
                        at = __builtin_amdgcn_mfma_f32_32x32x16_bf16(ak, qfr[ks], at, 0, 0, 0);
                    }
                    if (st == ct) {
#pragma unroll
                        for (int r = 0; r < 16; ++r) { const int srow = (r & 3) + 8 * (r >> 2) + 4 * hh; at[r] = (srow <= r32) ? at[r] : 0.f; }
                    }
#pragma unroll
                    for (int s2 = 0; s2 < 2; ++s2) {
                        u32x4 w; w.x = cvt_pk(at[8 * s2 + 0], at[8 * s2 + 1]); w.y = cvt_pk(at[8 * s2 + 2], at[8 * s2 + 3]); w.z = cvt_pk(at[8 * s2 + 4], at[8 * s2 + 5]); w.w = cvt_pk(at[8 * s2 + 6], at[8 * s2 + 7]);
                        const HG_LAS unsigned char* vp = lds + L_VT + (32 * st + 16 * s2 + 4 * hh) * TSTR + 64 * vt + trp;
                        const s16x4 lo = vtr(vp), hi = vtr(vp + 8 * TSTR);
                        const bf16x8 av = (bf16x8){lo[0], lo[1], lo[2], lo[3], hi[0], hi[1], hi[2], hi[3]};
                        o = __builtin_amdgcn_mfma_f32_32x32x16_bf16(av, __builtin_bit_cast(bf16x8, w), o, 0, 0, 0);
                    }
                }
            }
#pragma unroll
            for (int cs = 0; cs < 4; ++cs) {
                const HG_LAS unsigned char* kp_ = lds + L_KINT + (16 * cs + 8 * hh) * TSTR + 64 * kt + trp;
                const s16x4 klo = vtr(kp_), khi = vtr(kp_ + 4 * TSTR);
                const bf16x8 ak = (bf16x8){klo[0], klo[1], klo[2], klo[3], khi[0], khi[1], khi[2], khi[3]};
#pragma unroll
                for (int vv = 0; vv < 2; ++vv) {
                    const HG_LAS unsigned char* vp = lds + L_VT + (16 * cs + 8 * hh) * TSTR + 64 * (2 * vpair + vv) + trp;
                    const s16x4 vlo = vtr(vp), vhi = vtr(vp + 4 * TSTR);
                    const bf16x8 bv = (bf16x8){vlo[0], vlo[1], vlo[2], vlo[3], vhi[0], vhi[1], vhi[2], vhi[3]};
                    S[vv] = __builtin_amdgcn_mfma_f32_32x32x16_bf16(ak, bv, S[vv], 0, 0, 0);
                }
            }
#pragma unroll
            for (int rq4 = 0; rq4 < 4; ++rq4) {
                const f32x4 d4 = *(const HG_LAS f32x4*)(lds + L_DEC + (32 * kt + 8 * rq4 + 4 * hh) * 4);
#pragma unroll
                for (int j = 0; j < 4; ++j) { S[0][4 * rq4 + j] *= d4[j]; S[1][4 * rq4 + j] *= d4[j]; }
            }
            __syncthreads();
#pragma unroll
            for (int vv = 0; vv < 2; ++vv)
#pragma unroll
                for (int rq4 = 0; rq4 < 4; ++rq4) {
                    u32x2 w; w.x = cvt_pk(S[vv][4 * rq4], S[vv][4 * rq4 + 1]); w.y = cvt_pk(S[vv][4 * rq4 + 2], S[vv][4 * rq4 + 3]);
                    *(HG_LAS u32x2*)(lds + L_SBT + (32 * (2 * vpair + vv) + r32) * RSTR + (32 * kt + 8 * rq4 + 4 * hh) * 2) = w;
                }
            {
                const int tok = HG_TIME(64 * n + 32 * ct + r32);
                float* op = OSC + ((size_t)dir * NTOK + (size_t)b * SEQ + tok) * 512 + h * 128 + 32 * vt + 4 * hh;
#pragma unroll
                for (int rq4 = 0; rq4 < 4; ++rq4) *(f32x4*)(op + 8 * rq4) = (f32x4){o[4 * rq4], o[4 * rq4 + 1], o[4 * rq4 + 2], o[4 * rq4 + 3]};
            }
        }
        __syncthreads();
#undef HG_LOAD
#undef HG_TIME
    }
}
}
namespace xa {
#define XA_LAS __attribute__((address_space(3)))
typedef short bf16x8 __attribute__((ext_vector_type(8)));
typedef short s16x4 __attribute__((ext_vector_type(4)));
typedef float f32x16 __attribute__((ext_vector_type(16)));
typedef unsigned u32x4 __attribute__((ext_vector_type(4)));
typedef unsigned u32x2 __attribute__((ext_vector_type(2)));
constexpr int KSTR = 528, VSTR = 576;
constexpr int K_BYTES = 64 * KSTR, V_BYTES = 64 * VSTR;
constexpr float THR = 4.0f;
__device__ __forceinline__ unsigned cvt_pk(float lo, float hi) { unsigned r; asm volatile("v_cvt_pk_bf16_f32 %0, %1, %2" : "=v"(r) : "v"(lo), "v"(hi)); return r; }
__device__ __forceinline__ s16x4 vtr(const XA_LAS unsigned char* p) { typedef short v4i16_t __attribute__((ext_vector_type(4)));
    return __builtin_bit_cast(s16x4, __builtin_amdgcn_ds_read_tr16_b64_v4i16((XA_LAS v4i16_t*)p)); }

__device__ __forceinline__ void xattn_phase(XA_LAS unsigned char* lds, const bf16_t* Q, bf16_t* O, const bf16_t* KV, int vcu, int G) {
    int tid_ = threadIdx.x; asm volatile("" : "+v"(tid_));
    const int tid = tid_, lane = tid & 63, wave = __builtin_amdgcn_readfirstlane(tid >> 6), qs = wave >> 2, dq = wave & 3;
    const int r32 = lane & 31, hh = lane >> 5, gi = lane >> 4, li = lane & 15;
    const int srow = tid >> 5, sch = tid & 31;
    const int kfrag = r32 * KSTR + hh * 16;
    const int vfrag = (4 * hh + (li >> 2)) * VSTR + (16 * (gi & 1) + 4 * (li & 3)) * 2 + 128 * dq;
    for (int u = vcu; u < BATCH * 4 * 32; u += G) {
        const int qb = u & 31, h = (u >> 5) & 3, b = u >> 7;
        const bf16_t* ksrc = KV + (size_t)(b * MEML + srow) * 2048 + h * 256 + sch * 8;
        const bf16_t* vsrc = ksrc + 1024;
        const size_t roff = (size_t)(b * SEQ + qb * 64 + qs * 32 + r32) * DM + h * 256;
        const bf16_t* qrow = Q + roff;
        bf16x8 qf[16];
#pragma unroll
        for (int ds = 0; ds < 16; ++ds) qf[ds] = *(const bf16x8*)(qrow + ds * 16 + hh * 8);
        f32x16 o[2];
#pragma unroll
        for (int r = 0; r < 16; ++r) { o[0][r] = 0.f; o[1][r] = 0.f; }
        float m = -INFINITY, l = 0.f;
        u32x4 rk[4], rv[4];
#pragma unroll
        for (int i = 0; i < 4; ++i) { rk[i] = *(const u32x4*)(ksrc + (size_t)(16 * i) * 2048); rv[i] = *(const u32x4*)(vsrc + (size_t)(16 * i) * 2048); }
        for (int t = 0; t < MEML / 64; ++t) {
#pragma unroll
            for (int i = 0; i < 4; ++i) { *(XA_LAS u32x4*)(lds + (srow + 16 * i) * KSTR + sch * 16) = rk[i]; *(XA_LAS u32x4*)(lds + K_BYTES + (srow + 16 * i) * VSTR + sch * 16) = rv[i]; }
            if (t + 1 < MEML / 64) {
#pragma unroll
                for (int i = 0; i < 4; ++i) { rk[i] = *(const u32x4*)(ksrc + (size_t)(64 * (t + 1) + 16 * i) * 2048); rv[i] = *(const u32x4*)(vsrc + (size_t)(64 * (t + 1) + 16 * i) * 2048); }
            }
            __syncthreads();
            const XA_LAS unsigned char* Kt = lds + kfrag;
            f32x16 p0, p1;
#pragma unroll
            for (int r = 0; r < 16; ++r) { p0[r] = 0.f; p1[r] = 0.f; }
#pragma unroll
            for (int ds = 0; ds < 16; ++ds) {
                const bf16x8 a0 = *(const XA_LAS bf16x8*)(Kt + ds * 32), a1 = *(const XA_LAS bf16x8*)(Kt + 32 * KSTR + ds * 32);
                p0 = __builtin_amdgcn_mfma_f32_32x32x16_bf16(a0, qf[ds], p0, 0, 0, 0);
                p1 = __builtin_amdgcn_mfma_f32_32x32x16_bf16(a1, qf[ds], p1, 0, 0, 0);
                if ((ds & 3) == 3) __builtin_amdgcn_sched_barrier(0);
            }
            float mx = fmaxf(p0[0], p1[0]);
#pragma unroll
            for (int r = 1; r < 16; ++r) mx = fmaxf(mx, fmaxf(p0[r], p1[r]));
            mx = fmaxf(mx, __shfl_xor(mx, 32));
            if (!__all(mx - m <= THR)) {
                const float mn = fmaxf(m, mx), alpha = __builtin_amdgcn_exp2f(m - mn);
                m = mn; l *= alpha; o[0] = o[0] * alpha; o[1] = o[1] * alpha;
            }
            float rs = 0.f;
#pragma unroll
            for (int r = 0; r < 16; ++r) { p0[r] = __builtin_amdgcn_exp2f(p0[r] - m); p1[r] = __builtin_amdgcn_exp2f(p1[r] - m); rs += p0[r] + p1[r]; }
            l += rs;
            bf16x8 pf[4];
#pragma unroll
            for (int s = 0; s < 2; ++s) {
                u32x4 w0, w1;
                w0.x = cvt_pk(p0[8 * s + 0], p0[8 * s + 1]); w0.y = cvt_pk(p0[8 * s + 2], p0[8 * s + 3]); w0.z = cvt_pk(p0[8 * s + 4], p0[8 * s + 5]); w0.w = cvt_pk(p0[8 * s + 6], p0[8 * s + 7]);
                w1.x = cvt_pk(p1[8 * s + 0], p1[8 * s + 1]); w1.y = cvt_pk(p1[8 * s + 2], p1[8 * s + 3]); w1.z = cvt_pk(p1[8 * s + 4], p1[8 * s + 5]); w1.w = cvt_pk(p1[8 * s + 6], p1[8 * s + 7]);
                pf[s] = __builtin_bit_cast(bf16x8, w0); pf[2 + s] = __builtin_bit_cast(bf16x8, w1);
            }
            const XA_LAS unsigned char* Vt = lds + K_BYTES + vfrag;
#pragma unroll
            for (int d0 = 0; d0 < 2; ++d0)
#pragma unroll
                for (int ks = 0; ks < 4; ++ks) {
                    const s16x4 lo = vtr(Vt + (16 * ks) * VSTR + 64 * d0), hi = vtr(Vt + (16 * ks + 8) * VSTR + 64 * d0);
                    const bf16x8 av = (bf16x8){lo[0], lo[1], lo[2], lo[3], hi[0], hi[1], hi[2], hi[3]};
                    o[d0] = __builtin_amdgcn_mfma_f32_32x32x16_bf16(av, pf[ks], o[d0], 0, 0, 0);
                }
            __syncthreads();
        }
        l += __shfl_xor(l, 32);
        const float il = 1.f / l;
        bf16_t* orow = O + roff + 64 * dq + 4 * hh;
#pragma unroll
        for (int d0 = 0; d0 < 2; ++d0)
#pragma unroll
            for (int rq = 0; rq < 4; ++rq) {
                u32x2 w; w.x = cvt_pk(o[d0][4 * rq] * il, o[d0][4 * rq + 1] * il); w.y = cvt_pk(o[d0][4 * rq + 2] * il, o[d0][4 * rq + 3] * il);
                *(u32x2*)(orow + 32 * d0 + 8 * rq) = w;
            }
    }
}
}
namespace cg = cooperative_groups;
#ifndef PROBE_PHASE
#define PROBE_PHASE -1
#endif
#define REPEAT(k) for (int _rep = 0; _rep < ((k) == PROBE_PHASE ? 3 : 1); ++_rep)
constexpr int NWAVES = 8;
constexpr int LDS_BYTES = 147456;
enum { PH_PROLOGUE = 0, PH_INPROJ, PH_MIXER, PH_HGRN_COMB, PH_MIXGEMM, PH_LN1, PH_QPROJ, PH_XATTN, PH_WOGEMM, PH_LN2, PH_TOPK, PH_MOE1, PH_MOE2, PH_FINAL, PH_COUNT };
constexpr int CW_QUEUE = 0;
constexpr int CW_BAR = 4096;
struct MKArgs { const float* in[27]; float* out; unsigned char* ws; int ph_lo, ph_hi; };
struct OneUnit { int pm, pn; __device__ bool next(int i, pg8::Unit& u) const { if (i) return false; u.pm = pm; u.pn = pn; return true; }
    __device__ __forceinline__ void a_ready(const pg8::Unit&) const {} __device__ __forceinline__ void done(const pg8::Unit&) const {} };

__global__ void __launch_bounds__(NWAVES * 64, 2) mk_fwd(MKArgs a) {
    extern __shared__ __attribute__((aligned(16))) unsigned char lds_raw[];
    PG8_LAS unsigned char* lds = (PG8_LAS unsigned char*)lds_raw;
    float* smem = (float*)lds_raw;
    unsigned char* ws = a.ws;
    const int G = gridDim.x, bx = blockIdx.x;
    const int vcu = (G % 8 == 0) ? (bx % 8) * (G / 8) + bx / 8 : bx;
    const int lo = a.ph_lo, hi = a.ph_hi;
#define IN(k) (lo <= (k) && (k) < hi)
#define SEAM(k) do { if (IN(k) && IN((k) + 1)) { if ((k) == PH_PROLOGUE) cg::this_grid().sync(); else xcd_barrier(bar); } } while (0)
    float* H = a.out;
    for (int u = threadIdx.x; u < (LDS_BYTES - 131072) / 4; u += NWAVES * 64) ((PG8_LAS unsigned*)(lds + 131072))[u] = 0u;
    __syncthreads();
    XcdBarrier bar; bar.bar = (unsigned*)(ws + WS_CTL) + CW_BAR; bar.x = 0; bar.st = nullptr;
    if (hi - lo > 1) bar = xcd_barrier_post((unsigned*)(ws + WS_CTL) + CW_BAR, (volatile LAS unsigned*)(lds + 131072 + 320) + 8);
    float* ROPE = (float*)(ws + WS_ROPE); float* LB = (float*)(ws + WS_LB); float* LAM = LB + 1024;
    float* AFF = (float*)(ws + WS_AFF); int* INV = (int*)(ws + WS_INV); int* IDX = (int*)(ws + WS_IDX); float* GATE = (float*)(ws + WS_GATE);
    bf16_t* XN = (bf16_t*)(ws + WS_XN); bf16_t* MIX = (bf16_t*)(ws + WS_MIX); bf16_t* U = (bf16_t*)(ws + WS_U); bf16_t* XS = (bf16_t*)(ws + WS_XS);
    bf16_t* KV = (bf16_t*)(ws + WS_KV); bf16_t* MEMB = (bf16_t*)(ws + WS_MEMB);
    float* SC_XS = (float*)(ws + WS_XS);

    if (IN(PH_PROLOGUE)) REPEAT(PH_PROLOGUE) {
        sp_prep_small(a.in[5], a.in[7], a.in[8], a.in[9], a.in[10], ROPE, LB);
        tp_all(smem, a.in, ws, vcu, G);
        sp_cvt_bf16(a.in[1], MEMB, (long)NMEM * DM);
        sp_ln_rows<0>(a.in[0], a.in[2], a.in[3], H, XN, nullptr, nullptr);
    }
    SEAM(PH_PROLOGUE);
    if (IN(PH_INPROJ)) REPEAT(PH_INPROJ) {
        pg8::Gemm g{XN, (const bf16_t*)(ws + WS_WIN), NTOK, NU, DM}; pg8::StaticOrder S; S.init(NTOK, NU, G, bx);
        pg8::EpiStore E{U, NU, 1.f, 1, ROPE};
        pg8::gemm_phase<pg8::EpiStore, pg8::StaticOrder, true, true>(lds, g, S, E);
    }
    SEAM(PH_INPROJ);
    if (IN(PH_MIXER)) {
        unsigned* qhead = (unsigned*)(ws + WS_CTL) + CW_QUEUE;
        volatile PG8_LAS unsigned* qslot = (volatile PG8_LAS unsigned*)(lds + 131072 + 64);
        for (;;) {
            if (threadIdx.x == 0) qslot[0] = __hip_atomic_fetch_add(qhead, 1u, __ATOMIC_RELAXED, __HIP_MEMORY_SCOPE_AGENT);
            __syncthreads();
            const int item = (int)qslot[0];
            __syncthreads();
            if (item >= 640) break;
            if (item < 64) hg::hgrn_phase(lds, U, LB, SC_XS, item, 1 << 20);
            else if (item < 128) {
                pg8::Gemm g{MEMB, (const bf16_t*)(ws + WS_WKV), NMEM, 2048, DM}; OneUnit S{(item - 64) >> 3, (item - 64) & 7};
                pg8::EpiStore E{KV, 2048, 1.f, 0, nullptr};
                pg8::gemm_phase<pg8::EpiStore, OneUnit, true, true>(lds, g, S, E);
            } else da::dattn_phase(lds, U, LAM, a.in[11], MIX, item - 128, 1 << 20);
        }
    }
    SEAM(PH_MIXER);
    if (IN(PH_HGRN_COMB)) REPEAT(PH_HGRN_COMB) sp_hgrn_combine(SC_XS, U, a.in[6], MIX);
    SEAM(PH_HGRN_COMB);
    if (IN(PH_MIXGEMM)) {
        pg8::Gemm g{MIX, (const bf16_t*)(ws + WS_WMIX), NTOK, DM, DM}; pg8::StaticOrder S; S.init(NTOK, DM, G, bx);
        pg8::EpiResid E{H, ALPHA};
        pg8::gemm_phase<pg8::EpiResid, pg8::StaticOrder, true, true>(lds, g, S, E);
    }
    SEAM(PH_MIXGEMM);
    if (IN(PH_LN1)) sp_ln_rows<1>(nullptr, a.in[13], a.in[14], H, XN, nullptr, nullptr);
    SEAM(PH_LN1);
    if (IN(PH_QPROJ)) REPEAT(PH_QPROJ) {
        pg8::Gemm g{XN, (const bf16_t*)(ws + WS_WQ), NTOK, DM, DM}; pg8::StaticOrder S; S.init(NTOK, DM, G, bx);
        pg8::EpiStore E{MIX, DM, pg8::QSCALE_XA, 0, nullptr};
        pg8::gemm_phase<pg8::EpiStore, pg8::StaticOrder, true, true>(lds, g, S, E);
    }
    SEAM(PH_QPROJ);
    if (IN(PH_XATTN)) REPEAT(PH_XATTN) xa::xattn_phase(lds, MIX, XN, KV, vcu, G);
    SEAM(PH_XATTN);
    if (IN(PH_WOGEMM)) {
        pg8::Gemm g{XN, (const bf16_t*)(ws + WS_WO), NTOK, DM, DM}; pg8::StaticOrder S; S.init(NTOK, DM, G, bx);
        pg8::EpiResid E{H, ALPHA};
        pg8::gemm_phase<pg8::EpiResid, pg8::StaticOrder, true, true>(lds, g, S, E);
    }
    SEAM(PH_WOGEMM);
    if (IN(PH_LN2)) sp_ln_rows<2>(nullptr, a.in[19], a.in[20], H, XN, a.in[21], AFF);
    SEAM(PH_LN2);
    if (IN(PH_TOPK)) REPEAT(PH_TOPK) sp_topk2(smem, AFF, XN, IDX, GATE, INV, XS);
    SEAM(PH_TOPK);
    if (IN(PH_MOE1)) REPEAT(PH_MOE1) {
        pg8::Gemm g{XS, (const bf16_t*)(ws + WS_WGU), NGRP * CAP, NEXP * 4096, DM}; pg8::MoeOrder<1> S{G, bx};
        pg8::EpiSwiglu E{U};
        pg8::gemm_phase<pg8::EpiSwiglu, pg8::MoeOrder<1>, true, true>(lds, g, S, E);
    }
    SEAM(PH_MOE1);
    if (IN(PH_MOE2)) REPEAT(PH_MOE2) {
        pg8::Gemm g{U, (const bf16_t*)(ws + WS_WD), NGRP * CAP, NEXP * DM, DFF}; pg8::MoeOrder<2> S{G, bx};
        pg8::EpiYGate E{XS, GATE};
        pg8::gemm_phase<pg8::EpiYGate, pg8::MoeOrder<2>, true, true>(lds, g, S, E);
    }
    SEAM(PH_MOE2);
    if (IN(PH_FINAL)) sp_final(H, XS, INV, a.in[25], a.in[26]);
#undef IN
#undef SEAM
}

extern "C" void kernel_launch(void* const* d_in, const int* in_sizes, int n_in, void* d_out, int out_size, void* d_ws, size_t ws_size, hipStream_t stream) {
    if (n_in != 27 || out_size != NTOK * DM || ws_size < WS_END) { fprintf(stderr, "kernel_launch: unexpected shapes (n_in %d out %d ws %zu)\n", n_in, out_size, ws_size); return; }
    static int grid = 0;
    if (grid == 0) {
        int dev = 0, cus = 0, per_cu = 0;
        (void)hipGetDevice(&dev); (void)hipDeviceGetAttribute(&cus, hipDeviceAttributeMultiprocessorCount, dev);
        (void)hipFuncSetAttribute((const void*)mk_fwd, hipFuncAttributeMaxDynamicSharedMemorySize, LDS_BYTES);
        (void)hipOccupancyMaxActiveBlocksPerMultiprocessor(&per_cu, (const void*)mk_fwd, NWAVES * 64, LDS_BYTES);
        (void)hipGetLastError();
        if (per_cu < 1) { fprintf(stderr, "kernel_launch: occupancy query says %d blocks/CU\n", per_cu); per_cu = 1; }
        grid = cus;
    }
    MKArgs ka{};
    for (int i = 0; i < 27; ++i) ka.in[i] = (const float*)d_in[i];
    ka.out = (float*)d_out; ka.ws = (unsigned char*)d_ws;
    ka.ph_lo = 0; ka.ph_hi = PH_COUNT;
    (void)hipMemsetAsync((char*)d_ws + WS_CTL, 0, 65536, stream);
    void* args[] = {&ka};
    hipError_t e = hipLaunchCooperativeKernel((const void*)mk_fwd, dim3(grid), dim3(NWAVES * 64), args, LDS_BYTES, stream);
    if (e != hipSuccess) fprintf(stderr, "kernel_launch: cooperative launch failed: %s (grid %d)\n", hipGetErrorString(e), grid);
}
```

```cpp
#include <hip/hip_runtime.h>
#include <hip/hip_cooperative_groups.h>
#include <cstdint>
#include <cstdio>

typedef unsigned short bf16_t;

constexpr int BATCH = 8, SEQ = 2048, DM = 1024, NTOK = BATCH * SEQ;
constexpr int MEML = 256, NMEM = BATCH * MEML;
constexpr int NU = 4096;
constexpr int U_HQ = 0, U_HI = 512, U_HG = 1024, U_HFF = 1536, U_HFB = 2048, U_DQ = 2560, U_DK = 3072, U_DV = 3584;
constexpr int NEXP = 16, CAP = 256, DFF = 2048, NGRP = BATCH * NEXP;
constexpr float ALPHA = 1.189207115002721f;
constexpr float LN_EPS = 1e-5f, RMS_EPS = 1e-6f;
constexpr float LAMBDA_INIT = 0.2f;

constexpr size_t MiB = 1u << 20;
constexpr size_t WS_CTL = 0;
constexpr size_t WS_ROPE = 1 * MiB;
constexpr size_t WS_LB = WS_ROPE + 256 * 1024;
constexpr size_t WS_AFF = 2 * MiB;
constexpr size_t WS_INV = 3 * MiB;
constexpr size_t WS_IDX = 4 * MiB;
constexpr size_t WS_GATE = 4 * MiB + 512 * 1024;
constexpr size_t WS_WIN = 5 * MiB;
constexpr size_t WS_WKV = 13 * MiB;
constexpr size_t WS_WMIX = 17 * MiB;
constexpr size_t WS_WQ = 19 * MiB;
constexpr size_t WS_WO = 21 * MiB;
constexpr size_t WS_WGU = 23 * MiB;
constexpr size_t WS_WD = 151 * MiB;
constexpr size_t WS_U = 215 * MiB;
constexpr size_t WS_XN = 343 * MiB;
constexpr size_t WS_MIX = 375 * MiB;
constexpr size_t WS_KV = 407 * MiB;
constexpr size_t WS_XS = 415 * MiB;
constexpr size_t WS_MEMB = 479 * MiB;
constexpr size_t WS_END = 483 * MiB;

__device__ __forceinline__ unsigned f2bf(float f) { unsigned u = __builtin_bit_cast(unsigned, f); return (u + 0x7fffu + ((u >> 16) & 1u)) >> 16; }
__device__ __forceinline__ float bf2f(bf16_t b) { return __builtin_bit_cast(float, (unsigned)b << 16); }
__device__ __forceinline__ float wave_sum(float v) {
#pragma unroll
    for (int o = 1; o < 64; o <<= 1) v += __shfl_xor(v, o);
    return v;
}
__device__ __forceinline__ float silu_f(float x) { return x / (1.f + expf(-x)); }
__device__ __forceinline__ float sigmoid_f(float x) { return 1.f / (1.f + expf(-x)); }

#define VB_LOOP(NT, nvb, vb, valid, tid, sub) \
    for (int _r = 0, _sub = (int)threadIdx.x / (NT), tid = (int)threadIdx.x % (NT), sub = _sub, _pr = (int)gridDim.x * (512 / (NT)), _nr = ((nvb) + _pr - 1) / _pr, vb = 0, valid = 0; \
         _r < _nr && ((vb = (_r * (int)gridDim.x + (int)blockIdx.x) * (512 / (NT)) + _sub), (valid = vb < (nvb)), true); ++_r)

__device__ __forceinline__ void sp_prep_small(const float* lb_logits, const float* lq1, const float* lk1, const float* lq2, const float* lk2, float* rope, float* lb) {
    for (int i = blockIdx.x * 512 + threadIdx.x; i < SEQ * 8; i += gridDim.x * 512) {
        const int t = i / 8, j = i % 8;
        const float inv = (float)(1.0 / pow(500000.0, (double)j / 8.0));
        const float ang = (float)t * inv;
        rope[t * 16 + j] = (float)cos((double)ang);
        rope[t * 16 + 8 + j] = (float)sin((double)ang);
        if (i < 1024) {
            const int d = i / 512, c = i % 512;
            const float l0 = lb_logits[d * 1024 + c], l1 = lb_logits[d * 1024 + 512 + c];
            const float m = fmaxf(l0, l1); const float e0 = expf(l0 - m), e1 = expf(l1 - m);
            lb[i] = e0 / (e0 + e1);
        }
        if (i == 0) {
            float s1 = 0.f, s2 = 0.f;
            for (int k = 0; k < 64; ++k) { s1 += lq1[k] * lk1[k]; s2 += lq2[k] * lk2[k]; }
            lb[1024] = expf(s1) - expf(s2) + LAMBDA_INIT;
        }
    }
}
__device__ __forceinline__ void sp_transpose(float* smem, const float* W, int K, int N, bf16_t* WT, int mode, long src_zs, long dst_zs, int nz) {
    const int nbx = N / 32, nby = K / 32, nvb = nbx * nby * nz;
    VB_LOOP(256, nvb, vb, valid, tid, sub) {
        float* t = smem + sub * (32 * 33);
        const int z = vb / (nbx * nby), rem = vb % (nbx * nby), by = rem / nbx, bxx = rem % nbx;
        const float* Wz = W + (long)z * src_zs; bf16_t* WTz = WT + (long)z * dst_zs;
        const int k0 = by * 32, n0 = bxx * 32, tx = tid & 31, ty = tid >> 5;
        if (valid) for (int i = ty; i < 32; i += 8) t[i * 33 + tx] = Wz[(long)(k0 + i) * N + n0 + tx];
        __syncthreads();
        if (valid) for (int i = ty; i < 32; i += 8) {
            const int n = n0 + i; long r = n;
            if (mode == 1) r = (long)(n / 128) * 256 + (n % 128);
            if (mode == 2) r = (long)(n / 128) * 256 + 128 + (n % 128);
            WTz[r * K + k0 + tx] = (bf16_t)f2bf(t[tx * 33 + i]);
        }
        __syncthreads();
    }
}
__device__ __forceinline__ void sp_cvt_bf16(const float* src, bf16_t* dst, long n) {
    for (long i = (long)blockIdx.x * 512 + threadIdx.x; i < n; i += (long)gridDim.x * 512) dst[i] = (bf16_t)f2bf(src[i]);
}

template <int MODE>
__device__ __forceinline__ void sp_ln_rows(const float* X, const float* g, const float* b, float* H, bf16_t* XN, const float* wr, float* AFF) {
    const int lane = threadIdx.x & 63;
    for (int row = blockIdx.x * 8 + (threadIdx.x >> 6); row < NTOK; row += gridDim.x * 8) {
        float4 v[4]; float s = 0.f;
#pragma unroll
        for (int j = 0; j < 4; ++j) {
            const long off = (long)row * DM + 4 * lane + 256 * j;
            v[j] = (MODE == 0) ? *(const float4*)(X + off) : *(const float4*)(H + off);
            s += (v[j].x + v[j].y) + (v[j].z + v[j].w);
        }
        const float mean = wave_sum(s) * (1.f / DM); float s2 = 0.f;
#pragma unroll
        for (int j = 0; j < 4; ++j) { v[j].x -= mean; v[j].y -= mean; v[j].z -= mean; v[j].w -= mean; s2 += (v[j].x * v[j].x + v[j].y * v[j].y) + (v[j].z * v[j].z + v[j].w * v[j].w); }
        const float rstd = 1.f / sqrtf(wave_sum(s2) * (1.f / DM) + LN_EPS);
#pragma unroll
        for (int j = 0; j < 4; ++j) {
            const int c = 4 * lane + 256 * j; const float4 gg = *(const float4*)(g + c), bb = *(const float4*)(b + c);
            v[j].x = v[j].x * rstd * gg.x + bb.x; v[j].y = v[j].y * rstd * gg.y + bb.y; v[j].z = v[j].z * rstd * gg.z + bb.z; v[j].w = v[j].w * rstd * gg.w + bb.w;
            *(float4*)(H + (long)row * DM + c) = v[j];
            uint2 o; o.x = f2bf(v[j].x) | (f2bf(v[j].y) << 16); o.y = f2bf(v[j].z) | (f2bf(v[j].w) << 16);
            *(uint2*)(XN + (long)row * DM + c) = o;
        }
        if (MODE == 2) {
            float acc[16];
#pragma unroll
            for (int e = 0; e < 16; ++e) acc[e] = 0.f;
#pragma unroll
            for (int j = 0; j < 4; ++j) {
                const float vv[4] = {v[j].x, v[j].y, v[j].z, v[j].w};
#pragma unroll
                for (int i = 0; i < 4; ++i) {
                    const float4* w4 = (const float4*)(wr + (long)(4 * lane + 256 * j + i) * 16);
#pragma unroll
                    for (int q = 0; q < 4; ++q) { const float4 w = w4[q]; acc[4 * q] += vv[i] * w.x; acc[4 * q + 1] += vv[i] * w.y; acc[4 * q + 2] += vv[i] * w.z; acc[4 * q + 3] += vv[i] * w.w; }
                }
                __builtin_amdgcn_sched_barrier(0);
            }
            float m = -INFINITY;
#pragma unroll
            for (int e = 0; e < 16; ++e) { acc[e] = wave_sum(acc[e]); m = fmaxf(m, acc[e]); }
            float sum = 0.f;
#pragma unroll
            for (int e = 0; e < 16; ++e) { acc[e] = expf(acc[e] - m); sum += acc[e]; }
            if (lane == 0) {
#pragma unroll
                for (int q = 0; q < 4; ++q) *(float4*)(AFF + (long)row * 16 + 4 * q) = make_float4(acc[4 * q] / sum, acc[4 * q + 1] / sum, acc[4 * q + 2] / sum, acc[4 * q + 3] / sum);
            }
        }
    }
}

__device__ __forceinline__ void sp_gemm(float* smem, const bf16_t* A0, long sa_z, int lda, const bf16_t* B0, long sb_z, long sbn, long sbk, float* C0, long sc_z, int ldc, int M, int N, int K, int Z) {
    const int nbx = N / 64, nby = M / 64, nvb = nbx * nby * Z;
    VB_LOOP(256, nvb, vb, valid, tid, sub) {
        float* As = smem + sub * (2 * 16 * 65); float* Bs = As + 16 * 65;
        const int z = vb / (nbx * nby), rem = vb % (nbx * nby), by = rem / nbx, bxx = rem % nbx;
        const bf16_t* A = A0 + (long)z * sa_z; const bf16_t* B = B0 + (long)z * sb_z; float* C = C0 + (long)z * sc_z;
        const int m0 = by * 64, n0 = bxx * 64, tx = tid & 15, ty = tid >> 4;
        float acc[4][4];
#pragma unroll
        for (int i = 0; i < 4; ++i)
#pragma unroll
            for (int j = 0; j < 4; ++j) acc[i][j] = 0.f;
        for (int k0 = 0; k0 < K; k0 += 16) {
            if (valid) {
                for (int i = tid; i < 1024; i += 256) { const int m = i >> 4, k = i & 15; As[k * 65 + m] = bf2f(A[(long)(m0 + m) * lda + k0 + k]); }
                for (int i = tid; i < 1024; i += 256) { const int n = i >> 4, k = i & 15; Bs[k * 65 + n] = bf2f(B[(long)(n0 + n) * sbn + (long)(k0 + k) * sbk]); }
            }
            __syncthreads();
#pragma unroll
            for (int k = 0; k < 16; ++k) {
                float a[4], bb[4];
#pragma unroll
                for (int i = 0; i < 4; ++i) { a[i] = As[k * 65 + ty * 4 + i]; bb[i] = Bs[k * 65 + tx * 4 + i]; }
#pragma unroll
                for (int i = 0; i < 4; ++i)
#pragma unroll
                    for (int j = 0; j < 4; ++j) acc[i][j] += a[i] * bb[j];
            }
            __syncthreads();
        }
        if (valid) {
#pragma unroll
            for (int i = 0; i < 4; ++i)
#pragma unroll
                for (int j = 0; j < 4; ++j) C[(long)(m0 + ty * 4 + i) * ldc + n0 + tx * 4 + j] = acc[i][j];
        }
    }
}
__device__ __forceinline__ void sp_cvt2d(const float* SC, int ldsc, bf16_t* dst, int ldd, int rows, int cols) {
    const long n = (long)rows * cols;
    for (long i = (long)blockIdx.x * 512 + threadIdx.x; i < n; i += (long)gridDim.x * 512) { const int r = (int)(i / cols), c = (int)(i % cols); dst[(long)r * ldd + c] = (bf16_t)f2bf(SC[(long)r * ldsc + c]); }
}

__device__ __forceinline__ void sp_hgrn(float* smem, const bf16_t* U, const float* LB, float* OSC) {
    VB_LOOP(128, 8 * 4 * 16, vb, valid, k, sub) {
        float* red = smem + sub * 32;
        const int dvs = vb & 7, h = (vb >> 3) & 3, bz = vb >> 5, b = bz >> 1, dir = bz & 1;
        float S[16];
#pragma unroll
        for (int j = 0; j < 16; ++j) S[j] = 0.f;
        const float lbv = valid ? LB[dir * 512 + h * 128 + k] : 0.5f;
        for (int step = 0; step < SEQ; ++step) {
            const int t = dir ? (SEQ - 1 - step) : step; const long row = (long)(valid ? b : 0) * SEQ + t;
            const bf16_t* ur = U + row * NU;
            const float qv = bf2f(ur[U_HQ + h * 128 + k]);
            const float uf = bf2f(ur[(dir ? U_HFB : U_HFF) + h * 128 + k]);
            const float f = lbv + (1.f - lbv) * sigmoid_f(uf), kk = 1.f - f;
            float part[16];
#pragma unroll
            for (int j = 0; j < 16; ++j) { const float vv = bf2f(ur[U_HI + h * 128 + dvs * 16 + j]); S[j] = f * S[j] + kk * vv; part[j] = wave_sum(S[j] * qv); }
            if ((k & 63) == 0) {
#pragma unroll
                for (int j = 0; j < 16; ++j) red[(k >> 6) * 16 + j] = part[j];
            }
            __syncthreads();
            if (valid && k < 16) OSC[((long)dir * NTOK + row) * 512 + h * 128 + dvs * 16 + k] = red[k] + red[16 + k];
            __syncthreads();
        }
    }
}
__device__ __forceinline__ void sp_hgrn_combine(const float* OSC, const bf16_t* U, const float* ng, bf16_t* MIX) {
    const int lane = threadIdx.x & 63;
    for (long w = (long)blockIdx.x * 8 + (threadIdx.x >> 6); w < (long)NTOK * 4; w += (long)gridDim.x * 8) {
        const long row = w >> 2; const int h = (int)(w & 3);
        float o[2]; float ss = 0.f;
#pragma unroll
        for (int i = 0; i < 2; ++i) { const int d = lane + 64 * i; o[i] = OSC[row * 512 + h * 128 + d] + OSC[((long)NTOK + row) * 512 + h * 128 + d]; ss += o[i] * o[i]; }
        const float r = 1.f / sqrtf(wave_sum(ss) * (1.f / 128.f) + RMS_EPS);
#pragma unroll
        for (int i = 0; i < 2; ++i) { const int d = lane + 64 * i; const float y = o[i] * r * ng[h * 128 + d] * bf2f(U[row * NU + U_HG + h * 128 + d]); MIX[row * DM + h * 128 + d] = (bf16_t)f2bf(y); }
    }
}

__device__ __forceinline__ void sp_dattn(float* smem, const bf16_t* U, float* OSC) {
    VB_LOOP(256, 32 * 8 * 8, vb, valid, tid, sub) {
        float* Ks = smem + sub * (16 * 64 + 16 * 128); float* Vs = Ks + 16 * 64;
        const int qb = vb & 31, g = (vb >> 5) & 7, b = valid ? (vb >> 8) : 0, h = g >> 1, r = tid & 63, qt = tid >> 6;
        const long row = (long)b * SEQ + qb * 64 + r;
        float q[64], o[32];
#pragma unroll
        for (int d = 0; d < 64; ++d) q[d] = bf2f(U[row * NU + U_DQ + g * 64 + d]);
#pragma unroll
        for (int d = 0; d < 32; ++d) o[d] = 0.f;
        float m = -INFINITY, l = 0.f;
        for (int k0 = 0; k0 < SEQ; k0 += 16) {
            for (int i = tid; i < 16 * 64; i += 256) { const int kk = i >> 6, d = i & 63; Ks[kk * 64 + d] = bf2f(U[((long)b * SEQ + k0 + kk) * NU + U_DK + g * 64 + d]); }
            for (int i = tid; i < 16 * 128; i += 256) { const int kk = i >> 7, d = i & 127; Vs[kk * 128 + d] = bf2f(U[((long)b * SEQ + k0 + kk) * NU + U_DV + h * 128 + d]); }
            __syncthreads();
            float s[16]; float tm = m;
#pragma unroll
            for (int kk = 0; kk < 16; ++kk) { float a = 0.f;
#pragma unroll
                for (int d = 0; d < 64; ++d) a += q[d] * Ks[kk * 64 + d];
                s[kk] = a; tm = fmaxf(tm, a); }
            const float corr = exp2f(m - tm); m = tm; l *= corr;
#pragma unroll
            for (int d = 0; d < 32; ++d) o[d] *= corr;
#pragma unroll
            for (int kk = 0; kk < 16; ++kk) { const float p = exp2f(s[kk] - m); l += p;
#pragma unroll
                for (int d = 0; d < 32; ++d) o[d] += p * Vs[kk * 128 + qt * 32 + d]; }
            __syncthreads();
        }
        const float il = 1.f / l;
        if (valid) {
#pragma unroll
            for (int d = 0; d < 32; ++d) OSC[(row * 8 + g) * 128 + qt * 32 + d] = o[d] * il;
        }
    }
}
__device__ __forceinline__ void sp_dattn_combine(const float* OSC, const float* lamp, const float* sg, bf16_t* MIX) {
    const int lane = threadIdx.x & 63; const float lam = lamp[0];
    for (long w = (long)blockIdx.x * 8 + (threadIdx.x >> 6); w < (long)NTOK * 4; w += (long)gridDim.x * 8) {
        const long row = w >> 2; const int h = (int)(w & 3);
        float o[2]; float ss = 0.f;
#pragma unroll
        for (int i = 0; i < 2; ++i) { const int d = lane + 64 * i; o[i] = OSC[(row * 8 + 2 * h) * 128 + d] - lam * OSC[(row * 8 + 2 * h + 1) * 128 + d]; ss += o[i] * o[i]; }
        const float r = 1.f / sqrtf(wave_sum(ss) * (1.f / 128.f) + RMS_EPS);
#pragma unroll
        for (int i = 0; i < 2; ++i) { const int d = lane + 64 * i; MIX[row * DM + 512 + h * 128 + d] = (bf16_t)f2bf(o[i] * r * sg[d] * (1.f - LAMBDA_INIT)); }
    }
}

__device__ __forceinline__ void sp_softmax256(const float* S, bf16_t* P, long nrows) {
    const int lane = threadIdx.x & 63;
    for (long row = (long)blockIdx.x * 8 + (threadIdx.x >> 6); row < nrows; row += (long)gridDim.x * 8) {
        float4 v = *(const float4*)(S + row * 256 + 4 * lane);
        float m = fmaxf(fmaxf(v.x, v.y), fmaxf(v.z, v.w));
#pragma unroll
        for (int o = 1; o < 64; o <<= 1) m = fmaxf(m, __shfl_xor(m, o));
        v.x = exp2f(v.x - m); v.y = exp2f(v.y - m); v.z = exp2f(v.z - m); v.w = exp2f(v.w - m);
        const float il = 1.f / wave_sum((v.x + v.y) + (v.z + v.w));
        uint2 o; o.x = f2bf(v.x * il) | (f2bf(v.y * il) << 16); o.y = f2bf(v.z * il) | (f2bf(v.w * il) << 16);
        *(uint2*)(P + row * 256 + 4 * lane) = o;
    }
}

__device__ __forceinline__ void sp_topk_gather(float* smem, const float* AFF, const bf16_t* XN, int* IDX, float* GATE, int* INV, bf16_t* XS) {
    VB_LOOP(256, NGRP, grp, valid, tid, sub) {
        float* a = smem + sub * (SEQ + CAP); int* sel = (int*)(a + SEQ);
        const int b = valid ? (grp >> 4) : 0, e = grp & 15;
        for (int t = tid; t < SEQ; t += 256) a[t] = AFF[((long)b * SEQ + t) * 16 + e];
        __syncthreads();
        if (valid) for (int t = tid; t < SEQ; t += 256) {
            const float mine = a[t]; int rank = 0;
            for (int u = 0; u < SEQ; ++u) { const float x = a[u]; rank += (x > mine || (x == mine && u < t)) ? 1 : 0; }
            if (rank < CAP) { sel[rank] = t; IDX[grp * CAP + rank] = t; GATE[grp * CAP + rank] = mine; INV[((long)b * SEQ + t) * 16 + e] = rank; }
            else INV[((long)b * SEQ + t) * 16 + e] = -1;
        }
        __syncthreads();
        const int lane = tid & 63, wv = tid >> 6;
        if (valid) for (int r = wv; r < CAP; r += 4) {
            const uint4* src = (const uint4*)(XN + ((long)b * SEQ + sel[r]) * DM); uint4* dst = (uint4*)(XS + ((long)grp * CAP + r) * DM);
            dst[lane] = src[lane]; dst[lane + 64] = src[lane + 64];
        }
        __syncthreads();
    }
}

__device__ __forceinline__ void sp_final(float* H, const bf16_t* Y, const int* INV, const float* g, const float* b) {
    const int lane = threadIdx.x & 63;
    for (long row = (long)blockIdx.x * 8 + (threadIdx.x >> 6); row < NTOK; row += (long)gridDim.x * 8) {
        const int bt = (int)(row / SEQ);
        float4 v[4];
#pragma unroll
        for (int j = 0; j < 4; ++j) { const float4 h = *(const float4*)(H + row * DM + 4 * lane + 256 * j); v[j] = make_float4(ALPHA * h.x, ALPHA * h.y, ALPHA * h.z, ALPHA * h.w); }
        for (int e = 0; e < 16; ++e) {
            const int slot = INV[row * 16 + e];
            if (slot >= 0) {
                const bf16_t* yr = Y + ((long)(bt * 16 + e) * CAP + slot) * DM;
#pragma unroll
                for (int j = 0; j < 4; ++j) { const uint2 p = *(const uint2*)(yr + 4 * lane + 256 * j);
                    v[j].x += bf2f((bf16_t)(p.x & 0xffff)); v[j].y += bf2f((bf16_t)(p.x >> 16)); v[j].z += bf2f((bf16_t)(p.y & 0xffff)); v[j].w += bf2f((bf16_t)(p.y >> 16)); }
            }
        }
        float s = 0.f;
#pragma unroll
        for (int j = 0; j < 4; ++j) s += (v[j].x + v[j].y) + (v[j].z + v[j].w);
        const float mean = wave_sum(s) * (1.f / DM); float s2 = 0.f;
#pragma unroll
        for (int j = 0; j < 4; ++j) { v[j].x -= mean; v[j].y -= mean; v[j].z -= mean; v[j].w -= mean; s2 += (v[j].x * v[j].x + v[j].y * v[j].y) + (v[j].z * v[j].z + v[j].w * v[j].w); }
        const float rstd = 1.f / sqrtf(wave_sum(s2) * (1.f / DM) + LN_EPS);
#pragma unroll
        for (int j = 0; j < 4; ++j) {
            const int c = 4 * lane + 256 * j; const float4 gg = *(const float4*)(g + c), bb = *(const float4*)(b + c);
            float4 o; o.x = v[j].x * rstd * gg.x + bb.x; o.y = v[j].y * rstd * gg.y + bb.y; o.z = v[j].z * rstd * gg.z + bb.z; o.w = v[j].w * rstd * gg.w + bb.w;
            *(float4*)(H + row * DM + c) = o;
        }
    }
}

__device__ __forceinline__ void tp_item(const float* W, int K, int N, bf16_t* WT, long rbase, int k0, int n0, float* scr, int lane) {
#pragma unroll 8
    for (int i = 0; i < 32; ++i) { const int kk = 2 * i + (lane >> 5); scr[kk * 33 + (lane & 31)] = W[(size_t)(k0 + kk) * N + n0 + (lane & 31)]; }
    asm volatile("s_waitcnt lgkmcnt(0)" ::: "memory");
    const int c = lane & 7;
#pragma unroll
    for (int j = 0; j < 4; ++j) {
        const int n = (lane >> 3) + 8 * j; const float* s = scr + (8 * c) * 33 + n;
        uint4 o; o.x = f2bf(s[0]) | (f2bf(s[33]) << 16); o.y = f2bf(s[2 * 33]) | (f2bf(s[3 * 33]) << 16); o.z = f2bf(s[4 * 33]) | (f2bf(s[5 * 33]) << 16); o.w = f2bf(s[6 * 33]) | (f2bf(s[7 * 33]) << 16);
        *(uint4*)(WT + (size_t)(rbase + n) * K + k0 + 8 * c) = o;
    }
    asm volatile("s_waitcnt lgkmcnt(0)" ::: "memory");
}
__device__ __forceinline__ void tp_all(float* smem, const float* const* in, unsigned char* ws, int vcu, int G) {
    const int lane = threadIdx.x & 63, wave = threadIdx.x >> 6;
    float* scr = smem + wave * 4096;
    constexpr int I_IN = (DM / 64) * (NU / 32), I_SQ = (DM / 64) * (DM / 32), I_GU = (DM / 64) * (DFF / 32), I_D = (DFF / 64) * (DM / 32);
    constexpr int NIT = I_IN + 5 * I_SQ + NEXP * (2 * I_GU + I_D);
    for (int it = vcu * 8 + wave; it < NIT; it += G * 8) {
        int r = it;
        if (r < I_IN) { const int nb = NU / 32; tp_item(in[4], DM, NU, (bf16_t*)(ws + WS_WIN), 32 * (r % nb), 64 * (r / nb), 32 * (r % nb), scr, lane); continue; }
        r -= I_IN;
        if (r < 5 * I_SQ) {
            const int which = r / I_SQ, q = r % I_SQ, nb = DM / 32; const int k0 = 64 * (q / nb), n0 = 32 * (q % nb);
            const float* W = which == 0 ? in[16] : which == 1 ? in[17] : which == 2 ? in[12] : which == 3 ? in[15] : in[18];
            bf16_t* WT = which == 0 ? (bf16_t*)(ws + WS_WKV) : which == 1 ? (bf16_t*)(ws + WS_WKV) + (size_t)DM * DM : which == 2 ? (bf16_t*)(ws + WS_WMIX) : which == 3 ? (bf16_t*)(ws + WS_WQ) : (bf16_t*)(ws + WS_WO);
            tp_item(W, DM, DM, WT, n0, k0, n0, scr, lane); continue;
        }
        r -= 5 * I_SQ;
        const int e = r / (2 * I_GU + I_D); int q = r % (2 * I_GU + I_D);
        if (q < 2 * I_GU) {
            const int up = q / I_GU; q %= I_GU; const int nb = DFF / 32; const int k0 = 64 * (q / nb), n0 = 32 * (q % nb);
            tp_item((up ? in[23] : in[22]) + (size_t)e * DM * DFF, DM, DFF, (bf16_t*)(ws + WS_WGU) + (size_t)e * 2 * DFF * DM, (long)(n0 / 128) * 256 + (n0 % 128) + 128 * up, k0, n0, scr, lane);
        } else {
            q -= 2 * I_GU; const int nb = DM / 32; const int k0 = 64 * (q / nb), n0 = 32 * (q % nb);
            tp_item(in[24] + (size_t)e * DFF * DM, DFF, DM, (bf16_t*)(ws + WS_WD) + (size_t)e * DM * DFF, n0, k0, n0, scr, lane);
        }
    }
}

__device__ __forceinline__ void sp_topk2(float* smem, const float* AFF, const bf16_t* XN, int* IDX, float* GATE, int* INV, bf16_t* XS) {
    const int tid = threadIdx.x, lane = tid & 63, wave = tid >> 6;
    int* cnt = (int*)smem;
    int* wtot = (int*)smem + 16;
    int* sel = (int*)smem + 64;
    const unsigned long long lt_mask = (lane == 0) ? 0ull : (~0ull >> (64 - lane));
    for (int item = blockIdx.x; item < NGRP * 2; item += gridDim.x) {
        const int grp = item >> 1, half = item & 1, b = grp >> 4, e = grp & 15;
        unsigned key[4];
#pragma unroll
        for (int j = 0; j < 4; ++j) key[j] = __builtin_bit_cast(unsigned, AFF[((size_t)b * SEQ + 512 * j + tid) * 16 + e]);
        unsigned T = 0u;
        for (int bit = 31; bit >= 0; --bit) {
            const unsigned cand = T | (1u << bit);
            int c = 0;
#pragma unroll
            for (int j = 0; j < 4; ++j) c += __popcll(__ballot(key[j] >= cand));
            int* cb = cnt + ((bit & 1) << 3);
            if (lane == 0) cb[wave] = c;
            __syncthreads();
            int tot = 0;
#pragma unroll
            for (int w = 0; w < 8; ++w) tot += cb[w];
            if (tot >= CAP) T = cand;
        }
        unsigned long long bt[4], bg[4];
#pragma unroll
        for (int j = 0; j < 4; ++j) { bt[j] = __ballot(key[j] == T); bg[j] = __ballot(key[j] > T); }
        __syncthreads();
        if (lane == 0) {
#pragma unroll
            for (int j = 0; j < 4; ++j) { wtot[j * 8 + wave] = __popcll(bt[j]); wtot[32 + j * 8 + wave] = __popcll(bg[j]); }
        }
        __syncthreads();
        int n_gt = 0;
#pragma unroll
        for (int q = 0; q < 32; ++q) n_gt += wtot[32 + q];
        const int need = CAP - n_gt;
        unsigned long long bs[4];
#pragma unroll
        for (int j = 0; j < 4; ++j) {
            int tpre = 0;
            for (int q = 0; q < j * 8 + wave; ++q) tpre += wtot[q];
            const int trank = tpre + __popcll(bt[j] & lt_mask);
            const bool s = (key[j] > T) || (key[j] == T && trank < need);
            bs[j] = __ballot(s);
        }
        __syncthreads();
        if (lane == 0) {
#pragma unroll
            for (int j = 0; j < 4; ++j) wtot[j * 8 + wave] = __popcll(bs[j]);
        }
        __syncthreads();
#pragma unroll
        for (int j = 0; j < 4; ++j) {
            int spre = 0;
            for (int q = 0; q < j * 8 + wave; ++q) spre += wtot[q];
            const int slot = spre + __popcll(bs[j] & lt_mask);
            const bool s = (bs[j] >> lane) & 1ull;
            const int t = 512 * j + tid;
            if (s) sel[slot] = t;
            if (half == 0) {
                if (s) { IDX[grp * CAP + slot] = t; GATE[grp * CAP + slot] = __builtin_bit_cast(float, key[j]); }
                INV[((size_t)b * SEQ + t) * 16 + e] = s ? slot : -1;
            }
        }
        __syncthreads();
        for (int r = half * 128 + wave; r < half * 128 + 128; r += 8) {
            const uint4* src = (const uint4*)(XN + ((size_t)b * SEQ + sel[r]) * DM); uint4* dst = (uint4*)(XS + ((size_t)grp * CAP + r) * DM);
            dst[lane] = src[lane]; dst[lane + 64] = src[lane + 64];
        }
        __syncthreads();
    }
}

__device__ __forceinline__ void sp_hgrn_combine_bh(const float* OSC, const bf16_t* U, const float* ng, bf16_t* MIX, int bh) {
    const int lane = threadIdx.x & 63, b = bh >> 2, h = bh & 3;
    for (int t = threadIdx.x >> 6; t < SEQ; t += 8) {
        const long row = (long)b * SEQ + t;
        float o[2]; float ss = 0.f;
#pragma unroll
        for (int i = 0; i < 2; ++i) { const int d = lane + 64 * i; o[i] = OSC[row * 512 + h * 128 + d] + OSC[((long)NTOK + row) * 512 + h * 128 + d]; ss += o[i] * o[i]; }
        const float r = 1.f / sqrtf(wave_sum(ss) * (1.f / 128.f) + RMS_EPS);
#pragma unroll
        for (int i = 0; i < 2; ++i) { const int d = lane + 64 * i; const float y = o[i] * r * ng[h * 128 + d] * bf2f(U[row * NU + U_HG + h * 128 + d]); MIX[row * DM + h * 128 + d] = (bf16_t)f2bf(y); }
    }
}
namespace pg8 {
#define PG8_LAS __attribute__((address_space(3)))
typedef unsigned short bf16_t;
typedef short bf16x8 __attribute__((ext_vector_type(8)));
typedef float f32x4 __attribute__((ext_vector_type(4)));
typedef unsigned u32x4 __attribute__((ext_vector_type(4)));
constexpr int BM = 256, BK = 64, HALF = 128, HTB = HALF * BK * 2  , STAGE_BYTES = 8 * HTB, NXCD = 8, WGM = 8;

__host__ __device__ __forceinline__ int lds_byte(int r, int c) { const int st = (r >> 4) * 2 + (c >> 5), rr = r & 15, cc = c & 31, ob = rr * 64 + cc * 2; return st * 1024 + (ob ^ (((ob >> 9) & 1) << 5)); }
__host__ __device__ __forceinline__ void stage_rc(int b, int& R, int& C) { const int st = b / 1024, sb = b % 1024, swz = sb ^ (((sb >> 9) & 1) << 5); R = (st >> 1) * 16 + swz / 64; C = (st & 1) * 32 + (swz % 64) / 2; }
__host__ __device__ __forceinline__ int perm32(int rho) { const int n = rho >> 4, i = rho & 15; return 8 * (i >> 2) + 4 * n + (i & 3); }

struct Unit { int pm, pn; };
struct Gemm { const bf16_t* A; const bf16_t* Bt; int M, N, K; };

struct StaticOrder {
    int nM, nN, nwg, G, c;
    __host__ __device__ void init(int M, int N, int G_, int c_) { nM = M / BM; nN = N / BM; nwg = nM * nN; G = G_; c = c_; }
    __host__ __device__ bool next(int i, Unit& u) const {
        const long L = (long)i * G + c; if (L >= nwg) return false;
        int wgid = (int)L; { const int q = nwg / NXCD, r = nwg % NXCD, xcd = wgid % NXCD, off = wgid / NXCD; wgid = (xcd < r ? xcd * (q + 1) : r * (q + 1) + (xcd - r) * q) + off; }
        const int nig = WGM * nN, gid = wgid / nig, fm = gid * WGM, gsz = (nM - fm) < WGM ? (nM - fm) : WGM;
        u.pm = fm + ((wgid % nig) % gsz); u.pn = (wgid % nig) / gsz; return true;
    }
    __device__ __forceinline__ void a_ready(const Unit&) const {}
    __device__ __forceinline__ void done(const Unit&) const {}
};

__device__ __forceinline__ unsigned cvt_pk_bf16(float lo, float hi) { unsigned r; asm volatile("v_cvt_pk_bf16_f32 %0, %1, %2" : "=v"(r) : "v"(lo), "v"(hi)); return r; }
typedef float f32x2 __attribute__((ext_vector_type(2)));
typedef unsigned u32x4 __attribute__((ext_vector_type(4)));
constexpr float QSCALE_DA = 0.125f * 1.4426950408889634f;
constexpr float QSCALE_XA = 0.0625f * 1.4426950408889634f;
__device__ __forceinline__ float silu_fast(float x) { return x * __builtin_amdgcn_rcpf(1.f + __builtin_amdgcn_exp2f(-1.4426950408889634f * x)); }

struct EpiStore {
    static constexpr bool PERM = true, AFTER_DRAIN = false;
    bf16_t* O; int ldc; float scale; int mode; const float* rope;
    __device__ __forceinline__ void operator()(const f32x4 (&acc)[2][2][4][2], const Unit& u, int wr, int wc, int fr, int fq) const {
        const int row0 = u.pm * BM + wr * 64 + fr, col0 = u.pn * BM + wc * 32 + 8 * fq;
        int op = 0; float sc = scale;
        if (mode == 1) { const int seg = u.pn >> 1; op = (seg == 0 || seg == 2) ? 1 : (seg == 5 ? 2 : (seg == 6 ? 3 : 0)); if (seg == 5) sc = QSCALE_DA; }
        const bool do_rope = (op >= 2) && !(wc & 1);
#pragma unroll
        for (int ai = 0; ai < 2; ++ai)
#pragma unroll
            for (int m = 0; m < 4; ++m) {
                const int row = row0 + ai * HALF + m * 16; bf16_t* rowp = O + (size_t)row * ldc + col0;
                f32x4 c0 = {1.f, 1.f, 1.f, 1.f}, c1 = c0, s0 = {0.f, 0.f, 0.f, 0.f}, s1 = s0;
                if (do_rope) { const float* rp = rope + (row & 2047) * 16; c0 = *(const f32x4*)rp; c1 = *(const f32x4*)(rp + 4); s0 = *(const f32x4*)(rp + 8); s1 = *(const f32x4*)(rp + 12);
                    if (fq == 0) { s0 = -s0; s1 = -s1; } else if (fq >= 2) { c0 = (f32x4){1.f, 1.f, 1.f, 1.f}; c1 = c0; s0 = (f32x4){0.f, 0.f, 0.f, 0.f}; s1 = s0; } }
#pragma unroll
                for (int bj = 0; bj < 2; ++bj) {
                    f32x4 v0 = acc[ai][bj][m][0], v1 = acc[ai][bj][m][1];
                    if (op == 1) {
#pragma unroll
                        for (int j = 0; j < 4; ++j) { v0[j] = silu_fast(v0[j]); v1[j] = silu_fast(v1[j]); }
                    }
                    if (do_rope) {
                        f32x4 p0, p1;
#pragma unroll
                        for (int j = 0; j < 4; ++j) { p0[j] = __shfl_xor(v0[j], 16); p1[j] = __shfl_xor(v1[j], 16); }
                        v0 = v0 * c0 + p0 * s0; v1 = v1 * c1 + p1 * s1;
                    }
                    v0 = v0 * sc; v1 = v1 * sc;
                    u32x4 w; w.x = cvt_pk_bf16(v0[0], v0[1]); w.y = cvt_pk_bf16(v0[2], v0[3]); w.z = cvt_pk_bf16(v1[0], v1[1]); w.w = cvt_pk_bf16(v1[2], v1[3]);
                    *(u32x4*)(rowp + bj * HALF) = w;
                }
            }
    }
};
struct EpiResid {
    static constexpr bool PERM = false, AFTER_DRAIN = false;
    float* H; float alpha;
    __device__ __forceinline__ void operator()(const f32x4 (&acc)[2][2][4][2], const Unit& u, int wr, int wc, int fr, int fq) const {
        const int row0 = u.pm * BM + wr * 64 + fr, col0 = u.pn * BM + wc * 32 + 4 * fq;
#pragma unroll
        for (int ai = 0; ai < 2; ++ai)
#pragma unroll
            for (int m = 0; m < 4; ++m) { float* rowp = H + (size_t)(row0 + ai * HALF + m * 16) * 1024 + col0;
#pragma unroll
                for (int bj = 0; bj < 2; ++bj)
#pragma unroll
                    for (int n = 0; n < 2; ++n) { f32x4* p = (f32x4*)(rowp + bj * HALF + n * 16); const f32x4 h = *p; *p = h * alpha + acc[ai][bj][m][n]; } }
    }
};
struct EpiSwiglu {
    static constexpr bool PERM = true, AFTER_DRAIN = false;
    bf16_t* ACT;
    __device__ __forceinline__ void operator()(const f32x4 (&acc)[2][2][4][2], const Unit& u, int wr, int wc, int fr, int fq) const {
        const int row0 = u.pm * BM + wr * 64 + fr, col0 = (u.pn & 15) * 128 + wc * 32 + 8 * fq;
#pragma unroll
        for (int ai = 0; ai < 2; ++ai)
#pragma unroll
            for (int m = 0; m < 4; ++m) {
                f32x4 v0 = acc[ai][0][m][0], v1 = acc[ai][0][m][1]; const f32x4 u0 = acc[ai][1][m][0], u1 = acc[ai][1][m][1];
#pragma unroll
                for (int j = 0; j < 4; ++j) { v0[j] = silu_fast(v0[j]) * u0[j]; v1[j] = silu_fast(v1[j]) * u1[j]; }
                u32x4 w; w.x = cvt_pk_bf16(v0[0], v0[1]); w.y = cvt_pk_bf16(v0[2], v0[3]); w.z = cvt_pk_bf16(v1[0], v1[1]); w.w = cvt_pk_bf16(v1[2], v1[3]);
                *(u32x4*)(ACT + (size_t)(row0 + ai * HALF + m * 16) * 2048 + col0) = w;
            }
    }
};
struct EpiYGate {
    static constexpr bool PERM = true, AFTER_DRAIN = false;
    bf16_t* Y; const float* GATE;
    __device__ __forceinline__ void operator()(const f32x4 (&acc)[2][2][4][2], const Unit& u, int wr, int wc, int fr, int fq) const {
        const int row0 = u.pm * BM + wr * 64 + fr, col0 = (u.pn & 3) * BM + wc * 32 + 8 * fq;
#pragma unroll
        for (int ai = 0; ai < 2; ++ai)
#pragma unroll
            for (int m = 0; m < 4; ++m) { const int row = row0 + ai * HALF + m * 16; const float gt = GATE[row]; bf16_t* rowp = Y + (size_t)row * 1024 + col0;
#pragma unroll
                for (int bj = 0; bj < 2; ++bj) { const f32x4 v0 = acc[ai][bj][m][0] * gt, v1 = acc[ai][bj][m][1] * gt;
                    u32x4 w; w.x = cvt_pk_bf16(v0[0], v0[1]); w.y = cvt_pk_bf16(v0[2], v0[3]); w.z = cvt_pk_bf16(v1[0], v1[1]); w.w = cvt_pk_bf16(v1[2], v1[3]);
                    *(u32x4*)(rowp + bj * HALF) = w; } }
    }
};
template <int WHICH> struct MoeOrder {
    int G, c;
    __device__ bool next(int i, Unit& u) const {
        constexpr int NWG = WHICH == 1 ? 2048 : 512;
        const int L = i * G + c; if (L >= NWG) return false;
        const int Ux = (G % 8 == 0 && NWG % 8 == 0) ? (L % 8) * (NWG / 8) + L / 8 : L;
        if (WHICH == 1) { const int e = Ux >> 7, jg = (Ux & 127) >> 5, b = (Ux & 31) >> 2, jj = Ux & 3; u.pm = b * 16 + e; u.pn = e * 16 + jg * 4 + jj; }
        else { const int e = Ux >> 5, b = (Ux & 31) >> 2, j = Ux & 3; u.pm = b * 16 + e; u.pn = e * 4 + j; }
        return true;
    }
    __device__ __forceinline__ void a_ready(const Unit&) const {}
    __device__ __forceinline__ void done(const Unit&) const {}
};
template <class Epi, class Sched, bool ALIGN_EPI = false, bool SP2 = false>
__device__ __forceinline__ void gemm_phase(PG8_LAS unsigned char* lds, const Gemm g, const Sched& S, const Epi& E) {
    int tid_ = threadIdx.x; asm volatile("" : "+v"(tid_));
    const int tid = tid_, wid = __builtin_amdgcn_readfirstlane(tid >> 6), lane = tid & 63, wr = wid >> 2, wc = wid & 3, fr = lane & 15, fq = lane >> 4;
    const int K = g.K, nt = K / BK;
    unsigned voffA[2], voffB[2];
#pragma unroll
    for (int i = 0; i < 2; ++i) { int R, C; stage_rc(tid * 16 + i * 8192, R, C); const int Rb = Epi::PERM ? ((R & ~31) + perm32(R & 31)) : R;
        voffA[i] = (unsigned)(R * K + C) * 2u; voffB[i] = (unsigned)(Rb * K + C) * 2u; }
    const size_t kstep = (size_t)(BK * 2);
    const size_t hstep = (size_t)HALF * K * 2;
    const size_t tstep = 2 * hstep;
    const unsigned ldsw = (unsigned)wid * 1024u;
    const int aoff = lds_byte(wr * 64 + fr, fq * 8), boff = lds_byte(wc * 32 + fr, fq * 8);
#define PG8_SA(b, h) (((b) * 2 + (h)) * HTB)
#define PG8_SB(b, h) ((4 + (b) * 2 + (h)) * HTB)
#define PG8_STAGE(bufoff, gbase, voff) do { _Pragma("unroll") for (int _i = 0; _i < 2; ++_i) \
        __builtin_amdgcn_global_load_lds((const unsigned*)((const char*)(gbase) + (voff)[_i]), (PG8_LAS unsigned*)(lds + (bufoff) + ldsw + _i * 8192), 16, 0, 0); } while (0)
#define PG8_LDA(dst, b, h) do { _Pragma("unroll") for (int m = 0; m < 4; ++m) _Pragma("unroll") for (int k = 0; k < 2; ++k) dst[m][k] = *(const PG8_LAS bf16x8*)(lds + PG8_SA(b, h) + aoff + m * 2048 + k * 1024); } while (0)
#define PG8_LDB(dst, b, h) do { _Pragma("unroll") for (int n = 0; n < 2; ++n) _Pragma("unroll") for (int k = 0; k < 2; ++k) dst[n][k] = *(const PG8_LAS bf16x8*)(lds + PG8_SB(b, h) + boff + n * 2048 + k * 1024); } while (0)
#define PG8_MMA(ai, bj, At, Bt) do { __builtin_amdgcn_s_setprio(1); _Pragma("unroll") for (int m = 0; m < 4; ++m) _Pragma("unroll") for (int n = 0; n < 2; ++n) _Pragma("unroll") for (int k = 0; k < 2; ++k) \
        acc[ai][bj][m][n] = __builtin_amdgcn_mfma_f32_16x16x32_bf16(Bt[n][k], At[m][k], acc[ai][bj][m][n], 0, 0, 0); __builtin_amdgcn_s_setprio(0); } while (0)
#define PG8_WAIT_V(n) asm volatile("s_waitcnt vmcnt(" #n ")" ::: "memory")
#define PG8_WAIT_L(n) asm volatile("s_waitcnt lgkmcnt(" #n ")" ::: "memory")
#define PG8_BAR __builtin_amdgcn_s_barrier()
#define PG8_SCHED __builtin_amdgcn_sched_barrier(0)
    Unit cur, nxt; int ui = 0;
    if (!S.next(0, cur)) return;
    f32x4 acc[2][2][4][2];
#pragma unroll
    for (int a = 0; a < 2; ++a)
#pragma unroll
        for (int b = 0; b < 2; ++b)
#pragma unroll
            for (int m = 0; m < 4; ++m)
#pragma unroll
                for (int n = 0; n < 2; ++n) acc[a][b][m][n] = (f32x4){0.f, 0.f, 0.f, 0.f};
    bf16x8 At[4][2], B0[2][2], B1[2][2];
    const char* cA = (const char*)g.A + (size_t)cur.pm * tstep; const char* cB = (const char*)g.Bt + (size_t)cur.pn * tstep;
    S.a_ready(cur);
    if constexpr (SP2) {
        PG8_STAGE(PG8_SB(0, 0), cB, voffB); PG8_STAGE(PG8_SB(0, 1), cB + hstep, voffB); PG8_STAGE(PG8_SA(0, 0), cA, voffA); PG8_STAGE(PG8_SA(0, 1), cA + hstep, voffA);
        if (wr == 1) PG8_BAR;
        PG8_WAIT_V(2); PG8_BAR;
        PG8_STAGE(PG8_SB(1, 0), cB + kstep, voffB); PG8_STAGE(PG8_SA(1, 0), cA + kstep, voffA); PG8_STAGE(PG8_SB(1, 1), cB + hstep + kstep, voffB);
        PG8_WAIT_V(6); PG8_BAR;
    } else {
        PG8_STAGE(PG8_SB(0, 0), cB, voffB); PG8_STAGE(PG8_SA(0, 0), cA, voffA); PG8_STAGE(PG8_SB(0, 1), cB + hstep, voffB); PG8_STAGE(PG8_SA(0, 1), cA + hstep, voffA);
        if (wr == 1) PG8_BAR;
        PG8_WAIT_V(4); PG8_BAR;
        PG8_STAGE(PG8_SB(1, 0), cB + kstep, voffB); PG8_STAGE(PG8_SA(1, 0), cA + kstep, voffA); PG8_STAGE(PG8_SB(1, 1), cB + hstep + kstep, voffB);
        PG8_WAIT_V(6); PG8_BAR;
    }
    for (;;) {
        const bool has_next = S.next(ui + 1, nxt);
        const char* nA = has_next ? (const char*)g.A + (size_t)nxt.pm * tstep : cA; const char* nB = has_next ? (const char*)g.Bt + (size_t)nxt.pn * tstep : cB;
        for (int t = 0; t < nt; t += 2) {
            const bool last = (t == nt - 2);
            const char* a1 = cA + (size_t)(t + 1) * kstep;
            const char* a2 = last ? nA : cA + (size_t)(t + 2) * kstep; const char* b2 = last ? nB : cB + (size_t)(t + 2) * kstep;
            const char* a3 = a2 + kstep; const char* b3 = b2 + kstep;
            if (last && has_next) S.a_ready(nxt);
            if constexpr (SP2) {
            PG8_LDB(B0, 0, 0); PG8_LDB(B1, 0, 1); PG8_SCHED; PG8_LDA(At, 0, 0); PG8_STAGE(PG8_SA(1, 1), a1 + hstep, voffA);
            PG8_WAIT_V(8); PG8_WAIT_L(0); PG8_BAR; PG8_MMA(0, 0, At, B0); PG8_MMA(0, 1, At, B1); PG8_BAR; PG8_SCHED;
            PG8_LDA(At, 0, 1); PG8_STAGE(PG8_SB(0, 0), b2, voffB); PG8_STAGE(PG8_SB(0, 1), b2 + hstep, voffB); PG8_STAGE(PG8_SA(0, 0), a2, voffA);
            PG8_WAIT_V(8); PG8_WAIT_L(0); PG8_BAR; PG8_MMA(1, 0, At, B0); PG8_MMA(1, 1, At, B1); PG8_BAR; PG8_SCHED;
            PG8_LDB(B0, 1, 0); PG8_LDB(B1, 1, 1); PG8_SCHED; PG8_LDA(At, 1, 0); PG8_STAGE(PG8_SA(0, 1), a2 + hstep, voffA);
            PG8_WAIT_V(8); PG8_WAIT_L(0); PG8_BAR; PG8_MMA(0, 0, At, B0); PG8_MMA(0, 1, At, B1); PG8_BAR; PG8_SCHED;
            PG8_LDA(At, 1, 1); PG8_STAGE(PG8_SB(1, 0), b3, voffB); PG8_STAGE(PG8_SB(1, 1), b3 + hstep, voffB); PG8_STAGE(PG8_SA(1, 0), a3, voffA);
            PG8_WAIT_V(8); PG8_WAIT_L(0); PG8_BAR; PG8_MMA(1, 0, At, B0); PG8_MMA(1, 1, At, B1); PG8_BAR; PG8_SCHED;
            } else {
            PG8_LDB(B0, 0, 0); PG8_SCHED; PG8_LDA(At, 0, 0); PG8_STAGE(PG8_SA(1, 1), a1 + hstep, voffA);
            PG8_WAIT_L(8); PG8_BAR; PG8_WAIT_L(0); PG8_MMA(0, 0, At, B0); PG8_BAR; PG8_SCHED;
            PG8_LDB(B1, 0, 1); PG8_STAGE(PG8_SB(0, 0), b2, voffB);
            PG8_BAR; PG8_WAIT_L(0); PG8_MMA(0, 1, At, B1); PG8_BAR;
            PG8_LDA(At, 0, 1); PG8_STAGE(PG8_SA(0, 0), a2, voffA);
            PG8_BAR; PG8_WAIT_L(0); PG8_MMA(1, 0, At, B0); PG8_BAR; PG8_SCHED;
            PG8_STAGE(PG8_SB(0, 1), b2 + hstep, voffB);
            PG8_WAIT_V(6); PG8_BAR; PG8_MMA(1, 1, At, B1); PG8_BAR;
            PG8_LDB(B0, 1, 0); PG8_SCHED; PG8_LDA(At, 1, 0); PG8_STAGE(PG8_SA(0, 1), a2 + hstep, voffA);
            PG8_WAIT_L(8); PG8_BAR; PG8_WAIT_L(0); PG8_MMA(0, 0, At, B0); PG8_BAR; PG8_SCHED;
            PG8_LDB(B1, 1, 1); PG8_STAGE(PG8_SB(1, 0), b3, voffB);
            PG8_BAR; PG8_WAIT_L(0); PG8_MMA(0, 1, At, B1); PG8_BAR;
            PG8_LDA(At, 1, 1); PG8_STAGE(PG8_SA(1, 0), a3, voffA);
            PG8_BAR; PG8_WAIT_L(0); PG8_MMA(1, 0, At, B0); PG8_BAR; PG8_SCHED;
            PG8_STAGE(PG8_SB(1, 1), b3 + hstep, voffB);
            PG8_WAIT_V(6); PG8_BAR; PG8_MMA(1, 1, At, B1); PG8_BAR;
            }
        }
        if constexpr (ALIGN_EPI) { if (wr == 0) PG8_BAR; }
        if constexpr (!Epi::AFTER_DRAIN) { E(acc, cur, wr, wc, fr, fq); S.done(cur); }
        if (!has_next) break;
#pragma unroll
        for (int a = 0; a < 2; ++a)
#pragma unroll
            for (int b = 0; b < 2; ++b)
#pragma unroll
                for (int m = 0; m < 4; ++m)
#pragma unroll
                    for (int n = 0; n < 2; ++n) acc[a][b][m][n] = (f32x4){0.f, 0.f, 0.f, 0.f};
        cur = nxt; cA = nA; cB = nB; ++ui;
        if constexpr (ALIGN_EPI) { if (wr == 1) PG8_BAR; }
    }
    PG8_WAIT_V(0);
    if constexpr (!ALIGN_EPI) { if (wr == 0) PG8_BAR; }
    PG8_BAR;
    if constexpr (Epi::AFTER_DRAIN) { E.fused(acc, cur, wr, wc, fr, fq, lds, wid, lane); S.done(cur); }
#undef PG8_SA
#undef PG8_SB
#undef PG8_STAGE
#undef PG8_LDA
#undef PG8_LDB
#undef PG8_MMA
#undef PG8_WAIT_V
#undef PG8_WAIT_L
#undef PG8_BAR
#undef PG8_SCHED
}
}
#define LAS __attribute__((address_space(3)))
#define XB_TMO      128
#define XB_XCNT(j)  (256  + 64 * (j))
#define XB_XSUB(j)  (1280 + 64 * (j))
#define XB_XGEN(j)  (2304 + 64 * (j))
#define XB_TOP      3328
#define XB_TOPGEN   3392
#define XCD_BAR_WORDS 3456
#define XB_SPIN_CAP (1u << 18)

__device__ __forceinline__ unsigned xb_ld(unsigned* p)              { return __hip_atomic_load(p, __ATOMIC_RELAXED, __HIP_MEMORY_SCOPE_AGENT); }
__device__ __forceinline__ unsigned xb_add(unsigned* p, unsigned v) { return __hip_atomic_fetch_add(p, v, __ATOMIC_RELAXED, __HIP_MEMORY_SCOPE_AGENT); }
__device__ __forceinline__ unsigned xb_xcc_id() { return (unsigned)__builtin_amdgcn_s_getreg((3 << 11) | 20) & 0xFu; }
#define XB_SPIN(cond, bar) do { unsigned _sp = 0; while (cond) { __builtin_amdgcn_s_sleep(1); \
    if ((++_sp & 255u) == 0u) { if (xb_ld(&(bar)[XB_TMO])) break; if (_sp > XB_SPIN_CAP) { atomicAdd(&(bar)[XB_TMO], 1u); break; } } } } while (0)

struct XcdBarrier {
    unsigned* bar; unsigned x;
    volatile LAS unsigned* st;
};

__device__ __forceinline__ XcdBarrier xcd_barrier_post(unsigned* bar, volatile LAS unsigned* st) {
    XcdBarrier b; b.bar = bar; b.x = xb_xcc_id(); b.st = st;
    if (threadIdx.x == 0) (void)xb_add(&bar[XB_XCNT(b.x)], 1u);
    return b;
}
__device__ __forceinline__ void xcd_barrier_complete(unsigned* bar, unsigned x, unsigned& nloc, unsigned& nx) {
    const unsigned G = gridDim.x * gridDim.y * gridDim.z;
    unsigned sum, cnt, mine, sp = 0u;
    for (;;) {
        sum = 0u; cnt = 0u; mine = 0u;
#pragma unroll
        for (unsigned j = 0; j < 16; ++j) { const unsigned c = xb_ld(&bar[XB_XCNT(j)]); sum += c; cnt += (c > 0u) ? 1u : 0u; mine = (j == x) ? c : mine; }
        if (sum == G) break;
        __builtin_amdgcn_s_sleep(1);
        if ((++sp & 255u) == 0u) { if (xb_ld(&bar[XB_TMO])) break; if (sp > XB_SPIN_CAP) { atomicAdd(&bar[XB_TMO], 1u); break; } }
    }
    nloc = mine > 0u ? mine : 1u; nx = cnt > 0u ? cnt : 1u;
}

__device__ __forceinline__ void xcd_barrier(const XcdBarrier& b) {
    asm volatile("s_waitcnt vmcnt(0)" ::: "memory");
    __syncthreads();
    if (threadIdx.x == 0) {
        unsigned* bar = b.bar;
        __builtin_amdgcn_s_waitcnt(0);
        unsigned nloc = b.st[0], nx = b.st[1];
        if (nloc == 0u) { xcd_barrier_complete(bar, b.x, nloc, nx); b.st[0] = nloc; b.st[1] = nx; }
        const unsigned old = xb_add(&bar[XB_XSUB(b.x)], 1u);
        const unsigned gen = old / nloc;
        if (old + 1u == (gen + 1u) * nloc) {
            __builtin_amdgcn_fence(__ATOMIC_RELEASE, "agent");
            asm volatile("s_waitcnt vmcnt(0)" ::: "memory");
            const unsigned og = xb_add(&bar[XB_TOP], 1u);
            const unsigned tg = og / nx;
            if (og + 1u == (tg + 1u) * nx) xb_add(&bar[XB_TOPGEN], 1u);
            else XB_SPIN(xb_ld(&bar[XB_TOPGEN]) == tg, bar);
            __builtin_amdgcn_fence(__ATOMIC_ACQUIRE, "agent");
            xb_add(&bar[XB_XGEN(b.x)], 1u);
            asm volatile("s_waitcnt vmcnt(0)" ::: "memory");
        } else {
            XB_SPIN(xb_ld(&bar[XB_XGEN(b.x)]) == gen, bar);
            __builtin_amdgcn_fence(__ATOMIC_ACQUIRE, "agent");
            asm volatile("s_waitcnt vmcnt(0)" ::: "memory");
        }
    }
    __syncthreads();
}
namespace da {
#define DA_LAS __attribute__((address_space(3)))
typedef short bf16x8 __attribute__((ext_vector_type(8)));
typedef short s16x4 __attribute__((ext_vector_type(4)));
typedef float f32x16 __attribute__((ext_vector_type(16)));
typedef float f32x4 __attribute__((ext_vector_type(4)));
typedef unsigned u32x4 __attribute__((ext_vector_type(4)));
typedef unsigned u32x2 __attribute__((ext_vector_type(2)));
constexpr int KSTR = 144, VSTR = 320;
constexpr int K_BYTES = 64 * KSTR, V_BYTES = 64 * VSTR, STAGE = 2 * K_BYTES + V_BYTES;
constexpr float THR = 4.0f;
__device__ __forceinline__ unsigned cvt_pk(float lo, float hi) { unsigned r; asm volatile("v_cvt_pk_bf16_f32 %0, %1, %2" : "=v"(r) : "v"(lo), "v"(hi)); return r; }
__device__ __forceinline__ s16x4 vtr(const DA_LAS unsigned char* p) { typedef short v4i16_t __attribute__((ext_vector_type(4)));
    return __builtin_bit_cast(s16x4, __builtin_amdgcn_ds_read_tr16_b64_v4i16((DA_LAS v4i16_t*)p)); }

__device__ __forceinline__ void dattn_phase(DA_LAS unsigned char* lds, const bf16_t* U, const float* lamp, const float* subln_g, bf16_t* MIX, int vcu, int G) {
    int tid_ = threadIdx.x; asm volatile("" : "+v"(tid_));
    const int tid = tid_, lane = tid & 63, wave = __builtin_amdgcn_readfirstlane(tid >> 6), comp = wave >> 2, qs = wave & 3;
    const int r32 = lane & 31, hh = lane >> 5, gi = lane >> 4, li = lane & 15;
    const float lam = lamp[0];
    const int krow = tid >> 3, kch = tid & 7, vrow0 = tid >> 4, vch = tid & 15;
    const int kdst = krow * KSTR + kch * 16, vdst0 = vrow0 * VSTR + vch * 16, vdst1 = (vrow0 + 32) * VSTR + vch * 16;
    const int kfrag = r32 * KSTR + hh * 16;
    const int vfrag = (4 * hh + (li >> 2)) * VSTR + (16 * (gi & 1) + 4 * (li & 3)) * 2;
    for (int u = vcu; u < BATCH * 4 * 16; u += G) {
        const int qb = u & 15, h = (u >> 4) & 3, b = u >> 6;
        const bf16_t* Ub = U + (size_t)b * SEQ * NU;
        const bf16_t* ksrc0 = Ub + (size_t)krow * NU + U_DK + (2 * h) * 64 + kch * 8;
        const bf16_t* ksrc1 = ksrc0 + 64;
        const bf16_t* vsrc0 = Ub + (size_t)vrow0 * NU + U_DV + h * 128 + vch * 8;
        const bf16_t* vsrc1 = vsrc0 + (size_t)32 * NU;
        bf16x8 qf[4];
        { const bf16_t* qp = Ub + (size_t)(qb * 128 + qs * 32 + r32) * NU + U_DQ + (2 * h + comp) * 64 + hh * 8;
#pragma unroll
          for (int ds = 0; ds < 4; ++ds) qf[ds] = *(const bf16x8*)(qp + ds * 16); }
        f32x16 o[4];
#pragma unroll
        for (int d0 = 0; d0 < 4; ++d0)
#pragma unroll
            for (int r = 0; r < 16; ++r) o[d0][r] = 0.f;
        float m = -INFINITY, l = 0.f;
        u32x4 rk0 = *(const u32x4*)ksrc0, rk1 = *(const u32x4*)ksrc1, rv0 = *(const u32x4*)vsrc0, rv1 = *(const u32x4*)vsrc1;
        *(DA_LAS u32x4*)(lds + kdst) = rk0; *(DA_LAS u32x4*)(lds + K_BYTES + kdst) = rk1; *(DA_LAS u32x4*)(lds + 2 * K_BYTES + vdst0) = rv0; *(DA_LAS u32x4*)(lds + 2 * K_BYTES + vdst1) = rv1;
        __syncthreads();
        for (int t = 0; t < SEQ / 64; ++t) {
            const DA_LAS unsigned char* st = lds + (t & 1) * STAGE;
            DA_LAS unsigned char* nst = lds + ((t + 1) & 1) * STAGE;
            if (t + 1 < SEQ / 64) { const size_t go = (size_t)(t + 1) * 64 * NU; rk0 = *(const u32x4*)(ksrc0 + go); rk1 = *(const u32x4*)(ksrc1 + go); rv0 = *(const u32x4*)(vsrc0 + go); rv1 = *(const u32x4*)(vsrc1 + go); }
            const DA_LAS unsigned char* Kt = st + comp * K_BYTES + kfrag;
            f32x16 p0, p1;
#pragma unroll
            for (int r = 0; r < 16; ++r) { p0[r] = 0.f; p1[r] = 0.f; }
#pragma unroll
            for (int ds = 0; ds < 4; ++ds) {
                const bf16x8 a0 = *(const DA_LAS bf16x8*)(Kt + ds * 32), a1 = *(const DA_LAS bf16x8*)(Kt + 32 * KSTR + ds * 32);
                p0 = __builtin_amdgcn_mfma_f32_32x32x16_bf16(a0, qf[ds], p0, 0, 0, 0);
                p1 = __builtin_amdgcn_mfma_f32_32x32x16_bf16(a1, qf[ds], p1, 0, 0, 0);
            }
            float mx = fmaxf(p0[0], p1[0]);
#pragma unroll
            for (int r = 1; r < 16; ++r) mx = fmaxf(mx, fmaxf(p0[r], p1[r]));
            mx = fmaxf(mx, __shfl_xor(mx, 32));
            if (!__all(mx - m <= THR)) {
                const float mn = fmaxf(m, mx), alpha = __builtin_amdgcn_exp2f(m - mn);
                m = mn; l *= alpha;
#pragma unroll
                for (int d0 = 0; d0 < 4; ++d0) o[d0] = o[d0] * alpha;
            }
            float rs = 0.f;
#pragma unroll
            for (int r = 0; r < 16; ++r) { p0[r] = __builtin_amdgcn_exp2f(p0[r] - m); p1[r] = __builtin_amdgcn_exp2f(p1[r] - m); rs += p0[r] + p1[r]; }
            l += rs;
            bf16x8 pf[4];
#pragma unroll
            for (int s = 0; s < 2; ++s) {
                u32x4 w0, w1;
                w0.x = cvt_pk(p0[8 * s + 0], p0[8 * s + 1]); w0.y = cvt_pk(p0[8 * s + 2], p0[8 * s + 3]); w0.z = cvt_pk(p0[8 * s + 4], p0[8 * s + 5]); w0.w = cvt_pk(p0[8 * s + 6], p0[8 * s + 7]);
                w1.x = cvt_pk(p1[8 * s + 0], p1[8 * s + 1]); w1.y = cvt_pk(p1[8 * s + 2], p1[8 * s + 3]); w1.z = cvt_pk(p1[8 * s + 4], p1[8 * s + 5]); w1.w = cvt_pk(p1[8 * s + 6], p1[8 * s + 7]);
                pf[s] = __builtin_bit_cast(bf16x8, w0); pf[2 + s] = __builtin_bit_cast(bf16x8, w1);
            }
            const DA_LAS unsigned char* Vt = st + 2 * K_BYTES + vfrag;
#pragma unroll
            for (int d0 = 0; d0 < 4; ++d0)
#pragma unroll
                for (int ks = 0; ks < 4; ++ks) {
                    const s16x4 lo = vtr(Vt + (16 * ks) * VSTR + 64 * d0), hi = vtr(Vt + (16 * ks + 8) * VSTR + 64 * d0);
                    const bf16x8 av = (bf16x8){lo[0], lo[1], lo[2], lo[3], hi[0], hi[1], hi[2], hi[3]};
                    o[d0] = __builtin_amdgcn_mfma_f32_32x32x16_bf16(av, pf[ks], o[d0], 0, 0, 0);
                }
            if (t + 1 < SEQ / 64) { *(DA_LAS u32x4*)(nst + kdst) = rk0; *(DA_LAS u32x4*)(nst + K_BYTES + kdst) = rk1; *(DA_LAS u32x4*)(nst + 2 * K_BYTES + vdst0) = rv0; *(DA_LAS u32x4*)(nst + 2 * K_BYTES + vdst1) = rv1; }
            __syncthreads();
        }
        l += __shfl_xor(l, 32);
        const float il = 1.f / l;
        DA_LAS float* xch = (DA_LAS float*)lds + (size_t)qs * 64 * 64 + lane;
        if (comp == 1) {
#pragma unroll
            for (int d0 = 0; d0 < 4; ++d0)
#pragma unroll
                for (int r = 0; r < 16; ++r) xch[(d0 * 16 + r) * 64] = o[d0][r] * il;
        }
        __syncthreads();
        if (comp == 0) {
            float ss = 0.f;
#pragma unroll
            for (int d0 = 0; d0 < 4; ++d0)
#pragma unroll
                for (int r = 0; r < 16; ++r) { const float v = o[d0][r] * il - lam * xch[(d0 * 16 + r) * 64]; o[d0][r] = v; ss += v * v; }
            ss += __shfl_xor(ss, 32);
            const float rn = (1.f - LAMBDA_INIT) / sqrtf(ss * (1.f / 128.f) + RMS_EPS);
            bf16_t* orow = MIX + (size_t)(b * SEQ + qb * 128 + qs * 32 + r32) * DM + 512 + h * 128 + 4 * hh;
#pragma unroll
            for (int d0 = 0; d0 < 4; ++d0)
#pragma unroll
                for (int rq = 0; rq < 4; ++rq) {
                    const f32x4 g4 = *(const f32x4*)(subln_g + 32 * d0 + 8 * rq + 4 * hh);
                    u32x2 w; w.x = cvt_pk(o[d0][4 * rq] * rn * g4[0], o[d0][4 * rq + 1] * rn * g4[1]); w.y = cvt_pk(o[d0][4 * rq + 2] * rn * g4[2], o[d0][4 * rq + 3] * rn * g4[3]);
                    *(u32x2*)(orow + 32 * d0 + 8 * rq) = w;
                }
        }
        __syncthreads();
    }
}
}
namespace hg {
#define HG_LAS __attribute__((address_space(3)))
typedef short bf16x8 __attribute__((ext_vector_type(8)));
typedef short s16x4 __attribute__((ext_vector_type(4)));
typedef float f32x16 __attribute__((ext_vector_type(16)));
typedef float f32x4 __attribute__((ext_vector_type(4)));
typedef unsigned u32x4 __attribute__((ext_vector_type(4)));
typedef unsigned u32x2 __attribute__((ext_vector_type(2)));
typedef float f32x2 __attribute__((ext_vector_type(2)));
constexpr int RSTR = 272, TSTR = 320;
constexpr int L_QIN = 0, L_KIN = L_QIN + 64 * RSTR, L_KINT = L_KIN + 64 * RSTR, L_VT = L_KINT + 64 * TSTR, L_SBT = L_VT + 64 * TSTR, L_DEC = L_SBT + 128 * RSTR, L_SEGT = L_DEC + 512, L_END = L_SEGT + 8 * 128 * 4;
static_assert(L_END <= 131072, "hgrn LDS map");
constexpr float LOG2E = 1.4426950408889634f;
__device__ __forceinline__ unsigned cvt_pk(float lo, float hi) { unsigned r; asm volatile("v_cvt_pk_bf16_f32 %0, %1, %2" : "=v"(r) : "v"(lo), "v"(hi)); return r; }
__device__ __forceinline__ s16x4 vtr(const HG_LAS unsigned char* p) { typedef short v4i16_t __attribute__((ext_vector_type(4)));
    return __builtin_bit_cast(s16x4, __builtin_amdgcn_ds_read_tr16_b64_v4i16((HG_LAS v4i16_t*)p)); }
__device__ __forceinline__ float bflo(unsigned w) { return __builtin_bit_cast(float, w << 16); }
__device__ __forceinline__ float bfhi(unsigned w) { return __builtin_bit_cast(float, w & 0xffff0000u); }

__device__ __forceinline__ void hgrn_phase(HG_LAS unsigned char* lds, const bf16_t* U, const float* LB, float* OSC, int first, int stride) {
    int tid_ = threadIdx.x; asm volatile("" : "+v"(tid_));
    const int tid = tid_, lane = tid & 63, wave = __builtin_amdgcn_readfirstlane(tid >> 6);
    const int r32 = lane & 31, hh = lane >> 5, gi = lane >> 4, li = lane & 15;
    const int vt = wave >> 1, ct = wave & 1, kt = wave >> 1, vpair = wave & 1;
    const int kp = lane, seg = wave;
    const int vrow0 = tid >> 4, vch = tid & 15;
    const int trp = (li >> 2) * TSTR + (16 * (gi & 1) + 4 * (li & 3)) * 2;
    for (int item = first; item < BATCH * 4 * 2; item += stride) {
        const int dir = item & 1, h = (item >> 1) & 3, b = item >> 3;
        const bf16_t* Ub = U + (size_t)b * SEQ * NU;
        const int qcol = U_HQ + h * 128 + 2 * kp, fcol = (dir ? U_HFB : U_HFF) + h * 128 + 2 * kp, vcol = U_HI + h * 128 + vch * 8;
        const float lb0 = LB[dir * 512 + h * 128 + 2 * kp], lb1 = LB[dir * 512 + h * 128 + 2 * kp + 1];
        for (int i = tid; i < 128 * RSTR / 4; i += 512) ((HG_LAS unsigned*)(lds + L_SBT))[i] = 0u;
        f32x16 S[2];
#pragma unroll
        for (int r = 0; r < 16; ++r) { S[0][r] = 0.f; S[1][r] = 0.f; }
        unsigned rq[8], rf[8]; u32x4 rv0, rv1;
#define HG_TIME(p) (dir ? (SEQ - 1 - (p)) : (p))
#define HG_LOAD(n) do { _Pragma("unroll") for (int i = 0; i < 8; ++i) { const bf16_t* rp = Ub + (size_t)HG_TIME(64 * (n) + 8 * seg + i) * NU; rq[i] = *(const unsigned*)(rp + qcol); rf[i] = *(const unsigned*)(rp + fcol); } \
        rv0 = *(const u32x4*)(Ub + (size_t)HG_TIME(64 * (n) + vrow0) * NU + vcol); rv1 = *(const u32x4*)(Ub + (size_t)HG_TIME(64 * (n) + vrow0 + 32) * NU + vcol); } while (0)
        HG_LOAD(0);
        __syncthreads();
        for (int n = 0; n < SEQ / 64; ++n) {
            float c0[8], c1[8], k0[8], k1[8]; float a0 = 0.f, a1 = 0.f;
#pragma unroll
            for (int i = 0; i < 8; ++i) {
                const float u0 = bflo(rf[i]), u1 = bfhi(rf[i]);
                const float f0 = lb0 + (1.f - lb0) * __builtin_amdgcn_rcpf(1.f + __builtin_amdgcn_exp2f(-LOG2E * u0));
                const float f1 = lb1 + (1.f - lb1) * __builtin_amdgcn_rcpf(1.f + __builtin_amdgcn_exp2f(-LOG2E * u1));
                k0[i] = 1.f - f0; k1[i] = 1.f - f1;
                a0 += __builtin_amdgcn_logf(f0); a1 += __builtin_amdgcn_logf(f1);
                c0[i] = a0; c1[i] = a1;
            }
            *(HG_LAS f32x2*)(lds + L_SEGT + (seg * 128 + 2 * kp) * 4) = (f32x2){a0, a1};
            __syncthreads();
            float off0 = 0.f, off1 = 0.f, tot0 = 0.f, tot1 = 0.f;
#pragma unroll
            for (int s2 = 0; s2 < 8; ++s2) { const f32x2 tq = *(const HG_LAS f32x2*)(lds + L_SEGT + (s2 * 128 + 2 * kp) * 4); if (s2 < seg) { off0 += tq.x; off1 += tq.y; } tot0 += tq.x; tot1 += tq.y; }
            if (seg == 0) *(HG_LAS f32x2*)(lds + L_DEC + 2 * kp * 4) = (f32x2){__builtin_amdgcn_exp2f(tot0), __builtin_amdgcn_exp2f(tot1)};
#pragma unroll
            for (int i = 0; i < 8; ++i) {
                const int c = 8 * seg + i; const float b0 = off0 + c0[i], b1 = off1 + c1[i];
                const unsigned qi = cvt_pk(bflo(rq[i]) * __builtin_amdgcn_exp2f(b0), bfhi(rq[i]) * __builtin_amdgcn_exp2f(b1));
                const unsigned ki = cvt_pk(k0[i] * __builtin_amdgcn_exp2f(-b0), k1[i] * __builtin_amdgcn_exp2f(-b1));
                *(HG_LAS unsigned*)(lds + L_QIN + c * RSTR + 4 * kp) = qi;
                *(HG_LAS unsigned*)(lds + L_KIN + c * RSTR + 4 * kp) = ki;
                *(HG_LAS unsigned*)(lds + L_KINT + c * TSTR + 4 * kp) = ki;
            }
            *(HG_LAS u32x4*)(lds + L_VT + vrow0 * TSTR + vch * 16) = rv0; *(HG_LAS u32x4*)(lds + L_VT + (vrow0 + 32) * TSTR + vch * 16) = rv1;
            if (n + 1 < SEQ / 64) HG_LOAD(n + 1);
            __syncthreads();
            bf16x8 qfr[8];
#pragma unroll
            for (int ks = 0; ks < 8; ++ks) qfr[ks] = *(const HG_LAS bf16x8*)(lds + L_QIN + (32 * ct + r32) * RSTR + ks * 32 + hh * 16);
            f32x16 o;
#pragma unroll
            for (int r = 0; r < 16; ++r) o[r] = 0.f;
#pragma unroll
            for (int ks = 0; ks < 8; ++ks) {
                const bf16x8 as = *(const HG_LAS bf16x8*)(lds + L_SBT + (32 * vt + r32) * RSTR + ks * 32 + hh * 16);
                o = __builtin_amdgcn_mfma_f32_32x32x16_bf16(as, qfr[ks], o, 0, 0, 0);
            }
#pragma unroll
            for (int st = 0; st < 2; ++st) {
                if (st <= ct) {
                    f32x16 at;
#pragma unroll
                    for (int r = 0; r < 16; ++r) at[r] = 0.f;
#pragma unroll
                    for (int ks = 0; ks < 8; ++ks) {
                        const bf16x8 ak = *(const HG_LAS bf16x8*)(lds + L_KIN + (32 * st + r32) * RSTR + ks * 32 + hh * 16);
                        at = __builtin_amdgcn_mfma_f32_32x32x16_bf16(ak, qfr[ks], at, 0, 0, 0);
                    }
                    if (st == ct) {
#pragma unroll
                        for (int r = 0; r < 16; ++r) { const int srow = (r & 3) + 8 * (r >> 2) + 4 * hh; at[r] = (srow <= r32) ? at[r] : 0.f; }
                    }
#pragma unroll
                    for (int s2 = 0; s2 < 2; ++s2) {
                        u32x4 w; w.x = cvt_pk(at[8 * s2 + 0], at[8 * s2 + 1]); w.y = cvt_pk(at[8 * s2 + 2], at[8 * s2 + 3]); w.z = cvt_pk(at[8 * s2 + 4], at[8 * s2 + 5]); w.w = cvt_pk(at[8 * s2 + 6], at[8 * s2 + 7]);
                        const HG_LAS unsigned char* vp = lds + L_VT + (32 * st + 16 * s2 + 4 * hh) * TSTR + 64 * vt + trp;
                        const s16x4 lo = vtr(vp), hi = vtr(vp + 8 * TSTR);
                        const bf16x8 av = (bf16x8){lo[0], lo[1], lo[2], lo[3], hi[0], hi[1], hi[2], hi[3]};
                        o = __builtin_amdgcn_mfma_f32_32x32x16_bf16(av, __builtin_bit_cast(bf16x8, w), o, 0, 0, 0);
                    }
                }
            }
#pragma unroll
            for (int cs = 0; cs < 4; ++cs) {
                const HG_LAS unsigned char* kp_ = lds + L_KINT + (16 * cs + 8 * hh) * TSTR + 64 * kt + trp;
                const s16x4 klo = vtr(kp_), khi = vtr(kp_ + 4 * TSTR);
                const bf16x8 ak = (bf16x8){klo[0], klo[1], klo[2], klo[3], khi[0], khi[1], khi[2], khi[3]};
#pragma unroll
                for (int vv = 0; vv < 2; ++vv) {
                    const HG_LAS unsigned char* vp = lds + L_VT + (16 * cs + 8 * hh) * TSTR + 64 * (2 * vpair + vv) + trp;
                    const s16x4 vlo = vtr(vp), vhi = vtr(vp + 4 * TSTR);
                    const bf16x8 bv = (bf16x8){vlo[0], vlo[1], vlo[2], vlo[3], vhi[0], vhi[1], vhi[2], vhi[3]};
                    S[vv] = __builtin_amdgcn_mfma_f32_32x32x16_bf16(ak, bv, S[vv], 0, 0, 0);
                }
            }
#pragma unroll
            for (int rq4 = 0; rq4 < 4; ++rq4) {
                const f32x4 d4 = *(const HG_LAS f32x4*)(lds + L_DEC + (32 * kt + 8 * rq4 + 4 * hh) * 4);
#pragma unroll
                for (int j = 0; j < 4; ++j) { S[0][4 * rq4 + j] *= d4[j]; S[1][4 * rq4 + j] *= d4[j]; }
            }
            __syncthreads();
#pragma unroll
            for (int vv = 0; vv < 2; ++vv)
#pragma unroll
                for (int rq4 = 0; rq4 < 4; ++rq4) {
                    u32x2 w; w.x = cvt_pk(S[vv][4 * rq4], S[vv][4 * rq4 + 1]); w.y = cvt_pk(S[vv][4 * rq4 + 2], S[vv][4 * rq4 + 3]);
                    *(HG_LAS u32x2*)(lds + L_SBT + (32 * (2 * vpair + vv) + r32) * RSTR + (32 * kt + 8 * rq4 + 4 * hh) * 2) = w;
                }
            {
                const int tok = HG_TIME(64 * n + 32 * ct + r32);
                float* op = OSC + ((size_t)dir * NTOK + (size_t)b * SEQ + tok) * 512 + h * 128 + 32 * vt + 4 * hh;
#pragma unroll
                for (int rq4 = 0; rq4 < 4; ++rq4) *(f32x4*)(op + 8 * rq4) = (f32x4){o[4 * rq4], o[4 * rq4 + 1], o[4 * rq4 + 2], o[4 * rq4 + 3]};
            }
        }
        __syncthreads();
#undef HG_LOAD
#undef HG_TIME
    }
}
}
namespace xa {
#define XA_LAS __attribute__((address_space(3)))
typedef short bf16x8 __attribute__((ext_vector_type(8)));
typedef short s16x4 __attribute__((ext_vector_type(4)));
typedef float f32x16 __attribute__((ext_vector_type(16)));
typedef unsigned u32x4 __attribute__((ext_vector_type(4)));
typedef unsigned u32x2 __attribute__((ext_vector_type(2)));
constexpr int KSTR = 528, VSTR = 576;
constexpr int K_BYTES = 64 * KSTR, V_BYTES = 64 * VSTR;
constexpr float THR = 4.0f;
__device__ __forceinline__ unsigned cvt_pk(float lo, float hi) { unsigned r; asm volatile("v_cvt_pk_bf16_f32 %0, %1, %2" : "=v"(r) : "v"(lo), "v"(hi)); return r; }
__device__ __forceinline__ s16x4 vtr(const XA_LAS unsigned char* p) { typedef short v4i16_t __attribute__((ext_vector_type(4)));
    return __builtin_bit_cast(s16x4, __builtin_amdgcn_ds_read_tr16_b64_v4i16((XA_LAS v4i16_t*)p)); }

__device__ __forceinline__ void xattn_phase(XA_LAS unsigned char* lds, const bf16_t* Q, bf16_t* O, const bf16_t* KV, int vcu, int G) {
    int tid_ = threadIdx.x; asm volatile("" : "+v"(tid_));
    const int tid = tid_, lane = tid & 63, wave = __builtin_amdgcn_readfirstlane(tid >> 6), qs = wave >> 2, dq = wave & 3;
    const int r32 = lane & 31, hh = lane >> 5, gi = lane >> 4, li = lane & 15;
    const int srow = tid >> 5, sch = tid & 31;
    const int kfrag = r32 * KSTR + hh * 16;
    const int vfrag = (4 * hh + (li >> 2)) * VSTR + (16 * (gi & 1) + 4 * (li & 3)) * 2 + 128 * dq;
    for (int u = vcu; u < BATCH * 4 * 32; u += G) {
        const int qb = u & 31, h = (u >> 5) & 3, b = u >> 7;
        const bf16_t* ksrc = KV + (size_t)(b * MEML + srow) * 2048 + h * 256 + sch * 8;
        const bf16_t* vsrc = ksrc + 1024;
        const size_t roff = (size_t)(b * SEQ + qb * 64 + qs * 32 + r32) * DM + h * 256;
        const bf16_t* qrow = Q + roff;
        bf16x8 qf[16];
#pragma unroll
        for (int ds = 0; ds < 16; ++ds) qf[ds] = *(const bf16x8*)(qrow + ds * 16 + hh * 8);
        f32x16 o[2];
#pragma unroll
        for (int r = 0; r < 16; ++r) { o[0][r] = 0.f; o[1][r] = 0.f; }
        float m = -INFINITY, l = 0.f;
        u32x4 rk[4], rv[4];
#pragma unroll
        for (int i = 0; i < 4; ++i) { rk[i] = *(const u32x4*)(ksrc + (size_t)(16 * i) * 2048); rv[i] = *(const u32x4*)(vsrc + (size_t)(16 * i) * 2048); }
        for (int t = 0; t < MEML / 64; ++t) {
#pragma unroll
            for (int i = 0; i < 4; ++i) { *(XA_LAS u32x4*)(lds + (srow + 16 * i) * KSTR + sch * 16) = rk[i]; *(XA_LAS u32x4*)(lds + K_BYTES + (srow + 16 * i) * VSTR + sch * 16) = rv[i]; }
            if (t + 1 < MEML / 64) {
#pragma unroll
                for (int i = 0; i < 4; ++i) { rk[i] = *(const u32x4*)(ksrc + (size_t)(64 * (t + 1) + 16 * i) * 2048); rv[i] = *(const u32x4*)(vsrc + (size_t)(64 * (t + 1) + 16 * i) * 2048); }
            }
            __syncthreads();
            const XA_LAS unsigned char* Kt = lds + kfrag;
            f32x16 p0, p1;
#pragma unroll
            for (int r = 0; r < 16; ++r) { p0[r] = 0.f; p1[r] = 0.f; }
#pragma unroll
            for (int ds = 0; ds < 16; ++ds) {
                const bf16x8 a0 = *(const XA_LAS bf16x8*)(Kt + ds * 32), a1 = *(const XA_LAS bf16x8*)(Kt + 32 * KSTR + ds * 32);
                p0 = __builtin_amdgcn_mfma_f32_32x32x16_bf16(a0, qf[ds], p0, 0, 0, 0);
                p1 = __builtin_amdgcn_mfma_f32_32x32x16_bf16(a1, qf[ds], p1, 0, 0, 0);
                if ((ds & 3) == 3) __builtin_amdgcn_sched_barrier(0);
            }
            float mx = fmaxf(p0[0], p1[0]);
#pragma unroll
            for (int r = 1; r < 16; ++r) mx = fmaxf(mx, fmaxf(p0[r], p1[r]));
            mx = fmaxf(mx, __shfl_xor(mx, 32));
            if (!__all(mx - m <= THR)) {
                const float mn = fmaxf(m, mx), alpha = __builtin_amdgcn_exp2f(m - mn);
                m = mn; l *= alpha; o[0] = o[0] * alpha; o[1] = o[1] * alpha;
            }
            float rs = 0.f;
#pragma unroll
            for (int r = 0; r < 16; ++r) { p0[r] = __builtin_amdgcn_exp2f(p0[r] - m); p1[r] = __builtin_amdgcn_exp2f(p1[r] - m); rs += p0[r] + p1[r]; }
            l += rs;
            bf16x8 pf[4];
#pragma unroll
            for (int s = 0; s < 2; ++s) {
                u32x4 w0, w1;
                w0.x = cvt_pk(p0[8 * s + 0], p0[8 * s + 1]); w0.y = cvt_pk(p0[8 * s + 2], p0[8 * s + 3]); w0.z = cvt_pk(p0[8 * s + 4], p0[8 * s + 5]); w0.w = cvt_pk(p0[8 * s + 6], p0[8 * s + 7]);
                w1.x = cvt_pk(p1[8 * s + 0], p1[8 * s + 1]); w1.y = cvt_pk(p1[8 * s + 2], p1[8 * s + 3]); w1.z = cvt_pk(p1[8 * s + 4], p1[8 * s + 5]); w1.w = cvt_pk(p1[8 * s + 6], p1[8 * s + 7]);
                pf[s] = __builtin_bit_cast(bf16x8, w0); pf[2 + s] = __builtin_bit_cast(bf16x8, w1);
            }
            const XA_LAS unsigned char* Vt = lds + K_BYTES + vfrag;
#pragma unroll
            for (int d0 = 0; d0 < 2; ++d0)
#pragma unroll
                for (int ks = 0; ks < 4; ++ks) {
                    const s16x4 lo = vtr(Vt + (16 * ks) * VSTR + 64 * d0), hi = vtr(Vt + (16 * ks + 8) * VSTR + 64 * d0);
                    const bf16x8 av = (bf16x8){lo[0], lo[1], lo[2], lo[3], hi[0], hi[1], hi[2], hi[3]};
                    o[d0] = __builtin_amdgcn_mfma_f32_32x32x16_bf16(av, pf[ks], o[d0], 0, 0, 0);
                }
            __syncthreads();
        }
        l += __shfl_xor(l, 32);
        const float il = 1.f / l;
        bf16_t* orow = O + roff + 64 * dq + 4 * hh;
#pragma unroll
        for (int d0 = 0; d0 < 2; ++d0)
#pragma unroll
            for (int rq = 0; rq < 4; ++rq) {
                u32x2 w; w.x = cvt_pk(o[d0][4 * rq] * il, o[d0][4 * rq + 1] * il); w.y = cvt_pk(o[d0][4 * rq + 2] * il, o[d0][4 * rq + 3] * il);
                *(u32x2*)(orow + 32 * d0 + 8 * rq) = w;
            }
    }
}
}
namespace cg = cooperative_groups;
#ifndef PROBE_PHASE
#define PROBE_PHASE -1
#endif
#define REPEAT(k) for (int _rep = 0; _rep < ((k) == PROBE_PHASE ? 3 : 1); ++_rep)
#ifndef USE_GRID_SYNC_FIRST
#define USE_GRID_SYNC_FIRST 0
#endif
constexpr int NWAVES = 8;
constexpr int LDS_BYTES = 147456;
enum { PH_PROLOGUE = 0, PH_INPROJ, PH_MIXER, PH_HGRN_COMB, PH_MIXGEMM, PH_LN1, PH_QPROJ, PH_XATTN, PH_WOGEMM, PH_LN2, PH_TOPK, PH_MOE1, PH_MOE2, PH_FINAL, PH_COUNT };
constexpr int CW_QUEUE = 0;
constexpr int CW_HGDONE = 64;
constexpr int CW_TMO = 3000;
constexpr int CW_BAR = 4096;
struct MKArgs { const float* in[27]; float* out; unsigned char* ws; int ph_lo, ph_hi; };
struct OneUnit { int pm, pn; __device__ bool next(int i, pg8::Unit& u) const { if (i) return false; u.pm = pm; u.pn = pn; return true; }
    __device__ __forceinline__ void a_ready(const pg8::Unit&) const {} __device__ __forceinline__ void done(const pg8::Unit&) const {} };

__global__ void __launch_bounds__(NWAVES * 64, 2) mk_fwd(MKArgs a) {
    extern __shared__ __attribute__((aligned(16))) unsigned char lds_raw[];
    PG8_LAS unsigned char* lds = (PG8_LAS unsigned char*)lds_raw;
    float* smem = (float*)lds_raw;
    unsigned char* ws = a.ws;
    const int G = gridDim.x, bx = blockIdx.x;
    const int vcu = (G % 8 == 0) ? (bx % 8) * (G / 8) + bx / 8 : bx;
    const int lo = a.ph_lo, hi = a.ph_hi;
#define IN(k) (lo <= (k) && (k) < hi)
#define SEAM(k) do { if (IN(k) && IN((k) + 1)) { if (USE_GRID_SYNC_FIRST && (k) == PH_PROLOGUE) cg::this_grid().sync(); else xcd_barrier(bar); } } while (0)
    float* H = a.out;
    for (int u = threadIdx.x; u < (LDS_BYTES - 131072) / 4; u += NWAVES * 64) ((PG8_LAS unsigned*)(lds + 131072))[u] = 0u;
    __syncthreads();
    XcdBarrier bar; bar.bar = (unsigned*)(ws + WS_CTL) + CW_BAR; bar.x = 0; bar.st = nullptr;
    if (hi - lo > 1) bar = xcd_barrier_post((unsigned*)(ws + WS_CTL) + CW_BAR, (volatile LAS unsigned*)(lds + 131072 + 320) + 8);
    float* ROPE = (float*)(ws + WS_ROPE); float* LB = (float*)(ws + WS_LB); float* LAM = LB + 1024;
    float* AFF = (float*)(ws + WS_AFF); int* INV = (int*)(ws + WS_INV); int* IDX = (int*)(ws + WS_IDX); float* GATE = (float*)(ws + WS_GATE);
    bf16_t* XN = (bf16_t*)(ws + WS_XN); bf16_t* MIX = (bf16_t*)(ws + WS_MIX); bf16_t* U = (bf16_t*)(ws + WS_U); bf16_t* XS = (bf16_t*)(ws + WS_XS);
    bf16_t* KV = (bf16_t*)(ws + WS_KV); bf16_t* MEMB = (bf16_t*)(ws + WS_MEMB);
    float* SC_XS = (float*)(ws + WS_XS);

    if (IN(PH_PROLOGUE)) REPEAT(PH_PROLOGUE) {
        sp_prep_small(a.in[5], a.in[7], a.in[8], a.in[9], a.in[10], ROPE, LB);
        tp_all(smem, a.in, ws, vcu, G);
        sp_cvt_bf16(a.in[1], MEMB, (long)NMEM * DM);
        sp_ln_rows<0>(a.in[0], a.in[2], a.in[3], H, XN, nullptr, nullptr);
    }
    SEAM(PH_PROLOGUE);
    if (IN(PH_INPROJ)) REPEAT(PH_INPROJ) {
        pg8::Gemm g{XN, (const bf16_t*)(ws + WS_WIN), NTOK, NU, DM}; pg8::StaticOrder S; S.init(NTOK, NU, G, bx);
        pg8::EpiStore E{U, NU, 1.f, 1, ROPE};
        pg8::gemm_phase<pg8::EpiStore, pg8::StaticOrder, true, true>(lds, g, S, E);
    }
    SEAM(PH_INPROJ);
    if (IN(PH_MIXER)) {
        unsigned* ctl = (unsigned*)(ws + WS_CTL);
        unsigned* qhead = ctl + CW_QUEUE;
        volatile PG8_LAS unsigned* qslot = (volatile PG8_LAS unsigned*)(lds + 131072 + 64);
        for (;;) {
            if (threadIdx.x == 0) qslot[0] = __hip_atomic_fetch_add(qhead, 1u, __ATOMIC_RELAXED, __HIP_MEMORY_SCOPE_AGENT);
            __syncthreads();
            const int item = (int)qslot[0];
            __syncthreads();
            if (item >= 640) break;
            if (item < 64) hg::hgrn_phase(lds, U, LB, SC_XS, item, 1 << 20);
            else if (item < 128) {
                pg8::Gemm g{MEMB, (const bf16_t*)(ws + WS_WKV), NMEM, 2048, DM}; OneUnit S{(item - 64) >> 3, (item - 64) & 7};
                pg8::EpiStore E{KV, 2048, 1.f, 0, nullptr};
                pg8::gemm_phase<pg8::EpiStore, OneUnit, true, true>(lds, g, S, E);
            } else da::dattn_phase(lds, U, LAM, a.in[11], MIX, item - 128, 1 << 20);
        }
    }
    SEAM(PH_MIXER);
    if (IN(PH_HGRN_COMB)) REPEAT(PH_HGRN_COMB) sp_hgrn_combine(SC_XS, U, a.in[6], MIX);
    SEAM(PH_HGRN_COMB);
    if (IN(PH_MIXGEMM)) {
        pg8::Gemm g{MIX, (const bf16_t*)(ws + WS_WMIX), NTOK, DM, DM}; pg8::StaticOrder S; S.init(NTOK, DM, G, bx);
        pg8::EpiResid E{H, ALPHA};
        pg8::gemm_phase<pg8::EpiResid, pg8::StaticOrder, true, true>(lds, g, S, E);
    }
    SEAM(PH_MIXGEMM);
    if (IN(PH_LN1)) sp_ln_rows<1>(nullptr, a.in[13], a.in[14], H, XN, nullptr, nullptr);
    SEAM(PH_LN1);
    if (IN(PH_QPROJ)) REPEAT(PH_QPROJ) {
        pg8::Gemm g{XN, (const bf16_t*)(ws + WS_WQ), NTOK, DM, DM}; pg8::StaticOrder S; S.init(NTOK, DM, G, bx);
        pg8::EpiStore E{MIX, DM, pg8::QSCALE_XA, 0, nullptr};
        pg8::gemm_phase<pg8::EpiStore, pg8::StaticOrder, true, true>(lds, g, S, E);
    }
    SEAM(PH_QPROJ);
    if (IN(PH_XATTN)) REPEAT(PH_XATTN) xa::xattn_phase(lds, MIX, XN, KV, vcu, G);
    SEAM(PH_XATTN);
    if (IN(PH_WOGEMM)) {
        pg8::Gemm g{XN, (const bf16_t*)(ws + WS_WO), NTOK, DM, DM}; pg8::StaticOrder S; S.init(NTOK, DM, G, bx);
        pg8::EpiResid E{H, ALPHA};
        pg8::gemm_phase<pg8::EpiResid, pg8::StaticOrder, true, true>(lds, g, S, E);
    }
    SEAM(PH_WOGEMM);
    if (IN(PH_LN2)) sp_ln_rows<2>(nullptr, a.in[19], a.in[20], H, XN, a.in[21], AFF);
    SEAM(PH_LN2);
    if (IN(PH_TOPK)) REPEAT(PH_TOPK) sp_topk2(smem, AFF, XN, IDX, GATE, INV, XS);
    SEAM(PH_TOPK);
    if (IN(PH_MOE1)) REPEAT(PH_MOE1) {
        pg8::Gemm g{XS, (const bf16_t*)(ws + WS_WGU), NGRP * CAP, NEXP * 4096, DM}; pg8::MoeOrder<1> S{G, bx};
        pg8::EpiSwiglu E{U};
        pg8::gemm_phase<pg8::EpiSwiglu, pg8::MoeOrder<1>, true, true>(lds, g, S, E);
    }
    SEAM(PH_MOE1);
    if (IN(PH_MOE2)) REPEAT(PH_MOE2) {
        pg8::Gemm g{U, (const bf16_t*)(ws + WS_WD), NGRP * CAP, NEXP * DM, DFF}; pg8::MoeOrder<2> S{G, bx};
        pg8::EpiYGate E{XS, GATE};
        pg8::gemm_phase<pg8::EpiYGate, pg8::MoeOrder<2>, true, true>(lds, g, S, E);
    }
    SEAM(PH_MOE2);
    if (IN(PH_FINAL)) sp_final(H, XS, INV, a.in[25], a.in[26]);
#undef IN
#undef SEAM
}

extern "C" void kernel_launch(void* const* d_in, const int* in_sizes, int n_in, void* d_out, int out_size, void* d_ws, size_t ws_size, hipStream_t stream) {
    if (n_in != 27 || out_size != NTOK * DM || ws_size < WS_END) { fprintf(stderr, "kernel_launch: unexpected shapes (n_in %d out %d ws %zu)\n", n_in, out_size, ws_size); return; }
    static int grid = 0;
    if (grid == 0) {
        int dev = 0, cus = 0, per_cu = 0;
        (void)hipGetDevice(&dev); (void)hipDeviceGetAttribute(&cus, hipDeviceAttributeMultiprocessorCount, dev);
        (void)hipFuncSetAttribute((const void*)mk_fwd, hipFuncAttributeMaxDynamicSharedMemorySize, LDS_BYTES);
        (void)hipOccupancyMaxActiveBlocksPerMultiprocessor(&per_cu, (const void*)mk_fwd, NWAVES * 64, LDS_BYTES);
        (void)hipGetLastError();
        if (per_cu < 1) { fprintf(stderr, "kernel_launch: occupancy query says %d blocks/CU\n", per_cu); per_cu = 1; }
        grid = cus;
    }
    MKArgs ka{};
    for (int i = 0; i < 27; ++i) ka.in[i] = (const float*)d_in[i];
    ka.out = (float*)d_out; ka.ws = (unsigned char*)d_ws;
    ka.ph_lo = 0; ka.ph_hi = PH_COUNT;
    (void)hipMemsetAsync((char*)d_ws + WS_CTL, 0, 65536, stream);
    void* args[] = {&ka};
    hipError_t e = hipLaunchCooperativeKernel((const void*)mk_fwd, dim3(grid), dim3(NWAVES * 64), args, LDS_BYTES, stream);
    if (e != hipSuccess) fprintf(stderr, "kernel_launch: cooperative launch failed: %s (grid %d)\n", hipGetErrorString(e), grid);
}
```
